# Optimizing an MI355X kernel written in HIP

```python
import math
import jax, jax.numpy as jnp
from jax import lax
import numpy as np

D_MODEL = 1024
BATCH = 32
SEQ = 256
DEPTH = 2
DEC_BATCH = 2
DEC_SEQ = 1024
PAST_LEN = 256

GRID_W = 64
N_EVEN = (DEPTH + 1) // 2
N_ODD = DEPTH // 2
A_WIDTH = D_MODEL // 2
A_HEADS = 4
A_HEAD_DIM = A_WIDTH // A_HEADS
A_HALF = A_HEAD_DIM // 2
B_WIDTH = D_MODEL - A_WIDTH
B_HEAD = 64
B_HEADS = B_WIDTH // B_HEAD
LORA_W = 64
LORA_A = 64
LORA_G = 128
IN_B = 3 * B_WIDTH + 2 * LORA_W + 2 * LORA_A + LORA_G
IN_EVEN = 3 * A_WIDTH + IN_B
C_GROUPS = 8
C_GROUP_DIM = D_MODEL // C_GROUPS
D_FF = 2816
ROPE_BASE = 10000.0
Q_BLOCK = 128
RMS_EPS = 1e-6
LNX_EPS = 64e-5

kernel_name = "hybrid_diffattn_rwkv7_fnet_prefix_step"


def rmsnorm(x, g):
    xf = x.astype(jnp.float32)
    y = xf * lax.rsqrt(jnp.mean(xf * xf, axis=-1, keepdims=True) + RMS_EPS)
    return y.astype(x.dtype) * g


def axial_rope_tables(rows):
    row = jnp.repeat(jnp.arange(rows, dtype=jnp.float32), GRID_W)
    col = jnp.tile(jnp.arange(GRID_W, dtype=jnp.float32), rows)
    n_freq = A_HALF // 4
    inv = ROPE_BASE ** (-jnp.arange(n_freq, dtype=jnp.float32) / n_freq)
    ang = jnp.concatenate([row[:, None] * inv, col[:, None] * inv], axis=-1)
    return jnp.cos(ang), jnp.sin(ang)


def apply_rope(x, cos, sin):
    xf = x.astype(jnp.float32)
    x1, x2 = xf[..., 0::2], xf[..., 1::2]
    c = cos[:, None, None, :]
    s = sin[:, None, None, :]
    out = jnp.stack([x1 * c - x2 * s, x1 * s + x2 * c], axis=-1).reshape(x.shape)
    return out.astype(x.dtype)


def diff_attention(q, k, v, lam):
    b, lq = q.shape[0], q.shape[1]
    nblk = lq // Q_BLOCK
    qb = q.reshape(b, nblk, Q_BLOCK, A_HEADS, 2, A_HALF).transpose(1, 0, 2, 3, 4, 5)
    scale = A_HALF ** -0.5

    def one_block(qblk):
        s = jnp.einsum("bqhmd,bkhmd->bmhqk", qblk, k).astype(jnp.float32) * scale
        p = jax.nn.softmax(s, axis=-1)
        w = p[:, 0] - lam * p[:, 1]
        return jnp.einsum("bhqk,bkhd->bqhd", w.astype(v.dtype), v)

    out = lax.map(one_block, qb)
    return out.transpose(1, 0, 2, 3, 4).reshape(b, lq, A_HEADS, A_HEAD_DIM)


def token_shift_centred(f, mu):
    prev = jnp.pad(f, ((0, 0), (1, 0), (0, 0)))[:, :-1]
    nxt = jnp.pad(f, ((0, 0), (0, 1), (0, 0)))[:, 1:]
    return f + mu[0] * (prev - f) + mu[1] * (nxt - f)


def wkv_scan(state0, r, w, k, v, kk, a):
    def step(S, inp):
        r_t, w_t, k_t, v_t, kk_t, a_t = inp
        sa = jnp.einsum("bhij,bhj->bhi", S, -kk_t)
        S = (S * w_t[:, :, None, :] + sa[..., None] * (kk_t * a_t)[:, :, None, :]
             + v_t[..., None] * k_t[:, :, None, :])
        return S, jnp.einsum("bhij,bhj->bhi", S, r_t)

    xs = tuple(jnp.moveaxis(t, 1, 0) for t in (r, w, k, v, kk, a))
    S, y = lax.scan(step, state0.astype(jnp.float32), xs)
    return S, jnp.moveaxis(y, 0, 1)


def rwkv7_bidir(fb, s0, e, P):
    b, L, _ = fb.shape
    fb = token_shift_centred(fb, P["rwkv_shift_mu"][e])
    r = fb[..., :B_WIDTH]
    k = fb[..., B_WIDTH:2 * B_WIDTH]
    v = fb[..., 2 * B_WIDTH:3 * B_WIDTH]
    off = 3 * B_WIDTH
    wd = fb[..., off:off + 2 * LORA_W].reshape(b, L, 2, LORA_W)
    off = off + 2 * LORA_W
    ad = fb[..., off:off + 2 * LORA_A].reshape(b, L, 2, LORA_A)
    off = off + 2 * LORA_A
    gd = fb[..., off:]
    g = jax.nn.sigmoid(gd) @ P["rwkv_g2"][e]
    kvec = P["rwkv_kvec"][e]

    def heads(t):
        return t.reshape(b, L, B_HEADS, B_HEAD).astype(jnp.float32)

    rh, vh = heads(r), heads(v)
    kk = heads(k * kvec[0])
    kk = kk * lax.rsqrt(jnp.sum(kk * kk, axis=-1, keepdims=True) + 1e-12)
    r_k = kvec[2].reshape(B_HEADS, B_HEAD).astype(jnp.float32)
    ys = 0.0
    bonus = 0.0
    finals = []
    for d in range(2):
        w_raw = (P["rwkv_w0"][e, d] + jnp.tanh(wd[:, :, d]) @ P["rwkv_w2"][e, d]).astype(jnp.float32)
        decay = jnp.exp(-jnp.exp(-jax.nn.softplus(-w_raw) - 0.5))
        a = jax.nn.sigmoid(P["rwkv_a0"][e, d] + ad[:, :, d] @ P["rwkv_a2"][e, d])
        kd = k * (1 + (a - 1) * kvec[1])
        ah, kdh, wh = heads(a), heads(kd), heads(decay)
        inputs = (rh, wh, kdh, vh, kk, ah)
        if d == 1:
            inputs = tuple(jnp.flip(t, axis=1) for t in inputs)
        S, y = wkv_scan(s0[:, d], *inputs)
        if d == 1:
            y = jnp.flip(y, axis=1)
        ys = ys + y
        bonus = bonus + jnp.sum(rh * kdh * r_k, axis=-1, keepdims=True) * vh
        finals.append(S)
    mu = jnp.mean(ys, axis=-1, keepdims=True)
    var = jnp.mean((ys - mu) ** 2, axis=-1, keepdims=True)
    yn = ((ys - mu) * lax.rsqrt(var + LNX_EPS)).reshape(b, L, B_WIDTH)
    lnx = P["rwkv_lnx"][e]
    y = (yn * lnx[0] + lnx[1] + bonus.reshape(b, L, B_WIDTH)).astype(fb.dtype) * g
    return y, jnp.stack(finals, axis=1).astype(fb.dtype)


def fourier_mix(h, w_out):
    b, L, _ = h.shape
    hg = h.reshape(b, L, C_GROUPS, C_GROUP_DIM).astype(jnp.float32)
    f = jnp.fft.fft2(hg, axes=(1, 3), norm="ortho").real
    return f.reshape(b, L, D_MODEL).astype(h.dtype) @ w_out


def conv_ffn(h, w_in, conv_w, conv_b, w_out):
    L = h.shape[1]
    ug = h @ w_in
    u, g = ug[..., :D_FF], ug[..., D_FF:]
    gp = jnp.pad(g, ((0, 0), (1, 1), (0, 0)))
    g = gp[:, :L] * conv_w[0] + gp[:, 1:L + 1] * conv_w[1] + gp[:, 2:] * conv_w[2] + conv_b
    return (jax.nn.silu(g) * u) @ w_out


def even_mixer(h, l, rope, ctx, P):
    e = l // 2
    b, L, _ = h.shape
    proj = h @ P["w_in_even"][e]
    q = proj[..., :A_WIDTH].reshape(b, L, A_HEADS, 2, A_HALF)
    k = proj[..., A_WIDTH:2 * A_WIDTH].reshape(b, L, A_HEADS, 2, A_HALF)
    v = proj[..., 2 * A_WIDTH:3 * A_WIDTH].reshape(b, L, A_HEADS, A_HEAD_DIM)
    fb = proj[..., 3 * A_WIDTH:]
    if ctx is None:
        keys, vals = k, v
        s0 = jnp.zeros((b, 2, B_HEADS, B_HEAD, B_HEAD), jnp.float32)
    else:
        ck, cv, cs = ctx
        cos, sin = rope
        q = apply_rope(q, cos, sin)
        k_lat = apply_rope(k, cos, sin)
        keys = jnp.concatenate([ck.reshape(b, -1, A_HEADS, 2, A_HALF), k_lat], axis=1)
        vals = jnp.concatenate([cv, v], axis=1)
        s0 = cs
    lp = P["diff_lambda"][e].astype(jnp.float32)
    lam_init = 0.8 - 0.6 * math.exp(-0.3 * l)
    lam = jnp.exp(jnp.sum(lp[0] * lp[1])) - jnp.exp(jnp.sum(lp[2] * lp[3])) + lam_init
    ya = diff_attention(q, keys, vals, lam)
    ya = rmsnorm(ya, P["diff_subln"][e]) * (1.0 - lam_init)
    yb, s_final = rwkv7_bidir(fb, s0, e, P)
    m = jnp.concatenate([ya.reshape(b, L, A_WIDTH), yb], axis=-1) @ P["w_out_even"][e]
    new_ctx = (k.reshape(b, L, A_HEADS, A_HEAD_DIM), v, s_final) if ctx is None else None
    return m, new_ctx


def trunk_layer(l, x, mod, rope, ctx, P):
    shift_m, scale_m, gate_m, shift_f, scale_f, gate_f = jnp.split(mod, 6, axis=-1)
    gains = P["norm_gains"][l]
    h = rmsnorm(x, gains[0]) * (1 + scale_m) + shift_m
    if l % 2 == 0:
        m, new_ctx = even_mixer(h, l, rope, ctx, P)
    else:
        m, new_ctx = fourier_mix(h, P["w_out_odd"][l // 2]), None
    x = x + gate_m * rmsnorm(m, gains[1])
    h = rmsnorm(x, gains[2]) * (1 + scale_f) + shift_f
    f = conv_ffn(h, P["w_ffn_in"][l], P["ffn_conv"][l], P["ffn_conv_b"][l], P["w_ffn_out"][l])
    x = x + gate_f * rmsnorm(f, gains[3])
    return x, new_ctx


def setup_inputs(seed: int = 0) -> dict:
    key = jax.random.key(seed)
    ks = jax.random.split(key, 32)
    D = D_MODEL

    def nrm(k, shape, s):
        return jax.random.normal(k, shape, jnp.float32) * s

    return {
        "x_prompt": nrm(ks[0], (BATCH, SEQ, D), 1.0),
        "x_sample": nrm(ks[1], (DEC_BATCH, DEC_SEQ, D), 1.0),
        "cache_k": nrm(ks[2], (DEC_BATCH, N_EVEN, PAST_LEN, A_HEADS, A_HEAD_DIM), 1.0),
        "cache_v": nrm(ks[3], (DEC_BATCH, N_EVEN, PAST_LEN, A_HEADS, A_HEAD_DIM), 1.0),
        "state_wkv": nrm(ks[4], (DEC_BATCH, N_EVEN, 2, B_HEADS, B_HEAD, B_HEAD), 0.5),
        "c": nrm(ks[5], (DEC_BATCH, D), 1.0),
        "c_ctx": nrm(ks[6], (D,), 1.0),
        "w_ada": nrm(ks[7], (DEPTH, D, 6 * D), 0.5 * D ** -0.5),
        "b_ada": nrm(ks[8], (DEPTH, 6 * D), 0.02),
        "norm_gains": 1.0 + nrm(ks[9], (DEPTH, 4, D), 0.05),
        "w_in_even": nrm(ks[10], (N_EVEN, D, IN_EVEN), D ** -0.5),
        "w_out_even": nrm(ks[11], (N_EVEN, D, D), D ** -0.5),
        "diff_lambda": nrm(ks[12], (N_EVEN, 4, A_HALF), 0.1),
        "diff_subln": 1.0 + nrm(ks[13], (N_EVEN, A_HEAD_DIM), 0.05),
        "rwkv_shift_mu": jax.random.uniform(ks[14], (N_EVEN, 2, IN_B), jnp.float32, 0.0, 0.5),
        "rwkv_w0": jax.random.uniform(ks[15], (N_EVEN, 2, B_WIDTH), jnp.float32, -6.0, -1.0),
        "rwkv_w2": nrm(ks[16], (N_EVEN, 2, LORA_W, B_WIDTH), 0.1),
        "rwkv_a0": nrm(ks[17], (N_EVEN, 2, B_WIDTH), 0.1),
        "rwkv_a2": nrm(ks[18], (N_EVEN, 2, LORA_A, B_WIDTH), 0.1),
        "rwkv_g2": nrm(ks[19], (N_EVEN, LORA_G, B_WIDTH), LORA_G ** -0.5),
        "rwkv_kvec": jnp.array([0.85, 1.0, 0.0], jnp.float32)[None, :, None]
        + nrm(ks[20], (N_EVEN, 3, B_WIDTH), 0.1),
        "rwkv_lnx": jnp.array([1.0, 0.0], jnp.float32)[None, :, None]
        + nrm(ks[21], (N_EVEN, 2, B_WIDTH), 0.05),
        "w_out_odd": nrm(ks[22], (N_ODD, D, D), D ** -0.5),
        "w_ffn_in": nrm(ks[23], (DEPTH, D, 2 * D_FF), D ** -0.5),
        "ffn_conv": nrm(ks[24], (DEPTH, 3, D_FF), 3 ** -0.5),
        "ffn_conv_b": nrm(ks[25], (DEPTH, D_FF), 0.02),
        "w_ffn_out": nrm(ks[26], (DEPTH, D_FF, D), D_FF ** -0.5),
    }


def reference(x_prompt, x_sample, cache_k, cache_v, state_wkv, c, c_ctx, w_ada, b_ada,
              norm_gains, w_in_even, w_out_even, diff_lambda, diff_subln, rwkv_shift_mu,
              rwkv_w0, rwkv_w2, rwkv_a0, rwkv_a2, rwkv_g2, rwkv_kvec, rwkv_lnx, w_out_odd,
              w_ffn_in, ffn_conv, ffn_conv_b, w_ffn_out):
    P = {
        "norm_gains": norm_gains, "w_in_even": w_in_even, "w_out_even": w_out_even,
        "diff_lambda": diff_lambda, "diff_subln": diff_subln, "rwkv_shift_mu": rwkv_shift_mu,
        "rwkv_w0": rwkv_w0, "rwkv_w2": rwkv_w2, "rwkv_a0": rwkv_a0, "rwkv_a2": rwkv_a2,
        "rwkv_g2": rwkv_g2, "rwkv_kvec": rwkv_kvec, "rwkv_lnx": rwkv_lnx,
        "w_out_odd": w_out_odd, "w_ffn_in": w_ffn_in, "ffn_conv": ffn_conv,
        "ffn_conv_b": ffn_conv_b, "w_ffn_out": w_ffn_out,
    }
    x = x_prompt
    ks, vs, ss = [], [], []
    for l in range(DEPTH):
        mod = (jax.nn.silu(c_ctx) @ w_ada[l] + b_ada[l])[None, None, :]
        x, new_ctx = trunk_layer(l, x, mod, None, None, P)
        if new_ctx is not None:
            ks.append(new_ctx[0])
            vs.append(new_ctx[1])
            ss.append(new_ctx[2])
    y_prompt = x
    new_cache_k = jnp.stack(ks, axis=1)
    new_cache_v = jnp.stack(vs, axis=1)
    new_state_wkv = jnp.stack(ss, axis=1)

    rows = x_sample.shape[1] // GRID_W
    rope = axial_rope_tables(rows)
    x = x_sample
    for l in range(DEPTH):
        mod = (jax.nn.silu(c) @ w_ada[l] + b_ada[l])[:, None, :]
        if l % 2 == 0:
            e = l // 2
            ctx = (cache_k[:, e], cache_v[:, e], state_wkv[:, e])
        else:
            ctx = None
        x, _ = trunk_layer(l, x, mod, rope, ctx, P)
    y_sample = x
    return (y_prompt, y_sample, new_cache_k, new_cache_v, new_state_wkv)
```

```cpp
#include <hip/hip_runtime.h>
#include <type_traits>
#include <cstdio>
#include <cstdint>

#ifndef MK_N_LAUNCHES
#define MK_N_LAUNCHES 1
#endif

#define LAS __attribute__((address_space(3)))
typedef unsigned short bf16;
typedef short bf16x8 __attribute__((ext_vector_type(8)));
typedef float f32x4 __attribute__((ext_vector_type(4)));
typedef float f32x2 __attribute__((ext_vector_type(2)));
typedef float f32x16 __attribute__((ext_vector_type(16)));
typedef unsigned u32x4 __attribute__((ext_vector_type(4)));
typedef unsigned u32x2 __attribute__((ext_vector_type(2)));
typedef __bf16 bf16x2_t __attribute__((ext_vector_type(2)));

constexpr int DM = 1024;
constexpr int NPR = 8192, NSA = 2048, NT = 10240;
constexpr int SEQ = 256, DSEQ = 1024, PAST = 256, LKS = 1280;
constexpr int INE = 3456, INE_PAD = 3584, INB = 1920, DFF = 2816, DFF2 = 5632;
constexpr int OUT_YP = 0, OUT_CK = 10485760, OUT_CV = 14680064, OUT_ST = 18874368;

constexpr size_t MiB = 1u << 20;
constexpr size_t WS_CTL = 252 * MiB, CTL_ZERO_BYTES = 65536 + 1310720;
constexpr size_t WS_MOD = 1 * MiB;
constexpr size_t WS_ROPE = 1 * MiB + 256 * 1024;
constexpr size_t WS_LAM = 1 * MiB + 768 * 1024;
constexpr size_t WS_WIN = 2 * MiB;
constexpr size_t WS_WO = 9 * MiB;
constexpr size_t WS_WODD = 11 * MiB;
constexpr size_t WS_WFI = 13 * MiB;
constexpr size_t WS_WFO = 35 * MiB;
constexpr size_t WS_W2T = 46 * MiB;
constexpr size_t WS_A2T = 46 * MiB + 128 * 1024;
constexpr size_t WS_G2T = 46 * MiB + 256 * 1024;
constexpr size_t WS_WDFT = 46 * MiB + 512 * 1024;
constexpr size_t WS_A2P = 46 * MiB + 768 * 1024;
constexpr size_t WS_XN = 52 * MiB;
constexpr size_t WS_MF = 72 * MiB;
constexpr size_t WS_XB = 92 * MiB;
constexpr size_t WS_BIG = 112 * MiB;
constexpr size_t WS_Q = 216 * MiB;
constexpr size_t WS_KP = 226 * MiB;
constexpr size_t WS_KS = 234 * MiB;
constexpr size_t WS_VTP = 237 * MiB;
constexpr size_t WS_VTS = 245 * MiB;
constexpr size_t WS_BONUS = 24 * MiB;
constexpr size_t WS_ACT = WS_BIG;
constexpr size_t WS_SB = 51 * MiB;
constexpr size_t WS_F32B = WS_MF;
constexpr size_t WS_YTP = WS_BIG;
constexpr size_t WS_YTS = WS_BIG + 32 * MiB;
constexpr size_t WS_MOD1 = WS_CTL + 32768;
constexpr size_t WS_PCNT = WS_CTL + 57344;
constexpr size_t WS_XSLOT = WS_CTL + 65536;
constexpr size_t WS_END = 256 * MiB;
static_assert(WS_ACT + (size_t)NT * DFF * 2 <= WS_END, "ws");

constexpr int RING_BYTES = 131072;
constexpr int ACT_OFF = 147456;
constexpr int MISC_OFF = 160256;
constexpr int PTAB_OFF = 160512;
constexpr int LDS_BYTES = 160768;

__device__ __forceinline__ unsigned pk2(float lo, float hi) { f32x2 v = {lo, hi}; bf16x2_t b = __builtin_convertvector(v, bf16x2_t); return __builtin_bit_cast(unsigned, b); }
__device__ __forceinline__ bf16 f2bf(float f) { return (bf16)(pk2(f, 0.f) & 0xffffu); }
__device__ __forceinline__ float bf2f(unsigned b) { return __uint_as_float(b << 16); }
__device__ __forceinline__ u32x2 pk4(f32x4 v) { u32x2 o; o.x = pk2(v[0], v[1]); o.y = pk2(v[2], v[3]); return o; }
__device__ __forceinline__ f32x4 unpk4(u32x2 w) { f32x4 v; v[0] = __uint_as_float(w.x << 16); v[1] = __uint_as_float(w.x & 0xffff0000u); v[2] = __uint_as_float(w.y << 16); v[3] = __uint_as_float(w.y & 0xffff0000u); return v; }
__device__ __forceinline__ float sigmoidf_(float x) { return __builtin_amdgcn_rcpf(1.f + __expf(-x)); }
__device__ __forceinline__ float wave_sum(float v) {
#pragma unroll
    for (int o = 1; o < 64; o <<= 1) v += __shfl_xor(v, o);
    return v;
}
__device__ __forceinline__ int keypos(int key) { return (key & ~12) | ((key & 4) << 1) | ((key & 8) >> 1); }

#define XB_TMO      128
#define XB_XCNT(j)  (256  + 64 * (j))
#define XB_XSUB(j)  (1280 + 64 * (j))
#define XB_XGEN(j)  (2304 + 64 * (j))
#define XB_TOP      3328
#define XB_TOPGEN   3392
#define XCD_BAR_WORDS 3456
#define XB_SPIN_CAP (1u << 20)
__device__ __forceinline__ unsigned xb_ld(unsigned* p)              { return __hip_atomic_load(p, __ATOMIC_RELAXED, __HIP_MEMORY_SCOPE_AGENT); }
__device__ __forceinline__ unsigned xb_add(unsigned* p, unsigned v) { return __hip_atomic_fetch_add(p, v, __ATOMIC_RELAXED, __HIP_MEMORY_SCOPE_AGENT); }
__device__ __forceinline__ unsigned xb_xcc_id() { return (unsigned)__builtin_amdgcn_s_getreg((3 << 11) | 20) & 0xFu; }
#define XB_SPIN(cond, bar) do { unsigned _sp = 0; while (cond) { __builtin_amdgcn_s_sleep(1); \
    if ((++_sp & 255u) == 0u) { if (xb_ld(&(bar)[XB_TMO])) break; if (_sp > XB_SPIN_CAP) { atomicAdd(&(bar)[XB_TMO], 1u); break; } } } } while (0)
struct XcdBarrier { unsigned* bar; unsigned x; volatile LAS unsigned* st; };
__device__ __forceinline__ XcdBarrier xcd_barrier_post(unsigned* bar, volatile LAS unsigned* st) {
    XcdBarrier b; b.bar = bar; b.x = xb_xcc_id(); b.st = st;
    if (threadIdx.x == 0) (void)xb_add(&bar[XB_XCNT(b.x)], 1u);
    return b;
}
__device__ __forceinline__ void xcd_barrier_complete(unsigned* bar, unsigned x, unsigned& nloc, unsigned& nx) {
    const unsigned G = gridDim.x * gridDim.y * gridDim.z;
    unsigned sum, cnt, mine, sp = 0u;
    for (;;) {
        sum = 0u; cnt = 0u; mine = 0u;
#pragma unroll
        for (unsigned j = 0; j < 16; ++j) { const unsigned c = xb_ld(&bar[XB_XCNT(j)]); sum += c; cnt += (c > 0u) ? 1u : 0u; mine = (j == x) ? c : mine; }
        if (sum == G) break;
        __builtin_amdgcn_s_sleep(1);
        if ((++sp & 255u) == 0u) { if (xb_ld(&bar[XB_TMO])) break; if (sp > XB_SPIN_CAP) { atomicAdd(&bar[XB_TMO], 1u); break; } }
    }
    nloc = mine > 0u ? mine : 1u; nx = cnt > 0u ? cnt : 1u;
}
__device__ __forceinline__ void xcd_barrier(const XcdBarrier& b) {
    asm volatile("s_waitcnt vmcnt(0)" ::: "memory");
    __syncthreads();
    if (threadIdx.x == 0) {
        unsigned* bar = b.bar;
        __builtin_amdgcn_s_waitcnt(0);
        unsigned nloc = b.st[0], nx = b.st[1];
        if (nloc == 0u) { xcd_barrier_complete(bar, b.x, nloc, nx); b.st[0] = nloc; b.st[1] = nx; }
        const unsigned old = xb_add(&bar[XB_XSUB(b.x)], 1u);
        const unsigned gen = old / nloc;
        if (old + 1u == (gen + 1u) * nloc) {
            __builtin_amdgcn_fence(__ATOMIC_RELEASE, "agent");
            asm volatile("s_waitcnt vmcnt(0)" ::: "memory");
            const unsigned og = xb_add(&bar[XB_TOP], 1u);
            const unsigned tg = og / nx;
            if (og + 1u == (tg + 1u) * nx) xb_add(&bar[XB_TOPGEN], 1u);
            else XB_SPIN(xb_ld(&bar[XB_TOPGEN]) == tg, bar);
            __builtin_amdgcn_fence(__ATOMIC_ACQUIRE, "agent");
            xb_add(&bar[XB_XGEN(b.x)], 1u);
            asm volatile("s_waitcnt vmcnt(0)" ::: "memory");
        } else {
            XB_SPIN(xb_ld(&bar[XB_XGEN(b.x)]) == gen, bar);
            __builtin_amdgcn_fence(__ATOMIC_ACQUIRE, "agent");
            asm volatile("s_waitcnt vmcnt(0)" ::: "memory");
        }
    }
    __syncthreads();
}

namespace pg8 {
constexpr int BM = 256, BK = 64, HALF = 128, HTB = HALF * BK * 2, STAGE_BYTES = 8 * HTB, NXCD = 8, WGM = 8;
__host__ __device__ __forceinline__ int lds_byte(int r, int c) { const int st = (r >> 4) * 2 + (c >> 5), rr = r & 15, cc = c & 31, ob = rr * 64 + cc * 2; return st * 1024 + (ob ^ (((ob >> 9) & 1) << 5)); }
__host__ __device__ __forceinline__ void stage_rc(int b, int& R, int& C) { const int st = b / 1024, sb = b % 1024, swz = sb ^ (((sb >> 9) & 1) << 5); R = (st >> 1) * 16 + swz / 64; C = (st & 1) * 32 + (swz % 64) / 2; }

struct Unit { int pm, pn, z; const char* a; const char* b; };
struct Gemm { int lda, ldb, K; };

struct PlainOrder {
    int nM, nN, nwg, G, c; const char* A; const char* Bt; size_t ta, tb;
    __device__ void init(const void* A_, const void* Bt_, int M, int N, int lda, int ldb, int G_, int c_) { A = (const char*)A_; Bt = (const char*)Bt_; nM = M / BM; nN = N / BM; nwg = nM * nN; G = G_; c = c_; ta = (size_t)BM * lda * 2; tb = (size_t)BM * ldb * 2; }
    __device__ __forceinline__ bool next(int i, Unit& u) const {
        const long L = (long)i * G + c; if (L >= nwg) return false;
        int wgid = (int)L; { const int q = nwg / NXCD, r = nwg % NXCD, xcd = wgid % NXCD, off = wgid / NXCD; wgid = (xcd < r ? xcd * (q + 1) : r * (q + 1) + (xcd - r) * q) + off; }
        const int nig = WGM * nN, gid = wgid / nig, fm = gid * WGM, gsz = (nM - fm) < WGM ? (nM - fm) : WGM;
        u.pm = fm + ((wgid % nig) % gsz); u.pn = (wgid % nig) / gsz; u.z = 0;
        u.a = A + (size_t)u.pm * ta; u.b = Bt + (size_t)u.pn * tb; return true;
    }
};

template <class F> __device__ __forceinline__ void epi_each(const f32x4 (&acc)[2][2][4][2], int row0, int col0, F&& f) {
#pragma unroll
    for (int ai = 0; ai < 2; ++ai)
#pragma unroll
        for (int m = 0; m < 4; ++m)
#pragma unroll
            for (int bj = 0; bj < 2; ++bj)
#pragma unroll
                for (int n = 0; n < 2; ++n) f(row0 + ai * HALF + m * 16, col0 + bj * HALF + n * 16, acc[ai][bj][m][n]);
}

template <class Epi, class Sched>
__device__ __forceinline__ void gemm_phase(LAS unsigned char* lds, const Gemm g, const Sched& S, const Epi& E) {
    int tid = threadIdx.x; asm volatile("" : "+v"(tid));
    const int wid = __builtin_amdgcn_readfirstlane(tid >> 6), lane = tid & 63, wr = wid >> 2, wc = wid & 3, fr = lane & 15, fq = lane >> 4;
    const int K = g.K, nt = K / BK;
    unsigned voffA[2], voffB[2];
#pragma unroll
    for (int i = 0; i < 2; ++i) { int R, C; stage_rc(tid * 16 + i * 8192, R, C); voffA[i] = (unsigned)(R * g.lda + C) * 2u; voffB[i] = (unsigned)(R * g.ldb + C) * 2u; }
    const size_t kstep = (size_t)(BK * 2);
    const size_t hstepA = (size_t)HALF * g.lda * 2, hstepB = (size_t)HALF * g.ldb * 2;
    const unsigned ldsw = (unsigned)wid * 1024u;
    const int aoff = lds_byte(wr * 64 + fr, fq * 8), boff = lds_byte(wc * 32 + fr, fq * 8);
#define PG8_SA(b, h) (((b) * 2 + (h)) * HTB)
#define PG8_SB(b, h) ((4 + (b) * 2 + (h)) * HTB)
#define PG8_STAGE(bufoff, gbase, voff) do { _Pragma("unroll") for (int _i = 0; _i < 2; ++_i) \
        __builtin_amdgcn_global_load_lds((const unsigned*)((const char*)(gbase) + (voff)[_i]), (LAS unsigned*)(lds + (bufoff) + ldsw + _i * 8192), 16, 0, 0); } while (0)
#define PG8_LDA(dst, b, h) do { _Pragma("unroll") for (int m = 0; m < 4; ++m) _Pragma("unroll") for (int k = 0; k < 2; ++k) dst[m][k] = *(const LAS bf16x8*)(lds + PG8_SA(b, h) + aoff + m * 2048 + k * 1024); } while (0)
#define PG8_LDB(dst, b, h) do { _Pragma("unroll") for (int n = 0; n < 2; ++n) _Pragma("unroll") for (int k = 0; k < 2; ++k) dst[n][k] = *(const LAS bf16x8*)(lds + PG8_SB(b, h) + boff + n * 2048 + k * 1024); } while (0)
#define PG8_MMA(ai, bj, At, Bt) do { __builtin_amdgcn_s_setprio(1); _Pragma("unroll") for (int m = 0; m < 4; ++m) _Pragma("unroll") for (int n = 0; n < 2; ++n) _Pragma("unroll") for (int k = 0; k < 2; ++k) \
        acc[ai][bj][m][n] = __builtin_amdgcn_mfma_f32_16x16x32_bf16(Bt[n][k], At[m][k], acc[ai][bj][m][n], 0, 0, 0); __builtin_amdgcn_s_setprio(0); } while (0)
#define PG8_WAIT_V(n) asm volatile("s_waitcnt vmcnt(" #n ")" ::: "memory")
#define PG8_WAIT_L(n) asm volatile("s_waitcnt lgkmcnt(" #n ")" ::: "memory")
#define PG8_BAR __builtin_amdgcn_s_barrier()
#define PG8_SCHED __builtin_amdgcn_sched_barrier(0)
    Unit cur, nxt; int ui = 0;
    if (!S.next(0, cur)) return;
    f32x4 acc[2][2][4][2];
#pragma unroll
    for (int a = 0; a < 2; ++a)
#pragma unroll
        for (int b = 0; b < 2; ++b)
#pragma unroll
            for (int m = 0; m < 4; ++m)
#pragma unroll
                for (int n = 0; n < 2; ++n) acc[a][b][m][n] = (f32x4){0.f, 0.f, 0.f, 0.f};
    bf16x8 At[4][2], B0[2][2], B1[2][2];
    const char* cA = cur.a; const char* cB = cur.b;
    PG8_STAGE(PG8_SB(0, 0), cB, voffB); PG8_STAGE(PG8_SA(0, 0), cA, voffA); PG8_STAGE(PG8_SB(0, 1), cB + hstepB, voffB); PG8_STAGE(PG8_SA(0, 1), cA + hstepA, voffA);
    if (wr == 1) PG8_BAR;
    PG8_WAIT_V(4); PG8_BAR;
    PG8_STAGE(PG8_SB(1, 0), cB + kstep, voffB); PG8_STAGE(PG8_SA(1, 0), cA + kstep, voffA); PG8_STAGE(PG8_SB(1, 1), cB + hstepB + kstep, voffB);
    PG8_WAIT_V(6); PG8_BAR;
    for (;;) {
        const bool has_next = S.next(ui + 1, nxt);
        const char* nA = has_next ? nxt.a : cA; const char* nB = has_next ? nxt.b : cB;
        for (int t = 0; t < nt; t += 2) {
            const bool last = (t == nt - 2);
            const char* a1 = cA + (size_t)(t + 1) * kstep;
            const char* a2 = last ? nA : cA + (size_t)(t + 2) * kstep; const char* b2 = last ? nB : cB + (size_t)(t + 2) * kstep;
            const char* a3 = a2 + kstep; const char* b3 = b2 + kstep;
            PG8_LDB(B0, 0, 0); PG8_SCHED; PG8_LDA(At, 0, 0); PG8_STAGE(PG8_SA(1, 1), a1 + hstepA, voffA);
            PG8_WAIT_L(8); PG8_BAR; PG8_WAIT_L(0); PG8_MMA(0, 0, At, B0); PG8_BAR; PG8_SCHED;
            PG8_LDB(B1, 0, 1); PG8_STAGE(PG8_SB(0, 0), b2, voffB);
            PG8_BAR; PG8_WAIT_L(0); PG8_MMA(0, 1, At, B1); PG8_BAR;
            PG8_LDA(At, 0, 1); PG8_STAGE(PG8_SA(0, 0), a2, voffA);
            PG8_BAR; PG8_WAIT_L(0); PG8_MMA(1, 0, At, B0); PG8_BAR; PG8_SCHED;
            PG8_STAGE(PG8_SB(0, 1), b2 + hstepB, voffB);
            PG8_WAIT_V(6); PG8_BAR; PG8_MMA(1, 1, At, B1); PG8_BAR;
            PG8_LDB(B0, 1, 0); PG8_SCHED; PG8_LDA(At, 1, 0); PG8_STAGE(PG8_SA(0, 1), a2 + hstepA, voffA);
            PG8_WAIT_L(8); PG8_BAR; PG8_WAIT_L(0); PG8_MMA(0, 0, At, B0); PG8_BAR; PG8_SCHED;
            PG8_LDB(B1, 1, 1); PG8_STAGE(PG8_SB(1, 0), b3, voffB);
            PG8_BAR; PG8_WAIT_L(0); PG8_MMA(0, 1, At, B1); PG8_BAR;
            PG8_LDA(At, 1, 1); PG8_STAGE(PG8_SA(1, 0), a3, voffA);
            PG8_BAR; PG8_WAIT_L(0); PG8_MMA(1, 0, At, B0); PG8_BAR; PG8_SCHED;
            PG8_STAGE(PG8_SB(1, 1), b3 + hstepB, voffB);
            PG8_WAIT_V(6); PG8_BAR; PG8_MMA(1, 1, At, B1); PG8_BAR;
        }
        if constexpr (Epi::ALIGN) { if (wr == 0) PG8_BAR; }
        E(acc, cur, wr, wc, fr, fq);
        if (!has_next) break;
#pragma unroll
        for (int a = 0; a < 2; ++a)
#pragma unroll
            for (int b = 0; b < 2; ++b)
#pragma unroll
                for (int m = 0; m < 4; ++m)
#pragma unroll
                    for (int n = 0; n < 2; ++n) acc[a][b][m][n] = (f32x4){0.f, 0.f, 0.f, 0.f};
        cur = nxt; cA = nA; cB = nB; ++ui;
        if constexpr (Epi::ALIGN) { if (wr == 1) PG8_BAR; }
    }
    PG8_WAIT_V(0);
    if constexpr (!Epi::ALIGN) { if (wr == 0) PG8_BAR; }
    PG8_BAR;
#undef PG8_SA
#undef PG8_SB
#undef PG8_STAGE
#undef PG8_LDA
#undef PG8_LDB
#undef PG8_MMA
#undef PG8_WAIT_V
#undef PG8_WAIT_L
#undef PG8_BAR
#undef PG8_SCHED
}

struct PlainOrder160 {
    int nM, nN, nwg, G, c; const char* A; const char* Bt; size_t ta, tb;
    __device__ void init(const void* A_, const void* Bt_, int M, int N, int lda, int ldb, int G_, int c_) { A = (const char*)A_; Bt = (const char*)Bt_; nM = M / 160; nN = N / BM; nwg = nM * nN; G = G_; c = c_; ta = (size_t)160 * lda * 2; tb = (size_t)BM * ldb * 2; }
    __device__ __forceinline__ bool next(int i, Unit& u) const {
        const long L = (long)i * G + c; if (L >= nwg) return false;
        int wgid = (int)L; { const int q = nwg / NXCD, r = nwg % NXCD, xcd = wgid % NXCD, off = wgid / NXCD; wgid = (xcd < r ? xcd * (q + 1) : r * (q + 1) + (xcd - r) * q) + off; }
        const int nig = WGM * nN, gid = wgid / nig, fm = gid * WGM, gsz = (nM - fm) < WGM ? (nM - fm) : WGM;
        u.pm = fm + ((wgid % nig) % gsz); u.pn = (wgid % nig) / gsz; u.z = 0;
        u.a = A + (size_t)u.pm * ta; u.b = Bt + (size_t)u.pn * tb; return true;
    }
};
template <class Epi, class Sched>
__device__ __forceinline__ void gemm_phase160(LAS unsigned char* lds, const Gemm g, const Sched& S, const Epi& E) {
    int tid = threadIdx.x; asm volatile("" : "+v"(tid));
    const int wid = __builtin_amdgcn_readfirstlane(tid >> 6), lane = tid & 63, half = wid >> 2, fr = lane & 15, fq = lane >> 4;
    const int K = g.K, nt = K / BK;
    constexpr int HTA = 80 * BK * 2;
    unsigned voffA[2], voffB[2];
    { int R, C; stage_rc(tid * 16, R, C); voffA[0] = (unsigned)(R * g.lda + C) * 2u; stage_rc((512 + (tid & 127)) * 16, R, C); voffA[1] = (unsigned)(R * g.lda + C) * 2u; }
#pragma unroll
    for (int i = 0; i < 2; ++i) { int R, C; stage_rc(tid * 16 + i * 8192, R, C); voffB[i] = (unsigned)(R * g.ldb + C) * 2u; }
    const size_t kstep = (size_t)(BK * 2);
    const size_t hstepA = (size_t)80 * g.lda * 2, hstepB = (size_t)HALF * g.ldb * 2;
    const unsigned ldswA0 = (unsigned)wid * 1024u, ldswA1 = 8192u + (unsigned)(wid & 1) * 1024u, ldswB = (unsigned)wid * 1024u;
    const int aoff = lds_byte(fr, fq * 8), boff = lds_byte(wid * 16 + fr, fq * 8);
#define PG8_SA(b, h) (((b) * 2 + (h)) * HTA)
#define PG8_SB(b, h) (4 * HTA + ((b) * 2 + (h)) * HTB)
#define PG8_STAGEA(bufoff, gbase) do { \
        __builtin_amdgcn_global_load_lds((const unsigned*)((const char*)(gbase) + voffA[0]), (LAS unsigned*)(lds + (bufoff) + ldswA0), 16, 0, 0); \
        __builtin_amdgcn_global_load_lds((const unsigned*)((const char*)(gbase) + voffA[1]), (LAS unsigned*)(lds + (bufoff) + ldswA1), 16, 0, 0); } while (0)
#define PG8_STAGEB(bufoff, gbase) do { _Pragma("unroll") for (int _i = 0; _i < 2; ++_i) \
        __builtin_amdgcn_global_load_lds((const unsigned*)((const char*)(gbase) + voffB[_i]), (LAS unsigned*)(lds + (bufoff) + ldswB + _i * 8192), 16, 0, 0); } while (0)
#define PG8_LDA(dst, b, h) do { _Pragma("unroll") for (int m = 0; m < 5; ++m) _Pragma("unroll") for (int k = 0; k < 2; ++k) dst[m][k] = *(const LAS bf16x8*)(lds + PG8_SA(b, h) + aoff + m * 2048 + k * 1024); } while (0)
#define PG8_LDB(dst, b, h) do { _Pragma("unroll") for (int k = 0; k < 2; ++k) dst[k] = *(const LAS bf16x8*)(lds + PG8_SB(b, h) + boff + k * 1024); } while (0)
#define PG8_MMA(ai, bj, At, Bt) do { __builtin_amdgcn_s_setprio(1); _Pragma("unroll") for (int m = 0; m < 5; ++m) _Pragma("unroll") for (int k = 0; k < 2; ++k) \
        acc[ai][bj][m] = __builtin_amdgcn_mfma_f32_16x16x32_bf16(Bt[k], At[m][k], acc[ai][bj][m], 0, 0, 0); __builtin_amdgcn_s_setprio(0); } while (0)
#define PG8_WAIT_V(n) asm volatile("s_waitcnt vmcnt(" #n ")" ::: "memory")
#define PG8_WAIT_L(n) asm volatile("s_waitcnt lgkmcnt(" #n ")" ::: "memory")
#define PG8_BAR __builtin_amdgcn_s_barrier()
#define PG8_SCHED __builtin_amdgcn_sched_barrier(0)
    Unit cur, nxt; int ui = 0;
    if (!S.next(0, cur)) return;
    f32x4 acc[2][2][5];
#pragma unroll
    for (int a = 0; a < 2; ++a)
#pragma unroll
        for (int b = 0; b < 2; ++b)
#pragma unroll
            for (int m = 0; m < 5; ++m) acc[a][b][m] = (f32x4){0.f, 0.f, 0.f, 0.f};
    bf16x8 At[5][2], B0[2], B1[2];
    const char* cA = cur.a; const char* cB = cur.b;
    PG8_STAGEB(PG8_SB(0, 0), cB); PG8_STAGEA(PG8_SA(0, 0), cA); PG8_STAGEB(PG8_SB(0, 1), cB + hstepB); PG8_STAGEA(PG8_SA(0, 1), cA + hstepA);
    if (half == 1) PG8_BAR;
    PG8_WAIT_V(4); PG8_BAR;
    PG8_STAGEB(PG8_SB(1, 0), cB + kstep); PG8_STAGEA(PG8_SA(1, 0), cA + kstep); PG8_STAGEB(PG8_SB(1, 1), cB + hstepB + kstep);
    PG8_WAIT_V(6); PG8_BAR;
    for (;;) {
        const bool has_next = S.next(ui + 1, nxt);
        const char* nA = has_next ? nxt.a : cA; const char* nB = has_next ? nxt.b : cB;
        for (int t = 0; t < nt; t += 2) {
            const bool last = (t == nt - 2);
            const char* a1 = cA + (size_t)(t + 1) * kstep;
            const char* a2 = last ? nA : cA + (size_t)(t + 2) * kstep; const char* b2 = last ? nB : cB + (size_t)(t + 2) * kstep;
            const char* a3 = a2 + kstep; const char* b3 = b2 + kstep;
            PG8_LDB(B0, 0, 0); PG8_SCHED; PG8_LDA(At, 0, 0); PG8_STAGEA(PG8_SA(1, 1), a1 + hstepA);
            PG8_WAIT_L(10); PG8_BAR; PG8_WAIT_L(0); PG8_MMA(0, 0, At, B0); PG8_BAR; PG8_SCHED;
            PG8_LDB(B1, 0, 1); PG8_STAGEB(PG8_SB(0, 0), b2);
            PG8_BAR; PG8_WAIT_L(0); PG8_MMA(0, 1, At, B1); PG8_BAR;
            PG8_LDA(At, 0, 1); PG8_STAGEA(PG8_SA(0, 0), a2);
            PG8_BAR; PG8_WAIT_L(0); PG8_MMA(1, 0, At, B0); PG8_BAR; PG8_SCHED;
            PG8_STAGEB(PG8_SB(0, 1), b2 + hstepB);
            PG8_WAIT_V(6); PG8_BAR; PG8_MMA(1, 1, At, B1); PG8_BAR;
            PG8_LDB(B0, 1, 0); PG8_SCHED; PG8_LDA(At, 1, 0); PG8_STAGEA(PG8_SA(0, 1), a2 + hstepA);
            PG8_WAIT_L(10); PG8_BAR; PG8_WAIT_L(0); PG8_MMA(0, 0, At, B0); PG8_BAR; PG8_SCHED;
            PG8_LDB(B1, 1, 1); PG8_STAGEB(PG8_SB(1, 0), b3);
            PG8_BAR; PG8_WAIT_L(0); PG8_MMA(0, 1, At, B1); PG8_BAR;
            PG8_LDA(At, 1, 1); PG8_STAGEA(PG8_SA(1, 0), a3);
            PG8_BAR; PG8_WAIT_L(0); PG8_MMA(1, 0, At, B0); PG8_BAR; PG8_SCHED;
            PG8_STAGEB(PG8_SB(1, 1), b3 + hstepB);
            PG8_WAIT_V(6); PG8_BAR; PG8_MMA(1, 1, At, B1); PG8_BAR;
        }
        E(acc, cur, wid, fr, fq);
        if (!has_next) break;
#pragma unroll
        for (int a = 0; a < 2; ++a)
#pragma unroll
            for (int b = 0; b < 2; ++b)
#pragma unroll
                for (int m = 0; m < 5; ++m) acc[a][b][m] = (f32x4){0.f, 0.f, 0.f, 0.f};
        cur = nxt; cA = nA; cB = nB; ++ui;
    }
    PG8_WAIT_V(0);
    if (half == 0) PG8_BAR;
    PG8_BAR;
#undef PG8_SA
#undef PG8_SB
#undef PG8_STAGEA
#undef PG8_STAGEB
#undef PG8_LDA
#undef PG8_LDB
#undef PG8_MMA
#undef PG8_WAIT_V
#undef PG8_WAIT_L
#undef PG8_BAR
#undef PG8_SCHED
}

template <int MF, class Epi, class Sched>
__device__ __forceinline__ void gemm_phase160b_run(LAS unsigned char* lds, const Gemm g, const Sched& S, const Epi& E, int tid, int wid, int lane, int wr, int wc) {
    const int fr = lane & 15, fq = lane >> 4;
    const int K = g.K, nt = K / BK;
    constexpr int HTA = 80 * BK * 2;
    unsigned voffA[2], voffB[2];
    { int R, C; stage_rc(tid * 16, R, C); voffA[0] = (unsigned)(R * g.lda + C) * 2u; stage_rc((512 + (tid & 127)) * 16, R, C); voffA[1] = (unsigned)(R * g.lda + C) * 2u; }
#pragma unroll
    for (int i = 0; i < 2; ++i) { int R, C; stage_rc(tid * 16 + i * 8192, R, C); voffB[i] = (unsigned)(R * g.ldb + C) * 2u; }
    const size_t kstep = (size_t)(BK * 2);
    const size_t hstepA = (size_t)80 * g.lda * 2, hstepB = (size_t)HALF * g.ldb * 2;
    const unsigned ldswA0 = (unsigned)wid * 1024u, ldswA1 = 8192u + (unsigned)(wid & 1) * 1024u, ldswB = (unsigned)wid * 1024u;
    const int aoff = lds_byte(wr * 48 + fr, fq * 8), boff = lds_byte(wc * 32 + fr, fq * 8);
#define PG8_SA(b, h) (((b) * 2 + (h)) * HTA)
#define PG8_SB(b, h) (4 * HTA + ((b) * 2 + (h)) * HTB)
#define PG8_STAGEA(bufoff, gbase) do { \
        __builtin_amdgcn_global_load_lds((const unsigned*)((const char*)(gbase) + voffA[0]), (LAS unsigned*)(lds + (bufoff) + ldswA0), 16, 0, 0); \
        __builtin_amdgcn_global_load_lds((const unsigned*)((const char*)(gbase) + voffA[1]), (LAS unsigned*)(lds + (bufoff) + ldswA1), 16, 0, 0); } while (0)
#define PG8_STAGEB(bufoff, gbase) do { _Pragma("unroll") for (int _i = 0; _i < 2; ++_i) \
        __builtin_amdgcn_global_load_lds((const unsigned*)((const char*)(gbase) + voffB[_i]), (LAS unsigned*)(lds + (bufoff) + ldswB + _i * 8192), 16, 0, 0); } while (0)
#define PG8_LDA(dst, b, h) do { _Pragma("unroll") for (int m = 0; m < MF; ++m) _Pragma("unroll") for (int k = 0; k < 2; ++k) dst[m][k] = *(const LAS bf16x8*)(lds + PG8_SA(b, h) + aoff + m * 2048 + k * 1024); } while (0)
#define PG8_LDB(dst, b, h) do { _Pragma("unroll") for (int n = 0; n < 2; ++n) _Pragma("unroll") for (int k = 0; k < 2; ++k) dst[n][k] = *(const LAS bf16x8*)(lds + PG8_SB(b, h) + boff + n * 2048 + k * 1024); } while (0)
#define PG8_MMA(ai, bj, At, Bt) do { __builtin_amdgcn_s_setprio(1); _Pragma("unroll") for (int m = 0; m < MF; ++m) _Pragma("unroll") for (int n = 0; n < 2; ++n) _Pragma("unroll") for (int k = 0; k < 2; ++k) \
        acc[ai][bj][m][n] = __builtin_amdgcn_mfma_f32_16x16x32_bf16(Bt[n][k], At[m][k], acc[ai][bj][m][n], 0, 0, 0); __builtin_amdgcn_s_setprio(0); } while (0)
#define PG8_WAIT_V(n) asm volatile("s_waitcnt vmcnt(" #n ")" ::: "memory")
#define PG8_WAIT_L(n) asm volatile("s_waitcnt lgkmcnt(" #n ")" ::: "memory")
#define PG8_WAIT_LA() do { if (MF == 3) PG8_WAIT_L(6); else PG8_WAIT_L(4); } while (0)
#define PG8_BAR __builtin_amdgcn_s_barrier()
#define PG8_SCHED __builtin_amdgcn_sched_barrier(0)
    Unit cur, nxt; int ui = 0;
    if (!S.next(0, cur)) return;
    f32x4 acc[2][2][MF][2];
#pragma unroll
    for (int a = 0; a < 2; ++a)
#pragma unroll
        for (int b = 0; b < 2; ++b)
#pragma unroll
            for (int m = 0; m < MF; ++m)
#pragma unroll
                for (int n = 0; n < 2; ++n) acc[a][b][m][n] = (f32x4){0.f, 0.f, 0.f, 0.f};
    bf16x8 At[MF][2], B0[2][2], B1[2][2];
    const char* cA = cur.a; const char* cB = cur.b;
    PG8_STAGEB(PG8_SB(0, 0), cB); PG8_STAGEA(PG8_SA(0, 0), cA); PG8_STAGEB(PG8_SB(0, 1), cB + hstepB); PG8_STAGEA(PG8_SA(0, 1), cA + hstepA);
    if (wr == 1) PG8_BAR;
    PG8_WAIT_V(4); PG8_BAR;
    PG8_STAGEB(PG8_SB(1, 0), cB + kstep); PG8_STAGEA(PG8_SA(1, 0), cA + kstep); PG8_STAGEB(PG8_SB(1, 1), cB + hstepB + kstep);
    PG8_WAIT_V(6); PG8_BAR;
    for (;;) {
        const bool has_next = S.next(ui + 1, nxt);
        const char* nA = has_next ? nxt.a : cA; const char* nB = has_next ? nxt.b : cB;
        for (int t = 0; t < nt; t += 2) {
            const bool last = (t == nt - 2);
            const char* a1 = cA + (size_t)(t + 1) * kstep;
            const char* a2 = last ? nA : cA + (size_t)(t + 2) * kstep; const char* b2 = last ? nB : cB + (size_t)(t + 2) * kstep;
            const char* a3 = a2 + kstep; const char* b3 = b2 + kstep;
            PG8_LDB(B0, 0, 0); PG8_SCHED; PG8_LDA(At, 0, 0); PG8_STAGEA(PG8_SA(1, 1), a1 + hstepA);
            PG8_WAIT_LA(); PG8_BAR; PG8_WAIT_L(0); PG8_MMA(0, 0, At, B0); PG8_BAR; PG8_SCHED;
            PG8_LDB(B1, 0, 1); PG8_STAGEB(PG8_SB(0, 0), b2);
            PG8_BAR; PG8_WAIT_L(0); PG8_MMA(0, 1, At, B1); PG8_BAR;
            PG8_LDA(At, 0, 1); PG8_STAGEA(PG8_SA(0, 0), a2);
            PG8_BAR; PG8_WAIT_L(0); PG8_MMA(1, 0, At, B0); PG8_BAR; PG8_SCHED;
            PG8_STAGEB(PG8_SB(0, 1), b2 + hstepB);
            PG8_WAIT_V(6); PG8_BAR; PG8_MMA(1, 1, At, B1); PG8_BAR;
            PG8_LDB(B0, 1, 0); PG8_SCHED; PG8_LDA(At, 1, 0); PG8_STAGEA(PG8_SA(0, 1), a2 + hstepA);
            PG8_WAIT_LA(); PG8_BAR; PG8_WAIT_L(0); PG8_MMA(0, 0, At, B0); PG8_BAR; PG8_SCHED;
            PG8_LDB(B1, 1, 1); PG8_STAGEB(PG8_SB(1, 0), b3);
            PG8_BAR; PG8_WAIT_L(0); PG8_MMA(0, 1, At, B1); PG8_BAR;
            PG8_LDA(At, 1, 1); PG8_STAGEA(PG8_SA(1, 0), a3);
            PG8_BAR; PG8_WAIT_L(0); PG8_MMA(1, 0, At, B0); PG8_BAR; PG8_SCHED;
            PG8_STAGEB(PG8_SB(1, 1), b3 + hstepB);
            PG8_WAIT_V(6); PG8_BAR; PG8_MMA(1, 1, At, B1); PG8_BAR;
        }
        if constexpr (!Epi::AFTER_DRAIN) E.template tile<MF>(acc, cur, wr, wc, fr, fq);
        if (!has_next) break;
#pragma unroll
        for (int a = 0; a < 2; ++a)
#pragma unroll
            for (int b = 0; b < 2; ++b)
#pragma unroll
                for (int m = 0; m < MF; ++m)
#pragma unroll
                    for (int n = 0; n < 2; ++n) acc[a][b][m][n] = (f32x4){0.f, 0.f, 0.f, 0.f};
        cur = nxt; cA = nA; cB = nB; ++ui;
    }
    PG8_WAIT_V(0);
    if (wr == 0) PG8_BAR;
    PG8_BAR;
    if constexpr (Epi::AFTER_DRAIN) E.template fused<MF>(acc, cur, wr, wc, fr, fq, lds, wid, lane, tid);
#undef PG8_SA
#undef PG8_SB
#undef PG8_STAGEA
#undef PG8_STAGEB
#undef PG8_LDA
#undef PG8_LDB
#undef PG8_MMA
#undef PG8_WAIT_V
#undef PG8_WAIT_L
#undef PG8_WAIT_LA
#undef PG8_BAR
#undef PG8_SCHED
}
template <class Epi, class Sched>
__device__ __forceinline__ void gemm_phase160b(LAS unsigned char* lds, const Gemm g, const Sched& S, const Epi& E) {
    int tid = threadIdx.x; asm volatile("" : "+v"(tid));
    const int wid = __builtin_amdgcn_readfirstlane(tid >> 6), lane = tid & 63, wr = wid >> 2, wc = wid & 3;
    if (wr == 0) gemm_phase160b_run<3>(lds, g, S, E, tid, wid, lane, wr, wc);
    else gemm_phase160b_run<2>(lds, g, S, E, tid, wid, lane, wr, wc);
}
}

struct Args { const void* in[27]; float* out; unsigned char* ws; int ph_lo, ph_hi; };
enum { I_XP = 0, I_XS, I_CK, I_CV, I_ST, I_C, I_CCTX, I_WADA, I_BADA, I_GAINS, I_WIN, I_WOUT, I_LAMBDA, I_SUBLN, I_MU, I_W0, I_W2, I_A0, I_A2, I_G2, I_KVEC, I_LNX, I_WODD, I_WFI, I_CONVW, I_CONVB, I_WFO };
#define FIN(k) ((const float*)a.in[k])
#define WSB(off) ((bf16*)(a.ws + (off)))
#define WSF(off) ((float*)(a.ws + (off)))


__device__ __forceinline__ const void* ptab_ld(LAS unsigned char* lds, int k) {
    const u32x2 w = *(const LAS u32x2*)(lds + PTAB_OFF + 8 * k);
    const unsigned long long v = ((unsigned long long)(unsigned)__builtin_amdgcn_readfirstlane((int)w.y) << 32) | (unsigned)__builtin_amdgcn_readfirstlane((int)w.x);
    return (const void*)(const __attribute__((address_space(1))) void*)v;
}
__device__ __forceinline__ Args load_args(LAS unsigned char* lds, int ph_lo, int ph_hi) {
    Args r;
#pragma unroll
    for (int i = 0; i < 27; ++i) r.in[i] = ptab_ld(lds, i);
    r.out = (float*)ptab_ld(lds, 27); r.ws = (unsigned char*)ptab_ld(lds, 28); r.ph_lo = ph_lo; r.ph_hi = ph_hi;
    return r;
}
__device__ __forceinline__ int row_cond(int row) { return row < NPR ? 0 : 1 + ((row - NPR) >> 10); }

template <bool FFN_PERM = false>
__device__ __forceinline__ void p0_transpose_item(const float* W, int K, int N, bf16* WT, LAS float* scr, int item, int lane) {
    const int nblk = N / 32, kb = item / nblk, nb = item % nblk, k0 = 64 * kb, n0 = 32 * nb;
    const int d0 = FFN_PERM ? (n0 < DFF ? (n0 / 128) * 256 + (n0 % 128) : ((n0 - DFF) / 128) * 256 + 128 + ((n0 - DFF) % 128)) : n0;
#pragma unroll 8
    for (int i = 0; i < 32; ++i) { const int kk = 2 * i + (lane >> 5); scr[kk * 33 + (lane & 31)] = W[(size_t)(k0 + kk) * N + n0 + (lane & 31)]; }
    asm volatile("s_waitcnt lgkmcnt(0)" ::: "memory");
    const int c = lane & 7;
#pragma unroll
    for (int j = 0; j < 4; ++j) { const int n = (lane >> 3) + 8 * j; const LAS float* s = scr + (8 * c) * 33 + n;
        u32x4 o; o.x = pk2(s[0 * 33], s[1 * 33]); o.y = pk2(s[2 * 33], s[3 * 33]); o.z = pk2(s[4 * 33], s[5 * 33]); o.w = pk2(s[6 * 33], s[7 * 33]);
        *(u32x4*)(WT + (size_t)(d0 + n) * K + k0 + 8 * c) = o; }
    asm volatile("s_waitcnt lgkmcnt(0)" ::: "memory");
}

template <int STAGE>
__device__ __forceinline__ void phase_prep(const Args& a, LAS unsigned char* lds, int bid, int G, int vgw = -2, int nmine = 1, int nvw = 0) {
    int tid = threadIdx.x; asm volatile("" : "+v"(tid));
    const int lane = tid & 63, wave = tid >> 6;
    const int gw = bid * 8 + wave, NGW = G * 8;
    const int gt = bid * 512 + tid, NGT = G * 512;
    constexpr int I_IN = (1024 / 64) * (INE / 32), I_SQ = (1024 / 64) * (1024 / 32), I_FI = (1024 / 64) * (DFF2 / 32), I_FO = (DFF / 64) * (1024 / 32), I_L64 = 1 * (512 / 32), I_L128 = 2 * (512 / 32);
    if (STAGE == 1 || STAGE == 3) {
        LAS float* scr = (LAS float*)(lds + wave * 16384);
        constexpr int NITEMS = I_IN + 4 * I_L64 + I_L128;
        for (int it = gw; it < NITEMS; it += NGW) {
            int r = it;
            if (r < I_IN) { p0_transpose_item(FIN(I_WIN), 1024, INE, WSB(WS_WIN), scr, r, lane); continue; } r -= I_IN;
            if (r < 2 * I_L64) { const int d = r / I_L64; p0_transpose_item(FIN(I_W2) + (size_t)d * 64 * 512, 64, 512, WSB(WS_W2T) + (size_t)d * 512 * 64, scr, r % I_L64, lane); continue; } r -= 2 * I_L64;
            if (r < 2 * I_L64) { const int d = r / I_L64; p0_transpose_item(FIN(I_A2) + (size_t)d * 64 * 512, 64, 512, WSB(WS_A2T) + (size_t)d * 512 * 64, scr, r % I_L64, lane); continue; } r -= 2 * I_L64;
            p0_transpose_item(FIN(I_G2), 128, 512, WSB(WS_G2T), scr, r, lane);
        }
        for (int i = gt; i < (INE_PAD - INE) * 1024 / 8; i += NGT) ((u32x4*)(WSB(WS_WIN) + (size_t)INE * 1024))[i] = (u32x4){0u, 0u, 0u, 0u};
    }
    if (STAGE == 2) {
        LAS float* scr = (LAS float*)(lds + wave * 16384);
        constexpr int NITEMS = 2 * I_SQ + I_FI + 2 * I_FO;
        const int s0 = vgw == -2 ? gw : vgw, ns = vgw == -2 ? NGW : nvw;
        for (int sl = 0; sl < nmine; ++sl)
        for (int it = s0 < 0 ? NITEMS : s0 + sl; it < NITEMS; it += ns) {
            int r = it;
            if (r < I_SQ) { p0_transpose_item(FIN(I_WOUT), 1024, 1024, WSB(WS_WO), scr, r, lane); continue; } r -= I_SQ;
            if (r < I_SQ) { p0_transpose_item(FIN(I_WODD), 1024, 1024, WSB(WS_WODD), scr, r, lane); continue; } r -= I_SQ;
            if (r < I_FI) { p0_transpose_item<true>(FIN(I_WFI), 1024, DFF2, WSB(WS_WFI), scr, r, lane); continue; } r -= I_FI;
            const int l = r / I_FO; p0_transpose_item(FIN(I_WFO) + (size_t)l * DFF * 1024, DFF, 1024, WSB(WS_WFO) + (size_t)l * 1024 * DFF, scr, r % I_FO, lane);
        }
    }
    if (STAGE == 0 || STAGE == 3) {
        for (int i = gt; i < 256 * 128; i += NGT) {
            const int n = i >> 7, c = i & 127, m = (c * (n & 127)) & 127; const float x = (float)m * (2.0f / 128.0f);
            WSB(WS_WDFT)[i] = f2bf(n < 128 ? cospif(x) : sinpif(x));
        }
        for (int i = gt; i < 256 * 512; i += NGT) {
            const int lp = i >> 9, k = i & 511, l = k & 255, m = (lp * l) & 255; const float x = (float)m * (2.0f / 256.0f), s = 0.00552427172801990f;
            WSB(WS_A2P)[i] = f2bf(k < 256 ? s * cospif(x) : -s * sinpif(x));
        }
        for (int i = gt; i < 1024 * 32; i += NGT) {
            const int t = i >> 5, f = i & 31; const float inv = powf(10000.0f, -(float)(f & 15) / 16.0f), pos = (float)(f < 16 ? (t >> 6) : (t & 63)), ang = pos * inv;
            WSF(WS_ROPE)[i] = cosf(ang); WSF(WS_ROPE)[1024 * 32 + i] = sinf(ang);
        }
        if (gt == 0) {
            const float* lp = FIN(I_LAMBDA); float s1 = 0.f, s2 = 0.f;
            for (int i = 0; i < 64; ++i) { s1 += lp[i] * lp[64 + i]; s2 += lp[128 + i] * lp[192 + i]; }
            WSF(WS_LAM)[0] = expf(s1) - expf(s2) + 0.2f;
        }
        for (int i = gt; i < 2 * 256 * 512; i += NGT) {
            const int b = i >> 17, t = (i >> 9) & 255, c = i & 511;
            WSB(WS_KS)[((size_t)b * LKS + t) * 512 + c] = f2bf(FIN(I_CK)[i]);
            const int h = c >> 7, d = c & 127;
            WSB(WS_VTS)[((size_t)(b * 4 + h) * 128 + d) * LKS + keypos(t)] = f2bf(FIN(I_CV)[i]);
        }
    }
    if (STAGE == 0 || STAGE == 1 || STAGE == 3) {
        LAS float* sc = (LAS float*)lds;
        LAS float* red = (LAS float*)(lds + 16384);
        __syncthreads();
        for (int i = tid; i < 3 * 1024; i += 512) { const int cd = i >> 10, k = i & 1023; const float x = cd == 0 ? FIN(I_CCTX)[k] : FIN(I_C)[(cd - 1) * 1024 + k]; sc[i] = x / (1.f + __expf(-x)); }
        __syncthreads();
        const int kq = tid >> 3, nl = tid & 7;
        const int it_lo = STAGE == 0 ? 0 : 64, it_hi = STAGE == 0 ? 64 : 2 * 192;
        for (int q = 0; ; ++q) {
            int it;
            if (STAGE == 3) {
                if (G == 256) { if (q == 0) { if (bid >= 64) continue; it = bid; } else if (q == 1) { if (bid < 64) continue; it = bid; } else if (q == 2) { if (bid >= 128) continue; it = 256 + bid; } else break; }
                else { it = bid + q * G; if (it >= 2 * 192) break; }
            } else { it = it_lo + bid + q * G; if (it >= it_hi) break; }
            const int l = it / 192, n0 = (it % 192) * 32;
            const float* W = FIN(I_WADA) + (size_t)l * 1024 * 6144 + n0 + 4 * nl;
            f32x4 s0 = {0.f, 0.f, 0.f, 0.f}, s1 = s0, s2 = s0;
#pragma unroll 4
            for (int kk = 0; kk < 16; ++kk) { const int k = kq * 16 + kk; const f32x4 w = *(const f32x4*)(W + (size_t)k * 6144); s0 += w * sc[k]; s1 += w * sc[1024 + k]; s2 += w * sc[2048 + k]; }
            *(LAS f32x4*)(red + (kq * 3 + 0) * 32 + 4 * nl) = s0; *(LAS f32x4*)(red + (kq * 3 + 1) * 32 + 4 * nl) = s1; *(LAS f32x4*)(red + (kq * 3 + 2) * 32 + 4 * nl) = s2;
            __syncthreads();
            if (tid < 96) { const int cd = tid >> 5, n = tid & 31; float s = FIN(I_BADA)[l * 6144 + n0 + n];
                for (int qq = 0; qq < 64; ++qq) s += red[(qq * 3 + cd) * 32 + n];
                if (STAGE == 3 && it < 64)
                    __hip_atomic_store((unsigned*)(a.ws + WS_MOD1) + cd * 2048 + n0 + n, __float_as_uint(s) | 1u, __ATOMIC_RELAXED, __HIP_MEMORY_SCOPE_AGENT);
                else WSF(WS_MOD)[(size_t)(l * 3 + cd) * 6144 + n0 + n] = s; }
            __syncthreads();
        }
    }
}

__device__ __forceinline__ void phase_first_norm(const Args& a, LAS unsigned char* lds, int bid, int G, const float* gB) {
    int tid = threadIdx.x; asm volatile("" : "+v"(tid));
    const int lane = tid & 63, wave = tid >> 6;
    const int gw = bid * 8 + wave, NGW = G * 8;
    LAS float* modl = (LAS float*)lds;
    __syncthreads();
    {   const unsigned* side = (const unsigned*)(a.ws + WS_MOD1);
        unsigned v[12]; unsigned spins = 0;
        for (;;) { bool ok = true;
#pragma unroll
            for (int i = 0; i < 12; ++i) { v[i] = __hip_atomic_load(side + tid + 512 * i, __ATOMIC_RELAXED, __HIP_MEMORY_SCOPE_AGENT); ok = ok && (v[i] != 0u); }
            if (ok || ++spins > (1u << 20)) break;
            __builtin_amdgcn_s_sleep(2); }
#pragma unroll
        for (int i = 0; i < 12; ++i) modl[tid + 512 * i] = __uint_as_float(v[i]);
    }
    __syncthreads();
    bf16* XN = WSB(WS_XN);
    constexpr int R = 5;
    for (int row0 = gw; row0 < NT; row0 += R * NGW) {
        f32x4 x[R][4];
#pragma unroll
        for (int q = 0; q < R; ++q) { const int row = row0 + q * NGW; if (row < NT) {
            const float* xin = row < NPR ? FIN(I_XP) + (size_t)row * DM : FIN(I_XS) + (size_t)(row - NPR) * DM;
#pragma unroll
            for (int j = 0; j < 4; ++j) x[q][j] = *(const f32x4*)(xin + 4 * lane + 256 * j); } }
#pragma unroll
        for (int q = 0; q < R; ++q) { const int row = row0 + q * NGW; if (row < NT) {
            const LAS float* ml = modl + row_cond(row) * 2048;
            float ss = 0.f;
#pragma unroll
            for (int j = 0; j < 4; ++j) ss += (x[q][j][0] * x[q][j][0] + x[q][j][1] * x[q][j][1]) + (x[q][j][2] * x[q][j][2] + x[q][j][3] * x[q][j][3]);
            const float rinv = rsqrtf(wave_sum(ss) * (1.f / DM) + 1e-6f);
#pragma unroll
            for (int j = 0; j < 4; ++j) { const f32x4 g = *(const f32x4*)(gB + 4 * lane + 256 * j), sc = *(const LAS f32x4*)(ml + 1024 + 4 * lane + 256 * j), sh = *(const LAS f32x4*)(ml + 4 * lane + 256 * j);
                const f32x4 h = (x[q][j] * rinv * g) * (sc + 1.f) + sh; *(u32x2*)(XN + (size_t)row * DM + 4 * lane + 256 * j) = pk4(h); }
        } }
    }
}

__device__ __forceinline__ void phase_transpose_wfi1(const Args& a, LAS unsigned char* lds, int bid, int G) {
    int tid = threadIdx.x; asm volatile("" : "+v"(tid));
    const int lane = tid & 63, wave = tid >> 6;
    LAS float* scr = (LAS float*)(lds + wave * 16384);
    constexpr int I_FI = (1024 / 64) * (DFF2 / 32);
    for (int it = bid * 8 + wave; it < I_FI; it += G * 8) p0_transpose_item<true>(FIN(I_WFI) + (size_t)1024 * DFF2, 1024, DFF2, WSB(WS_WFI) + (size_t)DFF2 * 1024, scr, it, lane);
    __syncthreads();
}
template <bool HAS_RES, bool HAS_H, bool X_FROM_INPUT, bool X_TO_OUTPUT = false>
__device__ __forceinline__ void phase_resnorm(const Args& a, int bid, int G, const bf16* mf, const float* gA, int gate_off, int layer_gate, const float* gB, int shift_off, int scale_off, int layer_mod) {
    int tid = threadIdx.x; asm volatile("" : "+v"(tid));
    const int lane = tid & 63, wave = tid >> 6;
    const int gw = bid * 8 + wave, NGW = G * 8;
    float* X = a.out; bf16* XB = WSB(WS_XB);
    bf16* XN = WSB(WS_XN);
    constexpr int R = 5;
    for (int row0 = gw; row0 < NT; row0 += R * NGW) {
        f32x4 x[R][4], m[R][4];
#pragma unroll
        for (int q = 0; q < R; ++q) { const int row = row0 + q * NGW; if (row < NT) {
            const float* xin = row < NPR ? FIN(I_XP) + (size_t)row * DM : FIN(I_XS) + (size_t)(row - NPR) * DM;
#pragma unroll
            for (int j = 0; j < 4; ++j) { x[q][j] = X_FROM_INPUT ? *(const f32x4*)(xin + 4 * lane + 256 * j) : unpk4(*(const u32x2*)(XB + (size_t)row * DM + 4 * lane + 256 * j)); if (HAS_RES) m[q][j] = unpk4(*(const u32x2*)(mf + (size_t)row * DM + 4 * lane + 256 * j)); } } }
#pragma unroll
        for (int q = 0; q < R; ++q) { const int row = row0 + q * NGW; if (row < NT) {
            const float* mod = WSF(WS_MOD) + (size_t)(layer_mod * 3 + row_cond(row)) * 6144;
            const float* modg = WSF(WS_MOD) + (size_t)(layer_gate * 3 + row_cond(row)) * 6144;
            if (HAS_RES) {
                float ss = 0.f;
#pragma unroll
                for (int j = 0; j < 4; ++j) ss += (m[q][j][0] * m[q][j][0] + m[q][j][1] * m[q][j][1]) + (m[q][j][2] * m[q][j][2] + m[q][j][3] * m[q][j][3]);
                const float rinv = rsqrtf(wave_sum(ss) * (1.f / DM) + 1e-6f);
#pragma unroll
                for (int j = 0; j < 4; ++j) { const f32x4 g = *(const f32x4*)(gA + 4 * lane + 256 * j), gt = *(const f32x4*)(modg + gate_off + 4 * lane + 256 * j);
                    x[q][j] = x[q][j] + gt * (m[q][j] * rinv * g);
                    if (X_TO_OUTPUT) *(f32x4*)(X + (size_t)row * DM + 4 * lane + 256 * j) = x[q][j]; else *(u32x2*)(XB + (size_t)row * DM + 4 * lane + 256 * j) = pk4(x[q][j]); }
            }
            if (HAS_H) {
                float ss = 0.f;
#pragma unroll
                for (int j = 0; j < 4; ++j) ss += (x[q][j][0] * x[q][j][0] + x[q][j][1] * x[q][j][1]) + (x[q][j][2] * x[q][j][2] + x[q][j][3] * x[q][j][3]);
                const float rinv = rsqrtf(wave_sum(ss) * (1.f / DM) + 1e-6f);
#pragma unroll
                for (int j = 0; j < 4; ++j) { const f32x4 g = *(const f32x4*)(gB + 4 * lane + 256 * j), sc = *(const f32x4*)(mod + scale_off + 4 * lane + 256 * j), sh = *(const f32x4*)(mod + shift_off + 4 * lane + 256 * j);
                    const f32x4 h = (x[q][j] * rinv * g) * (sc + 1.f) + sh; *(u32x2*)(XN + (size_t)row * DM + 4 * lane + 256 * j) = pk4(h); }
            }
        } }
    }
}

struct EpiF32 {
    float* C; int ldc;
    static constexpr bool ALIGN = false;
    __device__ __forceinline__ void operator()(const f32x4 (&acc)[2][2][4][2], const pg8::Unit& u, int wr, int wc, int fr, int fq) const {
        pg8::epi_each(acc, u.pm * 256 + wr * 64 + fr, u.pn * 256 + wc * 32 + 4 * fq, [&](int row, int col, const f32x4& v) { *(f32x4*)(C + (size_t)row * ldc + col) = v; });
    }
};
struct EpiBf16 {
    bf16* O; int ldc;
    static constexpr bool ALIGN = false;
    __device__ __forceinline__ void operator()(const f32x4 (&acc)[2][2][4][2], const pg8::Unit& u, int wr, int wc, int fr, int fq) const {
        pg8::epi_each(acc, u.z + u.pm * 256 + wr * 64 + fr, u.pn * 256 + wc * 32 + 4 * fq, [&](int row, int col, const f32x4& v) { *(u32x2*)(O + (size_t)row * ldc + col) = pk4(v); });
    }
};

template <class F> __device__ __forceinline__ void epi_each160(const f32x4 (&acc)[2][2][5], const pg8::Unit& u, int wid, int fr, int fq, F&& f) {
#pragma unroll
    for (int ai = 0; ai < 2; ++ai)
#pragma unroll
        for (int m = 0; m < 5; ++m)
#pragma unroll
            for (int bj = 0; bj < 2; ++bj) f(u.pm * 160 + ai * 80 + m * 16 + fr, u.pn * 256 + bj * 128 + wid * 16 + 4 * fq, acc[ai][bj][m]);
}
struct EpiBf16_160 {
    bf16* O; int ldc;
    static constexpr bool AFTER_DRAIN = false;
    template <int MF> __device__ __forceinline__ void tile(const f32x4 (&acc)[2][2][MF][2], const pg8::Unit& u, int wr, int wc, int fr, int fq) const {
#pragma unroll
        for (int ai = 0; ai < 2; ++ai)
#pragma unroll
            for (int m = 0; m < MF; ++m)
#pragma unroll
                for (int bj = 0; bj < 2; ++bj)
#pragma unroll
                    for (int n = 0; n < 2; ++n) *(u32x2*)(O + (size_t)(u.pm * 160 + ai * 80 + wr * 48 + m * 16 + fr) * ldc + u.pn * 256 + bj * 128 + wc * 32 + n * 16 + 4 * fq) = pk4(acc[ai][bj][m][n]);
    }
    __device__ __forceinline__ void operator()(const f32x4 (&acc)[2][2][5], const pg8::Unit& u, int wid, int fr, int fq) const {
#pragma unroll
        for (int ai = 0; ai < 2; ++ai)
#pragma unroll
            for (int m = 0; m < 5; ++m)
#pragma unroll
                for (int bj = 0; bj < 2; ++bj) *(u32x2*)(O + (size_t)(u.pm * 160 + ai * 80 + m * 16 + fr) * ldc + u.pn * 256 + bj * 128 + wid * 16 + 4 * fq) = pk4(acc[ai][bj][m]);
    }
};

template <bool FROM_INPUT, bool FINAL>
struct EpiResNorm {
    static constexpr bool AFTER_DRAIN = true;
    const float* xin_p; const float* xin_s; const bf16* xb_in;
    bf16* xb_out; float* xf_out; bf16* xn_out;
    const float* gA; const float* gB; const float* mod;
    int gate_off, layer_gate, shift_off, scale_off, layer_mod;
    unsigned* slots; unsigned* cnt;

    template <int MF> __device__ __forceinline__ void exchange(const f32x4 (&v)[2][2][MF][2], int e, int pm, int pn, int wr, int wc, int fr, int fq, LAS float* P, LAS float* R, int wid, int lane, int tid) const {
#pragma unroll
        for (int ai = 0; ai < 2; ++ai)
#pragma unroll
            for (int m = 0; m < MF; ++m) {
                float s = 0.f;
#pragma unroll
                for (int bj = 0; bj < 2; ++bj)
#pragma unroll
                    for (int n = 0; n < 2; ++n) { const f32x4 x = v[ai][bj][m][n]; s += (x[0] * x[0] + x[1] * x[1]) + (x[2] * x[2] + x[3] * x[3]); }
                s += __shfl_xor(s, 16); s += __shfl_xor(s, 32);
                if (fq == 0) P[(80 * ai + 48 * wr + 16 * m + fr) * 4 + wc] = s;
            }
        asm volatile("s_waitcnt lgkmcnt(0)" ::: "memory"); __builtin_amdgcn_s_barrier(); asm volatile("" ::: "memory");
        unsigned long long* sl = (unsigned long long*)(slots + ((size_t)(e * 64 + pm) * 160) * 4);
        if (tid < 160) { const float tot = (P[tid * 4 + 0] + P[tid * 4 + 1]) + (P[tid * 4 + 2] + P[tid * 4 + 3]);
            __hip_atomic_store((unsigned*)sl + tid * 4 + pn, __float_as_uint(tot) | 1u, __ATOMIC_RELAXED, __HIP_MEMORY_SCOPE_AGENT);
            unsigned long long a, b; unsigned spins = 0;
            for (;;) {
                a = __hip_atomic_load(sl + tid * 2 + 0, __ATOMIC_RELAXED, __HIP_MEMORY_SCOPE_AGENT); b = __hip_atomic_load(sl + tid * 2 + 1, __ATOMIC_RELAXED, __HIP_MEMORY_SCOPE_AGENT);
                if (((unsigned)a != 0u && (unsigned)(a >> 32) != 0u && (unsigned)b != 0u && (unsigned)(b >> 32) != 0u) || ++spins > (1u << 20)) break;
                __builtin_amdgcn_s_sleep(1);
            }
            const float q = (__uint_as_float((unsigned)a) + __uint_as_float((unsigned)(a >> 32))) + (__uint_as_float((unsigned)b) + __uint_as_float((unsigned)(b >> 32)));
            R[tid] = rsqrtf(q * (1.f / 1024.f) + 1e-6f); }
        asm volatile("s_waitcnt lgkmcnt(0)" ::: "memory"); __builtin_amdgcn_s_barrier(); asm volatile("" ::: "memory");
    }

    template <int MF> __device__ __forceinline__ void fused(f32x4 (&acc)[2][2][MF][2], const pg8::Unit& u, int wr, int wc, int fr, int fq, LAS unsigned char* lds, int wid, int lane, int tid) const {
        LAS float* P = (LAS float*)lds; LAS float* R = (LAS float*)(lds + 4096);
        const int pm = u.pm, pn = u.pn, row0 = 160 * pm;
        int cb = 256 * pn + 32 * wc + 4 * fq; asm volatile("" : "+v"(cb));
        const int c_lo = row_cond(row0), c_hi = row_cond(row0 + 159);
        f32x4 g[4], gtl[4], gth[4];
        {   const float* ml = mod + (size_t)(layer_gate * 3 + c_lo) * 6144 + gate_off; const float* mh = mod + (size_t)(layer_gate * 3 + c_hi) * 6144 + gate_off;
#pragma unroll
            for (int q = 0; q < 4; ++q) { const int col = cb + 128 * (q >> 1) + 16 * (q & 1); g[q] = *(const f32x4*)(gA + col); gtl[q] = *(const f32x4*)(ml + col); gth[q] = *(const f32x4*)(mh + col); } }
        using XT = typename std::conditional<FROM_INPUT, f32x4, u32x2>::type;
        XT x0[MF * 4], x1[MF * 4];
        auto ldx = [&](XT (&xr)[MF * 4], int ai) {
#pragma unroll
            for (int m = 0; m < MF; ++m) { const int row = row0 + 80 * ai + 48 * wr + 16 * m + fr;
#pragma unroll
                for (int q = 0; q < 4; ++q) { const int col = cb + 128 * (q >> 1) + 16 * (q & 1);
                    if constexpr (FROM_INPUT) xr[m * 4 + q] = *(const f32x4*)((row < NPR ? xin_p + (size_t)row * DM : xin_s + (size_t)(row - NPR) * DM) + col);
                    else xr[m * 4 + q] = *(const u32x2*)(xb_in + (size_t)row * DM + col); } } };
        auto upd = [&](const XT (&xr)[MF * 4], int ai) {
#pragma unroll
            for (int m = 0; m < MF; ++m) { const int rl = 80 * ai + 48 * wr + 16 * m + fr; const float rinv = R[rl]; const bool hi = row_cond(row0 + 80 * ai + 48 * wr + 16 * m) != c_lo;
#pragma unroll
                for (int q = 0; q < 4; ++q) { f32x4 x; if constexpr (FROM_INPUT) x = xr[m * 4 + q]; else x = unpk4(xr[m * 4 + q]);
                    const f32x4 gt = hi ? gth[q] : gtl[q];
                    acc[ai][q >> 1][m][q & 1] = x + gt * (acc[ai][q >> 1][m][q & 1] * rinv * g[q]); } } };
        ldx(x0, 0);
        if constexpr (!FROM_INPUT) ldx(x1, 1);
        asm volatile("" ::: "memory");
        exchange<MF>(acc, 0, pm, pn, wr, wc, fr, fq, P, R, wid, lane, tid);
        upd(x0, 0);
        if constexpr (FROM_INPUT) { asm volatile("" ::: "memory"); ldx(x1, 1); }
        upd(x1, 1);
#pragma unroll
        for (int ai = 0; ai < 2; ++ai)
#pragma unroll
            for (int m = 0; m < MF; ++m) { const int row = row0 + 80 * ai + 48 * wr + 16 * m + fr;
#pragma unroll
                for (int q = 0; q < 4; ++q) { const int col = cb + 128 * (q >> 1) + 16 * (q & 1); const f32x4 x = acc[ai][q >> 1][m][q & 1];
                    if constexpr (FINAL) *(f32x4*)(xf_out + (size_t)row * DM + col) = x; else *(u32x2*)(xb_out + (size_t)row * DM + col) = pk4(x); } }
        if constexpr (!FINAL) {
            f32x4 al[4], ah[4], sl[4], sh[4];
            {   const float* ml = mod + (size_t)(layer_mod * 3 + c_lo) * 6144; const float* mh = mod + (size_t)(layer_mod * 3 + c_hi) * 6144;
#pragma unroll
                for (int q = 0; q < 4; ++q) { const int col = cb + 128 * (q >> 1) + 16 * (q & 1); const f32x4 gb = *(const f32x4*)(gB + col);
                    al[q] = gb * (*(const f32x4*)(ml + scale_off + col) + 1.f); ah[q] = gb * (*(const f32x4*)(mh + scale_off + col) + 1.f);
                    sl[q] = *(const f32x4*)(ml + shift_off + col); sh[q] = *(const f32x4*)(mh + shift_off + col); } }
            asm volatile("" ::: "memory");
            exchange<MF>(acc, 1, pm, pn, wr, wc, fr, fq, P, R, wid, lane, tid);
#pragma unroll
            for (int ai = 0; ai < 2; ++ai)
#pragma unroll
                for (int m = 0; m < MF; ++m) { const int rl = 80 * ai + 48 * wr + 16 * m + fr, row = row0 + rl; const float rinv = R[rl]; const bool hi = row_cond(row0 + 80 * ai + 48 * wr + 16 * m) != c_lo;
#pragma unroll
                    for (int q = 0; q < 4; ++q) { const int col = cb + 128 * (q >> 1) + 16 * (q & 1);
                        const f32x4 h = (acc[ai][q >> 1][m][q & 1] * rinv) * (hi ? ah[q] : al[q]) + (hi ? sh[q] : sl[q]);
                        *(u32x2*)(xn_out + (size_t)row * DM + col) = pk4(h); } }
        }
    }
};

struct EpiProj {
    bf16 *Q, *KP, *KS, *VTP, *VTS, *FB; float *ock, *ocv; const float* rope;
    static constexpr bool ALIGN = false, AFTER_DRAIN = false;
    __device__ __forceinline__ f32x4 do_rope(f32x4 v, int t, int col) const {
        const int i0 = (col & 63) >> 1;
        const f32x2 c = *(const f32x2*)(rope + t * 32 + i0), s = *(const f32x2*)(rope + 1024 * 32 + t * 32 + i0);
        f32x4 o; o[0] = v[0] * c[0] - v[1] * s[0]; o[1] = v[0] * s[0] + v[1] * c[0]; o[2] = v[2] * c[1] - v[3] * s[1]; o[3] = v[2] * s[1] + v[3] * c[1]; return o;
    }
    __device__ __forceinline__ void operator()(const f32x4 (&acc)[2][2][4][2], const pg8::Unit& u, int wr, int wc, int fr, int fq) const {
        pg8::epi_each(acc, u.pm * 256 + wr * 64 + fr, u.pn * 256 + wc * 32 + 4 * fq, [&](int row, int col, const f32x4& v) { elem(row, col, v); });
    }
    __device__ __forceinline__ void operator()(const f32x4 (&acc)[2][2][5], const pg8::Unit& u, int wid, int fr, int fq) const {
        epi_each160(acc, u, wid, fr, fq, [&](int row, int col, const f32x4& v) { elem(row, col, v); });
    }
    template <int MF> __device__ __forceinline__ void tile(const f32x4 (&acc)[2][2][MF][2], const pg8::Unit& u, int wr, int wc, int fr, int fq) const {
#pragma unroll
        for (int ai = 0; ai < 2; ++ai)
#pragma unroll
            for (int m = 0; m < MF; ++m)
#pragma unroll
                for (int bj = 0; bj < 2; ++bj)
#pragma unroll
                    for (int n = 0; n < 2; ++n) elem(u.pm * 160 + ai * 80 + wr * 48 + m * 16 + fr, u.pn * 256 + bj * 128 + wc * 32 + n * 16 + 4 * fq, acc[ai][bj][m][n]);
    }
    __device__ __forceinline__ void elem(int row, int col, const f32x4& v) const {
        {
            const bool smp = row >= NPR; const int sr = row - NPR, sb = sr >> 10, st = sr & 1023;
            if (col < 512) {
                f32x4 o = v; if (smp) o = do_rope(v, st, col);
                *(u32x2*)(Q + (size_t)row * 512 + col) = pk4(o);
            } else if (col < 1024) {
                const int c = col - 512;
                if (!smp) { *(f32x4*)(ock + (size_t)row * 512 + c) = v; *(u32x2*)(KP + (size_t)row * 512 + c) = pk4(v); }
                else { const f32x4 o = do_rope(v, st, c); *(u32x2*)(KS + ((size_t)sb * LKS + PAST + st) * 512 + c) = pk4(o); }
            } else if (col < 1536) {
                const int c = col - 1024, h = c >> 7, d = c & 127;
                if (!smp) { *(f32x4*)(ocv + (size_t)row * 512 + c) = v; const int b = row >> 8, t = row & 255; bf16* p = VTP + ((size_t)(b * 4 + h) * 128 + d) * SEQ + keypos(t);
#pragma unroll
                    for (int e = 0; e < 4; ++e) p[(size_t)e * SEQ] = f2bf(v[e]); }
                else { bf16* p = VTS + ((size_t)(sb * 4 + h) * 128 + d) * LKS + keypos(PAST + st);
#pragma unroll
                    for (int e = 0; e < 4; ++e) p[(size_t)e * LKS] = f2bf(v[e]); }
            } else if (col < INE) {
                *(u32x2*)(FB + (size_t)row * INB + (col - 1536)) = pk4(v);
            }
        }
    }
};


template <int CTRL> __device__ __forceinline__ float dpp_mv(float old, float src) { return __int_as_float(__builtin_amdgcn_update_dpp(__float_as_int(old), __float_as_int(src), CTRL, 0xf, 0xf, false)); }
template <int CTRL> __device__ __forceinline__ float dpp_rot(float src) { return __int_as_float(__builtin_amdgcn_mov_dpp(__float_as_int(src), CTRL, 0xf, 0xf, true)); }
__device__ __forceinline__ float silu_mul(float x, float u) { return x * __builtin_amdgcn_rcpf(1.f + __expf(-x)) * u; }
struct EpiFfnConv {
    static constexpr bool ALIGN = true;
    bf16* ACT; const float* cw; const float* cb; float* SB; LAS float* xch;
    __device__ __forceinline__ void operator()(const f32x4 (&acc)[2][2][4][2], const pg8::Unit& u, int wr, int wc, int fr, int fq) const {
        const int pm = u.pm, pn = u.pn;
        const bool smp = pm >= 32; const int sidx = pm - 32, sq = sidx & 3;
        const bool has_prev = smp && sq > 0, has_next = smp && sq < 3;
#pragma unroll
        for (int ai = 0; ai < 2; ++ai)
#pragma unroll
            for (int n = 0; n < 2; ++n) { const int c = 32 * wc + 16 * n + 4 * fq, blk = 2 * ai + wr;
                if (fr == 0) *(LAS f32x4*)(xch + (blk * 2 + 0) * 128 + c) = acc[ai][1][0][n];
                if (fr == 15) *(LAS f32x4*)(xch + (blk * 2 + 1) * 128 + c) = acc[ai][1][3][n]; }
        asm volatile("s_waitcnt lgkmcnt(0)" ::: "memory"); __builtin_amdgcn_s_barrier(); asm volatile("" ::: "memory");
#pragma unroll
        for (int n = 0; n < 2; ++n) {
            const int c = 32 * wc + 16 * n + 4 * fq, f = 128 * pn + c;
            const f32x4 c0 = *(const f32x4*)(cw + f), c1 = *(const f32x4*)(cw + DFF + f), c2 = *(const f32x4*)(cw + 2 * DFF + f), cbv = *(const f32x4*)(cb + f);
#pragma unroll
            for (int ai = 0; ai < 2; ++ai) {
                const int blk = 2 * ai + wr;
                f32x4 gabove = {0.f, 0.f, 0.f, 0.f}, gbelow = gabove;
                if (blk > 0) gabove = *(const LAS f32x4*)(xch + ((blk - 1) * 2 + 1) * 128 + c);
                if (blk < 3) gbelow = *(const LAS f32x4*)(xch + ((blk + 1) * 2 + 0) * 128 + c);
#pragma unroll
                for (int m = 0; m < 4; ++m) {
                    const f32x4 g = acc[ai][1][m][n], uu = acc[ai][0][m][n];
                    f32x4 o, xs;
#pragma unroll
                    for (int e = 0; e < 4; ++e) {
                        const float pold = m > 0 ? dpp_rot<0x121>(acc[ai][1][m - 1][n][e]) : gabove[e];
                        const float prev = dpp_mv<0x111>(pold, g[e]);
                        const float nold = m < 3 ? dpp_rot<0x12F>(acc[ai][1][m + 1][n][e]) : gbelow[e];
                        const float next = dpp_mv<0x101>(nold, g[e]);
                        const float x = c0[e] * prev + (c1[e] * g[e] + (c2[e] * next + cbv[e]));
                        xs[e] = x; o[e] = silu_mul(x, uu[e]);
                    }
                    const int r = 128 * ai + 64 * wr + 16 * m + fr;
                    *(u32x2*)(ACT + (size_t)(256 * pm + r) * DFF + f) = pk4(o);
                    if (smp) {
                        if (r == 0) { *(f32x4*)(SB + (size_t)(0 * 8 + sidx) * DFF + f) = g; if (has_prev) { *(f32x4*)(SB + (size_t)(2 * 8 + sidx) * DFF + f) = xs; *(f32x4*)(SB + (size_t)(3 * 8 + sidx) * DFF + f) = uu; } }
                        if (r == 255) { *(f32x4*)(SB + (size_t)(1 * 8 + sidx) * DFF + f) = g; if (has_next) { *(f32x4*)(SB + (size_t)(4 * 8 + sidx) * DFF + f) = xs; *(f32x4*)(SB + (size_t)(5 * 8 + sidx) * DFF + f) = uu; } }
                    }
                }
            }
        }
    }
};
template <class Sched>
__device__ __forceinline__ void ffn_seam_fixup(const Sched& S, int rows_per_unit, bf16* ACT, const float* cw, const float* SB) {
    pg8::Unit u;
    for (int i = 0; S.next(i, u); ++i) {
        const int lo = u.pm * rows_per_unit, hi = lo + rows_per_unit;
        if (hi <= NPR) continue;
        int t0 = threadIdx.x; asm volatile("" : "+v"(t0));
        for (int sidx = 0; sidx < 8; ++sidx) {
            const int sq = sidx & 3, r0 = 256 * (32 + sidx), r1 = r0 + 255;
            const bool fix0 = sq > 0 && r0 >= lo && r0 < hi, fix1 = sq < 3 && r1 >= lo && r1 < hi;
            if (!fix0 && !fix1) continue;
            for (int f = t0; f < DFF; f += 512) {
                if (fix0) { const float x = SB[(size_t)(2 * 8 + sidx) * DFF + f] + cw[f] * SB[(size_t)(1 * 8 + sidx - 1) * DFF + f]; ACT[(size_t)r0 * DFF + f] = f2bf(silu_mul(x, SB[(size_t)(3 * 8 + sidx) * DFF + f])); }
                if (fix1) { const float x = SB[(size_t)(4 * 8 + sidx) * DFF + f] + cw[2 * DFF + f] * SB[(size_t)(0 * 8 + sidx + 1) * DFF + f]; ACT[(size_t)r1 * DFF + f] = f2bf(silu_mul(x, SB[(size_t)(5 * 8 + sidx) * DFF + f])); }
            }
        }
    }
    asm volatile("s_waitcnt vmcnt(0)" ::: "memory");
    __syncthreads();
}

struct DftOrder {
    int G, c; const char* A; const char* BtS; const char* BtP;
    __device__ bool next(int i, pg8::Unit& u) const {
        const int j = i * G + c; if (j >= 160) return false;
        u.pm = 0; u.a = A;
        if (j < 32) { const int b = j >> 4, p = (j >> 2) & 3, pn = j & 3; u.pn = pn; u.z = NPR + b * 1024 + p; u.b = BtS + ((size_t)(b * 4 + p) * 1024 + pn * 256) * 512 * 2; }
        else { const int q = j - 32, b = q >> 2, pn = q & 3; u.pn = pn; u.z = b * 256; u.b = BtP + ((size_t)b * 1024 + pn * 256) * 512 * 2; }
        return true;
    }
};
struct EpiDft {
    bf16* O;
    static constexpr bool ALIGN = false;
    __device__ __forceinline__ void operator()(const f32x4 (&acc)[2][2][4][2], const pg8::Unit& u, int wr, int wc, int fr, int fq) const {
        const int st = u.z >= NPR ? 4 : 1;
        pg8::epi_each(acc, wr * 64 + fr, u.pn * 256 + wc * 32 + 4 * fq, [&](int r, int col, const f32x4& v) { *(u32x2*)(O + (size_t)(u.z + st * r) * 1024 + col) = pk4(v); });
    }
};

__device__ __forceinline__ f32x16 mfma32(bf16x8 x, bf16x8 y, f32x16 c) { return __builtin_amdgcn_mfma_f32_32x32x16_bf16(x, y, c, 0, 0, 0); }
__device__ __forceinline__ void phase_attention(const Args& a, LAS unsigned char* lds, int bid, int G) {
    int tid = threadIdx.x; asm volatile("" : "+v"(tid));
    const int lane = tid & 63, wave = __builtin_amdgcn_readfirstlane(tid >> 6), tk = lane & 31, hh = lane >> 5;
    const float cs = 0.125f * 1.4426950408889634f;
    const bf16* Q = WSB(WS_Q);
    bf16* AB = WSB(WS_XN);
    const float* subln = FIN(I_SUBLN);
    constexpr int KST = 136, VST = 40;
    LAS bf16* Kl = (LAS bf16*)lds;
    LAS bf16* Vl = (LAS bf16*)(lds + 2 * 32 * KST * 2);
    LAS bf16* Ql = (LAS bf16*)(lds + 40960 + wave * 8192);
    const int lkey = tid >> 4, lkc = tid & 15, lvd = tid >> 2, lvc = tid & 3;
    for (int ai = 0; ai < 2; ++ai) {
        int item;
        if (G == 256) {
            if (bid >= 224) item = ai == 0 ? bid - 224 : -1;
            else if (bid >= 160) item = 32 + 2 * (bid - 160) + ai;
            else item = -1;
        } else item = bid + ai * G;
        if (item < 0 || item >= 160) continue;
        int b, h, nkeys, qrow0; const bf16 *Kb, *VT;
        if (item < 32) { b = item >> 4; h = (item >> 2) & 3; const int qb = item & 3; nkeys = LKS; qrow0 = NPR + b * 1024 + qb * 256 + wave * 32; Kb = WSB(WS_KS) + (size_t)b * LKS * 512; VT = WSB(WS_VTS) + (size_t)(b * 4 + h) * 128 * LKS; }
        else { const int j = item - 32; b = j >> 2; h = j & 3; nkeys = SEQ; qrow0 = b * 256 + wave * 32; Kb = WSB(WS_KP) + (size_t)b * 256 * 512; VT = WSB(WS_VTP) + (size_t)(b * 4 + h) * 128 * SEQ; }
        f32x16 O[2][4];
#pragma unroll
        for (int m = 0; m < 2; ++m)
#pragma unroll
            for (int mt = 0; mt < 4; ++mt)
#pragma unroll
                for (int r = 0; r < 16; ++r) O[m][mt][r] = 0.f;
        float mx[2] = {-1e30f, -1e30f}, ls[2] = {0.f, 0.f};
        const bf16* kg = Kb + (size_t)lkey * 512 + h * 128 + lkc * 8;
        const bf16* vg = VT + (size_t)lvd * nkeys + lvc * 8;
        __syncthreads();
#pragma unroll
        for (int m = 0; m < 2; ++m)
#pragma unroll
            for (int s = 0; s < 4; ++s) *(LAS bf16x8*)(Ql + ((m * 4 + s) * 64 + lane) * 8) = *(const bf16x8*)(Q + (size_t)(qrow0 + tk) * 512 + h * 128 + m * 64 + 16 * s + 8 * hh);
        { const u32x4 k0v = *(const u32x4*)kg, v0v = *(const u32x4*)vg;
          *(LAS u32x4*)(Kl + lkey * KST + lkc * 8) = k0v; *(LAS u32x4*)(Vl + lvd * VST + lvc * 8) = v0v; }
        const int nt = nkeys / 32;
        for (int t = 0; t < nt; ++t) {
            const int cur = t & 1;
            const bool more = t + 1 < nt;
            u32x4 kn = {0u, 0u, 0u, 0u}, vn = kn;
            if (more) { kn = *(const u32x4*)(kg + (size_t)(t + 1) * 32 * 512); vn = *(const u32x4*)(vg + (t + 1) * 32); }
            __syncthreads();
            const LAS bf16* Kc = Kl + cur * 32 * KST + tk * KST + 8 * hh;
            const LAS bf16* Vc = Vl + cur * 128 * VST + tk * VST + 8 * hh;
            bf16x8 pb[2][2];
#pragma unroll
            for (int m = 0; m < 2; ++m) {
                f32x16 S;
#pragma unroll
                for (int r = 0; r < 16; ++r) S[r] = 0.f;
#pragma unroll
                for (int s = 0; s < 4; ++s) { const bf16x8 kf = *(const LAS bf16x8*)(Kc + m * 64 + 16 * s); const bf16x8 qfr = *(const LAS bf16x8*)(Ql + ((m * 4 + s) * 64 + lane) * 8); S = mfma32(kf, qfr, S); }
                float tm = S[0];
#pragma unroll
                for (int r = 1; r < 16; ++r) tm = fmaxf(tm, S[r]);
                tm = fmaxf(tm, __shfl_xor(tm, 32));
                if (__any(tm > mx[m] + 44.0f)) {
                    const float mn = fmaxf(mx[m], tm), alpha = __builtin_amdgcn_exp2f((mx[m] - mn) * cs); mx[m] = mn;
                    ls[m] *= alpha;
#pragma unroll
                    for (int mt = 0; mt < 4; ++mt)
#pragma unroll
                        for (int r = 0; r < 16; ++r) O[m][mt][r] *= alpha;
                }
                const float mcur = mx[m];
                float ps = 0.f;
#pragma unroll
                for (int r = 0; r < 16; ++r) { S[r] = __builtin_amdgcn_exp2f((S[r] - mcur) * cs); ps += S[r]; }
                ls[m] += ps;
#pragma unroll
                for (int s2 = 0; s2 < 2; ++s2) { u32x4 w; w.x = pk2(S[8 * s2 + 0], S[8 * s2 + 1]); w.y = pk2(S[8 * s2 + 2], S[8 * s2 + 3]); w.z = pk2(S[8 * s2 + 4], S[8 * s2 + 5]); w.w = pk2(S[8 * s2 + 6], S[8 * s2 + 7]); pb[m][s2] = __builtin_bit_cast(bf16x8, w); }
            }
#pragma unroll
            for (int mt = 0; mt < 4; ++mt) {
#pragma unroll
                for (int s2 = 0; s2 < 2; ++s2) { const bf16x8 vf = *(const LAS bf16x8*)(Vc + 32 * mt * VST + 16 * s2);
                    O[0][mt] = mfma32(vf, pb[0][s2], O[0][mt]); O[1][mt] = mfma32(vf, pb[1][s2], O[1][mt]); }
            }
            if (more) { *(LAS u32x4*)(Kl + (cur ^ 1) * 32 * KST + lkey * KST + lkc * 8) = kn; *(LAS u32x4*)(Vl + (cur ^ 1) * 128 * VST + lvd * VST + lvc * 8) = vn; }
        }
        const float l0 = ls[0] + __shfl_xor(ls[0], 32), l1 = ls[1] + __shfl_xor(ls[1], 32);
        const float lam = WSF(WS_LAM)[0];
        const float i0 = 1.f / l0, i1 = lam / l1;
        float ss = 0.f;
#pragma unroll
        for (int mt = 0; mt < 4; ++mt)
#pragma unroll
            for (int r = 0; r < 16; ++r) { const float o = O[0][mt][r] * i0 - O[1][mt][r] * i1; O[0][mt][r] = o; ss += o * o; }
        ss += __shfl_xor(ss, 32);
        const float rinv = rsqrtf(ss * (1.f / 128.f) + 1e-6f) * 0.8f;
        bf16* dst = AB + (size_t)(qrow0 + tk) * 1024 + h * 128;
#pragma unroll
        for (int mt = 0; mt < 4; ++mt)
#pragma unroll
            for (int rq = 0; rq < 4; ++rq) { const int d = 32 * mt + 8 * rq + 4 * hh; const f32x4 g = *(const f32x4*)(subln + d);
                f32x4 o; o[0] = O[0][mt][4 * rq + 0] * rinv * g[0]; o[1] = O[0][mt][4 * rq + 1] * rinv * g[1]; o[2] = O[0][mt][4 * rq + 2] * rinv * g[2]; o[3] = O[0][mt][4 * rq + 3] * rinv * g[3];
                *(u32x2*)(dst + d) = pk4(o); }
    }
}

__device__ __forceinline__ float allred4(float x) {
    { auto r = __builtin_amdgcn_permlane16_swap(__float_as_uint(x), __float_as_uint(x), false, false); x = __uint_as_float(r[0]) + __uint_as_float(r[1]); }
    { auto r = __builtin_amdgcn_permlane32_swap(__float_as_uint(x), __float_as_uint(x), false, false); x = __uint_as_float(r[0]) + __uint_as_float(r[1]); }
    return x;
}

constexpr int OPS_KGRG = 0, OPS_KDBD = 4096, OPS_CINIT = 8192, OPS_VIMG = 12288, OPS_GAM = 14336, OPS_ITEM = 14592;
constexpr size_t WS_OPS = WS_MF;
static_assert(WS_OPS + (size_t)2 * 5120 * OPS_ITEM <= WS_Q, "ws ops");
__device__ __forceinline__ f32x4 mfma16(bf16x8 x, bf16x8 y, f32x4 c) { return __builtin_amdgcn_mfma_f32_16x16x32_bf16(x, y, c, 0, 0, 0); }
__device__ __forceinline__ bf16x8 frag_lo(f32x4 v) { u32x4 w; w.x = pk2(v[0], v[1]); w.y = pk2(v[2], v[3]); w.z = 0u; w.w = 0u; return __builtin_bit_cast(bf16x8, w); }
__device__ __forceinline__ void wave_lds_sync() { __syncthreads(); }


template <bool REV>
__device__ __forceinline__ void wkv_chunk_ops(unsigned char* ops, LAS unsigned char* wl, int lane, const float (&kkn)[16], const float (&wv)[16], const float (&kraw)[16], const float (&ad)[16], const float ka_, const float (&rr)[16], const unsigned (&vp)[8]) {
    int lane_ = lane; asm volatile("" : "+v"(lane_));
    const int lr = lane_ & 15, lg = lane_ >> 4, j = lane_;
    LAS bf16* KgR = (LAS bf16*)wl; LAS bf16* RgR = KgR + 16 * 72; LAS bf16* KiR = RgR + 16 * 72; LAS bf16* BiR = KiR + 16 * 72;
    LAS bf16* KgT = (LAS bf16*)(wl + 9216); LAS float* RgT = (LAS float*)(wl + 9216 + 2048); LAS bf16* VT = (LAS bf16*)(wl + 9216 + 2048 + 5120);
    LAS float* NL = (LAS float*)wl; LAS float* TL = (LAS float*)(wl + 2304);
    float gall = 1.f;
#pragma unroll
    for (int t = 0; t < 16; ++t) gall *= wv[t];
    *(float*)(ops + OPS_GAM + 4 * j) = gall;
    float grun = 1.f;
#pragma unroll
    for (int g = 0; g < 4; ++g) {
        float kdv[4], bdv[4]; unsigned vb4[4];
#pragma unroll
        for (int e = 0; e < 4; ++e) {
            const int tau = 4 * g + e, t = REV ? 15 - tau : tau;
            const float gprev = grun; grun *= wv[t];
            const float inv = __builtin_amdgcn_rcpf(grun);
            const float kg = kkn[t] * gprev, rg = rr[t] * grun, ki = kraw[t] * (1.f + (ad[t] - 1.f) * ka_) * inv, bi = kkn[t] * ad[t] * inv;
            kdv[e] = ki * gall; bdv[e] = -bi * gall; vb4[e] = (vp[t >> 1] >> (16 * (t & 1))) & 0xffffu;
            KgR[tau * 72 + j] = f2bf(kg); RgR[tau * 72 + j] = f2bf(rg); KiR[tau * 72 + j] = f2bf(ki); BiR[tau * 72 + j] = f2bf(bi);
            KgT[(g * 64 + j) * 4 + e] = f2bf(kg); RgT[j * 20 + tau] = rg; VT[(g * 64 + j) * 4 + e] = (bf16)vb4[e];
        }
        u32x4 w; w.x = pk2(kdv[0], kdv[1]); w.y = pk2(kdv[2], kdv[3]); w.z = pk2(bdv[0], bdv[1]); w.w = pk2(bdv[2], bdv[3]);
        *(u32x4*)(ops + OPS_KDBD + (((j >> 4) * 64 + (j & 15) + 16 * g) * 16)) = w;
        u32x2 vw; vw.x = vb4[0] | (vb4[1] << 16); vw.y = vb4[2] | (vb4[3] << 16);
        *(u32x2*)(ops + OPS_VIMG + (((j >> 4) * 64 + (j & 15) + 16 * g) * 8)) = vw;
    }
    wave_lds_sync();
    f32x4 akk = {0.f, 0.f, 0.f, 0.f}, akb = akk, ark = akk, arb = akk;
#pragma unroll
    for (int ks = 0; ks < 2; ++ks) {
        const bf16x8 fki = *(const LAS bf16x8*)(KiR + lr * 72 + 32 * ks + 8 * lg), fbi = *(const LAS bf16x8*)(BiR + lr * 72 + 32 * ks + 8 * lg);
        const bf16x8 fkg = *(const LAS bf16x8*)(KgR + lr * 72 + 32 * ks + 8 * lg), frg = *(const LAS bf16x8*)(RgR + lr * 72 + 32 * ks + 8 * lg);
        akk = mfma16(fki, fkg, akk); akb = mfma16(fbi, fkg, akb); ark = mfma16(fki, frg, ark); arb = mfma16(fbi, frg, arb);
    }
#pragma unroll
    for (int e = 0; e < 4; ++e) { const int s = 4 * lg + e; if (!(s < lr)) { akk[e] = 0.f; akb[e] = 0.f; } if (!(s <= lr)) { ark[e] = 0.f; arb[e] = 0.f; } }
    asm volatile("" : "+v"(akk), "+v"(akb), "+v"(ark), "+v"(arb));
    wave_lds_sync();
    *(LAS f32x4*)(NL + lr * 16 + 4 * lg) = akb;
    wave_lds_sync();
    {
        float Tc[16];
#pragma unroll
        for (int t = 0; t < 16; ++t) {
            float acc = (t == lr) ? 1.f : 0.f;
#pragma unroll
            for (int q4 = 0; q4 < (t + 3) / 4; ++q4) { const f32x4 nv = *(const LAS f32x4*)(NL + t * 16 + 4 * q4);
#pragma unroll
                for (int e = 0; e < 4; ++e) if (4 * q4 + e < t) acc -= nv[e] * Tc[4 * q4 + e]; }
            Tc[t] = acc;
        }
        if (lg == 0) {
#pragma unroll
            for (int t = 0; t < 16; ++t) TL[t * 16 + lr] = Tc[t];
        }
    }
    wave_lds_sync();
    const bf16x8 aT = frag_lo(*(const LAS f32x4*)(TL + lr * 16 + 4 * lg));
    const bf16x8 aKK = frag_lo(akk), aRK = frag_lo(ark), aRBn = frag_lo(-arb);
    const f32x4 z4 = {0.f, 0.f, 0.f, 0.f};
#pragma unroll
    for (int it = 0; it < 4; ++it) {
        const u32x2 vq = *(const LAS u32x2*)(VT + (lg * 64 + 16 * it + lr) * 4);
        const bf16x8 bV = __builtin_bit_cast(bf16x8, (u32x4){vq.x, vq.y, 0u, 0u});
        const f32x4 x1 = mfma16(aKK, bV, z4);
        const f32x4 vd = mfma16(aT, frag_lo(x1), z4);
        f32x4 yl = mfma16(aRK, bV, z4); yl = mfma16(aRBn, frag_lo(vd), yl);
        *(u32x2*)(ops + OPS_CINIT + ((0 * 4 + it) * 64 + lane) * 8) = pk4(vd);
        *(u32x2*)(ops + OPS_CINIT + ((1 * 4 + it) * 64 + lane) * 8) = pk4(yl);
    }
#pragma unroll
    for (int jt = 0; jt < 4; ++jt) {
        const u32x2 kq = *(const LAS u32x2*)(KgT + (lg * 64 + 16 * jt + lr) * 4);
        const bf16x8 bK = __builtin_bit_cast(bf16x8, (u32x4){kq.x, kq.y, 0u, 0u});
        const f32x4 kgp = mfma16(aT, bK, z4);
        const f32x4 rgp = mfma16(aRBn, frag_lo(kgp), *(const LAS f32x4*)(RgT + (16 * jt + lr) * 20 + 4 * lg));
        bf16* img = (bf16*)(ops + OPS_KGRG);
#pragma unroll
        for (int e = 0; e < 4; ++e) { const int t = 4 * lg + e; const int off = (((jt >> 1)) * 64 + t + 16 * (lr >> 2)) * 8 + 4 * (jt & 1) + (lr & 3);
            img[off] = f2bf(kgp[e]); img[2 * 64 * 8 + off] = f2bf(rgp[e]); }
    }
    wave_lds_sync();
}

__device__ __forceinline__ void phase_wkv_front(const Args& a, LAS unsigned char* lds, int bid, int G) {
    int tid = threadIdx.x; asm volatile("" : "+v"(tid));
    const int lane = tid & 63, wave = __builtin_amdgcn_readfirstlane(tid >> 6);
    constexpr int AST = 392;
    typedef const __attribute__((address_space(1))) bf16* gcb;
    const bf16* FB = (const bf16*)a.out;
    LAS bf16* act = (LAS bf16*)(lds + ACT_OFF);
    LAS unsigned char* wl = lds + wave * 18432;
    LAS float* TR = (LAS float*)wl;
    const float* mu = FIN(I_MU); const float* kvec = FIN(I_KVEC); const float* w0 = FIN(I_W0); const float* a0 = FIN(I_A0);
    bf16* AB = WSB(WS_XN); bf16* BON = WSB(WS_BONUS);
    int it_lo, it_n;
    if (G == 256) { if (bid < 160) { it_lo = 3 * bid; it_n = 3; } else if (bid < 224) { it_lo = 480 + 2 * (bid - 160); it_n = 2; } else { it_lo = 608 + (bid - 224); it_n = 1; } }
    else { it_lo = bid; it_n = (640 - bid + G - 1) / G; }
    for (int ii = 0; ii < it_n; ++ii) {
        const int item = (G == 256) ? it_lo + ii : it_lo + ii * G;
        int smp, sq, c, L, rowbase, nc;
        if (item < 128) { smp = 1; sq = item >> 6; c = item & 63; L = DSEQ; rowbase = NPR + sq * DSEQ; nc = 64; }
        else { const int p = item - 128; smp = 0; sq = p >> 4; c = p & 15; L = SEQ; rowbase = sq * SEQ; nc = 16; }
        const int row0 = rowbase + 16 * c, tp0 = 16 * c;
        __syncthreads();
        int tq = tid; asm volatile("" : "+v"(tq));
        for (int idx = tq; idx < 16 * 96; idx += 512) {
            const int tl = idx / 96, cg = idx - tl * 96, col = 1536 + 4 * cg, row = row0 + tl, tp = tp0 + tl;
            const f32x4 f = unpk4(*(const u32x2*)(FB + (size_t)row * INB + col));
            const f32x4 p = unpk4(*(const u32x2*)(FB + (size_t)(tp > 0 ? row - 1 : row) * INB + col)) * (tp > 0 ? 1.f : 0.f);
            const f32x4 n = unpk4(*(const u32x2*)(FB + (size_t)(tp < L - 1 ? row + 1 : row) * INB + col)) * (tp < L - 1 ? 1.f : 0.f);
            const f32x4 m0 = *(const f32x4*)(mu + col), m1 = *(const f32x4*)(mu + INB + col);
            f32x4 s = f + m0 * (p - f) + m1 * (n - f);
            const int kind = cg >> 5;
            if (kind == 0) { s[0] = tanhf(s[0]); s[1] = tanhf(s[1]); s[2] = tanhf(s[2]); s[3] = tanhf(s[3]); }
            else if (kind == 2) { s[0] = sigmoidf_(s[0]); s[1] = sigmoidf_(s[1]); s[2] = sigmoidf_(s[2]); s[3] = sigmoidf_(s[3]); }
            *(LAS u32x2*)(act + tl * AST + 4 * cg) = pk4(s);
        }
        __syncthreads();
        int j = lane; asm volatile("" : "+v"(j));
        const int lr = j & 15, lg = j >> 4;
        const int h = wave, col = h * 64 + j;
        auto lora_mma = [&](const bf16* WT, int ldk, int k0, int nks, f32x4 (&acc)[4]) {
            gcb wb = (gcb)(WT + (size_t)(h * 64 + lr) * ldk + 8 * lg);
            const LAS bf16* ab = act + lr * AST + k0 + 8 * lg;
            asm volatile("" : "+v"(wb), "+v"(ab));
#pragma unroll
            for (int jt = 0; jt < 4; ++jt) acc[jt] = (f32x4){0.f, 0.f, 0.f, 0.f};
            for (int ks = 0; ks < nks; ++ks) {
                const bf16x8 fa = *(const LAS bf16x8*)(ab + 32 * ks);
#pragma unroll
                for (int jt = 0; jt < 4; ++jt) { const bf16x8 fb = *(const __attribute__((address_space(1))) bf16x8*)(wb + (size_t)(16 * jt) * ldk + 32 * ks); acc[jt] = mfma16(fa, fb, acc[jt]); }
            }
        };
        auto tr_put = [&](int b, const f32x4 (&acc)[4]) {
#pragma unroll
            for (int jt = 0; jt < 4; ++jt) *(LAS f32x4*)(TR + b * 1280 + (16 * jt + lr) * 20 + 4 * lg) = acc[jt];
        };
        auto tr_get = [&](int b, float (&out)[16]) {
#pragma unroll
            for (int q = 0; q < 4; ++q) { const f32x4 x = *(const LAS f32x4*)(TR + b * 1280 + j * 20 + 4 * q); out[4 * q] = x[0]; out[4 * q + 1] = x[1]; out[4 * q + 2] = x[2]; out[4 * q + 3] = x[3]; }
        };
        f32x4 accG[4], accA0[4], accA1[4], accW0[4];
        lora_mma(WSB(WS_G2T), 128, 256, 4, accG);
        lora_mma(WSB(WS_A2T), 64, 128, 2, accA0);
        lora_mma(WSB(WS_A2T) + 512 * 64, 64, 192, 2, accA1);
        lora_mma(WSB(WS_W2T), 64, 0, 2, accW0);
        float r[16], k[16]; unsigned vp[8];
        {
            unsigned raw[3][18]; float v[16];
#pragma unroll
            for (int x = 0; x < 3; ++x)
#pragma unroll
                for (int q = 0; q < 18; ++q) { const int tp = tp0 - 1 + q; const int rw = row0 - 1 + q + (tp < 0 ? 1 : 0) - (tp > L - 1 ? 1 : 0); raw[x][q] = FB[(size_t)rw * INB + 512 * x + col]; }
            const float pm = tp0 > 0 ? 1.f : 0.f, nm = tp0 + 16 < L ? 1.f : 0.f;
            const float mr0 = mu[col], mr1 = mu[INB + col], mk0 = mu[512 + col], mk1 = mu[INB + 512 + col], mv0 = mu[1024 + col], mv1 = mu[INB + 1024 + col];
#pragma unroll
            for (int t = 0; t < 16; ++t) {
                const float pmask = t == 0 ? pm : 1.f, nmask = t == 15 ? nm : 1.f;
                { const float f = bf2f(raw[0][t + 1]), p = bf2f(raw[0][t]) * pmask, n = bf2f(raw[0][t + 2]) * nmask; r[t] = f + mr0 * (p - f) + mr1 * (n - f); }
                { const float f = bf2f(raw[1][t + 1]), p = bf2f(raw[1][t]) * pmask, n = bf2f(raw[1][t + 2]) * nmask; k[t] = f + mk0 * (p - f) + mk1 * (n - f); }
                { const float f = bf2f(raw[2][t + 1]), p = bf2f(raw[2][t]) * pmask, n = bf2f(raw[2][t + 2]) * nmask; v[t] = f + mv0 * (p - f) + mv1 * (n - f); }
            }
#pragma unroll
            for (int q = 0; q < 8; ++q) vp[q] = pk2(v[2 * q], v[2 * q + 1]);
        }
        float av0[16], av1[16];
        {
            float graw[16];
            tr_put(0, accG); tr_put(1, accA0); tr_put(2, accA1);
            wave_lds_sync();
            tr_get(0, graw); tr_get(1, av0); tr_get(2, av1);
            wave_lds_sync();
#pragma unroll
            for (int t = 0; t < 16; ++t) AB[(size_t)(row0 + t) * 1024 + 512 + col] = f2bf(graw[t]);
        }
        float wv0[16];
        {
            tr_put(0, accW0);
            wave_lds_sync();
            tr_get(0, wv0);
            wave_lds_sync();
            const float w00 = w0[col];
#pragma unroll
            for (int t = 0; t < 16; ++t) wv0[t] = __expf(-0.60653065971f * sigmoidf_(w00 + wv0[t]));
        }
        const float kk_ = kvec[col], ka_ = kvec[512 + col], rk_ = kvec[1024 + col], a00 = a0[col], a01 = a0[512 + col];
        float kkn[16];
        {
            LAS float* RED1 = (LAS float*)wl; LAS float* RED2 = RED1 + 64 * 17; LAS float* TOT = RED2 + 64 * 17;
#pragma unroll
            for (int t = 0; t < 16; ++t) {
                av0[t] = sigmoidf_(a00 + av0[t]); av1[t] = sigmoidf_(a01 + av1[t]);
                const float kr = k[t] * kk_; kkn[t] = kr;
                RED1[j * 17 + t] = kr * kr; RED2[j * 17 + t] = r[t] * rk_ * k[t] * (2.f + (av0[t] + av1[t] - 2.f) * ka_);
            }
            wave_lds_sync();
            float s1 = 0.f, s2 = 0.f;
#pragma unroll
            for (int jj = 0; jj < 16; ++jj) { s1 += RED1[(16 * lg + jj) * 17 + lr]; s2 += RED2[(16 * lg + jj) * 17 + lr]; }
            s1 = allred4(s1); s2 = allred4(s2);
            if (lg == 0) { TOT[lr] = rsqrtf(s1 + 1e-12f); TOT[16 + lr] = s2; }
            wave_lds_sync();
#pragma unroll
            for (int q = 0; q < 4; ++q) { const f32x4 ri = *(const LAS f32x4*)(TOT + 4 * q), rs = *(const LAS f32x4*)(TOT + 16 + 4 * q);
#pragma unroll
                for (int e = 0; e < 4; ++e) { const int t = 4 * q + e; kkn[t] *= ri[e]; BON[(size_t)(row0 + t) * 512 + col] = f2bf(rs[e] * __uint_as_float((t & 1) ? (vp[t >> 1] & 0xffff0000u) : (vp[t >> 1] << 16))); } }
            wave_lds_sync();
        }
        {
            const int oi = smp ? 4096 + (sq * 8 + h) * 64 + c : (sq * 8 + h) * 16 + c;
            wkv_chunk_ops<false>(a.ws + WS_OPS + (size_t)oi * OPS_ITEM, wl, lane, kkn, wv0, k, av0, ka_, r, vp);
        }
        {
            float wv1[16];
            { f32x4 accW1[4]; lora_mma(WSB(WS_W2T) + 512 * 64, 64, 64, 2, accW1); tr_put(0, accW1); wave_lds_sync(); tr_get(0, wv1); wave_lds_sync();
              const float w01 = w0[512 + col];
#pragma unroll
              for (int t = 0; t < 16; ++t) wv1[t] = __expf(-0.60653065971f * sigmoidf_(w01 + wv1[t])); }
            const int cc = nc - 1 - c;
            const int oi = 5120 + (smp ? 4096 + (sq * 8 + h) * 64 + cc : (sq * 8 + h) * 16 + cc);
            wkv_chunk_ops<true>(a.ws + WS_OPS + (size_t)oi * OPS_ITEM, wl, lane, kkn, wv1, k, av1, ka_, r, vp);
        }
    }
}

struct ChainOps { bf16x8 kgrg[2][2]; u32x2 cinit[2]; bf16x8 kdbd[4]; u32x2 vimg; f32x4 gam[4]; };
__device__ __forceinline__ void chain_load(ChainOps& o, const unsigned char* ops, int lane, int it) {
    const int lg = lane >> 4;
#pragma unroll
    for (int rt = 0; rt < 2; ++rt) {
#pragma unroll
        for (int ks = 0; ks < 2; ++ks) o.kgrg[rt][ks] = *(const bf16x8*)(ops + OPS_KGRG + ((rt * 2 + ks) * 64 + lane) * 16);
        o.cinit[rt] = *(const u32x2*)(ops + OPS_CINIT + ((rt * 4 + it) * 64 + lane) * 8);
    }
#pragma unroll
    for (int jt = 0; jt < 4; ++jt) { o.kdbd[jt] = *(const bf16x8*)(ops + OPS_KDBD + (jt * 64 + lane) * 16); o.gam[jt] = *(const f32x4*)(ops + OPS_GAM + (16 * jt + 4 * lg) * 4); }
    o.vimg = *(const u32x2*)(ops + OPS_VIMG + (it * 64 + lane) * 8);
}
__device__ __forceinline__ void wkv_sample_wave(const Args& a, LAS float* ybuf, int idx, int lane) {
    const int lr = lane & 15, lg = lane >> 4;
    const int dir = idx >> 6, ch = (idx >> 2) & 15, it = idx & 3;
    const int b = ch >> 3, h = ch & 7, nc = 64, L = DSEQ, rowbase = NPR + b * DSEQ, opsbase = 4096 + ch * 64;
    float* Y = a.out;
    f32x4 H[4];
    { const float* sp = FIN(I_ST) + (size_t)((b * 2 + dir) * 8 + h) * 4096;
#pragma unroll
      for (int jt = 0; jt < 4; ++jt) H[jt] = *(const f32x4*)(sp + (16 * it + lr) * 64 + 16 * jt + 4 * lg); }
    const unsigned char* opsp = a.ws + WS_OPS + (size_t)(dir * 5120 + opsbase) * OPS_ITEM;
    float* yg = Y + ((size_t)dir * NT + rowbase) * 512 + h * 64 + 16 * it + 4 * (lane & 3);
    ChainOps o0, o1;
    chain_load(o0, opsp, lane, it);
    chain_load(o1, opsp + OPS_ITEM, lane, it);
    auto step = [&](const ChainOps& cur, int c) {
        bf16x8 bh[2];
#pragma unroll
        for (int ks = 0; ks < 2; ++ks) { const u32x2 p0 = pk4(H[2 * ks]), p1 = pk4(H[2 * ks + 1]); bh[ks] = __builtin_bit_cast(bf16x8, (u32x4){p0.x, p0.y, p1.x, p1.y}); }
        f32x4 u = unpk4(cur.cinit[0]), y = unpk4(cur.cinit[1]);
#pragma unroll
        for (int ks = 0; ks < 2; ++ks) { u = mfma16(cur.kgrg[0][ks], bh[ks], u); y = mfma16(cur.kgrg[1][ks], bh[ks], y); }
#pragma unroll
        for (int e = 0; e < 4; ++e) ybuf[(16 * (c & 15) + 4 * lg + e) * 16 + lr] = y[e];
        const u32x2 up = pk4(u);
        const bf16x8 bvu = __builtin_bit_cast(bf16x8, (u32x4){cur.vimg.x, cur.vimg.y, up.x, up.y});
#pragma unroll
        for (int jt = 0; jt < 4; ++jt) H[jt] = mfma16(cur.kdbd[jt], bvu, H[jt] * cur.gam[jt]);
    };
    auto flush = [&](int c) {
        if ((c & 15) == 15) {
            asm volatile("s_waitcnt lgkmcnt(0)" ::: "memory");
            const int base = 256 * (c >> 4);
#pragma unroll 1
            for (int r0 = 0; r0 < 256; r0 += 16) { const int lt = base + r0 + (lane >> 2);
                *(f32x4*)(yg + (size_t)(dir ? L - 1 - lt : lt) * 512) = *(const LAS f32x4*)(ybuf + (r0 + (lane >> 2)) * 16 + 4 * (lane & 3)); }
            asm volatile("s_waitcnt lgkmcnt(0)" ::: "memory");
        }
    };
    ChainOps o2; chain_load(o2, opsp + 2 * OPS_ITEM, lane, it);
    int c = 0;
#pragma unroll 1
    for (; c + 2 < nc; c += 3) {
        step(o0, c); chain_load(o0, opsp + (size_t)(c + 3 < nc ? c + 3 : nc - 1) * OPS_ITEM, lane, it); flush(c);
        step(o1, c + 1); chain_load(o1, opsp + (size_t)(c + 4 < nc ? c + 4 : nc - 1) * OPS_ITEM, lane, it); flush(c + 1);
        step(o2, c + 2); chain_load(o2, opsp + (size_t)(c + 5 < nc ? c + 5 : nc - 1) * OPS_ITEM, lane, it); flush(c + 2);
    }
    for (; c < nc; ++c) { step(o0, c); flush(c); }
    asm volatile("s_waitcnt vmcnt(0) lgkmcnt(0)" ::: "memory");
}

struct ChainSh { bf16x8 kg, kd; float gm; };
struct ChainPr { u32x2 ci0, ci1, vi; };
__device__ __forceinline__ void chain_sh(ChainSh& o, const unsigned char* ops, int lane, int it) {
    o.kg = *(const bf16x8*)(ops + OPS_KGRG + (it * 64 + lane) * 16);
    o.kd = *(const bf16x8*)(ops + OPS_KDBD + (it * 64 + lane) * 16);
    o.gm = *(const float*)(ops + OPS_GAM + (16 * it + (lane & 15)) * 4);
}
__device__ __forceinline__ void chain_pr(ChainPr& o, const unsigned char* ops, int lane, int it) {
    o.ci0 = *(const u32x2*)(ops + OPS_CINIT + ((0 * 4 + it) * 64 + lane) * 8);
    o.ci1 = *(const u32x2*)(ops + OPS_CINIT + ((1 * 4 + it) * 64 + lane) * 8);
    o.vi = *(const u32x2*)(ops + OPS_VIMG + (it * 64 + lane) * 8);
}
template <bool DRY = false>
__device__ __forceinline__ void phase_wkv_chain(const Args& a, LAS unsigned char* lds, int bid, int G) {
    int tid = threadIdx.x; asm volatile("" : "+v"(tid));
    const int lane = tid & 63, wave = __builtin_amdgcn_readfirstlane(tid >> 6);
    const int lr = lane & 15, lg = lane >> 4;
    float* Y = a.out;
    LAS float* ybuf = (LAS float*)(lds + wave * 16384);
    const int dir = wave >> 2, it = wave & 3;
    LAS unsigned char* slot = lds + 131072 + dir * 8448;
    const bf16* BON = WSB(WS_BONUS); bf16* AB = WSB(WS_XN);
    const float* lnx = FIN(I_LNX);
    if (G == 256 && bid < 128) {
        if (wave == 0) wkv_sample_wave(a, (LAS float*)lds, bid, lane);
        return;
    }
#pragma unroll 1
    for (int jrep = 0; ; ++jrep) {
        int k;
        if (G == 256) { if (jrep < 2) k = 16 + 2 * (bid - 128) + jrep; else break; }
        else { k = bid + jrep * G; if (k >= 272) break; }
        int smp, b, h, nc, L, rowbase, opsbase;
        if (k < 16) { smp = 1; b = k >> 3; h = k & 7; nc = 64; L = DSEQ; rowbase = NPR + b * DSEQ; opsbase = 4096 + k * 64; }
        else { const int p = k - 16; smp = 0; b = p >> 3; h = p & 7; nc = 16; L = SEQ; rowbase = b * SEQ; opsbase = p * 16; }
        f32x4 H[4];
        if (smp) {
            const float* sp = FIN(I_ST) + (size_t)((b * 2 + dir) * 8 + h) * 4096;
#pragma unroll
            for (int jt = 0; jt < 4; ++jt) H[jt] = *(const f32x4*)(sp + (16 * it + lr) * 64 + 16 * jt + 4 * lg);
        } else {
#pragma unroll
            for (int jt = 0; jt < 4; ++jt) H[jt] = (f32x4){0.f, 0.f, 0.f, 0.f};
        }
        const unsigned char* opsp = a.ws + WS_OPS + (size_t)(dir * 5120 + opsbase) * OPS_ITEM;
        float* yg = Y + ((size_t)dir * NT + rowbase) * 512 + h * 64 + 16 * it + 4 * (lane & 3);
        constexpr int D = 8;
        ChainSh sh[D]; ChainPr pr[D];
#pragma unroll
        for (int i = 0; i < D; ++i) { chain_sh(sh[i], opsp + (size_t)i * OPS_ITEM, lane, it); chain_pr(pr[i], opsp + (size_t)i * OPS_ITEM, lane, it); }
        auto put = [&](const ChainSh& o) {
            *(LAS bf16x8*)(slot + it * 1024 + lane * 16) = o.kg; *(LAS bf16x8*)(slot + 4096 + it * 1024 + lane * 16) = o.kd;
            if (lane < 16) *(LAS float*)(slot + 8192 + (16 * it + lane) * 4) = o.gm; };
        put(sh[0]);
        chain_sh(sh[0], opsp + (size_t)(D < nc ? D : nc - 1) * OPS_ITEM, lane, it);
        asm volatile("s_waitcnt lgkmcnt(0)" ::: "memory"); __builtin_amdgcn_s_barrier(); asm volatile("" ::: "memory");
#pragma unroll 1
        for (int c = 0; c < nc; c += D) {
#pragma unroll
            for (int i = 0; i < D; ++i) {
                const int cc = c + i;
                bf16x8 kgrg[2][2], kdbd[4]; f32x4 gam[4];
#pragma unroll
                for (int q = 0; q < 4; ++q) { kgrg[q >> 1][q & 1] = *(const LAS bf16x8*)(slot + q * 1024 + lane * 16); kdbd[q] = *(const LAS bf16x8*)(slot + 4096 + q * 1024 + lane * 16); gam[q] = *(const LAS f32x4*)(slot + 8192 + (16 * q + 4 * lg) * 4); }
                asm volatile("s_waitcnt lgkmcnt(0)" ::: "memory"); __builtin_amdgcn_s_barrier(); asm volatile("" ::: "memory");
                put(sh[(i + 1) % D]);
                chain_sh(sh[(i + 1) % D], opsp + (size_t)(cc + 1 + D < nc ? cc + 1 + D : nc - 1) * OPS_ITEM, lane, it);
                const u32x2 c0 = pr[i].ci0, c1 = pr[i].ci1, cv = pr[i].vi;
                bf16x8 bh[2];
#pragma unroll
                for (int ks = 0; ks < 2; ++ks) { const u32x2 p0 = pk4(H[2 * ks]), p1 = pk4(H[2 * ks + 1]); bh[ks] = __builtin_bit_cast(bf16x8, (u32x4){p0.x, p0.y, p1.x, p1.y}); }
                f32x4 u = unpk4(c0), y = unpk4(c1);
#pragma unroll
                for (int ks = 0; ks < 2; ++ks) { u = mfma16(kgrg[0][ks], bh[ks], u); y = mfma16(kgrg[1][ks], bh[ks], y); }
#pragma unroll
                for (int e = 0; e < 4; ++e) ybuf[(16 * (cc & 15) + 4 * lg + e) * 16 + lr] = y[e];
                const u32x2 up = pk4(u);
                const bf16x8 bvu = __builtin_bit_cast(bf16x8, (u32x4){cv.x, cv.y, up.x, up.y});
#pragma unroll
                for (int jt = 0; jt < 4; ++jt) H[jt] = mfma16(kdbd[jt], bvu, H[jt] * gam[jt]);
                chain_pr(pr[i], opsp + (size_t)(cc + D < nc ? cc + D : nc - 1) * OPS_ITEM, lane, it);
                if (smp && (cc & 15) == 15) {
                    asm volatile("s_waitcnt lgkmcnt(0)" ::: "memory");
                    const int base = 256 * (cc >> 4);
#pragma unroll 1
                    for (int r0 = 0; r0 < 256; r0 += 16) { const int lt = base + r0 + (lane >> 2);
                        *(f32x4*)(yg + (size_t)(dir ? L - 1 - lt : lt) * 512) = *(const LAS f32x4*)(ybuf + (r0 + (lane >> 2)) * 16 + 4 * (lane & 3)); }
                }
                asm volatile("s_waitcnt lgkmcnt(0)" ::: "memory"); __builtin_amdgcn_s_barrier(); asm volatile("" ::: "memory");
            }
        }
        if (!smp) { float* op = a.out + OUT_ST + (size_t)((b * 2 + dir) * 8 + h) * 4096;
#pragma unroll
            for (int jt = 0; jt < 4; ++jt) *(f32x4*)(op + (16 * it + lr) * 64 + 16 * jt + 4 * lg) = H[jt]; }
        asm volatile("s_waitcnt vmcnt(0) lgkmcnt(0)" ::: "memory");
        __syncthreads();
        if (smp) continue;
        {
            const int hf = tid & 1;
            const float* l0p = lnx + h * 64 + 32 * hf; const float* l1p = lnx + 512 + h * 64 + 32 * hf;
            for (int t = tid >> 1; t < L; t += 256) {
                float x[32];
#pragma unroll
                for (int q = 0; q < 8; ++q) { const int itq = 2 * hf + (q >> 2);
                    const f32x4 f = *(const LAS f32x4*)(lds + itq * 16384 + (t * 16 + 4 * (q & 3)) * 4), g = *(const LAS f32x4*)(lds + (4 + itq) * 16384 + ((L - 1 - t) * 16 + 4 * (q & 3)) * 4);
                    x[4 * q] = f[0] + g[0]; x[4 * q + 1] = f[1] + g[1]; x[4 * q + 2] = f[2] + g[2]; x[4 * q + 3] = f[3] + g[3]; }
                float s = 0.f;
#pragma unroll
                for (int e = 0; e < 32; ++e) s += x[e];
                s += __shfl_xor(s, 1);
                const float mu = s * (1.f / 64.f);
                float v = 0.f;
#pragma unroll
                for (int e = 0; e < 32; ++e) { x[e] -= mu; v += x[e] * x[e]; }
                v += __shfl_xor(v, 1);
                const float rstd = rsqrtf(v * (1.f / 64.f) + 64e-5f);
                const size_t row = (size_t)rowbase + t;
                const bf16* bp = BON + row * 512 + h * 64 + 32 * hf; bf16* gp = AB + row * 1024 + 512 + h * 64 + 32 * hf;
#pragma unroll
                for (int q = 0; q < 4; ++q) {
                    const u32x4 bw = *(const u32x4*)(bp + 8 * q), gw4 = *(const u32x4*)(gp + 8 * q);
                    const f32x4 bo0 = unpk4((u32x2){bw.x, bw.y}), bo1 = unpk4((u32x2){bw.z, bw.w}), gg0 = unpk4((u32x2){gw4.x, gw4.y}), gg1 = unpk4((u32x2){gw4.z, gw4.w});
                    const f32x4 l00 = *(const f32x4*)(l0p + 8 * q), l01 = *(const f32x4*)(l0p + 8 * q + 4), l10 = *(const f32x4*)(l1p + 8 * q), l11 = *(const f32x4*)(l1p + 8 * q + 4);
                    f32x4 o0, o1;
#pragma unroll
                    for (int e = 0; e < 4; ++e) { o0[e] = (x[8 * q + e] * rstd * l00[e] + l10[e] + bo0[e]) * gg0[e]; o1[e] = (x[8 * q + 4 + e] * rstd * l01[e] + l11[e] + bo1[e]) * gg1[e]; }
                    const u32x2 p0 = pk4(o0), p1 = pk4(o1);
                    *(u32x4*)((DRY ? (bf16*)(a.ws + 248 * MiB) + row * 512 + h * 64 + 32 * hf : gp) + 8 * q) = (u32x4){p0.x, p0.y, p1.x, p1.y};
                }
            }
        }
        __syncthreads();
    }
}

template <bool WT = false>
__device__ __forceinline__ void phase_combine(const Args& a, int bid, int G) {
    int tid = threadIdx.x; asm volatile("" : "+v"(tid));
    const int lane = tid & 63, wave = tid >> 6;
    const int gw = bid * 8 + wave, NGW = G * 8;
    const float* Y = a.out; const bf16* BON = WSB(WS_BONUS); bf16* AB = WSB(WS_XN);
    const float* lnx = FIN(I_LNX);
    const int c = lane * 8;
    constexpr int R = 1;
    for (int row0 = NPR + gw; row0 < NT; row0 += R * NGW) {
        f32x4 f0[R], f1[R], g0[R], g1[R]; u32x4 bw[R], gw4[R];
#pragma unroll
        for (int q = 0; q < R; ++q) { const int row = row0 + q * NGW; if (row < NT) {
            f0[q] = *(const f32x4*)(Y + (size_t)row * 512 + c); f1[q] = *(const f32x4*)(Y + (size_t)row * 512 + c + 4);
            g0[q] = *(const f32x4*)(Y + (size_t)(NT + row) * 512 + c); g1[q] = *(const f32x4*)(Y + (size_t)(NT + row) * 512 + c + 4);
            bw[q] = *(const u32x4*)(BON + (size_t)row * 512 + c); gw4[q] = *(const u32x4*)(AB + (size_t)row * 1024 + 512 + c); } }
        const f32x4 l00 = *(const f32x4*)(lnx + c), l01 = *(const f32x4*)(lnx + c + 4), l10 = *(const f32x4*)(lnx + 512 + c), l11 = *(const f32x4*)(lnx + 512 + c + 4);
#pragma unroll
        for (int q = 0; q < R; ++q) { const int row = row0 + q * NGW; if (row < NT) {
            float x[8];
#pragma unroll
            for (int e = 0; e < 4; ++e) { x[e] = f0[q][e] + g0[q][e]; x[4 + e] = f1[q][e] + g1[q][e]; }
            float s = 0.f;
#pragma unroll
            for (int e = 0; e < 8; ++e) s += x[e];
            s += __shfl_xor(s, 1); s += __shfl_xor(s, 2); s += __shfl_xor(s, 4);
            const float mu = s * (1.f / 64.f);
            float v = 0.f;
#pragma unroll
            for (int e = 0; e < 8; ++e) { x[e] -= mu; v += x[e] * x[e]; }
            v += __shfl_xor(v, 1); v += __shfl_xor(v, 2); v += __shfl_xor(v, 4);
            const float rstd = rsqrtf(v * (1.f / 64.f) + 64e-5f);
            const f32x4 bo0 = unpk4((u32x2){bw[q].x, bw[q].y}), bo1 = unpk4((u32x2){bw[q].z, bw[q].w}), gg0 = unpk4((u32x2){gw4[q].x, gw4[q].y}), gg1 = unpk4((u32x2){gw4[q].z, gw4[q].w});
            f32x4 o0, o1;
#pragma unroll
            for (int e = 0; e < 4; ++e) { o0[e] = (x[e] * rstd * l00[e] + l10[e] + bo0[e]) * gg0[e]; o1[e] = (x[4 + e] * rstd * l01[e] + l11[e] + bo1[e]) * gg1[e]; }
            const u32x2 p0 = pk4(o0), p1 = pk4(o1);
            const u32x4 ov = {p0.x, p0.y, p1.x, p1.y};
            if (WT) {
                bf16* dst = AB + (size_t)row * 1024 + 512 + c;
                asm volatile("global_store_dwordx4 %0, %1, off sc0 sc1" :: "v"(dst), "v"(ov) : "memory");
                asm volatile("s_waitcnt vmcnt(0)" ::: "memory");
                if (lane == 0) __hip_atomic_fetch_add((unsigned*)(a.ws + WS_PCNT) + (row / 160) * 16, 1u, __ATOMIC_RELAXED, __HIP_MEMORY_SCOPE_AGENT);
            } else *(u32x4*)(AB + (size_t)row * 1024 + 512 + c) = ov;
        } }
    }
}

__device__ __forceinline__ void phase_chdft(const Args& a, LAS unsigned char* lds, int bid, int G) {
    int tid = threadIdx.x; asm volatile("" : "+v"(tid));
    const int lane = tid & 63, wave = tid >> 6, tk = lane & 31, hh = lane >> 5;
    const int gw = bid * 8 + wave, NGW = G * 8;
    constexpr int WST = 136;
    LAS bf16* Wd = (LAS bf16*)lds;
    const bf16* WDFT = WSB(WS_WDFT); const bf16* XN = WSB(WS_XN);
    __syncthreads();
    for (int i = tid; i < 256 * 16; i += 512) { const int r = i >> 4, c8 = i & 15; *(LAS u32x4*)(Wd + r * WST + 8 * c8) = *(const u32x4*)(WDFT + r * 128 + 8 * c8); }
    __syncthreads();
    for (int it8 = gw; it8 < 1024; it8 += NGW) {
        const int it = it8 >> 3, mtp2 = it8 & 7;
        const int b = it >> 6, g = (it >> 3) & 7, lt = it & 7, l2 = 32 * lt + tk;
        float twc[4], tws[4]; twc[0] = 1.f; tws[0] = 0.f;
#pragma unroll
        for (int p = 1; p < 4; ++p) { const float x = (float)(l2 * p) * (2.0f / 1024.0f); twc[p] = cospif(x); tws[p] = sinpif(x); }
        const bf16* xin = XN + (size_t)(NPR + b * 1024 + 32 * lt + tk) * 1024 + g * 128 + 8 * hh;
        bf16* zt = WSB(WS_YTS) + (size_t)b * 4 * 1024 * 512 + (size_t)(g * 128 + 4 * hh) * 512 + l2;
        {
            const int mtp = mtp2 >> 1, ph = mtp2 & 1;
            f32x16 Zr[2], Zi[2];
#pragma unroll
            for (int p = 0; p < 2; ++p)
#pragma unroll
                for (int r = 0; r < 16; ++r) { Zr[p][r] = 0.f; Zi[p][r] = 0.f; }
#pragma unroll
            for (int l1 = 0; l1 < 4; ++l1) {
                f32x16 yc, ys;
#pragma unroll
                for (int r = 0; r < 16; ++r) { yc[r] = 0.f; ys[r] = 0.f; }
#pragma unroll
                for (int s = 0; s < 8; ++s) {
                    const bf16x8 hbv = *(const bf16x8*)(xin + (size_t)(256 * l1) * 1024 + 16 * s);
                    const bf16x8 ac = *(const LAS bf16x8*)(Wd + (32 * mtp + tk) * WST + 16 * s + 8 * hh), as = *(const LAS bf16x8*)(Wd + (128 + 32 * mtp + tk) * WST + 16 * s + 8 * hh);
                    yc = mfma32(ac, hbv, yc); ys = mfma32(as, hbv, ys);
                }
                if (ph == 0) { Zr[0] += yc; Zi[0] -= ys; if (l1 & 1) { Zr[1] -= yc; Zi[1] += ys; } else { Zr[1] += yc; Zi[1] -= ys; } }
                else {
                    if (l1 == 0) { Zr[0] += yc; Zi[0] -= ys; Zr[1] += yc; Zi[1] -= ys; }
                    else if (l1 == 1) { Zr[0] -= ys; Zi[0] -= yc; Zr[1] += ys; Zi[1] += yc; }
                    else if (l1 == 2) { Zr[0] -= yc; Zi[0] += ys; Zr[1] -= yc; Zi[1] += ys; }
                    else { Zr[0] += ys; Zi[0] += yc; Zr[1] -= ys; Zi[1] -= yc; }
                }
                asm volatile("" : "+v"(Zr[0]), "+v"(Zi[0]), "+v"(Zr[1]), "+v"(Zi[1]));
            }
            typedef __attribute__((address_space(1))) bf16* gbp;
#pragma unroll
            for (int pi = 0; pi < 2; ++pi) {
                const int p = ph + 2 * pi;
                const float c = 0.5f * (p == 0 ? twc[0] : p == 1 ? twc[1] : p == 2 ? twc[2] : twc[3]), s = 0.5f * (p == 0 ? tws[0] : p == 1 ? tws[1] : p == 2 ? tws[2] : tws[3]);
#pragma unroll
                for (int rq = 0; rq < 4; ++rq) {
                    gbp pp = (gbp)(zt + (size_t)p * 1024 * 512 + (size_t)(32 * mtp + 8 * rq) * 512);
                    asm volatile("" : "+v"(pp));
#pragma unroll
                    for (int e = 0; e < 4; ++e) { const float zr = Zr[pi][4 * rq + e], zi = Zi[pi][4 * rq + e];
                        pp[(size_t)e * 512] = f2bf(zr * c + zi * s); pp[(size_t)e * 512 + 256] = f2bf(zr * s - zi * c); }
                }
            }
        }
    }
    for (int it2 = gw; it2 < (NPR / 32) * 16; it2 += NGW) {
        const int it = it2 >> 1, hsel = it2 & 1;
        const int r0 = (it >> 3) * 32, g = it & 7;
        bf16x8 hb[8];
#pragma unroll
        for (int s = 0; s < 8; ++s) hb[s] = *(const bf16x8*)(XN + (size_t)(r0 + tk) * 1024 + g * 128 + 16 * s + 8 * hh);
        bf16* dst; int ld, Lh, l;
        if (r0 < NPR) { const int b = r0 >> 8; l = (r0 & 255) + tk; dst = WSB(WS_YTP) + (size_t)b * 1024 * 512; ld = 512; Lh = 256; }
        else { const int sb = (r0 - NPR) >> 10; l = ((r0 - NPR) & 1023) + tk; dst = WSB(WS_YTS) + (size_t)sb * 1024 * 2048; ld = 2048; Lh = 1024; }
#pragma unroll 1
        for (int half = hsel; half <= hsel; ++half) {
            f32x16 acc[4];
#pragma unroll
            for (int mt = 0; mt < 4; ++mt)
#pragma unroll
                for (int r = 0; r < 16; ++r) acc[mt][r] = 0.f;
#pragma unroll
            for (int s = 0; s < 8; ++s)
#pragma unroll
                for (int mt = 0; mt < 4; ++mt) { const bf16x8 af = *(const LAS bf16x8*)(Wd + (32 * (4 * half + mt) + tk) * WST + 16 * s + 8 * hh); acc[mt] = mfma32(af, hb[s], acc[mt]);
                    if (mt == 3 && (s & 1)) asm volatile("" : "+v"(acc[0]), "+v"(acc[1]), "+v"(acc[2]), "+v"(acc[3]) :: "memory"); }
            typedef __attribute__((address_space(1))) bf16* gbp;
            gbp p0 = (gbp)(dst + (size_t)(g * 128 + 4 * hh) * ld + half * Lh + l);
#pragma unroll
            for (int mt = 0; mt < 4; ++mt) {
#pragma unroll
                for (int rq = 0; rq < 4; ++rq) {
                    gbp p = p0 + (size_t)(32 * mt + 8 * rq) * ld;
                    asm volatile("" : "+v"(p));
#pragma unroll
                    for (int e = 0; e < 4; ++e) p[(size_t)e * ld] = f2bf(acc[mt][4 * rq + e]);
                }
            }
        }
    }
}

constexpr int NPHASE = 20;
__global__ void __launch_bounds__(512, 2) mk_fwd(Args a0) {
    extern __shared__ __attribute__((aligned(16))) unsigned char lds_raw[];
    LAS unsigned char* lds = (LAS unsigned char*)lds_raw;
    const int tid = threadIdx.x, bid = blockIdx.x, G = gridDim.x;
    volatile LAS unsigned* MISC = (volatile LAS unsigned*)(lds + MISC_OFF);
    if (tid < 32) MISC[tid] = 0u;
    if (tid < 29) *(LAS unsigned long long*)(lds + PTAB_OFF + 8 * tid) = (unsigned long long)(tid < 27 ? a0.in[tid] : tid == 27 ? (const void*)a0.out : (const void*)a0.ws);
    __syncthreads();
    const int ph_lo = a0.ph_lo, ph_hi = a0.ph_hi;
    unsigned char* const ws_ctl = a0.ws;
    const bool one_launch = (ph_hi - ph_lo) > 1;
    XcdBarrier bar; bar.bar = (unsigned*)(ws_ctl + WS_CTL) + 4096; bar.x = 0; bar.st = nullptr;
    if (one_launch) bar = xcd_barrier_post((unsigned*)(ws_ctl + WS_CTL) + 4096, MISC + 8);
#ifndef DUP_PHASE
#define DUP_PHASE -1
#endif
#ifndef DUP_N
#define DUP_N 2
#endif
#ifndef ONLY_PHASE
#define ONLY_PHASE -1
#endif
#define XSL(i) ((unsigned*)(a.ws + WS_XSLOT) + (size_t)(i) * 2 * 64 * 160 * 4)
#define XCN(i) ((unsigned*)(a.ws + WS_CTL) + 8192 + (i) * 2 * 64 * 16)
#define IN(k) ((ONLY_PHASE < 0 || ONLY_PHASE == (k)) && ph_lo <= (k) && (k) < ph_hi)
#define SEAM(k) do { if (IN(k) && IN((k) + 1)) xcd_barrier(bar); } while (0)
    if (IN(1)) { const Args a = load_args(lds, ph_lo, ph_hi); const float* gains = FIN(I_GAINS); phase_prep<3>(a, lds, bid, G); phase_first_norm(a, lds, bid, G, gains + 0 * 1024); } SEAM(1);
    if (IN(2)) for (int rep_ = 0; rep_ < (DUP_PHASE == 2 ? DUP_N : 1); ++rep_) { if (rep_) xcd_barrier(bar); const Args a = load_args(lds, ph_lo, ph_hi); const float* gains = FIN(I_GAINS); (void)gains;
        pg8::Gemm g{1024, 1024, 1024}; pg8::PlainOrder160 S; S.init(WSB(WS_XN), WSB(WS_WIN), NT, INE_PAD, 1024, 1024, G, bid);
        EpiProj E{WSB(WS_Q), WSB(WS_KP), WSB(WS_KS), WSB(WS_VTP), WSB(WS_VTS), (bf16*)a.out, a.out + OUT_CK, a.out + OUT_CV, WSF(WS_ROPE)};
        pg8::gemm_phase160b(lds, g, S, E);
    } SEAM(2);
    if (IN(3)) for (int rep_ = 0; rep_ < (DUP_PHASE == 3 ? DUP_N : 1); ++rep_) { if (rep_) xcd_barrier(bar); const Args a = load_args(lds, ph_lo, ph_hi); const float* gains = FIN(I_GAINS); (void)gains;
#ifndef NO_FRONT
        phase_wkv_front(a, lds, bid, G);
#endif
#ifdef DUP_FRONT
        __syncthreads(); phase_wkv_front(a, lds, bid, G);
#endif
        __syncthreads();
#ifndef NO_ATT
        phase_attention(a, lds, bid, G);
#endif
#ifdef DUP_ATT
        __syncthreads(); phase_attention(a, lds, bid, G);
#endif
    } SEAM(3);
    if (IN(4)) for (int rep_ = 0; rep_ < (DUP_PHASE == 4 ? DUP_N : 1); ++rep_) { if (rep_) xcd_barrier(bar); const Args a = load_args(lds, ph_lo, ph_hi); const float* gains = FIN(I_GAINS); (void)gains;
#if defined(DUP_P4)
        phase_wkv_chain<true>(a, lds, bid, G); phase_prep<2>(a, lds, bid, G); xcd_barrier(bar);
#elif defined(DUP_CHAIN)
        phase_wkv_chain<true>(a, lds, bid, G); xcd_barrier(bar);
#elif defined(DUP_PREP2)
        phase_prep<2>(a, lds, bid, G); xcd_barrier(bar);
#endif
        phase_wkv_chain(a, lds, bid, G);
        if (G == 256) {
            const int wv_ = __builtin_amdgcn_readfirstlane(threadIdx.x >> 6);
            if (bid < 128) phase_prep<2>(a, lds, bid, G, wv_ == 0 ? -1 : (bid * 7 + wv_ - 1) * 7, 7, 6272);
        } else phase_prep<2>(a, lds, bid, G);
    } SEAM(4);
    if (IN(6)) for (int rep_ = 0; rep_ < (DUP_PHASE == 6 ? DUP_N : 1); ++rep_) { if (rep_) xcd_barrier(bar); const Args a = load_args(lds, ph_lo, ph_hi); const float* gains = FIN(I_GAINS); (void)gains;
        phase_combine<true>(a, bid, G);
        phase_transpose_wfi1(a, lds, bid, G);
        pg8::Gemm g{1024, 1024, 1024}; pg8::PlainOrder160 S; S.init(WSB(WS_XN), WSB(WS_WO), NT, 1024, 1024, 1024, G, bid);
        {
            pg8::Unit u0;
            if (S.next(0, u0) && u0.pm * 160 + 160 > NPR) {
                const unsigned want = (unsigned)(u0.pm * 160 + 160 - (u0.pm * 160 > NPR ? u0.pm * 160 : NPR));
                if (threadIdx.x == 0) { unsigned* pc = (unsigned*)(a.ws + WS_PCNT) + u0.pm * 16; unsigned spins = 0;
                    while (__hip_atomic_load(pc, __ATOMIC_RELAXED, __HIP_MEMORY_SCOPE_AGENT) < want) { __builtin_amdgcn_s_sleep(2); if (++spins > (1u << 20)) break; } }
            }
            __syncthreads();
        }
        EpiResNorm<true, false> E{FIN(I_XP), FIN(I_XS), nullptr, WSB(WS_XB), nullptr, WSB(WS_XN), gains + 1 * 1024, gains + 2 * 1024, WSF(WS_MOD), 2048, 0, 3072, 4096, 0, XSL(0), XCN(0)}; pg8::gemm_phase160b(lds, g, S, E);
    } SEAM(6);
    if (IN(8)) for (int rep_ = 0; rep_ < (DUP_PHASE == 8 ? DUP_N : 1); ++rep_) { if (rep_) xcd_barrier(bar); const Args a = load_args(lds, ph_lo, ph_hi); const float* gains = FIN(I_GAINS); (void)gains;
        pg8::Gemm g{1024, 1024, 1024}; pg8::PlainOrder S; S.init(WSB(WS_XN), WSB(WS_WFI), NT, DFF2, 1024, 1024, G, bid);
        EpiFfnConv E{WSB(WS_ACT), FIN(I_CONVW), FIN(I_CONVB), WSF(WS_SB), (LAS float*)(lds + 131072)}; pg8::gemm_phase(lds, g, S, E);
    }
    SEAM(8);
    if (IN(10)) for (int rep_ = 0; rep_ < (DUP_PHASE == 10 ? DUP_N : 1); ++rep_) { if (rep_) xcd_barrier(bar); const Args a = load_args(lds, ph_lo, ph_hi); const float* gains = FIN(I_GAINS); (void)gains;
        pg8::Gemm g{DFF, DFF, DFF}; pg8::PlainOrder160 S; S.init(WSB(WS_ACT), WSB(WS_WFO), NT, 1024, DFF, DFF, G, bid);
        ffn_seam_fixup(S, 160, WSB(WS_ACT), FIN(I_CONVW), WSF(WS_SB));
        EpiResNorm<false, false> E{nullptr, nullptr, WSB(WS_XB), WSB(WS_XB), nullptr, WSB(WS_XN), gains + 3 * 1024, gains + 4 * 1024, WSF(WS_MOD), 5120, 0, 0, 1024, 1, XSL(1), XCN(1)}; pg8::gemm_phase160b(lds, g, S, E);
    } SEAM(10);
    if (IN(12)) for (int rep_ = 0; rep_ < (DUP_PHASE == 12 ? DUP_N : 1); ++rep_) { if (rep_) xcd_barrier(bar); const Args a = load_args(lds, ph_lo, ph_hi); const float* gains = FIN(I_GAINS); (void)gains; phase_chdft(a, lds, bid, G); } SEAM(12);
    if (IN(13)) for (int rep_ = 0; rep_ < (DUP_PHASE == 13 ? DUP_N : 1); ++rep_) { if (rep_) xcd_barrier(bar); const Args a = load_args(lds, ph_lo, ph_hi); const float* gains = FIN(I_GAINS); (void)gains;
        { pg8::Gemm g{512, 512, 512}; DftOrder S{G, bid, (const char*)WSB(WS_A2P), (const char*)WSB(WS_YTS), (const char*)WSB(WS_YTP)}; EpiDft E{WSB(WS_XN)}; pg8::gemm_phase(lds, g, S, E); }
    } SEAM(13);
    if (IN(14)) for (int rep_ = 0; rep_ < (DUP_PHASE == 14 ? DUP_N : 1); ++rep_) { if (rep_) xcd_barrier(bar); const Args a = load_args(lds, ph_lo, ph_hi); const float* gains = FIN(I_GAINS); (void)gains;
        pg8::Gemm g{1024, 1024, 1024}; pg8::PlainOrder160 S; S.init(WSB(WS_XN), WSB(WS_WODD), NT, 1024, 1024, 1024, G, bid);
        EpiResNorm<false, false> E{nullptr, nullptr, WSB(WS_XB), WSB(WS_XB), nullptr, WSB(WS_XN), gains + 5 * 1024, gains + 6 * 1024, WSF(WS_MOD), 2048, 1, 3072, 4096, 1, XSL(2), XCN(2)}; pg8::gemm_phase160b(lds, g, S, E);
    } SEAM(14);
    if (IN(16)) for (int rep_ = 0; rep_ < (DUP_PHASE == 16 ? DUP_N : 1); ++rep_) { if (rep_) xcd_barrier(bar); const Args a = load_args(lds, ph_lo, ph_hi); const float* gains = FIN(I_GAINS); (void)gains;
        pg8::Gemm g{1024, 1024, 1024}; pg8::PlainOrder S; S.init(WSB(WS_XN), WSB(WS_WFI) + (size_t)DFF2 * 1024, NT, DFF2, 1024, 1024, G, bid);
        EpiFfnConv E{WSB(WS_ACT), FIN(I_CONVW) + 3 * DFF, FIN(I_CONVB) + DFF, WSF(WS_SB), (LAS float*)(lds + 131072)}; pg8::gemm_phase(lds, g, S, E);
    }
    SEAM(16);
    if (IN(18)) for (int rep_ = 0; rep_ < (DUP_PHASE == 18 ? DUP_N : 1); ++rep_) { if (rep_) xcd_barrier(bar); const Args a = load_args(lds, ph_lo, ph_hi); const float* gains = FIN(I_GAINS); (void)gains;
        pg8::Gemm g{DFF, DFF, DFF}; pg8::PlainOrder160 S; S.init(WSB(WS_ACT), WSB(WS_WFO) + (size_t)1024 * DFF, NT, 1024, DFF, DFF, G, bid);
        ffn_seam_fixup(S, 160, WSB(WS_ACT), FIN(I_CONVW) + 3 * DFF, WSF(WS_SB));
        EpiResNorm<false, true> E{nullptr, nullptr, WSB(WS_XB), nullptr, a.out, nullptr, gains + 7 * 1024, nullptr, WSF(WS_MOD), 5120, 1, 0, 0, 1, XSL(3), XCN(3)}; pg8::gemm_phase160b(lds, g, S, E);
    }
#undef IN
#undef SEAM
#undef XSL
#undef XCN
}

extern "C" void kernel_launch(void* const* d_in, const int* in_sizes, int n_in, void* d_out, int out_size, void* d_ws, size_t ws_size, hipStream_t stream) {
    static int grid = 0;
    if (grid == 0) {
        if (n_in != 27 || ws_size < WS_END) { fprintf(stderr, "kernel_launch: unexpected n_in %d / ws %zu\n", n_in, ws_size); grid = -1; return; }
        int dev = 0, cus = 0;
        if (hipGetDevice(&dev) != hipSuccess || hipDeviceGetAttribute(&cus, hipDeviceAttributeMultiprocessorCount, dev) != hipSuccess) { grid = -1; return; }
        if (hipFuncSetAttribute((const void*)mk_fwd, hipFuncAttributeMaxDynamicSharedMemorySize, LDS_BYTES) != hipSuccess) { fprintf(stderr, "kernel_launch: hipFuncSetAttribute failed\n"); grid = -1; return; }
        (void)hipGetLastError();
        if (cus < 256) { fprintf(stderr, "kernel_launch: needs 256 CUs (one workgroup per CU, 256 GEMM units per fused-norm phase), found %d\n", cus); grid = -1; return; }
        grid = 256;
    }
    if (grid < 0) return;
    (void)hipMemsetAsync((char*)d_ws + WS_CTL, 0, CTL_ZERO_BYTES, stream);
    Args a{};
    for (int i = 0; i < 27; ++i) a.in[i] = d_in[i];
    a.out = (float*)d_out; a.ws = (unsigned char*)d_ws;
#if MK_N_LAUNCHES == 1
    a.ph_lo = 0; a.ph_hi = NPHASE;
    hipLaunchKernelGGL(mk_fwd, dim3(grid), dim3(512), LDS_BYTES, stream, a);
#else
    for (int ph = 0; ph < NPHASE; ++ph) { a.ph_lo = ph; a.ph_hi = ph + 1; hipLaunchKernelGGL(mk_fwd, dim3(grid), dim3(512), LDS_BYTES, stream, a); }
#endif
}
```

```cpp
#include <hip/hip_runtime.h>
#include <type_traits>
#include <cstdio>
#include <cstdint>

#ifndef MK_N_LAUNCHES
#define MK_N_LAUNCHES 1
#endif

#define LAS __attribute__((address_space(3)))
typedef unsigned short bf16;
typedef short bf16x8 __attribute__((ext_vector_type(8)));
typedef float f32x4 __attribute__((ext_vector_type(4)));
typedef float f32x2 __attribute__((ext_vector_type(2)));
typedef float f32x16 __attribute__((ext_vector_type(16)));
typedef unsigned u32x4 __attribute__((ext_vector_type(4)));
typedef unsigned u32x2 __attribute__((ext_vector_type(2)));
typedef __bf16 bf16x2_t __attribute__((ext_vector_type(2)));

constexpr int DM = 1024;
constexpr int NPR = 8192, NSA = 2048, NT = 10240;
constexpr int SEQ = 256, DSEQ = 1024, PAST = 256, LKS = 1280;
constexpr int INE = 3456, INE_PAD = 3584, INB = 1920, DFF = 2816, DFF2 = 5632;
constexpr int OUT_YP = 0, OUT_CK = 10485760, OUT_CV = 14680064, OUT_ST = 18874368;

constexpr size_t MiB = 1u << 20;
constexpr size_t WS_CTL = 252 * MiB, CTL_ZERO_BYTES = 65536 + 1310720;
constexpr size_t WS_MOD = 1 * MiB;
constexpr size_t WS_ROPE = 1 * MiB + 256 * 1024;
constexpr size_t WS_LAM = 1 * MiB + 768 * 1024;
constexpr size_t WS_WIN = 2 * MiB;
constexpr size_t WS_WO = 9 * MiB;
constexpr size_t WS_WODD = 11 * MiB;
constexpr size_t WS_WFI = 13 * MiB;
constexpr size_t WS_WFO = 35 * MiB;
constexpr size_t WS_W2T = 46 * MiB;
constexpr size_t WS_A2T = 46 * MiB + 128 * 1024;
constexpr size_t WS_G2T = 46 * MiB + 256 * 1024;
constexpr size_t WS_WDFT = 46 * MiB + 512 * 1024;
constexpr size_t WS_A2P = 46 * MiB + 768 * 1024;
constexpr size_t WS_XN = 52 * MiB;
constexpr size_t WS_MF = 72 * MiB;
constexpr size_t WS_XB = 92 * MiB;
constexpr size_t WS_BIG = 112 * MiB;
constexpr size_t WS_Q = 216 * MiB;
constexpr size_t WS_KP = 226 * MiB;
constexpr size_t WS_KS = 234 * MiB;
constexpr size_t WS_VTP = 237 * MiB;
constexpr size_t WS_VTS = 245 * MiB;
constexpr size_t WS_BONUS = 24 * MiB;
constexpr size_t WS_ACT = WS_BIG;
constexpr size_t WS_SB = 51 * MiB;
constexpr size_t WS_F32B = WS_MF;
constexpr size_t WS_YTP = WS_BIG;
constexpr size_t WS_YTS = WS_BIG + 32 * MiB;
constexpr size_t WS_MOD1 = WS_CTL + 32768;
constexpr size_t WS_PCNT = WS_CTL + 57344;
constexpr size_t WS_XSLOT = WS_CTL + 65536;
constexpr size_t WS_END = 256 * MiB;
static_assert(WS_ACT + (size_t)NT * DFF * 2 <= WS_END, "ws");

constexpr int RING_BYTES = 131072;
constexpr int ACT_OFF = 147456;
constexpr int MISC_OFF = 160256;
constexpr int PTAB_OFF = 160512;
constexpr int LDS_BYTES = 160768;

__device__ __forceinline__ unsigned pk2(float lo, float hi) { f32x2 v = {lo, hi}; bf16x2_t b = __builtin_convertvector(v, bf16x2_t); return __builtin_bit_cast(unsigned, b); }
__device__ __forceinline__ bf16 f2bf(float f) { return (bf16)(pk2(f, 0.f) & 0xffffu); }
__device__ __forceinline__ float bf2f(unsigned b) { return __uint_as_float(b << 16); }
__device__ __forceinline__ u32x2 pk4(f32x4 v) { u32x2 o; o.x = pk2(v[0], v[1]); o.y = pk2(v[2], v[3]); return o; }
__device__ __forceinline__ f32x4 unpk4(u32x2 w) { f32x4 v; v[0] = __uint_as_float(w.x << 16); v[1] = __uint_as_float(w.x & 0xffff0000u); v[2] = __uint_as_float(w.y << 16); v[3] = __uint_as_float(w.y & 0xffff0000u); return v; }
__device__ __forceinline__ float sigmoidf_(float x) { return __builtin_amdgcn_rcpf(1.f + __expf(-x)); }
__device__ __forceinline__ float wave_sum(float v) {
#pragma unroll
    for (int o = 1; o < 64; o <<= 1) v += __shfl_xor(v, o);
    return v;
}
__device__ __forceinline__ int keypos(int key) { return (key & ~12) | ((key & 4) << 1) | ((key & 8) >> 1); }

#define XB_TMO      128
#define XB_XCNT(j)  (256  + 64 * (j))
#define XB_XSUB(j)  (1280 + 64 * (j))
#define XB_XGEN(j)  (2304 + 64 * (j))
#define XB_TOP      3328
#define XB_TOPGEN   3392
#define XCD_BAR_WORDS 3456
#define XB_SPIN_CAP (1u << 20)
__device__ __forceinline__ unsigned xb_ld(unsigned* p)              { return __hip_atomic_load(p, __ATOMIC_RELAXED, __HIP_MEMORY_SCOPE_AGENT); }
__device__ __forceinline__ unsigned xb_add(unsigned* p, unsigned v) { return __hip_atomic_fetch_add(p, v, __ATOMIC_RELAXED, __HIP_MEMORY_SCOPE_AGENT); }
__device__ __forceinline__ unsigned xb_xcc_id() { return (unsigned)__builtin_amdgcn_s_getreg((3 << 11) | 20) & 0xFu; }
#define XB_SPIN(cond, bar) do { unsigned _sp = 0; while (cond) { __builtin_amdgcn_s_sleep(1); \
    if ((++_sp & 255u) == 0u) { if (xb_ld(&(bar)[XB_TMO])) break; if (_sp > XB_SPIN_CAP) { atomicAdd(&(bar)[XB_TMO], 1u); break; } } } } while (0)
struct XcdBarrier { unsigned* bar; unsigned x; volatile LAS unsigned* st; };
__device__ __forceinline__ XcdBarrier xcd_barrier_post(unsigned* bar, volatile LAS unsigned* st) {
    XcdBarrier b; b.bar = bar; b.x = xb_xcc_id(); b.st = st;
    if (threadIdx.x == 0) (void)xb_add(&bar[XB_XCNT(b.x)], 1u);
    return b;
}
__device__ __forceinline__ void xcd_barrier_complete(unsigned* bar, unsigned x, unsigned& nloc, unsigned& nx) {
    const unsigned G = gridDim.x * gridDim.y * gridDim.z;
    unsigned sum, cnt, mine, sp = 0u;
    for (;;) {
        sum = 0u; cnt = 0u; mine = 0u;
#pragma unroll
        for (unsigned j = 0; j < 16; ++j) { const unsigned c = xb_ld(&bar[XB_XCNT(j)]); sum += c; cnt += (c > 0u) ? 1u : 0u; mine = (j == x) ? c : mine; }
        if (sum == G) break;
        __builtin_amdgcn_s_sleep(1);
        if ((++sp & 255u) == 0u) { if (xb_ld(&bar[XB_TMO])) break; if (sp > XB_SPIN_CAP) { atomicAdd(&bar[XB_TMO], 1u); break; } }
    }
    nloc = mine > 0u ? mine : 1u; nx = cnt > 0u ? cnt : 1u;
}
__device__ __forceinline__ void xcd_barrier(const XcdBarrier& b) {
    asm volatile("s_waitcnt vmcnt(0)" ::: "memory");
    __syncthreads();
    if (threadIdx.x == 0) {
        unsigned* bar = b.bar;
        __builtin_amdgcn_s_waitcnt(0);
        unsigned nloc = b.st[0], nx = b.st[1];
        if (nloc == 0u) { xcd_barrier_complete(bar, b.x, nloc, nx); b.st[0] = nloc; b.st[1] = nx; }
        const unsigned old = xb_add(&bar[XB_XSUB(b.x)], 1u);
        const unsigned gen = old / nloc;
        if (old + 1u == (gen + 1u) * nloc) {
            __builtin_amdgcn_fence(__ATOMIC_RELEASE, "agent");
            asm volatile("s_waitcnt vmcnt(0)" ::: "memory");
            const unsigned og = xb_add(&bar[XB_TOP], 1u);
            const unsigned tg = og / nx;
            if (og + 1u == (tg + 1u) * nx) xb_add(&bar[XB_TOPGEN], 1u);
            else XB_SPIN(xb_ld(&bar[XB_TOPGEN]) == tg, bar);
            xb_add(&bar[XB_XGEN(b.x)], 1u);
            __builtin_amdgcn_fence(__ATOMIC_ACQUIRE, "agent");
            asm volatile("s_waitcnt vmcnt(0)" ::: "memory");
        } else {
            XB_SPIN(xb_ld(&bar[XB_XGEN(b.x)]) == gen, bar);
            __builtin_amdgcn_fence(__ATOMIC_ACQUIRE, "agent");
            asm volatile("s_waitcnt vmcnt(0)" ::: "memory");
        }
    }
    __syncthreads();
}

namespace pg8 {
constexpr int BM = 256, BK = 64, HALF = 128, HTB = HALF * BK * 2, STAGE_BYTES = 8 * HTB, NXCD = 8, WGM = 8;
__host__ __device__ __forceinline__ int lds_byte(int r, int c) { const int st = (r >> 4) * 2 + (c >> 5), rr = r & 15, cc = c & 31, ob = rr * 64 + cc * 2; return st * 1024 + (ob ^ (((ob >> 9) & 1) << 5)); }
__host__ __device__ __forceinline__ void stage_rc(int b, int& R, int& C) { const int st = b / 1024, sb = b % 1024, swz = sb ^ (((sb >> 9) & 1) << 5); R = (st >> 1) * 16 + swz / 64; C = (st & 1) * 32 + (swz % 64) / 2; }

struct Unit { int pm, pn, z; const char* a; const char* b; };
struct Gemm { int lda, ldb, K; };

struct PlainOrder {
    int nM, nN, nwg, G, c; const char* A; const char* Bt; size_t ta, tb;
    __device__ void init(const void* A_, const void* Bt_, int M, int N, int lda, int ldb, int G_, int c_) { A = (const char*)A_; Bt = (const char*)Bt_; nM = M / BM; nN = N / BM; nwg = nM * nN; G = G_; c = c_; ta = (size_t)BM * lda * 2; tb = (size_t)BM * ldb * 2; }
    __device__ __forceinline__ bool next(int i, Unit& u) const {
        const long L = (long)i * G + c; if (L >= nwg) return false;
        int wgid = (int)L; { const int q = nwg / NXCD, r = nwg % NXCD, xcd = wgid % NXCD, off = wgid / NXCD; wgid = (xcd < r ? xcd * (q + 1) : r * (q + 1) + (xcd - r) * q) + off; }
        const int nig = WGM * nN, gid = wgid / nig, fm = gid * WGM, gsz = (nM - fm) < WGM ? (nM - fm) : WGM;
        u.pm = fm + ((wgid % nig) % gsz); u.pn = (wgid % nig) / gsz; u.z = 0;
        u.a = A + (size_t)u.pm * ta; u.b = Bt + (size_t)u.pn * tb; return true;
    }
};

template <class F> __device__ __forceinline__ void epi_each(const f32x4 (&acc)[2][2][4][2], int row0, int col0, F&& f) {
#pragma unroll
    for (int ai = 0; ai < 2; ++ai)
#pragma unroll
        for (int m = 0; m < 4; ++m)
#pragma unroll
            for (int bj = 0; bj < 2; ++bj)
#pragma unroll
                for (int n = 0; n < 2; ++n) f(row0 + ai * HALF + m * 16, col0 + bj * HALF + n * 16, acc[ai][bj][m][n]);
}

template <class Epi, class Sched>
__device__ __forceinline__ void gemm_phase(LAS unsigned char* lds, const Gemm g, const Sched& S, const Epi& E) {
    int tid = threadIdx.x; asm volatile("" : "+v"(tid));
    const int wid = __builtin_amdgcn_readfirstlane(tid >> 6), lane = tid & 63, wr = wid >> 2, wc = wid & 3, fr = lane & 15, fq = lane >> 4;
    const int K = g.K, nt = K / BK;
    unsigned voffA[2], voffB[2];
#pragma unroll
    for (int i = 0; i < 2; ++i) { int R, C; stage_rc(tid * 16 + i * 8192, R, C); voffA[i] = (unsigned)(R * g.lda + C) * 2u; voffB[i] = (unsigned)(R * g.ldb + C) * 2u; }
    const size_t kstep = (size_t)(BK * 2);
    const size_t hstepA = (size_t)HALF * g.lda * 2, hstepB = (size_t)HALF * g.ldb * 2;
    const unsigned ldsw = (unsigned)wid * 1024u;
    const int aoff = lds_byte(wr * 64 + fr, fq * 8), boff = lds_byte(wc * 32 + fr, fq * 8);
#define PG8_SA(b, h) (((b) * 2 + (h)) * HTB)
#define PG8_SB(b, h) ((4 + (b) * 2 + (h)) * HTB)
#define PG8_STAGE(bufoff, gbase, voff) do { _Pragma("unroll") for (int _i = 0; _i < 2; ++_i) \
        __builtin_amdgcn_global_load_lds((const unsigned*)((const char*)(gbase) + (voff)[_i]), (LAS unsigned*)(lds + (bufoff) + ldsw + _i * 8192), 16, 0, 0); } while (0)
#define PG8_LDA(dst, b, h) do { _Pragma("unroll") for (int m = 0; m < 4; ++m) _Pragma("unroll") for (int k = 0; k < 2; ++k) dst[m][k] = *(const LAS bf16x8*)(lds + PG8_SA(b, h) + aoff + m * 2048 + k * 1024); } while (0)
#define PG8_LDB(dst, b, h) do { _Pragma("unroll") for (int n = 0; n < 2; ++n) _Pragma("unroll") for (int k = 0; k < 2; ++k) dst[n][k] = *(const LAS bf16x8*)(lds + PG8_SB(b, h) + boff + n * 2048 + k * 1024); } while (0)
#define PG8_MMA(ai, bj, At, Bt) do { __builtin_amdgcn_s_setprio(1); _Pragma("unroll") for (int m = 0; m < 4; ++m) _Pragma("unroll") for (int n = 0; n < 2; ++n) _Pragma("unroll") for (int k = 0; k < 2; ++k) \
        acc[ai][bj][m][n] = __builtin_amdgcn_mfma_f32_16x16x32_bf16(Bt[n][k], At[m][k], acc[ai][bj][m][n], 0, 0, 0); __builtin_amdgcn_s_setprio(0); } while (0)
#define PG8_WAIT_V(n) asm volatile("s_waitcnt vmcnt(" #n ")" ::: "memory")
#define PG8_WAIT_L(n) asm volatile("s_waitcnt lgkmcnt(" #n ")" ::: "memory")
#define PG8_BAR __builtin_amdgcn_s_barrier()
#define PG8_SCHED __builtin_amdgcn_sched_barrier(0)
    Unit cur, nxt; int ui = 0;
    if (!S.next(0, cur)) return;
    f32x4 acc[2][2][4][2];
#pragma unroll
    for (int a = 0; a < 2; ++a)
#pragma unroll
        for (int b = 0; b < 2; ++b)
#pragma unroll
            for (int m = 0; m < 4; ++m)
#pragma unroll
                for (int n = 0; n < 2; ++n) acc[a][b][m][n] = (f32x4){0.f, 0.f, 0.f, 0.f};
    bf16x8 At[4][2], B0[2][2], B1[2][2];
    const char* cA = cur.a; const char* cB = cur.b;
    PG8_STAGE(PG8_SB(0, 0), cB, voffB); PG8_STAGE(PG8_SA(0, 0), cA, voffA); PG8_STAGE(PG8_SB(0, 1), cB + hstepB, voffB); PG8_STAGE(PG8_SA(0, 1), cA + hstepA, voffA);
    if (wr == 1) PG8_BAR;
    PG8_WAIT_V(4); PG8_BAR;
    PG8_STAGE(PG8_SB(1, 0), cB + kstep, voffB); PG8_STAGE(PG8_SA(1, 0), cA + kstep, voffA); PG8_STAGE(PG8_SB(1, 1), cB + hstepB + kstep, voffB);
    PG8_WAIT_V(6); PG8_BAR;
    for (;;) {
        const bool has_next = S.next(ui + 1, nxt);
        const char* nA = has_next ? nxt.a : cA; const char* nB = has_next ? nxt.b : cB;
        for (int t = 0; t < nt; t += 2) {
            const bool last = (t == nt - 2);
            const char* a1 = cA + (size_t)(t + 1) * kstep;
            const char* a2 = last ? nA : cA + (size_t)(t + 2) * kstep; const char* b2 = last ? nB : cB + (size_t)(t + 2) * kstep;
            const char* a3 = a2 + kstep; const char* b3 = b2 + kstep;
            PG8_LDB(B0, 0, 0); PG8_SCHED; PG8_LDA(At, 0, 0); PG8_STAGE(PG8_SA(1, 1), a1 + hstepA, voffA);
            PG8_WAIT_L(8); PG8_BAR; PG8_WAIT_L(0); PG8_MMA(0, 0, At, B0); PG8_BAR; PG8_SCHED;
            PG8_LDB(B1, 0, 1); PG8_STAGE(PG8_SB(0, 0), b2, voffB);
            PG8_BAR; PG8_WAIT_L(0); PG8_MMA(0, 1, At, B1); PG8_BAR;
            PG8_LDA(At, 0, 1); PG8_STAGE(PG8_SA(0, 0), a2, voffA);
            PG8_BAR; PG8_WAIT_L(0); PG8_MMA(1, 0, At, B0); PG8_BAR; PG8_SCHED;
            PG8_STAGE(PG8_SB(0, 1), b2 + hstepB, voffB);
            PG8_WAIT_V(6); PG8_BAR; PG8_MMA(1, 1, At, B1); PG8_BAR;
            PG8_LDB(B0, 1, 0); PG8_SCHED; PG8_LDA(At, 1, 0); PG8_STAGE(PG8_SA(0, 1), a2 + hstepA, voffA);
            PG8_WAIT_L(8); PG8_BAR; PG8_WAIT_L(0); PG8_MMA(0, 0, At, B0); PG8_BAR; PG8_SCHED;
            PG8_LDB(B1, 1, 1); PG8_STAGE(PG8_SB(1, 0), b3, voffB);
            PG8_BAR; PG8_WAIT_L(0); PG8_MMA(0, 1, At, B1); PG8_BAR;
            PG8_LDA(At, 1, 1); PG8_STAGE(PG8_SA(1, 0), a3, voffA);
            PG8_BAR; PG8_WAIT_L(0); PG8_MMA(1, 0, At, B0); PG8_BAR; PG8_SCHED;
            PG8_STAGE(PG8_SB(1, 1), b3 + hstepB, voffB);
            PG8_WAIT_V(6); PG8_BAR; PG8_MMA(1, 1, At, B1); PG8_BAR;
        }
        if constexpr (Epi::ALIGN) { if (wr == 0) PG8_BAR; }
        E(acc, cur, wr, wc, fr, fq);
        if (!has_next) break;
#pragma unroll
        for (int a = 0; a < 2; ++a)
#pragma unroll
            for (int b = 0; b < 2; ++b)
#pragma unroll
                for (int m = 0; m < 4; ++m)
#pragma unroll
                    for (int n = 0; n < 2; ++n) acc[a][b][m][n] = (f32x4){0.f, 0.f, 0.f, 0.f};
        cur = nxt; cA = nA; cB = nB; ++ui;
        if constexpr (Epi::ALIGN) { if (wr == 1) PG8_BAR; }
    }
    PG8_WAIT_V(0);
    if constexpr (!Epi::ALIGN) { if (wr == 0) PG8_BAR; }
    PG8_BAR;
#undef PG8_SA
#undef PG8_SB
#undef PG8_STAGE
#undef PG8_LDA
#undef PG8_LDB
#undef PG8_MMA
#undef PG8_WAIT_V
#undef PG8_WAIT_L
#undef PG8_BAR
#undef PG8_SCHED
}

struct PlainOrder160 {
    int nM, nN, nwg, G, c; const char* A; const char* Bt; size_t ta, tb;
    __device__ void init(const void* A_, const void* Bt_, int M, int N, int lda, int ldb, int G_, int c_) { A = (const char*)A_; Bt = (const char*)Bt_; nM = M / 160; nN = N / BM; nwg = nM * nN; G = G_; c = c_; ta = (size_t)160 * lda * 2; tb = (size_t)BM * ldb * 2; }
    __device__ __forceinline__ bool next(int i, Unit& u) const {
        const long L = (long)i * G + c; if (L >= nwg) return false;
        int wgid = (int)L; { const int q = nwg / NXCD, r = nwg % NXCD, xcd = wgid % NXCD, off = wgid / NXCD; wgid = (xcd < r ? xcd * (q + 1) : r * (q + 1) + (xcd - r) * q) + off; }
        const int nig = WGM * nN, gid = wgid / nig, fm = gid * WGM, gsz = (nM - fm) < WGM ? (nM - fm) : WGM;
        u.pm = fm + ((wgid % nig) % gsz); u.pn = (wgid % nig) / gsz; u.z = 0;
        u.a = A + (size_t)u.pm * ta; u.b = Bt + (size_t)u.pn * tb; return true;
    }
};
template <class Epi, class Sched>
__device__ __forceinline__ void gemm_phase160(LAS unsigned char* lds, const Gemm g, const Sched& S, const Epi& E) {
    int tid = threadIdx.x; asm volatile("" : "+v"(tid));
    const int wid = __builtin_amdgcn_readfirstlane(tid >> 6), lane = tid & 63, half = wid >> 2, fr = lane & 15, fq = lane >> 4;
    const int K = g.K, nt = K / BK;
    constexpr int HTA = 80 * BK * 2;
    unsigned voffA[2], voffB[2];
    { int R, C; stage_rc(tid * 16, R, C); voffA[0] = (unsigned)(R * g.lda + C) * 2u; stage_rc((512 + (tid & 127)) * 16, R, C); voffA[1] = (unsigned)(R * g.lda + C) * 2u; }
#pragma unroll
    for (int i = 0; i < 2; ++i) { int R, C; stage_rc(tid * 16 + i * 8192, R, C); voffB[i] = (unsigned)(R * g.ldb + C) * 2u; }
    const size_t kstep = (size_t)(BK * 2);
    const size_t hstepA = (size_t)80 * g.lda * 2, hstepB = (size_t)HALF * g.ldb * 2;
    const unsigned ldswA0 = (unsigned)wid * 1024u, ldswA1 = 8192u + (unsigned)(wid & 1) * 1024u, ldswB = (unsigned)wid * 1024u;
    const int aoff = lds_byte(fr, fq * 8), boff = lds_byte(wid * 16 + fr, fq * 8);
#define PG8_SA(b, h) (((b) * 2 + (h)) * HTA)
#define PG8_SB(b, h) (4 * HTA + ((b) * 2 + (h)) * HTB)
#define PG8_STAGEA(bufoff, gbase) do { \
        __builtin_amdgcn_global_load_lds((const unsigned*)((const char*)(gbase) + voffA[0]), (LAS unsigned*)(lds + (bufoff) + ldswA0), 16, 0, 0); \
        __builtin_amdgcn_global_load_lds((const unsigned*)((const char*)(gbase) + voffA[1]), (LAS unsigned*)(lds + (bufoff) + ldswA1), 16, 0, 0); } while (0)
#define PG8_STAGEB(bufoff, gbase) do { _Pragma("unroll") for (int _i = 0; _i < 2; ++_i) \
        __builtin_amdgcn_global_load_lds((const unsigned*)((const char*)(gbase) + voffB[_i]), (LAS unsigned*)(lds + (bufoff) + ldswB + _i * 8192), 16, 0, 0); } while (0)
#define PG8_LDA(dst, b, h) do { _Pragma("unroll") for (int m = 0; m < 5; ++m) _Pragma("unroll") for (int k = 0; k < 2; ++k) dst[m][k] = *(const LAS bf16x8*)(lds + PG8_SA(b, h) + aoff + m * 2048 + k * 1024); } while (0)
#define PG8_LDB(dst, b, h) do { _Pragma("unroll") for (int k = 0; k < 2; ++k) dst[k] = *(const LAS bf16x8*)(lds + PG8_SB(b, h) + boff + k * 1024); } while (0)
#define PG8_MMA(ai, bj, At, Bt) do { __builtin_amdgcn_s_setprio(1); _Pragma("unroll") for (int m = 0; m < 5; ++m) _Pragma("unroll") for (int k = 0; k < 2; ++k) \
        acc[ai][bj][m] = __builtin_amdgcn_mfma_f32_16x16x32_bf16(Bt[k], At[m][k], acc[ai][bj][m], 0, 0, 0); __builtin_amdgcn_s_setprio(0); } while (0)
#define PG8_WAIT_V(n) asm volatile("s_waitcnt vmcnt(" #n ")" ::: "memory")
#define PG8_WAIT_L(n) asm volatile("s_waitcnt lgkmcnt(" #n ")" ::: "memory")
#define PG8_BAR __builtin_amdgcn_s_barrier()
#define PG8_SCHED __builtin_amdgcn_sched_barrier(0)
    Unit cur, nxt; int ui = 0;
    if (!S.next(0, cur)) return;
    f32x4 acc[2][2][5];
#pragma unroll
    for (int a = 0; a < 2; ++a)
#pragma unroll
        for (int b = 0; b < 2; ++b)
#pragma unroll
            for (int m = 0; m < 5; ++m) acc[a][b][m] = (f32x4){0.f, 0.f, 0.f, 0.f};
    bf16x8 At[5][2], B0[2], B1[2];
    const char* cA = cur.a; const char* cB = cur.b;
    PG8_STAGEB(PG8_SB(0, 0), cB); PG8_STAGEA(PG8_SA(0, 0), cA); PG8_STAGEB(PG8_SB(0, 1), cB + hstepB); PG8_STAGEA(PG8_SA(0, 1), cA + hstepA);
    if (half == 1) PG8_BAR;
    PG8_WAIT_V(4); PG8_BAR;
    PG8_STAGEB(PG8_SB(1, 0), cB + kstep); PG8_STAGEA(PG8_SA(1, 0), cA + kstep); PG8_STAGEB(PG8_SB(1, 1), cB + hstepB + kstep);
    PG8_WAIT_V(6); PG8_BAR;
    for (;;) {
        const bool has_next = S.next(ui + 1, nxt);
        const char* nA = has_next ? nxt.a : cA; const char* nB = has_next ? nxt.b : cB;
        for (int t = 0; t < nt; t += 2) {
            const bool last = (t == nt - 2);
            const char* a1 = cA + (size_t)(t + 1) * kstep;
            const char* a2 = last ? nA : cA + (size_t)(t + 2) * kstep; const char* b2 = last ? nB : cB + (size_t)(t + 2) * kstep;
            const char* a3 = a2 + kstep; const char* b3 = b2 + kstep;
            PG8_LDB(B0, 0, 0); PG8_SCHED; PG8_LDA(At, 0, 0); PG8_STAGEA(PG8_SA(1, 1), a1 + hstepA);
            PG8_WAIT_L(10); PG8_BAR; PG8_WAIT_L(0); PG8_MMA(0, 0, At, B0); PG8_BAR; PG8_SCHED;
            PG8_LDB(B1, 0, 1); PG8_STAGEB(PG8_SB(0, 0), b2);
            PG8_BAR; PG8_WAIT_L(0); PG8_MMA(0, 1, At, B1); PG8_BAR;
            PG8_LDA(At, 0, 1); PG8_STAGEA(PG8_SA(0, 0), a2);
            PG8_BAR; PG8_WAIT_L(0); PG8_MMA(1, 0, At, B0); PG8_BAR; PG8_SCHED;
            PG8_STAGEB(PG8_SB(0, 1), b2 + hstepB);
            PG8_WAIT_V(6); PG8_BAR; PG8_MMA(1, 1, At, B1); PG8_BAR;
            PG8_LDB(B0, 1, 0); PG8_SCHED; PG8_LDA(At, 1, 0); PG8_STAGEA(PG8_SA(0, 1), a2 + hstepA);
            PG8_WAIT_L(10); PG8_BAR; PG8_WAIT_L(0); PG8_MMA(0, 0, At, B0); PG8_BAR; PG8_SCHED;
            PG8_LDB(B1, 1, 1); PG8_STAGEB(PG8_SB(1, 0), b3);
            PG8_BAR; PG8_WAIT_L(0); PG8_MMA(0, 1, At, B1); PG8_BAR;
            PG8_LDA(At, 1, 1); PG8_STAGEA(PG8_SA(1, 0), a3);
            PG8_BAR; PG8_WAIT_L(0); PG8_MMA(1, 0, At, B0); PG8_BAR; PG8_SCHED;
            PG8_STAGEB(PG8_SB(1, 1), b3 + hstepB);
            PG8_WAIT_V(6); PG8_BAR; PG8_MMA(1, 1, At, B1); PG8_BAR;
        }
        E(acc, cur, wid, fr, fq);
        if (!has_next) break;
#pragma unroll
        for (int a = 0; a < 2; ++a)
#pragma unroll
            for (int b = 0; b < 2; ++b)
#pragma unroll
                for (int m = 0; m < 5; ++m) acc[a][b][m] = (f32x4){0.f, 0.f, 0.f, 0.f};
        cur = nxt; cA = nA; cB = nB; ++ui;
    }
    PG8_WAIT_V(0);
    if (half == 0) PG8_BAR;
    PG8_BAR;
#undef PG8_SA
#undef PG8_SB
#undef PG8_STAGEA
#undef PG8_STAGEB
#undef PG8_LDA
#undef PG8_LDB
#undef PG8_MMA
#undef PG8_WAIT_V
#undef PG8_WAIT_L
#undef PG8_BAR
#undef PG8_SCHED
}

template <int MF, class Epi, class Sched>
__device__ __forceinline__ void gemm_phase160b_run(LAS unsigned char* lds, const Gemm g, const Sched& S, const Epi& E, int tid, int wid, int lane, int wr, int wc) {
    const int fr = lane & 15, fq = lane >> 4;
    const int K = g.K, nt = K / BK;
    constexpr int HTA = 80 * BK * 2;
    unsigned voffA[2], voffB[2];
    { int R, C; stage_rc(tid * 16, R, C); voffA[0] = (unsigned)(R * g.lda + C) * 2u; stage_rc((512 + (tid & 127)) * 16, R, C); voffA[1] = (unsigned)(R * g.lda + C) * 2u; }
#pragma unroll
    for (int i = 0; i < 2; ++i) { int R, C; stage_rc(tid * 16 + i * 8192, R, C); voffB[i] = (unsigned)(R * g.ldb + C) * 2u; }
    const size_t kstep = (size_t)(BK * 2);
    const size_t hstepA = (size_t)80 * g.lda * 2, hstepB = (size_t)HALF * g.ldb * 2;
    const unsigned ldswA0 = (unsigned)wid * 1024u, ldswA1 = 8192u + (unsigned)(wid & 1) * 1024u, ldswB = (unsigned)wid * 1024u;
    const int aoff = lds_byte(wr * 48 + fr, fq * 8), boff = lds_byte(wc * 32 + fr, fq * 8);
#define PG8_SA(b, h) (((b) * 2 + (h)) * HTA)
#define PG8_SB(b, h) (4 * HTA + ((b) * 2 + (h)) * HTB)
#define PG8_STAGEA(bufoff, gbase) do { \
        __builtin_amdgcn_global_load_lds((const unsigned*)((const char*)(gbase) + voffA[0]), (LAS unsigned*)(lds + (bufoff) + ldswA0), 16, 0, 0); \
        __builtin_amdgcn_global_load_lds((const unsigned*)((const char*)(gbase) + voffA[1]), (LAS unsigned*)(lds + (bufoff) + ldswA1), 16, 0, 0); } while (0)
#define PG8_STAGEB(bufoff, gbase) do { _Pragma("unroll") for (int _i = 0; _i < 2; ++_i) \
        __builtin_amdgcn_global_load_lds((const unsigned*)((const char*)(gbase) + voffB[_i]), (LAS unsigned*)(lds + (bufoff) + ldswB + _i * 8192), 16, 0, 0); } while (0)
#define PG8_LDA(dst, b, h) do { _Pragma("unroll") for (int m = 0; m < MF; ++m) _Pragma("unroll") for (int k = 0; k < 2; ++k) dst[m][k] = *(const LAS bf16x8*)(lds + PG8_SA(b, h) + aoff + m * 2048 + k * 1024); } while (0)
#define PG8_LDB(dst, b, h) do { _Pragma("unroll") for (int n = 0; n < 2; ++n) _Pragma("unroll") for (int k = 0; k < 2; ++k) dst[n][k] = *(const LAS bf16x8*)(lds + PG8_SB(b, h) + boff + n * 2048 + k * 1024); } while (0)
#define PG8_MMA(ai, bj, At, Bt) do { __builtin_amdgcn_s_setprio(1); _Pragma("unroll") for (int m = 0; m < MF; ++m) _Pragma("unroll") for (int n = 0; n < 2; ++n) _Pragma("unroll") for (int k = 0; k < 2; ++k) \
        acc[ai][bj][m][n] = __builtin_amdgcn_mfma_f32_16x16x32_bf16(Bt[n][k], At[m][k], acc[ai][bj][m][n], 0, 0, 0); __builtin_amdgcn_s_setprio(0); } while (0)
#define PG8_WAIT_V(n) asm volatile("s_waitcnt vmcnt(" #n ")" ::: "memory")
#define PG8_WAIT_L(n) asm volatile("s_waitcnt lgkmcnt(" #n ")" ::: "memory")
#define PG8_WAIT_LA() do { if (MF == 3) PG8_WAIT_L(6); else PG8_WAIT_L(4); } while (0)
#define PG8_BAR __builtin_amdgcn_s_barrier()
#define PG8_SCHED __builtin_amdgcn_sched_barrier(0)
    Unit cur, nxt; int ui = 0;
    if (!S.next(0, cur)) return;
    f32x4 acc[2][2][MF][2];
#pragma unroll
    for (int a = 0; a < 2; ++a)
#pragma unroll
        for (int b = 0; b < 2; ++b)
#pragma unroll
            for (int m = 0; m < MF; ++m)
#pragma unroll
                for (int n = 0; n < 2; ++n) acc[a][b][m][n] = (f32x4){0.f, 0.f, 0.f, 0.f};
    bf16x8 At[MF][2], B0[2][2], B1[2][2];
    const char* cA = cur.a; const char* cB = cur.b;
    PG8_STAGEB(PG8_SB(0, 0), cB); PG8_STAGEA(PG8_SA(0, 0), cA); PG8_STAGEB(PG8_SB(0, 1), cB + hstepB); PG8_STAGEA(PG8_SA(0, 1), cA + hstepA);
    if (wr == 1) PG8_BAR;
    PG8_WAIT_V(4); PG8_BAR;
    PG8_STAGEB(PG8_SB(1, 0), cB + kstep); PG8_STAGEA(PG8_SA(1, 0), cA + kstep); PG8_STAGEB(PG8_SB(1, 1), cB + hstepB + kstep);
    PG8_WAIT_V(6); PG8_BAR;
    for (;;) {
        const bool has_next = S.next(ui + 1, nxt);
        const char* nA = has_next ? nxt.a : cA; const char* nB = has_next ? nxt.b : cB;
        for (int t = 0; t < nt; t += 2) {
            const bool last = (t == nt - 2);
            const char* a1 = cA + (size_t)(t + 1) * kstep;
            const char* a2 = last ? nA : cA + (size_t)(t + 2) * kstep; const char* b2 = last ? nB : cB + (size_t)(t + 2) * kstep;
            const char* a3 = a2 + kstep; const char* b3 = b2 + kstep;
            PG8_LDB(B0, 0, 0); PG8_SCHED; PG8_LDA(At, 0, 0); PG8_STAGEA(PG8_SA(1, 1), a1 + hstepA);
            PG8_WAIT_LA(); PG8_BAR; PG8_WAIT_L(0); PG8_MMA(0, 0, At, B0); PG8_BAR; PG8_SCHED;
            PG8_LDB(B1, 0, 1); PG8_STAGEB(PG8_SB(0, 0), b2);
            PG8_BAR; PG8_WAIT_L(0); PG8_MMA(0, 1, At, B1); PG8_BAR;
            PG8_LDA(At, 0, 1); PG8_STAGEA(PG8_SA(0, 0), a2);
            PG8_BAR; PG8_WAIT_L(0); PG8_MMA(1, 0, At, B0); PG8_BAR; PG8_SCHED;
            PG8_STAGEB(PG8_SB(0, 1), b2 + hstepB);
            PG8_WAIT_V(6); PG8_BAR; PG8_MMA(1, 1, At, B1); PG8_BAR;
            PG8_LDB(B0, 1, 0); PG8_SCHED; PG8_LDA(At, 1, 0); PG8_STAGEA(PG8_SA(0, 1), a2 + hstepA);
            PG8_WAIT_LA(); PG8_BAR; PG8_WAIT_L(0); PG8_MMA(0, 0, At, B0); PG8_BAR; PG8_SCHED;
            PG8_LDB(B1, 1, 1); PG8_STAGEB(PG8_SB(1, 0), b3);
            PG8_BAR; PG8_WAIT_L(0); PG8_MMA(0, 1, At, B1); PG8_BAR;
            PG8_LDA(At, 1, 1); PG8_STAGEA(PG8_SA(1, 0), a3);
            PG8_BAR; PG8_WAIT_L(0); PG8_MMA(1, 0, At, B0); PG8_BAR; PG8_SCHED;
            PG8_STAGEB(PG8_SB(1, 1), b3 + hstepB);
            PG8_WAIT_V(6); PG8_BAR; PG8_MMA(1, 1, At, B1); PG8_BAR;
        }
        if constexpr (!Epi::AFTER_DRAIN) E.template tile<MF>(acc, cur, wr, wc, fr, fq);
        if (!has_next) break;
#pragma unroll
        for (int a = 0; a < 2; ++a)
#pragma unroll
            for (int b = 0; b < 2; ++b)
#pragma unroll
                for (int m = 0; m < MF; ++m)
#pragma unroll
                    for (int n = 0; n < 2; ++n) acc[a][b][m][n] = (f32x4){0.f, 0.f, 0.f, 0.f};
        cur = nxt; cA = nA; cB = nB; ++ui;
    }
    PG8_WAIT_V(0);
    if (wr == 0) PG8_BAR;
    PG8_BAR;
    if constexpr (Epi::AFTER_DRAIN) E.template fused<MF>(acc, cur, wr, wc, fr, fq, lds, wid, lane, tid);
#undef PG8_SA
#undef PG8_SB
#undef PG8_STAGEA
#undef PG8_STAGEB
#undef PG8_LDA
#undef PG8_LDB
#undef PG8_MMA
#undef PG8_WAIT_V
#undef PG8_WAIT_L
#undef PG8_WAIT_LA
#undef PG8_BAR
#undef PG8_SCHED
}
template <class Epi, class Sched>
__device__ __forceinline__ void gemm_phase160b(LAS unsigned char* lds, const Gemm g, const Sched& S, const Epi& E) {
    int tid = threadIdx.x; asm volatile("" : "+v"(tid));
    const int wid = __builtin_amdgcn_readfirstlane(tid >> 6), lane = tid & 63, wr = wid >> 2, wc = wid & 3;
    if (wr == 0) gemm_phase160b_run<3>(lds, g, S, E, tid, wid, lane, wr, wc);
    else gemm_phase160b_run<2>(lds, g, S, E, tid, wid, lane, wr, wc);
}
}

struct Args { const void* in[27]; float* out; unsigned char* ws; int ph_lo, ph_hi; };
enum { I_XP = 0, I_XS, I_CK, I_CV, I_ST, I_C, I_CCTX, I_WADA, I_BADA, I_GAINS, I_WIN, I_WOUT, I_LAMBDA, I_SUBLN, I_MU, I_W0, I_W2, I_A0, I_A2, I_G2, I_KVEC, I_LNX, I_WODD, I_WFI, I_CONVW, I_CONVB, I_WFO };
#define FIN(k) ((const float*)a.in[k])
#define WSB(off) ((bf16*)(a.ws + (off)))
#define WSF(off) ((float*)(a.ws + (off)))


__device__ __forceinline__ const void* ptab_ld(LAS unsigned char* lds, int k) {
    const u32x2 w = *(const LAS u32x2*)(lds + PTAB_OFF + 8 * k);
    const unsigned long long v = ((unsigned long long)(unsigned)__builtin_amdgcn_readfirstlane((int)w.y) << 32) | (unsigned)__builtin_amdgcn_readfirstlane((int)w.x);
    return (const void*)(const __attribute__((address_space(1))) void*)v;
}
__device__ __forceinline__ Args load_args(LAS unsigned char* lds, int ph_lo, int ph_hi) {
    Args r;
#pragma unroll
    for (int i = 0; i < 27; ++i) r.in[i] = ptab_ld(lds, i);
    r.out = (float*)ptab_ld(lds, 27); r.ws = (unsigned char*)ptab_ld(lds, 28); r.ph_lo = ph_lo; r.ph_hi = ph_hi;
    return r;
}
__device__ __forceinline__ int row_cond(int row) { return row < NPR ? 0 : 1 + ((row - NPR) >> 10); }

template <bool FFN_PERM = false>
__device__ __forceinline__ void p0_transpose_item(const float* W, int K, int N, bf16* WT, LAS float* scr, int item, int lane) {
    const int nblk = N / 32, kb = item / nblk, nb = item % nblk, k0 = 64 * kb, n0 = 32 * nb;
    const int d0 = FFN_PERM ? (n0 < DFF ? (n0 / 128) * 256 + (n0 % 128) : ((n0 - DFF) / 128) * 256 + 128 + ((n0 - DFF) % 128)) : n0;
#pragma unroll 8
    for (int i = 0; i < 32; ++i) { const int kk = 2 * i + (lane >> 5); scr[kk * 33 + (lane & 31)] = W[(size_t)(k0 + kk) * N + n0 + (lane & 31)]; }
    asm volatile("s_waitcnt lgkmcnt(0)" ::: "memory");
    const int c = lane & 7;
#pragma unroll
    for (int j = 0; j < 4; ++j) { const int n = (lane >> 3) + 8 * j; const LAS float* s = scr + (8 * c) * 33 + n;
        u32x4 o; o.x = pk2(s[0 * 33], s[1 * 33]); o.y = pk2(s[2 * 33], s[3 * 33]); o.z = pk2(s[4 * 33], s[5 * 33]); o.w = pk2(s[6 * 33], s[7 * 33]);
        *(u32x4*)(WT + (size_t)(d0 + n) * K + k0 + 8 * c) = o; }
    asm volatile("s_waitcnt lgkmcnt(0)" ::: "memory");
}

template <int STAGE>
__device__ __forceinline__ void phase_prep(const Args& a, LAS unsigned char* lds, int bid, int G, int vgw = -2, int nmine = 1, int nvw = 0) {
    int tid = threadIdx.x; asm volatile("" : "+v"(tid));
    const int lane = tid & 63, wave = tid >> 6;
    const int gw = bid * 8 + wave, NGW = G * 8;
    const int gt = bid * 512 + tid, NGT = G * 512;
    constexpr int I_IN = (1024 / 64) * (INE / 32), I_SQ = (1024 / 64) * (1024 / 32), I_FI = (1024 / 64) * (DFF2 / 32), I_FO = (DFF / 64) * (1024 / 32), I_L64 = 1 * (512 / 32), I_L128 = 2 * (512 / 32);
    if (STAGE == 1 || STAGE == 3) {
        LAS float* scr = (LAS float*)(lds + wave * 16384);
        constexpr int NITEMS = I_IN + 4 * I_L64 + I_L128;
        for (int it = gw; it < NITEMS; it += NGW) {
            int r = it;
            if (r < I_IN) { p0_transpose_item(FIN(I_WIN), 1024, INE, WSB(WS_WIN), scr, r, lane); continue; } r -= I_IN;
            if (r < 2 * I_L64) { const int d = r / I_L64; p0_transpose_item(FIN(I_W2) + (size_t)d * 64 * 512, 64, 512, WSB(WS_W2T) + (size_t)d * 512 * 64, scr, r % I_L64, lane); continue; } r -= 2 * I_L64;
            if (r < 2 * I_L64) { const int d = r / I_L64; p0_transpose_item(FIN(I_A2) + (size_t)d * 64 * 512, 64, 512, WSB(WS_A2T) + (size_t)d * 512 * 64, scr, r % I_L64, lane); continue; } r -= 2 * I_L64;
            p0_transpose_item(FIN(I_G2), 128, 512, WSB(WS_G2T), scr, r, lane);
        }
        for (int i = gt; i < (INE_PAD - INE) * 1024 / 8; i += NGT) ((u32x4*)(WSB(WS_WIN) + (size_t)INE * 1024))[i] = (u32x4){0u, 0u, 0u, 0u};
    }
    if (STAGE == 2) {
        LAS float* scr = (LAS float*)(lds + wave * 16384);
        constexpr int NITEMS = 2 * I_SQ + I_FI + 2 * I_FO;
        const int s0 = vgw == -2 ? gw : vgw, ns = vgw == -2 ? NGW : nvw;
        for (int sl = 0; sl < nmine; ++sl)
        for (int it = s0 < 0 ? NITEMS : s0 + sl; it < NITEMS; it += ns) {
            int r = it;
            if (r < I_SQ) { p0_transpose_item(FIN(I_WOUT), 1024, 1024, WSB(WS_WO), scr, r, lane); continue; } r -= I_SQ;
            if (r < I_SQ) { p0_transpose_item(FIN(I_WODD), 1024, 1024, WSB(WS_WODD), scr, r, lane); continue; } r -= I_SQ;
            if (r < I_FI) { p0_transpose_item<true>(FIN(I_WFI), 1024, DFF2, WSB(WS_WFI), scr, r, lane); continue; } r -= I_FI;
            const int l = r / I_FO; p0_transpose_item(FIN(I_WFO) + (size_t)l * DFF * 1024, DFF, 1024, WSB(WS_WFO) + (size_t)l * 1024 * DFF, scr, r % I_FO, lane);
        }
    }
    if (STAGE == 0 || STAGE == 3) {
        for (int i = gt; i < 256 * 128; i += NGT) {
            const int n = i >> 7, c = i & 127, m = (c * (n & 127)) & 127; const float x = (float)m * (2.0f / 128.0f);
            WSB(WS_WDFT)[i] = f2bf(n < 128 ? cospif(x) : sinpif(x));
        }
        for (int i = gt; i < 256 * 512; i += NGT) {
            const int lp = i >> 9, k = i & 511, l = k & 255, m = (lp * l) & 255; const float x = (float)m * (2.0f / 256.0f), s = 0.00552427172801990f;
            WSB(WS_A2P)[i] = f2bf(k < 256 ? s * cospif(x) : -s * sinpif(x));
        }
        for (int i = gt; i < 1024 * 32; i += NGT) {
            const int t = i >> 5, f = i & 31; const float inv = powf(10000.0f, -(float)(f & 15) / 16.0f), pos = (float)(f < 16 ? (t >> 6) : (t & 63)), ang = pos * inv;
            WSF(WS_ROPE)[i] = cosf(ang); WSF(WS_ROPE)[1024 * 32 + i] = sinf(ang);
        }
        if (gt == 0) {
            const float* lp = FIN(I_LAMBDA); float s1 = 0.f, s2 = 0.f;
            for (int i = 0; i < 64; ++i) { s1 += lp[i] * lp[64 + i]; s2 += lp[128 + i] * lp[192 + i]; }
            WSF(WS_LAM)[0] = expf(s1) - expf(s2) + 0.2f;
        }
        for (int i = gt; i < 2 * 256 * 512; i += NGT) {
            const int b = i >> 17, t = (i >> 9) & 255, c = i & 511;
            WSB(WS_KS)[((size_t)b * LKS + t) * 512 + c] = f2bf(FIN(I_CK)[i]);
            const int h = c >> 7, d = c & 127;
            WSB(WS_VTS)[((size_t)(b * 4 + h) * 128 + d) * LKS + keypos(t)] = f2bf(FIN(I_CV)[i]);
        }
    }
    if (STAGE == 0 || STAGE == 1 || STAGE == 3) {
        LAS float* sc = (LAS float*)lds;
        LAS float* red = (LAS float*)(lds + 16384);
        __syncthreads();
        for (int i = tid; i < 3 * 1024; i += 512) { const int cd = i >> 10, k = i & 1023; const float x = cd == 0 ? FIN(I_CCTX)[k] : FIN(I_C)[(cd - 1) * 1024 + k]; sc[i] = x / (1.f + __expf(-x)); }
        __syncthreads();
        const int kq = tid >> 3, nl = tid & 7;
        const int it_lo = STAGE == 0 ? 0 : 64, it_hi = STAGE == 0 ? 64 : 2 * 192;
        for (int q = 0; ; ++q) {
            int it;
            if (STAGE == 3) {
                if (G == 256) { if (q == 0) { if (bid >= 64) continue; it = bid; } else if (q == 1) { if (bid < 64) continue; it = bid; } else if (q == 2) { if (bid >= 128) continue; it = 256 + bid; } else break; }
                else { it = bid + q * G; if (it >= 2 * 192) break; }
            } else { it = it_lo + bid + q * G; if (it >= it_hi) break; }
            const int l = it / 192, n0 = (it % 192) * 32;
            const float* W = FIN(I_WADA) + (size_t)l * 1024 * 6144 + n0 + 4 * nl;
            f32x4 s0 = {0.f, 0.f, 0.f, 0.f}, s1 = s0, s2 = s0;
#pragma unroll 4
            for (int kk = 0; kk < 16; ++kk) { const int k = kq * 16 + kk; const f32x4 w = *(const f32x4*)(W + (size_t)k * 6144); s0 += w * sc[k]; s1 += w * sc[1024 + k]; s2 += w * sc[2048 + k]; }
            *(LAS f32x4*)(red + (kq * 3 + 0) * 32 + 4 * nl) = s0; *(LAS f32x4*)(red + (kq * 3 + 1) * 32 + 4 * nl) = s1; *(LAS f32x4*)(red + (kq * 3 + 2) * 32 + 4 * nl) = s2;
            __syncthreads();
            if (tid < 96) { const int cd = tid >> 5, n = tid & 31; float s = FIN(I_BADA)[l * 6144 + n0 + n];
                for (int qq = 0; qq < 64; ++qq) s += red[(qq * 3 + cd) * 32 + n];
                if (STAGE == 3 && it < 64)
                    __hip_atomic_store((unsigned*)(a.ws + WS_MOD1) + cd * 2048 + n0 + n, __float_as_uint(s) | 1u, __ATOMIC_RELAXED, __HIP_MEMORY_SCOPE_AGENT);
                else WSF(WS_MOD)[(size_t)(l * 3 + cd) * 6144 + n0 + n] = s; }
            __syncthreads();
        }
    }
}

__device__ __forceinline__ void phase_first_norm(const Args& a, LAS unsigned char* lds, int bid, int G, const float* gB) {
    int tid = threadIdx.x; asm volatile("" : "+v"(tid));
    const int lane = tid & 63, wave = tid >> 6;
    const int gw = bid * 8 + wave, NGW = G * 8;
    LAS float* modl = (LAS float*)lds;
    __syncthreads();
    {   const unsigned* side = (const unsigned*)(a.ws + WS_MOD1);
        unsigned v[12]; unsigned spins = 0;
        for (;;) { bool ok = true;
#pragma unroll
            for (int i = 0; i < 12; ++i) { v[i] = __hip_atomic_load(side + tid + 512 * i, __ATOMIC_RELAXED, __HIP_MEMORY_SCOPE_AGENT); ok = ok && (v[i] != 0u); }
            if (ok || ++spins > (1u << 20)) break;
            __builtin_amdgcn_s_sleep(2); }
#pragma unroll
        for (int i = 0; i < 12; ++i) modl[tid + 512 * i] = __uint_as_float(v[i]);
    }
    __syncthreads();
    bf16* XN = WSB(WS_XN);
    constexpr int R = 5;
    for (int row0 = gw; row0 < NT; row0 += R * NGW) {
        f32x4 x[R][4];
#pragma unroll
        for (int q = 0; q < R; ++q) { const int row = row0 + q * NGW; if (row < NT) {
            const float* xin = row < NPR ? FIN(I_XP) + (size_t)row * DM : FIN(I_XS) + (size_t)(row - NPR) * DM;
#pragma unroll
            for (int j = 0; j < 4; ++j) x[q][j] = *(const f32x4*)(xin + 4 * lane + 256 * j); } }
#pragma unroll
        for (int q = 0; q < R; ++q) { const int row = row0 + q * NGW; if (row < NT) {
            const LAS float* ml = modl + row_cond(row) * 2048;
            float ss = 0.f;
#pragma unroll
            for (int j = 0; j < 4; ++j) ss += (x[q][j][0] * x[q][j][0] + x[q][j][1] * x[q][j][1]) + (x[q][j][2] * x[q][j][2] + x[q][j][3] * x[q][j][3]);
            const float rinv = rsqrtf(wave_sum(ss) * (1.f / DM) + 1e-6f);
#pragma unroll
            for (int j = 0; j < 4; ++j) { const f32x4 g = *(const f32x4*)(gB + 4 * lane + 256 * j), sc = *(const LAS f32x4*)(ml + 1024 + 4 * lane + 256 * j), sh = *(const LAS f32x4*)(ml + 4 * lane + 256 * j);
                const f32x4 h = (x[q][j] * rinv * g) * (sc + 1.f) + sh; *(u32x2*)(XN + (size_t)row * DM + 4 * lane + 256 * j) = pk4(h); }
        } }
    }
}

__device__ __forceinline__ void phase_transpose_wfi1(const Args& a, LAS unsigned char* lds, int bid, int G) {
    int tid = threadIdx.x; asm volatile("" : "+v"(tid));
    const int lane = tid & 63, wave = tid >> 6;
    LAS float* scr = (LAS float*)(lds + wave * 16384);
    constexpr int I_FI = (1024 / 64) * (DFF2 / 32);
    for (int it = bid * 8 + wave; it < I_FI; it += G * 8) p0_transpose_item<true>(FIN(I_WFI) + (size_t)1024 * DFF2, 1024, DFF2, WSB(WS_WFI) + (size_t)DFF2 * 1024, scr, it, lane);
    __syncthreads();
}
template <bool HAS_RES, bool HAS_H, bool X_FROM_INPUT, bool X_TO_OUTPUT = false>
__device__ __forceinline__ void phase_resnorm(const Args& a, int bid, int G, const bf16* mf, const float* gA, int gate_off, int layer_gate, const float* gB, int shift_off, int scale_off, int layer_mod) {
    int tid = threadIdx.x; asm volatile("" : "+v"(tid));
    const int lane = tid & 63, wave = tid >> 6;
    const int gw = bid * 8 + wave, NGW = G * 8;
    float* X = a.out; bf16* XB = WSB(WS_XB);
    bf16* XN = WSB(WS_XN);
    constexpr int R = 5;
    for (int row0 = gw; row0 < NT; row0 += R * NGW) {
        f32x4 x[R][4], m[R][4];
#pragma unroll
        for (int q = 0; q < R; ++q) { const int row = row0 + q * NGW; if (row < NT) {
            const float* xin = row < NPR ? FIN(I_XP) + (size_t)row * DM : FIN(I_XS) + (size_t)(row - NPR) * DM;
#pragma unroll
            for (int j = 0; j < 4; ++j) { x[q][j] = X_FROM_INPUT ? *(const f32x4*)(xin + 4 * lane + 256 * j) : unpk4(*(const u32x2*)(XB + (size_t)row * DM + 4 * lane + 256 * j)); if (HAS_RES) m[q][j] = unpk4(*(const u32x2*)(mf + (size_t)row * DM + 4 * lane + 256 * j)); } } }
#pragma unroll
        for (int q = 0; q < R; ++q) { const int row = row0 + q * NGW; if (row < NT) {
            const float* mod = WSF(WS_MOD) + (size_t)(layer_mod * 3 + row_cond(row)) * 6144;
            const float* modg = WSF(WS_MOD) + (size_t)(layer_gate * 3 + row_cond(row)) * 6144;
            if (HAS_RES) {
                float ss = 0.f;
#pragma unroll
                for (int j = 0; j < 4; ++j) ss += (m[q][j][0] * m[q][j][0] + m[q][j][1] * m[q][j][1]) + (m[q][j][2] * m[q][j][2] + m[q][j][3] * m[q][j][3]);
                const float rinv = rsqrtf(wave_sum(ss) * (1.f / DM) + 1e-6f);
#pragma unroll
                for (int j = 0; j < 4; ++j) { const f32x4 g = *(const f32x4*)(gA + 4 * lane + 256 * j), gt = *(const f32x4*)(modg + gate_off + 4 * lane + 256 * j);
                    x[q][j] = x[q][j] + gt * (m[q][j] * rinv * g);
                    if (X_TO_OUTPUT) *(f32x4*)(X + (size_t)row * DM + 4 * lane + 256 * j) = x[q][j]; else *(u32x2*)(XB + (size_t)row * DM + 4 * lane + 256 * j) = pk4(x[q][j]); }
            }
            if (HAS_H) {
                float ss = 0.f;
#pragma unroll
                for (int j = 0; j < 4; ++j) ss += (x[q][j][0] * x[q][j][0] + x[q][j][1] * x[q][j][1]) + (x[q][j][2] * x[q][j][2] + x[q][j][3] * x[q][j][3]);
                const float rinv = rsqrtf(wave_sum(ss) * (1.f / DM) + 1e-6f);
#pragma unroll
                for (int j = 0; j < 4; ++j) { const f32x4 g = *(const f32x4*)(gB + 4 * lane + 256 * j), sc = *(const f32x4*)(mod + scale_off + 4 * lane + 256 * j), sh = *(const f32x4*)(mod + shift_off + 4 * lane + 256 * j);
                    const f32x4 h = (x[q][j] * rinv * g) * (sc + 1.f) + sh; *(u32x2*)(XN + (size_t)row * DM + 4 * lane + 256 * j) = pk4(h); }
            }
        } }
    }
}

struct EpiF32 {
    float* C; int ldc;
    static constexpr bool ALIGN = false;
    __device__ __forceinline__ void operator()(const f32x4 (&acc)[2][2][4][2], const pg8::Unit& u, int wr, int wc, int fr, int fq) const {
        pg8::epi_each(acc, u.pm * 256 + wr * 64 + fr, u.pn * 256 + wc * 32 + 4 * fq, [&](int row, int col, const f32x4& v) { *(f32x4*)(C + (size_t)row * ldc + col) = v; });
    }
};
struct EpiBf16 {
    bf16* O; int ldc;
    static constexpr bool ALIGN = false;
    __device__ __forceinline__ void operator()(const f32x4 (&acc)[2][2][4][2], const pg8::Unit& u, int wr, int wc, int fr, int fq) const {
        pg8::epi_each(acc, u.z + u.pm * 256 + wr * 64 + fr, u.pn * 256 + wc * 32 + 4 * fq, [&](int row, int col, const f32x4& v) { *(u32x2*)(O + (size_t)row * ldc + col) = pk4(v); });
    }
};

template <class F> __device__ __forceinline__ void epi_each160(const f32x4 (&acc)[2][2][5], const pg8::Unit& u, int wid, int fr, int fq, F&& f) {
#pragma unroll
    for (int ai = 0; ai < 2; ++ai)
#pragma unroll
        for (int m = 0; m < 5; ++m)
#pragma unroll
            for (int bj = 0; bj < 2; ++bj) f(u.pm * 160 + ai * 80 + m * 16 + fr, u.pn * 256 + bj * 128 + wid * 16 + 4 * fq, acc[ai][bj][m]);
}
struct EpiBf16_160 {
    bf16* O; int ldc;
    static constexpr bool AFTER_DRAIN = false;
    template <int MF> __device__ __forceinline__ void tile(const f32x4 (&acc)[2][2][MF][2], const pg8::Unit& u, int wr, int wc, int fr, int fq) const {
#pragma unroll
        for (int ai = 0; ai < 2; ++ai)
#pragma unroll
            for (int m = 0; m < MF; ++m)
#pragma unroll
                for (int bj = 0; bj < 2; ++bj)
#pragma unroll
                    for (int n = 0; n < 2; ++n) *(u32x2*)(O + (size_t)(u.pm * 160 + ai * 80 + wr * 48 + m * 16 + fr) * ldc + u.pn * 256 + bj * 128 + wc * 32 + n * 16 + 4 * fq) = pk4(acc[ai][bj][m][n]);
    }
    __device__ __forceinline__ void operator()(const f32x4 (&acc)[2][2][5], const pg8::Unit& u, int wid, int fr, int fq) const {
#pragma unroll
        for (int ai = 0; ai < 2; ++ai)
#pragma unroll
            for (int m = 0; m < 5; ++m)
#pragma unroll
                for (int bj = 0; bj < 2; ++bj) *(u32x2*)(O + (size_t)(u.pm * 160 + ai * 80 + m * 16 + fr) * ldc + u.pn * 256 + bj * 128 + wid * 16 + 4 * fq) = pk4(acc[ai][bj][m]);
    }
};

template <bool FROM_INPUT, bool FINAL>
struct EpiResNorm {
    static constexpr bool AFTER_DRAIN = true;
    const float* xin_p; const float* xin_s; const bf16* xb_in;
    bf16* xb_out; float* xf_out; bf16* xn_out;
    const float* gA; const float* gB; const float* mod;
    int gate_off, layer_gate, shift_off, scale_off, layer_mod;
    unsigned* slots; unsigned* cnt;

    template <int MF> __device__ __forceinline__ void exchange(const f32x4 (&v)[2][2][MF][2], int e, int pm, int pn, int wr, int wc, int fr, int fq, LAS float* P, LAS float* R, int wid, int lane, int tid) const {
#pragma unroll
        for (int ai = 0; ai < 2; ++ai)
#pragma unroll
            for (int m = 0; m < MF; ++m) {
                float s = 0.f;
#pragma unroll
                for (int bj = 0; bj < 2; ++bj)
#pragma unroll
                    for (int n = 0; n < 2; ++n) { const f32x4 x = v[ai][bj][m][n]; s += (x[0] * x[0] + x[1] * x[1]) + (x[2] * x[2] + x[3] * x[3]); }
                s += __shfl_xor(s, 16); s += __shfl_xor(s, 32);
                if (fq == 0) P[(80 * ai + 48 * wr + 16 * m + fr) * 4 + wc] = s;
            }
        asm volatile("s_waitcnt lgkmcnt(0)" ::: "memory"); __builtin_amdgcn_s_barrier(); asm volatile("" ::: "memory");
        unsigned long long* sl = (unsigned long long*)(slots + ((size_t)(e * 64 + pm) * 160) * 4);
        if (tid < 160) { const float tot = (P[tid * 4 + 0] + P[tid * 4 + 1]) + (P[tid * 4 + 2] + P[tid * 4 + 3]);
            __hip_atomic_store((unsigned*)sl + tid * 4 + pn, __float_as_uint(tot) | 1u, __ATOMIC_RELAXED, __HIP_MEMORY_SCOPE_AGENT);
            unsigned long long a, b; unsigned spins = 0;
            for (;;) {
                a = __hip_atomic_load(sl + tid * 2 + 0, __ATOMIC_RELAXED, __HIP_MEMORY_SCOPE_AGENT); b = __hip_atomic_load(sl + tid * 2 + 1, __ATOMIC_RELAXED, __HIP_MEMORY_SCOPE_AGENT);
                if (((unsigned)a != 0u && (unsigned)(a >> 32) != 0u && (unsigned)b != 0u && (unsigned)(b >> 32) != 0u) || ++spins > (1u << 20)) break;
                __builtin_amdgcn_s_sleep(1);
            }
            const float q = (__uint_as_float((unsigned)a) + __uint_as_float((unsigned)(a >> 32))) + (__uint_as_float((unsigned)b) + __uint_as_float((unsigned)(b >> 32)));
            R[tid] = rsqrtf(q * (1.f / 1024.f) + 1e-6f); }
        asm volatile("s_waitcnt lgkmcnt(0)" ::: "memory"); __builtin_amdgcn_s_barrier(); asm volatile("" ::: "memory");
    }

    template <int MF> __device__ __forceinline__ void fused(f32x4 (&acc)[2][2][MF][2], const pg8::Unit& u, int wr, int wc, int fr, int fq, LAS unsigned char* lds, int wid, int lane, int tid) const {
        LAS float* P = (LAS float*)lds; LAS float* R = (LAS float*)(lds + 4096);
        const int pm = u.pm, pn = u.pn, row0 = 160 * pm;
        int cb = 256 * pn + 32 * wc + 4 * fq; asm volatile("" : "+v"(cb));
        const int c_lo = row_cond(row0), c_hi = row_cond(row0 + 159);
        f32x4 g[4], gtl[4], gth[4];
        {   const float* ml = mod + (size_t)(layer_gate * 3 + c_lo) * 6144 + gate_off; const float* mh = mod + (size_t)(layer_gate * 3 + c_hi) * 6144 + gate_off;
#pragma unroll
            for (int q = 0; q < 4; ++q) { const int col = cb + 128 * (q >> 1) + 16 * (q & 1); g[q] = *(const f32x4*)(gA + col); gtl[q] = *(const f32x4*)(ml + col); gth[q] = *(const f32x4*)(mh + col); } }
        using XT = typename std::conditional<FROM_INPUT, f32x4, u32x2>::type;
        XT x0[MF * 4], x1[MF * 4];
        auto ldx = [&](XT (&xr)[MF * 4], int ai) {
#pragma unroll
            for (int m = 0; m < MF; ++m) { const int row = row0 + 80 * ai + 48 * wr + 16 * m + fr;
#pragma unroll
                for (int q = 0; q < 4; ++q) { const int col = cb + 128 * (q >> 1) + 16 * (q & 1);
                    if constexpr (FROM_INPUT) xr[m * 4 + q] = *(const f32x4*)((row < NPR ? xin_p + (size_t)row * DM : xin_s + (size_t)(row - NPR) * DM) + col);
                    else xr[m * 4 + q] = *(const u32x2*)(xb_in + (size_t)row * DM + col); } } };
        auto upd = [&](const XT (&xr)[MF * 4], int ai) {
#pragma unroll
            for (int m = 0; m < MF; ++m) { const int rl = 80 * ai + 48 * wr + 16 * m + fr; const float rinv = R[rl]; const bool hi = row_cond(row0 + 80 * ai + 48 * wr + 16 * m) != c_lo;
#pragma unroll
                for (int q = 0; q < 4; ++q) { f32x4 x; if constexpr (FROM_INPUT) x = xr[m * 4 + q]; else x = unpk4(xr[m * 4 + q]);
                    const f32x4 gt = hi ? gth[q] : gtl[q];
                    acc[ai][q >> 1][m][q & 1] = x + gt * (acc[ai][q >> 1][m][q & 1] * rinv * g[q]); } } };
        ldx(x0, 0);
        if constexpr (!FROM_INPUT) ldx(x1, 1);
        asm volatile("" ::: "memory");
        exchange<MF>(acc, 0, pm, pn, wr, wc, fr, fq, P, R, wid, lane, tid);
        upd(x0, 0);
        if constexpr (FROM_INPUT) { asm volatile("" ::: "memory"); ldx(x1, 1); }
        upd(x1, 1);
#pragma unroll
        for (int ai = 0; ai < 2; ++ai)
#pragma unroll
            for (int m = 0; m < MF; ++m) { const int row = row0 + 80 * ai + 48 * wr + 16 * m + fr;
#pragma unroll
                for (int q = 0; q < 4; ++q) { const int col = cb + 128 * (q >> 1) + 16 * (q & 1); const f32x4 x = acc[ai][q >> 1][m][q & 1];
                    if constexpr (FINAL) *(f32x4*)(xf_out + (size_t)row * DM + col) = x; else *(u32x2*)(xb_out + (size_t)row * DM + col) = pk4(x); } }
        if constexpr (!FINAL) {
            f32x4 al[4], ah[4], sl[4], sh[4];
            {   const float* ml = mod + (size_t)(layer_mod * 3 + c_lo) * 6144; const float* mh = mod + (size_t)(layer_mod * 3 + c_hi) * 6144;
#pragma unroll
                for (int q = 0; q < 4; ++q) { const int col = cb + 128 * (q >> 1) + 16 * (q & 1); const f32x4 gb = *(const f32x4*)(gB + col);
                    al[q] = gb * (*(const f32x4*)(ml + scale_off + col) + 1.f); ah[q] = gb * (*(const f32x4*)(mh + scale_off + col) + 1.f);
                    sl[q] = *(const f32x4*)(ml + shift_off + col); sh[q] = *(const f32x4*)(mh + shift_off + col); } }
            asm volatile("" ::: "memory");
            exchange<MF>(acc, 1, pm, pn, wr, wc, fr, fq, P, R, wid, lane, tid);
#pragma unroll
            for (int ai = 0; ai < 2; ++ai)
#pragma unroll
                for (int m = 0; m < MF; ++m) { const int rl = 80 * ai + 48 * wr + 16 * m + fr, row = row0 + rl; const float rinv = R[rl]; const bool hi = row_cond(row0 + 80 * ai + 48 * wr + 16 * m) != c_lo;
#pragma unroll
                    for (int q = 0; q < 4; ++q) { const int col = cb + 128 * (q >> 1) + 16 * (q & 1);
                        const f32x4 h = (acc[ai][q >> 1][m][q & 1] * rinv) * (hi ? ah[q] : al[q]) + (hi ? sh[q] : sl[q]);
                        *(u32x2*)(xn_out + (size_t)row * DM + col) = pk4(h); } }
        }
    }
};

struct EpiProj {
    bf16 *Q, *KP, *KS, *VTP, *VTS, *FB; float *ock, *ocv; const float* rope;
    static constexpr bool ALIGN = false, AFTER_DRAIN = false;
    __device__ __forceinline__ f32x4 do_rope(f32x4 v, int t, int col) const {
        const int i0 = (col & 63) >> 1;
        const f32x2 c = *(const f32x2*)(rope + t * 32 + i0), s = *(const f32x2*)(rope + 1024 * 32 + t * 32 + i0);
        f32x4 o; o[0] = v[0] * c[0] - v[1] * s[0]; o[1] = v[0] * s[0] + v[1] * c[0]; o[2] = v[2] * c[1] - v[3] * s[1]; o[3] = v[2] * s[1] + v[3] * c[1]; return o;
    }
    __device__ __forceinline__ void operator()(const f32x4 (&acc)[2][2][4][2], const pg8::Unit& u, int wr, int wc, int fr, int fq) const {
        pg8::epi_each(acc, u.pm * 256 + wr * 64 + fr, u.pn * 256 + wc * 32 + 4 * fq, [&](int row, int col, const f32x4& v) { elem(row, col, v); });
    }
    __device__ __forceinline__ void operator()(const f32x4 (&acc)[2][2][5], const pg8::Unit& u, int wid, int fr, int fq) const {
        epi_each160(acc, u, wid, fr, fq, [&](int row, int col, const f32x4& v) { elem(row, col, v); });
    }
    template <int MF> __device__ __forceinline__ void tile(const f32x4 (&acc)[2][2][MF][2], const pg8::Unit& u, int wr, int wc, int fr, int fq) const {
#pragma unroll
        for (int ai = 0; ai < 2; ++ai)
#pragma unroll
            for (int m = 0; m < MF; ++m)
#pragma unroll
                for (int bj = 0; bj < 2; ++bj)
#pragma unroll
                    for (int n = 0; n < 2; ++n) elem(u.pm * 160 + ai * 80 + wr * 48 + m * 16 + fr, u.pn * 256 + bj * 128 + wc * 32 + n * 16 + 4 * fq, acc[ai][bj][m][n]);
    }
    __device__ __forceinline__ void elem(int row, int col, const f32x4& v) const {
        {
            const bool smp = row >= NPR; const int sr = row - NPR, sb = sr >> 10, st = sr & 1023;
            if (col < 512) {
                f32x4 o = v; if (smp) o = do_rope(v, st, col);
                *(u32x2*)(Q + (size_t)row * 512 + col) = pk4(o);
            } else if (col < 1024) {
                const int c = col - 512;
                if (!smp) { *(f32x4*)(ock + (size_t)row * 512 + c) = v; *(u32x2*)(KP + (size_t)row * 512 + c) = pk4(v); }
                else { const f32x4 o = do_rope(v, st, c); *(u32x2*)(KS + ((size_t)sb * LKS + PAST + st) * 512 + c) = pk4(o); }
            } else if (col < 1536) {
                const int c = col - 1024, h = c >> 7, d = c & 127;
                if (!smp) { *(f32x4*)(ocv + (size_t)row * 512 + c) = v; const int b = row >> 8, t = row & 255; bf16* p = VTP + ((size_t)(b * 4 + h) * 128 + d) * SEQ + keypos(t);
#pragma unroll
                    for (int e = 0; e < 4; ++e) p[(size_t)e * SEQ] = f2bf(v[e]); }
                else { bf16* p = VTS + ((size_t)(sb * 4 + h) * 128 + d) * LKS + keypos(PAST + st);
#pragma unroll
                    for (int e = 0; e < 4; ++e) p[(size_t)e * LKS] = f2bf(v[e]); }
            } else if (col < INE) {
                *(u32x2*)(FB + (size_t)row * INB + (col - 1536)) = pk4(v);
            }
        }
    }
};


template <int CTRL> __device__ __forceinline__ float dpp_mv(float old, float src) { return __int_as_float(__builtin_amdgcn_update_dpp(__float_as_int(old), __float_as_int(src), CTRL, 0xf, 0xf, false)); }
template <int CTRL> __device__ __forceinline__ float dpp_rot(float src) { return __int_as_float(__builtin_amdgcn_mov_dpp(__float_as_int(src), CTRL, 0xf, 0xf, true)); }
__device__ __forceinline__ float silu_mul(float x, float u) { return x * __builtin_amdgcn_rcpf(1.f + __expf(-x)) * u; }
struct EpiFfnConv {
    static constexpr bool ALIGN = true;
    bf16* ACT; const float* cw; const float* cb; float* SB; LAS float* xch;
    __device__ __forceinline__ void operator()(const f32x4 (&acc)[2][2][4][2], const pg8::Unit& u, int wr, int wc, int fr, int fq) const {
        const int pm = u.pm, pn = u.pn;
        const bool smp = pm >= 32; const int sidx = pm - 32, sq = sidx & 3;
        const bool has_prev = smp && sq > 0, has_next = smp && sq < 3;
#pragma unroll
        for (int ai = 0; ai < 2; ++ai)
#pragma unroll
            for (int n = 0; n < 2; ++n) { const int c = 32 * wc + 16 * n + 4 * fq, blk = 2 * ai + wr;
                if (fr == 0) *(LAS f32x4*)(xch + (blk * 2 + 0) * 128 + c) = acc[ai][1][0][n];
                if (fr == 15) *(LAS f32x4*)(xch + (blk * 2 + 1) * 128 + c) = acc[ai][1][3][n]; }
        asm volatile("s_waitcnt lgkmcnt(0)" ::: "memory"); __builtin_amdgcn_s_barrier(); asm volatile("" ::: "memory");
#pragma unroll
        for (int n = 0; n < 2; ++n) {
            const int c = 32 * wc + 16 * n + 4 * fq, f = 128 * pn + c;
            const f32x4 c0 = *(const f32x4*)(cw + f), c1 = *(const f32x4*)(cw + DFF + f), c2 = *(const f32x4*)(cw + 2 * DFF + f), cbv = *(const f32x4*)(cb + f);
#pragma unroll
            for (int ai = 0; ai < 2; ++ai) {
                const int blk = 2 * ai + wr;
                f32x4 gabove = {0.f, 0.f, 0.f, 0.f}, gbelow = gabove;
                if (blk > 0) gabove = *(const LAS f32x4*)(xch + ((blk - 1) * 2 + 1) * 128 + c);
                if (blk < 3) gbelow = *(const LAS f32x4*)(xch + ((blk + 1) * 2 + 0) * 128 + c);
#pragma unroll
                for (int m = 0; m < 4; ++m) {
                    const f32x4 g = acc[ai][1][m][n], uu = acc[ai][0][m][n];
                    f32x4 o, xs;
#pragma unroll
                    for (int e = 0; e < 4; ++e) {
                        const float pold = m > 0 ? dpp_rot<0x121>(acc[ai][1][m - 1][n][e]) : gabove[e];
                        const float prev = dpp_mv<0x111>(pold, g[e]);
                        const float nold = m < 3 ? dpp_rot<0x12F>(acc[ai][1][m + 1][n][e]) : gbelow[e];
                        const float next = dpp_mv<0x101>(nold, g[e]);
                        const float x = c0[e] * prev + (c1[e] * g[e] + (c2[e] * next + cbv[e]));
                        xs[e] = x; o[e] = silu_mul(x, uu[e]);
                    }
                    const int r = 128 * ai + 64 * wr + 16 * m + fr;
                    *(u32x2*)(ACT + (size_t)(256 * pm + r) * DFF + f) = pk4(o);
                    if (smp) {
                        if (r == 0) { *(f32x4*)(SB + (size_t)(0 * 8 + sidx) * DFF + f) = g; if (has_prev) { *(f32x4*)(SB + (size_t)(2 * 8 + sidx) * DFF + f) = xs; *(f32x4*)(SB + (size_t)(3 * 8 + sidx) * DFF + f) = uu; } }
                        if (r == 255) { *(f32x4*)(SB + (size_t)(1 * 8 + sidx) * DFF + f) = g; if (has_next) { *(f32x4*)(SB + (size_t)(4 * 8 + sidx) * DFF + f) = xs; *(f32x4*)(SB + (size_t)(5 * 8 + sidx) * DFF + f) = uu; } }
                    }
                }
            }
        }
    }
};
template <class Sched>
__device__ __forceinline__ void ffn_seam_fixup(const Sched& S, int rows_per_unit, bf16* ACT, const float* cw, const float* SB) {
    pg8::Unit u;
    for (int i = 0; S.next(i, u); ++i) {
        const int lo = u.pm * rows_per_unit, hi = lo + rows_per_unit;
        if (hi <= NPR) continue;
        int t0 = threadIdx.x; asm volatile("" : "+v"(t0));
        for (int sidx = 0; sidx < 8; ++sidx) {
            const int sq = sidx & 3, r0 = 256 * (32 + sidx), r1 = r0 + 255;
            const bool fix0 = sq > 0 && r0 >= lo && r0 < hi, fix1 = sq < 3 && r1 >= lo && r1 < hi;
            if (!fix0 && !fix1) continue;
            for (int f = t0; f < DFF; f += 512) {
                if (fix0) { const float x = SB[(size_t)(2 * 8 + sidx) * DFF + f] + cw[f] * SB[(size_t)(1 * 8 + sidx - 1) * DFF + f]; ACT[(size_t)r0 * DFF + f] = f2bf(silu_mul(x, SB[(size_t)(3 * 8 + sidx) * DFF + f])); }
                if (fix1) { const float x = SB[(size_t)(4 * 8 + sidx) * DFF + f] + cw[2 * DFF + f] * SB[(size_t)(0 * 8 + sidx + 1) * DFF + f]; ACT[(size_t)r1 * DFF + f] = f2bf(silu_mul(x, SB[(size_t)(5 * 8 + sidx) * DFF + f])); }
            }
        }
    }
    asm volatile("s_waitcnt vmcnt(0)" ::: "memory");
    __syncthreads();
}

struct DftOrder {
    int G, c; const char* A; const char* BtS; const char* BtP;
    __device__ bool next(int i, pg8::Unit& u) const {
        const int j = i * G + c; if (j >= 160) return false;
        u.pm = 0; u.a = A;
        if (j < 32) { const int b = j >> 4, p = (j >> 2) & 3, pn = j & 3; u.pn = pn; u.z = NPR + b * 1024 + p; u.b = BtS + ((size_t)(b * 4 + p) * 1024 + pn * 256) * 512 * 2; }
        else { const int q = j - 32, b = q >> 2, pn = q & 3; u.pn = pn; u.z = b * 256; u.b = BtP + ((size_t)b * 1024 + pn * 256) * 512 * 2; }
        return true;
    }
};
struct EpiDft {
    bf16* O;
    static constexpr bool ALIGN = false;
    __device__ __forceinline__ void operator()(const f32x4 (&acc)[2][2][4][2], const pg8::Unit& u, int wr, int wc, int fr, int fq) const {
        const int st = u.z >= NPR ? 4 : 1;
        pg8::epi_each(acc, wr * 64 + fr, u.pn * 256 + wc * 32 + 4 * fq, [&](int r, int col, const f32x4& v) { *(u32x2*)(O + (size_t)(u.z + st * r) * 1024 + col) = pk4(v); });
    }
};

__device__ __forceinline__ f32x16 mfma32(bf16x8 x, bf16x8 y, f32x16 c) { return __builtin_amdgcn_mfma_f32_32x32x16_bf16(x, y, c, 0, 0, 0); }
__device__ __forceinline__ void phase_attention(const Args& a, LAS unsigned char* lds, int bid, int G) {
    int tid = threadIdx.x; asm volatile("" : "+v"(tid));
    const int lane = tid & 63, wave = __builtin_amdgcn_readfirstlane(tid >> 6), tk = lane & 31, hh = lane >> 5;
    const float cs = 0.125f * 1.4426950408889634f;
    const bf16* Q = WSB(WS_Q);
    bf16* AB = WSB(WS_XN);
    const float* subln = FIN(I_SUBLN);
    constexpr int KST = 136, VST = 40;
    LAS bf16* Kl = (LAS bf16*)lds;
    LAS bf16* Vl = (LAS bf16*)(lds + 2 * 32 * KST * 2);
    LAS bf16* Ql = (LAS bf16*)(lds + 40960 + wave * 8192);
    const int lkey = tid >> 4, lkc = tid & 15, lvd = tid >> 2, lvc = tid & 3;
    for (int ai = 0; ai < 2; ++ai) {
        int item;
        if (G == 256) {
            if (bid >= 224) item = ai == 0 ? bid - 224 : -1;
            else if (bid >= 160) item = 32 + 2 * (bid - 160) + ai;
            else item = -1;
        } else item = bid + ai * G;
        if (item < 0 || item >= 160) continue;
        int b, h, nkeys, qrow0; const bf16 *Kb, *VT;
        if (item < 32) { b = item >> 4; h = (item >> 2) & 3; const int qb = item & 3; nkeys = LKS; qrow0 = NPR + b * 1024 + qb * 256 + wave * 32; Kb = WSB(WS_KS) + (size_t)b * LKS * 512; VT = WSB(WS_VTS) + (size_t)(b * 4 + h) * 128 * LKS; }
        else { const int j = item - 32; b = j >> 2; h = j & 3; nkeys = SEQ; qrow0 = b * 256 + wave * 32; Kb = WSB(WS_KP) + (size_t)b * 256 * 512; VT = WSB(WS_VTP) + (size_t)(b * 4 + h) * 128 * SEQ; }
        f32x16 O[2][4];
#pragma unroll
        for (int m = 0; m < 2; ++m)
#pragma unroll
            for (int mt = 0; mt < 4; ++mt)
#pragma unroll
                for (int r = 0; r < 16; ++r) O[m][mt][r] = 0.f;
        float mx[2] = {-1e30f, -1e30f}, ls[2] = {0.f, 0.f};
        const bf16* kg = Kb + (size_t)lkey * 512 + h * 128 + lkc * 8;
        const bf16* vg = VT + (size_t)lvd * nkeys + lvc * 8;
        __syncthreads();
#pragma unroll
        for (int m = 0; m < 2; ++m)
#pragma unroll
            for (int s = 0; s < 4; ++s) *(LAS bf16x8*)(Ql + ((m * 4 + s) * 64 + lane) * 8) = *(const bf16x8*)(Q + (size_t)(qrow0 + tk) * 512 + h * 128 + m * 64 + 16 * s + 8 * hh);
        { const u32x4 k0v = *(const u32x4*)kg, v0v = *(const u32x4*)vg;
          *(LAS u32x4*)(Kl + lkey * KST + lkc * 8) = k0v; *(LAS u32x4*)(Vl + lvd * VST + lvc * 8) = v0v; }
        const int nt = nkeys / 32;
        for (int t = 0; t < nt; ++t) {
            const int cur = t & 1;
            const bool more = t + 1 < nt;
            u32x4 kn = {0u, 0u, 0u, 0u}, vn = kn;
            if (more) { kn = *(const u32x4*)(kg + (size_t)(t + 1) * 32 * 512); vn = *(const u32x4*)(vg + (t + 1) * 32); }
            __syncthreads();
            const LAS bf16* Kc = Kl + cur * 32 * KST + tk * KST + 8 * hh;
            const LAS bf16* Vc = Vl + cur * 128 * VST + tk * VST + 8 * hh;
            bf16x8 pb[2][2];
#pragma unroll
            for (int m = 0; m < 2; ++m) {
                f32x16 S;
#pragma unroll
                for (int r = 0; r < 16; ++r) S[r] = 0.f;
#pragma unroll
                for (int s = 0; s < 4; ++s) { const bf16x8 kf = *(const LAS bf16x8*)(Kc + m * 64 + 16 * s); const bf16x8 qfr = *(const LAS bf16x8*)(Ql + ((m * 4 + s) * 64 + lane) * 8); S = mfma32(kf, qfr, S); }
                float tm = S[0];
#pragma unroll
                for (int r = 1; r < 16; ++r) tm = fmaxf(tm, S[r]);
                tm = fmaxf(tm, __shfl_xor(tm, 32));
                if (__any(tm > mx[m] + 44.0f)) {
                    const float mn = fmaxf(mx[m], tm), alpha = __builtin_amdgcn_exp2f((mx[m] - mn) * cs); mx[m] = mn;
                    ls[m] *= alpha;
#pragma unroll
                    for (int mt = 0; mt < 4; ++mt)
#pragma unroll
                        for (int r = 0; r < 16; ++r) O[m][mt][r] *= alpha;
                }
                const float mcur = mx[m];
                float ps = 0.f;
#pragma unroll
                for (int r = 0; r < 16; ++r) { S[r] = __builtin_amdgcn_exp2f((S[r] - mcur) * cs); ps += S[r]; }
                ls[m] += ps;
#pragma unroll
                for (int s2 = 0; s2 < 2; ++s2) { u32x4 w; w.x = pk2(S[8 * s2 + 0], S[8 * s2 + 1]); w.y = pk2(S[8 * s2 + 2], S[8 * s2 + 3]); w.z = pk2(S[8 * s2 + 4], S[8 * s2 + 5]); w.w = pk2(S[8 * s2 + 6], S[8 * s2 + 7]); pb[m][s2] = __builtin_bit_cast(bf16x8, w); }
            }
#pragma unroll
            for (int mt = 0; mt < 4; ++mt) {
#pragma unroll
                for (int s2 = 0; s2 < 2; ++s2) { const bf16x8 vf = *(const LAS bf16x8*)(Vc + 32 * mt * VST + 16 * s2);
                    O[0][mt] = mfma32(vf, pb[0][s2], O[0][mt]); O[1][mt] = mfma32(vf, pb[1][s2], O[1][mt]); }
            }
            if (more) { *(LAS u32x4*)(Kl + (cur ^ 1) * 32 * KST + lkey * KST + lkc * 8) = kn; *(LAS u32x4*)(Vl + (cur ^ 1) * 128 * VST + lvd * VST + lvc * 8) = vn; }
        }
        const float l0 = ls[0] + __shfl_xor(ls[0], 32), l1 = ls[1] + __shfl_xor(ls[1], 32);
        const float lam = WSF(WS_LAM)[0];
        const float i0 = 1.f / l0, i1 = lam / l1;
        float ss = 0.f;
#pragma unroll
        for (int mt = 0; mt < 4; ++mt)
#pragma unroll
            for (int r = 0; r < 16; ++r) { const float o = O[0][mt][r] * i0 - O[1][mt][r] * i1; O[0][mt][r] = o; ss += o * o; }
        ss += __shfl_xor(ss, 32);
        const float rinv = rsqrtf(ss * (1.f / 128.f) + 1e-6f) * 0.8f;
        bf16* dst = AB + (size_t)(qrow0 + tk) * 1024 + h * 128;
#pragma unroll
        for (int mt = 0; mt < 4; ++mt)
#pragma unroll
            for (int rq = 0; rq < 4; ++rq) { const int d = 32 * mt + 8 * rq + 4 * hh; const f32x4 g = *(const f32x4*)(subln + d);
                f32x4 o; o[0] = O[0][mt][4 * rq + 0] * rinv * g[0]; o[1] = O[0][mt][4 * rq + 1] * rinv * g[1]; o[2] = O[0][mt][4 * rq + 2] * rinv * g[2]; o[3] = O[0][mt][4 * rq + 3] * rinv * g[3];
                *(u32x2*)(dst + d) = pk4(o); }
    }
}

__device__ __forceinline__ float allred4(float x) {
    { auto r = __builtin_amdgcn_permlane16_swap(__float_as_uint(x), __float_as_uint(x), false, false); x = __uint_as_float(r[0]) + __uint_as_float(r[1]); }
    { auto r = __builtin_amdgcn_permlane32_swap(__float_as_uint(x), __float_as_uint(x), false, false); x = __uint_as_float(r[0]) + __uint_as_float(r[1]); }
    return x;
}

constexpr int OPS_KGRG = 0, OPS_KDBD = 4096, OPS_CINIT = 8192, OPS_VIMG = 12288, OPS_GAM = 14336, OPS_ITEM = 14592;
constexpr size_t WS_OPS = WS_MF;
static_assert(WS_OPS + (size_t)2 * 5120 * OPS_ITEM <= WS_Q, "ws ops");
__device__ __forceinline__ f32x4 mfma16(bf16x8 x, bf16x8 y, f32x4 c) { return __builtin_amdgcn_mfma_f32_16x16x32_bf16(x, y, c, 0, 0, 0); }
__device__ __forceinline__ bf16x8 frag_lo(f32x4 v) { u32x4 w; w.x = pk2(v[0], v[1]); w.y = pk2(v[2], v[3]); w.z = 0u; w.w = 0u; return __builtin_bit_cast(bf16x8, w); }
__device__ __forceinline__ void wave_lds_sync() { __syncthreads(); }


template <bool REV>
__device__ __forceinline__ void wkv_chunk_ops(unsigned char* ops, LAS unsigned char* wl, int lane, const float (&kkn)[16], const float (&wv)[16], const float (&kraw)[16], const float (&ad)[16], const float ka_, const float (&rr)[16], const unsigned (&vp)[8]) {
    int lane_ = lane; asm volatile("" : "+v"(lane_));
    const int lr = lane_ & 15, lg = lane_ >> 4, j = lane_;
    LAS bf16* KgR = (LAS bf16*)wl; LAS bf16* RgR = KgR + 16 * 72; LAS bf16* KiR = RgR + 16 * 72; LAS bf16* BiR = KiR + 16 * 72;
    LAS bf16* KgT = (LAS bf16*)(wl + 9216); LAS float* RgT = (LAS float*)(wl + 9216 + 2048); LAS bf16* VT = (LAS bf16*)(wl + 9216 + 2048 + 5120);
    LAS float* NL = (LAS float*)wl; LAS float* TL = (LAS float*)(wl + 2304);
    float gall = 1.f;
#pragma unroll
    for (int t = 0; t < 16; ++t) gall *= wv[t];
    *(float*)(ops + OPS_GAM + 4 * j) = gall;
    float grun = 1.f;
#pragma unroll
    for (int g = 0; g < 4; ++g) {
        float kdv[4], bdv[4]; unsigned vb4[4];
#pragma unroll
        for (int e = 0; e < 4; ++e) {
            const int tau = 4 * g + e, t = REV ? 15 - tau : tau;
            const float gprev = grun; grun *= wv[t];
            const float inv = __builtin_amdgcn_rcpf(grun);
            const float kg = kkn[t] * gprev, rg = rr[t] * grun, ki = kraw[t] * (1.f + (ad[t] - 1.f) * ka_) * inv, bi = kkn[t] * ad[t] * inv;
            kdv[e] = ki * gall; bdv[e] = -bi * gall; vb4[e] = (vp[t >> 1] >> (16 * (t & 1))) & 0xffffu;
            KgR[tau * 72 + j] = f2bf(kg); RgR[tau * 72 + j] = f2bf(rg); KiR[tau * 72 + j] = f2bf(ki); BiR[tau * 72 + j] = f2bf(bi);
            KgT[(g * 64 + j) * 4 + e] = f2bf(kg); RgT[j * 20 + tau] = rg; VT[(g * 64 + j) * 4 + e] = (bf16)vb4[e];
        }
        u32x4 w; w.x = pk2(kdv[0], kdv[1]); w.y = pk2(kdv[2], kdv[3]); w.z = pk2(bdv[0], bdv[1]); w.w = pk2(bdv[2], bdv[3]);
        *(u32x4*)(ops + OPS_KDBD + (((j >> 4) * 64 + (j & 15) + 16 * g) * 16)) = w;
        u32x2 vw; vw.x = vb4[0] | (vb4[1] << 16); vw.y = vb4[2] | (vb4[3] << 16);
        *(u32x2*)(ops + OPS_VIMG + (((j >> 4) * 64 + (j & 15) + 16 * g) * 8)) = vw;
    }
    wave_lds_sync();
    f32x4 akk = {0.f, 0.f, 0.f, 0.f}, akb = akk, ark = akk, arb = akk;
#pragma unroll
    for (int ks = 0; ks < 2; ++ks) {
        const bf16x8 fki = *(const LAS bf16x8*)(KiR + lr * 72 + 32 * ks + 8 * lg), fbi = *(const LAS bf16x8*)(BiR + lr * 72 + 32 * ks + 8 * lg);
        const bf16x8 fkg = *(const LAS bf16x8*)(KgR + lr * 72 + 32 * ks + 8 * lg), frg = *(const LAS bf16x8*)(RgR + lr * 72 + 32 * ks + 8 * lg);
        akk = mfma16(fki, fkg, akk); akb = mfma16(fbi, fkg, akb); ark = mfma16(fki, frg, ark); arb = mfma16(fbi, frg, arb);
    }
#pragma unroll
    for (int e = 0; e < 4; ++e) { const int s = 4 * lg + e; if (!(s < lr)) { akk[e] = 0.f; akb[e] = 0.f; } if (!(s <= lr)) { ark[e] = 0.f; arb[e] = 0.f; } }
    asm volatile("" : "+v"(akk), "+v"(akb), "+v"(ark), "+v"(arb));
    wave_lds_sync();
    *(LAS f32x4*)(NL + lr * 16 + 4 * lg) = akb;
    wave_lds_sync();
    {
        float Tc[16];
#pragma unroll
        for (int t = 0; t < 16; ++t) {
            float acc = (t == lr) ? 1.f : 0.f;
#pragma unroll
            for (int q4 = 0; q4 < (t + 3) / 4; ++q4) { const f32x4 nv = *(const LAS f32x4*)(NL + t * 16 + 4 * q4);
#pragma unroll
                for (int e = 0; e < 4; ++e) if (4 * q4 + e < t) acc -= nv[e] * Tc[4 * q4 + e]; }
            Tc[t] = acc;
        }
        if (lg == 0) {
#pragma unroll
            for (int t = 0; t < 16; ++t) TL[t * 16 + lr] = Tc[t];
        }
    }
    wave_lds_sync();
    const bf16x8 aT = frag_lo(*(const LAS f32x4*)(TL + lr * 16 + 4 * lg));
    const bf16x8 aKK = frag_lo(akk), aRK = frag_lo(ark), aRBn = frag_lo(-arb);
    const f32x4 z4 = {0.f, 0.f, 0.f, 0.f};
#pragma unroll
    for (int it = 0; it < 4; ++it) {
        const u32x2 vq = *(const LAS u32x2*)(VT + (lg * 64 + 16 * it + lr) * 4);
        const bf16x8 bV = __builtin_bit_cast(bf16x8, (u32x4){vq.x, vq.y, 0u, 0u});
        const f32x4 x1 = mfma16(aKK, bV, z4);
        const f32x4 vd = mfma16(aT, frag_lo(x1), z4);
        f32x4 yl = mfma16(aRK, bV, z4); yl = mfma16(aRBn, frag_lo(vd), yl);
        *(u32x2*)(ops + OPS_CINIT + ((0 * 4 + it) * 64 + lane) * 8) = pk4(vd);
        *(u32x2*)(ops + OPS_CINIT + ((1 * 4 + it) * 64 + lane) * 8) = pk4(yl);
    }
#pragma unroll
    for (int jt = 0; jt < 4; ++jt) {
        const u32x2 kq = *(const LAS u32x2*)(KgT + (lg * 64 + 16 * jt + lr) * 4);
        const bf16x8 bK = __builtin_bit_cast(bf16x8, (u32x4){kq.x, kq.y, 0u, 0u});
        const f32x4 kgp = mfma16(aT, bK, z4);
        const f32x4 rgp = mfma16(aRBn, frag_lo(kgp), *(const LAS f32x4*)(RgT + (16 * jt + lr) * 20 + 4 * lg));
        bf16* img = (bf16*)(ops + OPS_KGRG);
#pragma unroll
        for (int e = 0; e < 4; ++e) { const int t = 4 * lg + e; const int off = (((jt >> 1)) * 64 + t + 16 * (lr >> 2)) * 8 + 4 * (jt & 1) + (lr & 3);
            img[off] = f2bf(kgp[e]); img[2 * 64 * 8 + off] = f2bf(rgp[e]); }
    }
    wave_lds_sync();
}

__device__ __forceinline__ void phase_wkv_front(const Args& a, LAS unsigned char* lds, int bid, int G) {
    int tid = threadIdx.x; asm volatile("" : "+v"(tid));
    const int lane = tid & 63, wave = __builtin_amdgcn_readfirstlane(tid >> 6);
    constexpr int AST = 392;
    typedef const __attribute__((address_space(1))) bf16* gcb;
    const bf16* FB = (const bf16*)a.out;
    LAS bf16* act = (LAS bf16*)(lds + ACT_OFF);
    LAS unsigned char* wl = lds + wave * 18432;
    LAS float* TR = (LAS float*)wl;
    const float* mu = FIN(I_MU); const float* kvec = FIN(I_KVEC); const float* w0 = FIN(I_W0); const float* a0 = FIN(I_A0);
    bf16* AB = WSB(WS_XN); bf16* BON = WSB(WS_BONUS);
    int it_lo, it_n;
    if (G == 256) { if (bid < 160) { it_lo = 3 * bid; it_n = 3; } else if (bid < 224) { it_lo = 480 + 2 * (bid - 160); it_n = 2; } else { it_lo = 608 + (bid - 224); it_n = 1; } }
    else { it_lo = bid; it_n = (640 - bid + G - 1) / G; }
    for (int ii = 0; ii < it_n; ++ii) {
        const int item = (G == 256) ? it_lo + ii : it_lo + ii * G;
        int smp, sq, c, L, rowbase, nc;
        if (item < 128) { smp = 1; sq = item >> 6; c = item & 63; L = DSEQ; rowbase = NPR + sq * DSEQ; nc = 64; }
        else { const int p = item - 128; smp = 0; sq = p >> 4; c = p & 15; L = SEQ; rowbase = sq * SEQ; nc = 16; }
        const int row0 = rowbase + 16 * c, tp0 = 16 * c;
        __syncthreads();
        int tq = tid; asm volatile("" : "+v"(tq));
        for (int idx = tq; idx < 16 * 96; idx += 512) {
            const int tl = idx / 96, cg = idx - tl * 96, col = 1536 + 4 * cg, row = row0 + tl, tp = tp0 + tl;
            const f32x4 f = unpk4(*(const u32x2*)(FB + (size_t)row * INB + col));
            const f32x4 p = unpk4(*(const u32x2*)(FB + (size_t)(tp > 0 ? row - 1 : row) * INB + col)) * (tp > 0 ? 1.f : 0.f);
            const f32x4 n = unpk4(*(const u32x2*)(FB + (size_t)(tp < L - 1 ? row + 1 : row) * INB + col)) * (tp < L - 1 ? 1.f : 0.f);
            const f32x4 m0 = *(const f32x4*)(mu + col), m1 = *(const f32x4*)(mu + INB + col);
            f32x4 s = f + m0 * (p - f) + m1 * (n - f);
            const int kind = cg >> 5;
            if (kind == 0) { s[0] = tanhf(s[0]); s[1] = tanhf(s[1]); s[2] = tanhf(s[2]); s[3] = tanhf(s[3]); }
            else if (kind == 2) { s[0] = sigmoidf_(s[0]); s[1] = sigmoidf_(s[1]); s[2] = sigmoidf_(s[2]); s[3] = sigmoidf_(s[3]); }
            *(LAS u32x2*)(act + tl * AST + 4 * cg) = pk4(s);
        }
        __syncthreads();
        int j = lane; asm volatile("" : "+v"(j));
        const int lr = j & 15, lg = j >> 4;
        const int h = wave, col = h * 64 + j;
        auto lora_mma = [&](const bf16* WT, int ldk, int k0, int nks, f32x4 (&acc)[4]) {
            gcb wb = (gcb)(WT + (size_t)(h * 64 + lr) * ldk + 8 * lg);
            const LAS bf16* ab = act + lr * AST + k0 + 8 * lg;
            asm volatile("" : "+v"(wb), "+v"(ab));
#pragma unroll
            for (int jt = 0; jt < 4; ++jt) acc[jt] = (f32x4){0.f, 0.f, 0.f, 0.f};
            for (int ks = 0; ks < nks; ++ks) {
                const bf16x8 fa = *(const LAS bf16x8*)(ab + 32 * ks);
#pragma unroll
                for (int jt = 0; jt < 4; ++jt) { const bf16x8 fb = *(const __attribute__((address_space(1))) bf16x8*)(wb + (size_t)(16 * jt) * ldk + 32 * ks); acc[jt] = mfma16(fa, fb, acc[jt]); }
            }
        };
        auto tr_put = [&](int b, const f32x4 (&acc)[4]) {
#pragma unroll
            for (int jt = 0; jt < 4; ++jt) *(LAS f32x4*)(TR + b * 1280 + (16 * jt + lr) * 20 + 4 * lg) = acc[jt];
        };
        auto tr_get = [&](int b, float (&out)[16]) {
#pragma unroll
            for (int q = 0; q < 4; ++q) { const f32x4 x = *(const LAS f32x4*)(TR + b * 1280 + j * 20 + 4 * q); out[4 * q] = x[0]; out[4 * q + 1] = x[1]; out[4 * q + 2] = x[2]; out[4 * q + 3] = x[3]; }
        };
        f32x4 accG[4], accA0[4], accA1[4], accW0[4];
        lora_mma(WSB(WS_G2T), 128, 256, 4, accG);
        lora_mma(WSB(WS_A2T), 64, 128, 2, accA0);
        lora_mma(WSB(WS_A2T) + 512 * 64, 64, 192, 2, accA1);
        lora_mma(WSB(WS_W2T), 64, 0, 2, accW0);
        float r[16], k[16]; unsigned vp[8];
        {
            unsigned raw[3][18]; float v[16];
#pragma unroll
            for (int x = 0; x < 3; ++x)
#pragma unroll
                for (int q = 0; q < 18; ++q) { const int tp = tp0 - 1 + q; const int rw = row0 - 1 + q + (tp < 0 ? 1 : 0) - (tp > L - 1 ? 1 : 0); raw[x][q] = FB[(size_t)rw * INB + 512 * x + col]; }
            const float pm = tp0 > 0 ? 1.f : 0.f, nm = tp0 + 16 < L ? 1.f : 0.f;
            const float mr0 = mu[col], mr1 = mu[INB + col], mk0 = mu[512 + col], mk1 = mu[INB + 512 + col], mv0 = mu[1024 + col], mv1 = mu[INB + 1024 + col];
#pragma unroll
            for (int t = 0; t < 16; ++t) {
                const float pmask = t == 0 ? pm : 1.f, nmask = t == 15 ? nm : 1.f;
                { const float f = bf2f(raw[0][t + 1]), p = bf2f(raw[0][t]) * pmask, n = bf2f(raw[0][t + 2]) * nmask; r[t] = f + mr0 * (p - f) + mr1 * (n - f); }
                { const float f = bf2f(raw[1][t + 1]), p = bf2f(raw[1][t]) * pmask, n = bf2f(raw[1][t + 2]) * nmask; k[t] = f + mk0 * (p - f) + mk1 * (n - f); }
                { const float f = bf2f(raw[2][t + 1]), p = bf2f(raw[2][t]) * pmask, n = bf2f(raw[2][t + 2]) * nmask; v[t] = f + mv0 * (p - f) + mv1 * (n - f); }
            }
#pragma unroll
            for (int q = 0; q < 8; ++q) vp[q] = pk2(v[2 * q], v[2 * q + 1]);
        }
        float av0[16], av1[16];
        {
            float graw[16];
            tr_put(0, accG); tr_put(1, accA0); tr_put(2, accA1);
            wave_lds_sync();
            tr_get(0, graw); tr_get(1, av0); tr_get(2, av1);
            wave_lds_sync();
#pragma unroll
            for (int t = 0; t < 16; ++t) AB[(size_t)(row0 + t) * 1024 + 512 + col] = f2bf(graw[t]);
        }
        float wv0[16];
        {
            tr_put(0, accW0);
            wave_lds_sync();
            tr_get(0, wv0);
            wave_lds_sync();
            const float w00 = w0[col];
#pragma unroll
            for (int t = 0; t < 16; ++t) wv0[t] = __expf(-0.60653065971f * sigmoidf_(w00 + wv0[t]));
        }
        const float kk_ = kvec[col], ka_ = kvec[512 + col], rk_ = kvec[1024 + col], a00 = a0[col], a01 = a0[512 + col];
        float kkn[16];
        {
            LAS float* RED1 = (LAS float*)wl; LAS float* RED2 = RED1 + 64 * 17; LAS float* TOT = RED2 + 64 * 17;
#pragma unroll
            for (int t = 0; t < 16; ++t) {
                av0[t] = sigmoidf_(a00 + av0[t]); av1[t] = sigmoidf_(a01 + av1[t]);
                const float kr = k[t] * kk_; kkn[t] = kr;
                RED1[j * 17 + t] = kr * kr; RED2[j * 17 + t] = r[t] * rk_ * k[t] * (2.f + (av0[t] + av1[t] - 2.f) * ka_);
            }
            wave_lds_sync();
            float s1 = 0.f, s2 = 0.f;
#pragma unroll
            for (int jj = 0; jj < 16; ++jj) { s1 += RED1[(16 * lg + jj) * 17 + lr]; s2 += RED2[(16 * lg + jj) * 17 + lr]; }
            s1 = allred4(s1); s2 = allred4(s2);
            if (lg == 0) { TOT[lr] = rsqrtf(s1 + 1e-12f); TOT[16 + lr] = s2; }
            wave_lds_sync();
#pragma unroll
            for (int q = 0; q < 4; ++q) { const f32x4 ri = *(const LAS f32x4*)(TOT + 4 * q), rs = *(const LAS f32x4*)(TOT + 16 + 4 * q);
#pragma unroll
                for (int e = 0; e < 4; ++e) { const int t = 4 * q + e; kkn[t] *= ri[e]; BON[(size_t)(row0 + t) * 512 + col] = f2bf(rs[e] * __uint_as_float((t & 1) ? (vp[t >> 1] & 0xffff0000u) : (vp[t >> 1] << 16))); } }
            wave_lds_sync();
        }
        {
            const int oi = smp ? 4096 + (sq * 8 + h) * 64 + c : (sq * 8 + h) * 16 + c;
            wkv_chunk_ops<false>(a.ws + WS_OPS + (size_t)oi * OPS_ITEM, wl, lane, kkn, wv0, k, av0, ka_, r, vp);
        }
        {
            float wv1[16];
            { f32x4 accW1[4]; lora_mma(WSB(WS_W2T) + 512 * 64, 64, 64, 2, accW1); tr_put(0, accW1); wave_lds_sync(); tr_get(0, wv1); wave_lds_sync();
              const float w01 = w0[512 + col];
#pragma unroll
              for (int t = 0; t < 16; ++t) wv1[t] = __expf(-0.60653065971f * sigmoidf_(w01 + wv1[t])); }
            const int cc = nc - 1 - c;
            const int oi = 5120 + (smp ? 4096 + (sq * 8 + h) * 64 + cc : (sq * 8 + h) * 16 + cc);
            wkv_chunk_ops<true>(a.ws + WS_OPS + (size_t)oi * OPS_ITEM, wl, lane, kkn, wv1, k, av1, ka_, r, vp);
        }
    }
}

struct ChainOps { bf16x8 kgrg[2][2]; u32x2 cinit[2]; bf16x8 kdbd[4]; u32x2 vimg; f32x4 gam[4]; };
__device__ __forceinline__ void chain_load(ChainOps& o, const unsigned char* ops, int lane, int it) {
    const int lg = lane >> 4;
#pragma unroll
    for (int rt = 0; rt < 2; ++rt) {
#pragma unroll
        for (int ks = 0; ks < 2; ++ks) o.kgrg[rt][ks] = *(const bf16x8*)(ops + OPS_KGRG + ((rt * 2 + ks) * 64 + lane) * 16);
        o.cinit[rt] = *(const u32x2*)(ops + OPS_CINIT + ((rt * 4 + it) * 64 + lane) * 8);
    }
#pragma unroll
    for (int jt = 0; jt < 4; ++jt) { o.kdbd[jt] = *(const bf16x8*)(ops + OPS_KDBD + (jt * 64 + lane) * 16); o.gam[jt] = *(const f32x4*)(ops + OPS_GAM + (16 * jt + 4 * lg) * 4); }
    o.vimg = *(const u32x2*)(ops + OPS_VIMG + (it * 64 + lane) * 8);
}
__device__ __forceinline__ void wkv_sample_wave(const Args& a, LAS float* ybuf, int idx, int lane) {
    const int lr = lane & 15, lg = lane >> 4;
    const int dir = idx >> 6, ch = (idx >> 2) & 15, it = idx & 3;
    const int b = ch >> 3, h = ch & 7, nc = 64, L = DSEQ, rowbase = NPR + b * DSEQ, opsbase = 4096 + ch * 64;
    float* Y = a.out;
    f32x4 H[4];
    { const float* sp = FIN(I_ST) + (size_t)((b * 2 + dir) * 8 + h) * 4096;
#pragma unroll
      for (int jt = 0; jt < 4; ++jt) H[jt] = *(const f32x4*)(sp + (16 * it + lr) * 64 + 16 * jt + 4 * lg); }
    const unsigned char* opsp = a.ws + WS_OPS + (size_t)(dir * 5120 + opsbase) * OPS_ITEM;
    float* yg = Y + ((size_t)dir * NT + rowbase) * 512 + h * 64 + 16 * it + 4 * (lane & 3);
    ChainOps o0, o1;
    chain_load(o0, opsp, lane, it);
    chain_load(o1, opsp + OPS_ITEM, lane, it);
    auto step = [&](const ChainOps& cur, int c) {
        bf16x8 bh[2];
#pragma unroll
        for (int ks = 0; ks < 2; ++ks) { const u32x2 p0 = pk4(H[2 * ks]), p1 = pk4(H[2 * ks + 1]); bh[ks] = __builtin_bit_cast(bf16x8, (u32x4){p0.x, p0.y, p1.x, p1.y}); }
        f32x4 u = unpk4(cur.cinit[0]), y = unpk4(cur.cinit[1]);
#pragma unroll
        for (int ks = 0; ks < 2; ++ks) { u = mfma16(cur.kgrg[0][ks], bh[ks], u); y = mfma16(cur.kgrg[1][ks], bh[ks], y); }
#pragma unroll
        for (int e = 0; e < 4; ++e) ybuf[(16 * (c & 15) + 4 * lg + e) * 16 + lr] = y[e];
        const u32x2 up = pk4(u);
        const bf16x8 bvu = __builtin_bit_cast(bf16x8, (u32x4){cur.vimg.x, cur.vimg.y, up.x, up.y});
#pragma unroll
        for (int jt = 0; jt < 4; ++jt) H[jt] = mfma16(cur.kdbd[jt], bvu, H[jt] * cur.gam[jt]);
    };
    auto flush = [&](int c) {
        if ((c & 15) == 15) {
            asm volatile("s_waitcnt lgkmcnt(0)" ::: "memory");
            const int base = 256 * (c >> 4);
#pragma unroll 1
            for (int r0 = 0; r0 < 256; r0 += 16) { const int lt = base + r0 + (lane >> 2);
                *(f32x4*)(yg + (size_t)(dir ? L - 1 - lt : lt) * 512) = *(const LAS f32x4*)(ybuf + (r0 + (lane >> 2)) * 16 + 4 * (lane & 3)); }
            asm volatile("s_waitcnt lgkmcnt(0)" ::: "memory");
        }
    };
    ChainOps o2; chain_load(o2, opsp + 2 * OPS_ITEM, lane, it);
    int c = 0;
#pragma unroll 1
    for (; c + 2 < nc; c += 3) {
        step(o0, c); chain_load(o0, opsp + (size_t)(c + 3 < nc ? c + 3 : nc - 1) * OPS_ITEM, lane, it); flush(c);
        step(o1, c + 1); chain_load(o1, opsp + (size_t)(c + 4 < nc ? c + 4 : nc - 1) * OPS_ITEM, lane, it); flush(c + 1);
        step(o2, c + 2); chain_load(o2, opsp + (size_t)(c + 5 < nc ? c + 5 : nc - 1) * OPS_ITEM, lane, it); flush(c + 2);
    }
    for (; c < nc; ++c) { step(o0, c); flush(c); }
    asm volatile("s_waitcnt vmcnt(0) lgkmcnt(0)" ::: "memory");
}

struct ChainSh { bf16x8 kg, kd; float gm; };
struct ChainPr { u32x2 ci0, ci1, vi; };
__device__ __forceinline__ void chain_sh(ChainSh& o, const unsigned char* ops, int lane, int it) {
    o.kg = *(const bf16x8*)(ops + OPS_KGRG + (it * 64 + lane) * 16);
    o.kd = *(const bf16x8*)(ops + OPS_KDBD + (it * 64 + lane) * 16);
    o.gm = *(const float*)(ops + OPS_GAM + (16 * it + (lane & 15)) * 4);
}
__device__ __forceinline__ void chain_pr(ChainPr& o, const unsigned char* ops, int lane, int it) {
    o.ci0 = *(const u32x2*)(ops + OPS_CINIT + ((0 * 4 + it) * 64 + lane) * 8);
    o.ci1 = *(const u32x2*)(ops + OPS_CINIT + ((1 * 4 + it) * 64 + lane) * 8);
    o.vi = *(const u32x2*)(ops + OPS_VIMG + (it * 64 + lane) * 8);
}
template <bool DRY = false>
__device__ __forceinline__ void phase_wkv_chain(const Args& a, LAS unsigned char* lds, int bid, int G) {
    int tid = threadIdx.x; asm volatile("" : "+v"(tid));
    const int lane = tid & 63, wave = __builtin_amdgcn_readfirstlane(tid >> 6);
    const int lr = lane & 15, lg = lane >> 4;
    float* Y = a.out;
    LAS float* ybuf = (LAS float*)(lds + wave * 16384);
    const int dir = wave >> 2, it = wave & 3;
    LAS unsigned char* slot = lds + 131072 + dir * 8448;
    const bf16* BON = WSB(WS_BONUS); bf16* AB = WSB(WS_XN);
    const float* lnx = FIN(I_LNX);
    if (G == 256 && bid < 128) {
        if (wave == 0) wkv_sample_wave(a, (LAS float*)lds, bid, lane);
        return;
    }
#pragma unroll 1
    for (int jrep = 0; ; ++jrep) {
        int k;
        if (G == 256) { if (jrep < 2) k = 16 + 2 * (bid - 128) + jrep; else break; }
        else { k = bid + jrep * G; if (k >= 272) break; }
        int smp, b, h, nc, L, rowbase, opsbase;
        if (k < 16) { smp = 1; b = k >> 3; h = k & 7; nc = 64; L = DSEQ; rowbase = NPR + b * DSEQ; opsbase = 4096 + k * 64; }
        else { const int p = k - 16; smp = 0; b = p >> 3; h = p & 7; nc = 16; L = SEQ; rowbase = b * SEQ; opsbase = p * 16; }
        f32x4 H[4];
        if (smp) {
            const float* sp = FIN(I_ST) + (size_t)((b * 2 + dir) * 8 + h) * 4096;
#pragma unroll
            for (int jt = 0; jt < 4; ++jt) H[jt] = *(const f32x4*)(sp + (16 * it + lr) * 64 + 16 * jt + 4 * lg);
        } else {
#pragma unroll
            for (int jt = 0; jt < 4; ++jt) H[jt] = (f32x4){0.f, 0.f, 0.f, 0.f};
        }
        const unsigned char* opsp = a.ws + WS_OPS + (size_t)(dir * 5120 + opsbase) * OPS_ITEM;
        float* yg = Y + ((size_t)dir * NT + rowbase) * 512 + h * 64 + 16 * it + 4 * (lane & 3);
        constexpr int D = 8;
        ChainSh sh[D]; ChainPr pr[D];
#pragma unroll
        for (int i = 0; i < D; ++i) { chain_sh(sh[i], opsp + (size_t)i * OPS_ITEM, lane, it); chain_pr(pr[i], opsp + (size_t)i * OPS_ITEM, lane, it); }
        auto put = [&](const ChainSh& o) {
            *(LAS bf16x8*)(slot + it * 1024 + lane * 16) = o.kg; *(LAS bf16x8*)(slot + 4096 + it * 1024 + lane * 16) = o.kd;
            if (lane < 16) *(LAS float*)(slot + 8192 + (16 * it + lane) * 4) = o.gm; };
        put(sh[0]);
        chain_sh(sh[0], opsp + (size_t)(D < nc ? D : nc - 1) * OPS_ITEM, lane, it);
        asm volatile("s_waitcnt lgkmcnt(0)" ::: "memory"); __builtin_amdgcn_s_barrier(); asm volatile("" ::: "memory");
#pragma unroll 1
        for (int c = 0; c < nc; c += D) {
#pragma unroll
            for (int i = 0; i < D; ++i) {
                const int cc = c + i;
                bf16x8 kgrg[2][2], kdbd[4]; f32x4 gam[4];
#pragma unroll
                for (int q = 0; q < 4; ++q) { kgrg[q >> 1][q & 1] = *(const LAS bf16x8*)(slot + q * 1024 + lane * 16); kdbd[q] = *(const LAS bf16x8*)(slot + 4096 + q * 1024 + lane * 16); gam[q] = *(const LAS f32x4*)(slot + 8192 + (16 * q + 4 * lg) * 4); }
                asm volatile("s_waitcnt lgkmcnt(0)" ::: "memory"); __builtin_amdgcn_s_barrier(); asm volatile("" ::: "memory");
                put(sh[(i + 1) % D]);
                chain_sh(sh[(i + 1) % D], opsp + (size_t)(cc + 1 + D < nc ? cc + 1 + D : nc - 1) * OPS_ITEM, lane, it);
                const u32x2 c0 = pr[i].ci0, c1 = pr[i].ci1, cv = pr[i].vi;
                bf16x8 bh[2];
#pragma unroll
                for (int ks = 0; ks < 2; ++ks) { const u32x2 p0 = pk4(H[2 * ks]), p1 = pk4(H[2 * ks + 1]); bh[ks] = __builtin_bit_cast(bf16x8, (u32x4){p0.x, p0.y, p1.x, p1.y}); }
                f32x4 u = unpk4(c0), y = unpk4(c1);
#pragma unroll
                for (int ks = 0; ks < 2; ++ks) { u = mfma16(kgrg[0][ks], bh[ks], u); y = mfma16(kgrg[1][ks], bh[ks], y); }
#pragma unroll
                for (int e = 0; e < 4; ++e) ybuf[(16 * (cc & 15) + 4 * lg + e) * 16 + lr] = y[e];
                const u32x2 up = pk4(u);
                const bf16x8 bvu = __builtin_bit_cast(bf16x8, (u32x4){cv.x, cv.y, up.x, up.y});
#pragma unroll
                for (int jt = 0; jt < 4; ++jt) H[jt] = mfma16(kdbd[jt], bvu, H[jt] * gam[jt]);
                chain_pr(pr[i], opsp + (size_t)(cc + D < nc ? cc + D : nc - 1) * OPS_ITEM, lane, it);
                if (smp && (cc & 15) == 15) {
                    asm volatile("s_waitcnt lgkmcnt(0)" ::: "memory");
                    const int base = 256 * (cc >> 4);
#pragma unroll 1
                    for (int r0 = 0; r0 < 256; r0 += 16) { const int lt = base + r0 + (lane >> 2);
                        *(f32x4*)(yg + (size_t)(dir ? L - 1 - lt : lt) * 512) = *(const LAS f32x4*)(ybuf + (r0 + (lane >> 2)) * 16 + 4 * (lane & 3)); }
                }
                asm volatile("s_waitcnt lgkmcnt(0)" ::: "memory"); __builtin_amdgcn_s_barrier(); asm volatile("" ::: "memory");
            }
        }
        if (!smp) { float* op = a.out + OUT_ST + (size_t)((b * 2 + dir) * 8 + h) * 4096;
#pragma unroll
            for (int jt = 0; jt < 4; ++jt) *(f32x4*)(op + (16 * it + lr) * 64 + 16 * jt + 4 * lg) = H[jt]; }
        asm volatile("s_waitcnt vmcnt(0) lgkmcnt(0)" ::: "memory");
        __syncthreads();
        if (smp) continue;
        {
            const int hf = tid & 1;
            const float* l0p = lnx + h * 64 + 32 * hf; const float* l1p = lnx + 512 + h * 64 + 32 * hf;
            for (int t = tid >> 1; t < L; t += 256) {
                float x[32];
#pragma unroll
                for (int q = 0; q < 8; ++q) { const int itq = 2 * hf + (q >> 2);
                    const f32x4 f = *(const LAS f32x4*)(lds + itq * 16384 + (t * 16 + 4 * (q & 3)) * 4), g = *(const LAS f32x4*)(lds + (4 + itq) * 16384 + ((L - 1 - t) * 16 + 4 * (q & 3)) * 4);
                    x[4 * q] = f[0] + g[0]; x[4 * q + 1] = f[1] + g[1]; x[4 * q + 2] = f[2] + g[2]; x[4 * q + 3] = f[3] + g[3]; }
                float s = 0.f;
#pragma unroll
                for (int e = 0; e < 32; ++e) s += x[e];
                s += __shfl_xor(s, 1);
                const float mu = s * (1.f / 64.f);
                float v = 0.f;
#pragma unroll
                for (int e = 0; e < 32; ++e) { x[e] -= mu; v += x[e] * x[e]; }
                v += __shfl_xor(v, 1);
                const float rstd = rsqrtf(v * (1.f / 64.f) + 64e-5f);
                const size_t row = (size_t)rowbase + t;
                const bf16* bp = BON + row * 512 + h * 64 + 32 * hf; bf16* gp = AB + row * 1024 + 512 + h * 64 + 32 * hf;
#pragma unroll
                for (int q = 0; q < 4; ++q) {
                    const u32x4 bw = *(const u32x4*)(bp + 8 * q), gw4 = *(const u32x4*)(gp + 8 * q);
                    const f32x4 bo0 = unpk4((u32x2){bw.x, bw.y}), bo1 = unpk4((u32x2){bw.z, bw.w}), gg0 = unpk4((u32x2){gw4.x, gw4.y}), gg1 = unpk4((u32x2){gw4.z, gw4.w});
                    const f32x4 l00 = *(const f32x4*)(l0p + 8 * q), l01 = *(const f32x4*)(l0p + 8 * q + 4), l10 = *(const f32x4*)(l1p + 8 * q), l11 = *(const f32x4*)(l1p + 8 * q + 4);
                    f32x4 o0, o1;
#pragma unroll
                    for (int e = 0; e < 4; ++e) { o0[e] = (x[8 * q + e] * rstd * l00[e] + l10[e] + bo0[e]) * gg0[e]; o1[e] = (x[8 * q + 4 + e] * rstd * l01[e] + l11[e] + bo1[e]) * gg1[e]; }
                    const u32x2 p0 = pk4(o0), p1 = pk4(o1);
                    *(u32x4*)((DRY ? (bf16*)(a.ws + 248 * MiB) + row * 512 + h * 64 + 32 * hf : gp) + 8 * q) = (u32x4){p0.x, p0.y, p1.x, p1.y};
                }
            }
        }
        __syncthreads();
    }
}

template <bool WT = false>
__device__ __forceinline__ void phase_combine(const Args& a, int bid, int G) {
    int tid = threadIdx.x; asm volatile("" : "+v"(tid));
    const int lane = tid & 63, wave = tid >> 6;
    const int gw = bid * 8 + wave, NGW = G * 8;
    const float* Y = a.out; const bf16* BON = WSB(WS_BONUS); bf16* AB = WSB(WS_XN);
    const float* lnx = FIN(I_LNX);
    const int c = lane * 8;
    constexpr int R = 1;
    for (int row0 = NPR + gw; row0 < NT; row0 += R * NGW) {
        f32x4 f0[R], f1[R], g0[R], g1[R]; u32x4 bw[R], gw4[R];
#pragma unroll
        for (int q = 0; q < R; ++q) { const int row = row0 + q * NGW; if (row < NT) {
            f0[q] = *(const f32x4*)(Y + (size_t)row * 512 + c); f1[q] = *(const f32x4*)(Y + (size_t)row * 512 + c + 4);
            g0[q] = *(const f32x4*)(Y + (size_t)(NT + row) * 512 + c); g1[q] = *(const f32x4*)(Y + (size_t)(NT + row) * 512 + c + 4);
            bw[q] = *(const u32x4*)(BON + (size_t)row * 512 + c); gw4[q] = *(const u32x4*)(AB + (size_t)row * 1024 + 512 + c); } }
        const f32x4 l00 = *(const f32x4*)(lnx + c), l01 = *(const f32x4*)(lnx + c + 4), l10 = *(const f32x4*)(lnx + 512 + c), l11 = *(const f32x4*)(lnx + 512 + c + 4);
#pragma unroll
        for (int q = 0; q < R; ++q) { const int row = row0 + q * NGW; if (row < NT) {
            float x[8];
#pragma unroll
            for (int e = 0; e < 4; ++e) { x[e] = f0[q][e] + g0[q][e]; x[4 + e] = f1[q][e] + g1[q][e]; }
            float s = 0.f;
#pragma unroll
            for (int e = 0; e < 8; ++e) s += x[e];
            s += __shfl_xor(s, 1); s += __shfl_xor(s, 2); s += __shfl_xor(s, 4);
            const float mu = s * (1.f / 64.f);
            float v = 0.f;
#pragma unroll
            for (int e = 0; e < 8; ++e) { x[e] -= mu; v += x[e] * x[e]; }
            v += __shfl_xor(v, 1); v += __shfl_xor(v, 2); v += __shfl_xor(v, 4);
            const float rstd = rsqrtf(v * (1.f / 64.f) + 64e-5f);
            const f32x4 bo0 = unpk4((u32x2){bw[q].x, bw[q].y}), bo1 = unpk4((u32x2){bw[q].z, bw[q].w}), gg0 = unpk4((u32x2){gw4[q].x, gw4[q].y}), gg1 = unpk4((u32x2){gw4[q].z, gw4[q].w});
            f32x4 o0, o1;
#pragma unroll
            for (int e = 0; e < 4; ++e) { o0[e] = (x[e] * rstd * l00[e] + l10[e] + bo0[e]) * gg0[e]; o1[e] = (x[4 + e] * rstd * l01[e] + l11[e] + bo1[e]) * gg1[e]; }
            const u32x2 p0 = pk4(o0), p1 = pk4(o1);
            const u32x4 ov = {p0.x, p0.y, p1.x, p1.y};
            if (WT) {
                bf16* dst = AB + (size_t)row * 1024 + 512 + c;
                asm volatile("global_store_dwordx4 %0, %1, off sc0 sc1" :: "v"(dst), "v"(ov) : "memory");
                asm volatile("s_waitcnt vmcnt(0)" ::: "memory");
                if (lane == 0) __hip_atomic_fetch_add((unsigned*)(a.ws + WS_PCNT) + (row / 160) * 16, 1u, __ATOMIC_RELAXED, __HIP_MEMORY_SCOPE_AGENT);
            } else *(u32x4*)(AB + (size_t)row * 1024 + 512 + c) = ov;
        } }
    }
}

__device__ __forceinline__ void phase_chdft(const Args& a, LAS unsigned char* lds, int bid, int G) {
    int tid = threadIdx.x; asm volatile("" : "+v"(tid));
    const int lane = tid & 63, wave = tid >> 6, tk = lane & 31, hh = lane >> 5;
    const int gw = bid * 8 + wave, NGW = G * 8;
    constexpr int WST = 136;
    LAS bf16* Wd = (LAS bf16*)lds;
    const bf16* WDFT = WSB(WS_WDFT); const bf16* XN = WSB(WS_XN);
    __syncthreads();
    for (int i = tid; i < 256 * 16; i += 512) { const int r = i >> 4, c8 = i & 15; *(LAS u32x4*)(Wd + r * WST + 8 * c8) = *(const u32x4*)(WDFT + r * 128 + 8 * c8); }
    __syncthreads();
    for (int it8 = gw; it8 < 1024; it8 += NGW) {
        const int it = it8 >> 3, mtp2 = it8 & 7;
        const int b = it >> 6, g = (it >> 3) & 7, lt = it & 7, l2 = 32 * lt + tk;
        float twc[4], tws[4]; twc[0] = 1.f; tws[0] = 0.f;
#pragma unroll
        for (int p = 1; p < 4; ++p) { const float x = (float)(l2 * p) * (2.0f / 1024.0f); twc[p] = cospif(x); tws[p] = sinpif(x); }
        const bf16* xin = XN + (size_t)(NPR + b * 1024 + 32 * lt + tk) * 1024 + g * 128 + 8 * hh;
        bf16* zt = WSB(WS_YTS) + (size_t)b * 4 * 1024 * 512 + (size_t)(g * 128 + 4 * hh) * 512 + l2;
        {
            const int mtp = mtp2 >> 1, ph = mtp2 & 1;
            f32x16 Zr[2], Zi[2];
#pragma unroll
            for (int p = 0; p < 2; ++p)
#pragma unroll
                for (int r = 0; r < 16; ++r) { Zr[p][r] = 0.f; Zi[p][r] = 0.f; }
#pragma unroll
            for (int l1 = 0; l1 < 4; ++l1) {
                f32x16 yc, ys;
#pragma unroll
                for (int r = 0; r < 16; ++r) { yc[r] = 0.f; ys[r] = 0.f; }
#pragma unroll
                for (int s = 0; s < 8; ++s) {
                    const bf16x8 hbv = *(const bf16x8*)(xin + (size_t)(256 * l1) * 1024 + 16 * s);
                    const bf16x8 ac = *(const LAS bf16x8*)(Wd + (32 * mtp + tk) * WST + 16 * s + 8 * hh), as = *(const LAS bf16x8*)(Wd + (128 + 32 * mtp + tk) * WST + 16 * s + 8 * hh);
                    yc = mfma32(ac, hbv, yc); ys = mfma32(as, hbv, ys);
                }
                if (ph == 0) { Zr[0] += yc; Zi[0] -= ys; if (l1 & 1) { Zr[1] -= yc; Zi[1] += ys; } else { Zr[1] += yc; Zi[1] -= ys; } }
                else {
                    if (l1 == 0) { Zr[0] += yc; Zi[0] -= ys; Zr[1] += yc; Zi[1] -= ys; }
                    else if (l1 == 1) { Zr[0] -= ys; Zi[0] -= yc; Zr[1] += ys; Zi[1] += yc; }
                    else if (l1 == 2) { Zr[0] -= yc; Zi[0] += ys; Zr[1] -= yc; Zi[1] += ys; }
                    else { Zr[0] += ys; Zi[0] += yc; Zr[1] -= ys; Zi[1] -= yc; }
                }
                asm volatile("" : "+v"(Zr[0]), "+v"(Zi[0]), "+v"(Zr[1]), "+v"(Zi[1]));
            }
            typedef __attribute__((address_space(1))) bf16* gbp;
#pragma unroll
            for (int pi = 0; pi < 2; ++pi) {
                const int p = ph + 2 * pi;
                const float c = 0.5f * (p == 0 ? twc[0] : p == 1 ? twc[1] : p == 2 ? twc[2] : twc[3]), s = 0.5f * (p == 0 ? tws[0] : p == 1 ? tws[1] : p == 2 ? tws[2] : tws[3]);
#pragma unroll
                for (int rq = 0; rq < 4; ++rq) {
                    gbp pp = (gbp)(zt + (size_t)p * 1024 * 512 + (size_t)(32 * mtp + 8 * rq) * 512);
                    asm volatile("" : "+v"(pp));
#pragma unroll
                    for (int e = 0; e < 4; ++e) { const float zr = Zr[pi][4 * rq + e], zi = Zi[pi][4 * rq + e];
                        pp[(size_t)e * 512] = f2bf(zr * c + zi * s); pp[(size_t)e * 512 + 256] = f2bf(zr * s - zi * c); }
                }
            }
        }
    }
    for (int it2 = gw; it2 < (NPR / 32) * 16; it2 += NGW) {
        const int it = it2 >> 1, hsel = it2 & 1;
        const int r0 = (it >> 3) * 32, g = it & 7;
        bf16x8 hb[8];
#pragma unroll
        for (int s = 0; s < 8; ++s) hb[s] = *(const bf16x8*)(XN + (size_t)(r0 + tk) * 1024 + g * 128 + 16 * s + 8 * hh);
        bf16* dst; int ld, Lh, l;
        if (r0 < NPR) { const int b = r0 >> 8; l = (r0 & 255) + tk; dst = WSB(WS_YTP) + (size_t)b * 1024 * 512; ld = 512; Lh = 256; }
        else { const int sb = (r0 - NPR) >> 10; l = ((r0 - NPR) & 1023) + tk; dst = WSB(WS_YTS) + (size_t)sb * 1024 * 2048; ld = 2048; Lh = 1024; }
#pragma unroll 1
        for (int half = hsel; half <= hsel; ++half) {
            f32x16 acc[4];
#pragma unroll
            for (int mt = 0; mt < 4; ++mt)
#pragma unroll
                for (int r = 0; r < 16; ++r) acc[mt][r] = 0.f;
#pragma unroll
            for (int s = 0; s < 8; ++s)
#pragma unroll
                for (int mt = 0; mt < 4; ++mt) { const bf16x8 af = *(const LAS bf16x8*)(Wd + (32 * (4 * half + mt) + tk) * WST + 16 * s + 8 * hh); acc[mt] = mfma32(af, hb[s], acc[mt]);
                    if (mt == 3 && (s & 1)) asm volatile("" : "+v"(acc[0]), "+v"(acc[1]), "+v"(acc[2]), "+v"(acc[3]) :: "memory"); }
            typedef __attribute__((address_space(1))) bf16* gbp;
            gbp p0 = (gbp)(dst + (size_t)(g * 128 + 4 * hh) * ld + half * Lh + l);
#pragma unroll
            for (int mt = 0; mt < 4; ++mt) {
#pragma unroll
                for (int rq = 0; rq < 4; ++rq) {
                    gbp p = p0 + (size_t)(32 * mt + 8 * rq) * ld;
                    asm volatile("" : "+v"(p));
#pragma unroll
                    for (int e = 0; e < 4; ++e) p[(size_t)e * ld] = f2bf(acc[mt][4 * rq + e]);
                }
            }
        }
    }
}

constexpr int NPHASE = 20;
__global__ void __launch_bounds__(512, 2) mk_fwd(Args a0) {
    extern __shared__ __attribute__((aligned(16))) unsigned char lds_raw[];
    LAS unsigned char* lds = (LAS unsigned char*)lds_raw;
    const int tid = threadIdx.x, bid = blockIdx.x, G = gridDim.x;
    volatile LAS unsigned* MISC = (volatile LAS unsigned*)(lds + MISC_OFF);
    if (tid < 32) MISC[tid] = 0u;
    if (tid < 29) *(LAS unsigned long long*)(lds + PTAB_OFF + 8 * tid) = (unsigned long long)(tid < 27 ? a0.in[tid] : tid == 27 ? (const void*)a0.out : (const void*)a0.ws);
    __syncthreads();
    const int ph_lo = a0.ph_lo, ph_hi = a0.ph_hi;
    unsigned char* const ws_ctl = a0.ws;
    const bool one_launch = (ph_hi - ph_lo) > 1;
    XcdBarrier bar; bar.bar = (unsigned*)(ws_ctl + WS_CTL) + 4096; bar.x = 0; bar.st = nullptr;
    if (one_launch) bar = xcd_barrier_post((unsigned*)(ws_ctl + WS_CTL) + 4096, MISC + 8);
#ifndef DUP_PHASE
#define DUP_PHASE -1
#endif
#ifndef DUP_N
#define DUP_N 2
#endif
#ifndef ONLY_PHASE
#define ONLY_PHASE -1
#endif
#define XSL(i) ((unsigned*)(a.ws + WS_XSLOT) + (size_t)(i) * 2 * 64 * 160 * 4)
#define XCN(i) ((unsigned*)(a.ws + WS_CTL) + 8192 + (i) * 2 * 64 * 16)
#define IN(k) ((ONLY_PHASE < 0 || ONLY_PHASE == (k)) && ph_lo <= (k) && (k) < ph_hi)
#define SEAM(k) do { if (IN(k) && IN((k) + 1)) xcd_barrier(bar); } while (0)
    if (IN(1)) { const Args a = load_args(lds, ph_lo, ph_hi); const float* gains = FIN(I_GAINS); phase_prep<3>(a, lds, bid, G); phase_first_norm(a, lds, bid, G, gains + 0 * 1024); } SEAM(1);
    if (IN(2)) for (int rep_ = 0; rep_ < (DUP_PHASE == 2 ? DUP_N : 1); ++rep_) { if (rep_) xcd_barrier(bar); const Args a = load_args(lds, ph_lo, ph_hi); const float* gains = FIN(I_GAINS); (void)gains;
        pg8::Gemm g{1024, 1024, 1024}; pg8::PlainOrder160 S; S.init(WSB(WS_XN), WSB(WS_WIN), NT, INE_PAD, 1024, 1024, G, bid);
        EpiProj E{WSB(WS_Q), WSB(WS_KP), WSB(WS_KS), WSB(WS_VTP), WSB(WS_VTS), (bf16*)a.out, a.out + OUT_CK, a.out + OUT_CV, WSF(WS_ROPE)};
        pg8::gemm_phase160b(lds, g, S, E);
    } SEAM(2);
    if (IN(3)) for (int rep_ = 0; rep_ < (DUP_PHASE == 3 ? DUP_N : 1); ++rep_) { if (rep_) xcd_barrier(bar); const Args a = load_args(lds, ph_lo, ph_hi); const float* gains = FIN(I_GAINS); (void)gains;
#ifndef NO_FRONT
        phase_wkv_front(a, lds, bid, G);
#endif
#ifdef DUP_FRONT
        __syncthreads(); phase_wkv_front(a, lds, bid, G);
#endif
        __syncthreads();
#ifndef NO_ATT
        phase_attention(a, lds, bid, G);
#endif
#ifdef DUP_ATT
        __syncthreads(); phase_attention(a, lds, bid, G);
#endif
    } SEAM(3);
    if (IN(4)) for (int rep_ = 0; rep_ < (DUP_PHASE == 4 ? DUP_N : 1); ++rep_) { if (rep_) xcd_barrier(bar); const Args a = load_args(lds, ph_lo, ph_hi); const float* gains = FIN(I_GAINS); (void)gains;
#if defined(DUP_P4)
        phase_wkv_chain<true>(a, lds, bid, G); phase_prep<2>(a, lds, bid, G); xcd_barrier(bar);
#elif defined(DUP_CHAIN)
        phase_wkv_chain<true>(a, lds, bid, G); xcd_barrier(bar);
#elif defined(DUP_PREP2)
        phase_prep<2>(a, lds, bid, G); xcd_barrier(bar);
#endif
        phase_wkv_chain(a, lds, bid, G);
        if (G == 256) {
            const int wv_ = __builtin_amdgcn_readfirstlane(threadIdx.x >> 6);
            if (bid < 128) phase_prep<2>(a, lds, bid, G, wv_ == 0 ? -1 : (bid * 7 + wv_ - 1) * 7, 7, 6272);
        } else phase_prep<2>(a, lds, bid, G);
    } SEAM(4);
    if (IN(6)) for (int rep_ = 0; rep_ < (DUP_PHASE == 6 ? DUP_N : 1); ++rep_) { if (rep_) xcd_barrier(bar); const Args a = load_args(lds, ph_lo, ph_hi); const float* gains = FIN(I_GAINS); (void)gains;
        phase_combine<true>(a, bid, G);
        phase_transpose_wfi1(a, lds, bid, G);
        pg8::Gemm g{1024, 1024, 1024}; pg8::PlainOrder160 S; S.init(WSB(WS_XN), WSB(WS_WO), NT, 1024, 1024, 1024, G, bid);
        {
            pg8::Unit u0;
            if (S.next(0, u0) && u0.pm * 160 + 160 > NPR) {
                const unsigned want = (unsigned)(u0.pm * 160 + 160 - (u0.pm * 160 > NPR ? u0.pm * 160 : NPR));
                if (threadIdx.x == 0) { unsigned* pc = (unsigned*)(a.ws + WS_PCNT) + u0.pm * 16; unsigned spins = 0;
                    while (__hip_atomic_load(pc, __ATOMIC_RELAXED, __HIP_MEMORY_SCOPE_AGENT) < want) { __builtin_amdgcn_s_sleep(2); if (++spins > (1u << 20)) break; } }
            }
            __syncthreads();
        }
        EpiResNorm<true, false> E{FIN(I_XP), FIN(I_XS), nullptr, WSB(WS_XB), nullptr, WSB(WS_XN), gains + 1 * 1024, gains + 2 * 1024, WSF(WS_MOD), 2048, 0, 3072, 4096, 0, XSL(0), XCN(0)}; pg8::gemm_phase160b(lds, g, S, E);
    } SEAM(6);
    if (IN(8)) for (int rep_ = 0; rep_ < (DUP_PHASE == 8 ? DUP_N : 1); ++rep_) { if (rep_) xcd_barrier(bar); const Args a = load_args(lds, ph_lo, ph_hi); const float* gains = FIN(I_GAINS); (void)gains;
        pg8::Gemm g{1024, 1024, 1024}; pg8::PlainOrder S; S.init(WSB(WS_XN), WSB(WS_WFI), NT, DFF2, 1024, 1024, G, bid);
        EpiFfnConv E{WSB(WS_ACT), FIN(I_CONVW), FIN(I_CONVB), WSF(WS_SB), (LAS float*)(lds + 131072)}; pg8::gemm_phase(lds, g, S, E);
    }
    SEAM(8);
    if (IN(10)) for (int rep_ = 0; rep_ < (DUP_PHASE == 10 ? DUP_N : 1); ++rep_) { if (rep_) xcd_barrier(bar); const Args a = load_args(lds, ph_lo, ph_hi); const float* gains = FIN(I_GAINS); (void)gains;
        pg8::Gemm g{DFF, DFF, DFF}; pg8::PlainOrder160 S; S.init(WSB(WS_ACT), WSB(WS_WFO), NT, 1024, DFF, DFF, G, bid);
        ffn_seam_fixup(S, 160, WSB(WS_ACT), FIN(I_CONVW), WSF(WS_SB));
        EpiResNorm<false, false> E{nullptr, nullptr, WSB(WS_XB), WSB(WS_XB), nullptr, WSB(WS_XN), gains + 3 * 1024, gains + 4 * 1024, WSF(WS_MOD), 5120, 0, 0, 1024, 1, XSL(1), XCN(1)}; pg8::gemm_phase160b(lds, g, S, E);
    } SEAM(10);
    if (IN(12)) for (int rep_ = 0; rep_ < (DUP_PHASE == 12 ? DUP_N : 1); ++rep_) { if (rep_) xcd_barrier(bar); const Args a = load_args(lds, ph_lo, ph_hi); const float* gains = FIN(I_GAINS); (void)gains; phase_chdft(a, lds, bid, G); } SEAM(12);
    if (IN(13)) for (int rep_ = 0; rep_ < (DUP_PHASE == 13 ? DUP_N : 1); ++rep_) { if (rep_) xcd_barrier(bar); const Args a = load_args(lds, ph_lo, ph_hi); const float* gains = FIN(I_GAINS); (void)gains;
        { pg8::Gemm g{512, 512, 512}; DftOrder S{G, bid, (const char*)WSB(WS_A2P), (const char*)WSB(WS_YTS), (const char*)WSB(WS_YTP)}; EpiDft E{WSB(WS_XN)}; pg8::gemm_phase(lds, g, S, E); }
    } SEAM(13);
    if (IN(14)) for (int rep_ = 0; rep_ < (DUP_PHASE == 14 ? DUP_N : 1); ++rep_) { if (rep_) xcd_barrier(bar); const Args a = load_args(lds, ph_lo, ph_hi); const float* gains = FIN(I_GAINS); (void)gains;
        pg8::Gemm g{1024, 1024, 1024}; pg8::PlainOrder160 S; S.init(WSB(WS_XN), WSB(WS_WODD), NT, 1024, 1024, 1024, G, bid);
        EpiResNorm<false, false> E{nullptr, nullptr, WSB(WS_XB), WSB(WS_XB), nullptr, WSB(WS_XN), gains + 5 * 1024, gains + 6 * 1024, WSF(WS_MOD), 2048, 1, 3072, 4096, 1, XSL(2), XCN(2)}; pg8::gemm_phase160b(lds, g, S, E);
    } SEAM(14);
    if (IN(16)) for (int rep_ = 0; rep_ < (DUP_PHASE == 16 ? DUP_N : 1); ++rep_) { if (rep_) xcd_barrier(bar); const Args a = load_args(lds, ph_lo, ph_hi); const float* gains = FIN(I_GAINS); (void)gains;
        pg8::Gemm g{1024, 1024, 1024}; pg8::PlainOrder S; S.init(WSB(WS_XN), WSB(WS_WFI) + (size_t)DFF2 * 1024, NT, DFF2, 1024, 1024, G, bid);
        EpiFfnConv E{WSB(WS_ACT), FIN(I_CONVW) + 3 * DFF, FIN(I_CONVB) + DFF, WSF(WS_SB), (LAS float*)(lds + 131072)}; pg8::gemm_phase(lds, g, S, E);
    }
    SEAM(16);
    if (IN(18)) for (int rep_ = 0; rep_ < (DUP_PHASE == 18 ? DUP_N : 1); ++rep_) { if (rep_) xcd_barrier(bar); const Args a = load_args(lds, ph_lo, ph_hi); const float* gains = FIN(I_GAINS); (void)gains;
        pg8::Gemm g{DFF, DFF, DFF}; pg8::PlainOrder160 S; S.init(WSB(WS_ACT), WSB(WS_WFO) + (size_t)1024 * DFF, NT, 1024, DFF, DFF, G, bid);
        ffn_seam_fixup(S, 160, WSB(WS_ACT), FIN(I_CONVW) + 3 * DFF, WSF(WS_SB));
        EpiResNorm<false, true> E{nullptr, nullptr, WSB(WS_XB), nullptr, a.out, nullptr, gains + 7 * 1024, nullptr, WSF(WS_MOD), 5120, 1, 0, 0, 1, XSL(3), XCN(3)}; pg8::gemm_phase160b(lds, g, S, E);
    }
#undef IN
#undef SEAM
#undef XSL
#undef XCN
}

extern "C" void kernel_launch(void* const* d_in, const int* in_sizes, int n_in, void* d_out, int out_size, void* d_ws, size_t ws_size, hipStream_t stream) {
    static int grid = 0;
    if (grid == 0) {
        if (n_in != 27 || ws_size < WS_END) { fprintf(stderr, "kernel_launch: unexpected n_in %d / ws %zu\n", n_in, ws_size); grid = -1; return; }
        int dev = 0, cus = 0;
        if (hipGetDevice(&dev) != hipSuccess || hipDeviceGetAttribute(&cus, hipDeviceAttributeMultiprocessorCount, dev) != hipSuccess) { grid = -1; return; }
        if (hipFuncSetAttribute((const void*)mk_fwd, hipFuncAttributeMaxDynamicSharedMemorySize, LDS_BYTES) != hipSuccess) { fprintf(stderr, "kernel_launch: hipFuncSetAttribute failed\n"); grid = -1; return; }
        (void)hipGetLastError();
        if (cus < 256) { fprintf(stderr, "kernel_launch: needs 256 CUs (one workgroup per CU, 256 GEMM units per fused-norm phase), found %d\n", cus); grid = -1; return; }
        grid = 256;
    }
    if (grid < 0) return;
    (void)hipMemsetAsync((char*)d_ws + WS_CTL, 0, CTL_ZERO_BYTES, stream);
    Args a{};
    for (int i = 0; i < 27; ++i) a.in[i] = d_in[i];
    a.out = (float*)d_out; a.ws = (unsigned char*)d_ws;
#if MK_N_LAUNCHES == 1
    a.ph_lo = 0; a.ph_hi = NPHASE;
    hipLaunchKernelGGL(mk_fwd, dim3(grid), dim3(512), LDS_BYTES, stream, a);
#else
    for (int ph = 0; ph < NPHASE; ++ph) { a.ph_lo = ph; a.ph_hi = ph + 1; hipLaunchKernelGGL(mk_fwd, dim3(grid), dim3(512), LDS_BYTES, stream, a); }
#endif
}
```

```cpp
#include <hip/hip_runtime.h>
#include <type_traits>
#include <cstdio>
#include <cstdint>

#ifndef MK_N_LAUNCHES
#define MK_N_LAUNCHES 1
#endif

#define LAS __attribute__((address_space(3)))
typedef unsigned short bf16;
typedef short bf16x8 __attribute__((ext_vector_type(8)));
typedef float f32x4 __attribute__((ext_vector_type(4)));
typedef float f32x2 __attribute__((ext_vector_type(2)));
typedef float f32x16 __attribute__((ext_vector_type(16)));
typedef unsigned u32x4 __attribute__((ext_vector_type(4)));
typedef unsigned u32x2 __attribute__((ext_vector_type(2)));
typedef __bf16 bf16x2_t __attribute__((ext_vector_type(2)));

constexpr int DM = 1024;
constexpr int NPR = 8192, NSA = 2048, NT = 10240;
constexpr int SEQ = 256, DSEQ = 1024, PAST = 256, LKS = 1280;
constexpr int INE = 3456, INE_PAD = 3584, INB = 1920, DFF = 2816, DFF2 = 5632;
constexpr int OUT_YP = 0, OUT_CK = 10485760, OUT_CV = 14680064, OUT_ST = 18874368;

constexpr size_t MiB = 1u << 20;
constexpr size_t WS_CTL = 252 * MiB, CTL_ZERO_BYTES = 65536 + 1310720;
constexpr size_t WS_MOD = 1 * MiB;
constexpr size_t WS_ROPE = 1 * MiB + 256 * 1024;
constexpr size_t WS_LAM = 1 * MiB + 768 * 1024;
constexpr size_t WS_WIN = 2 * MiB;
constexpr size_t WS_WO = 9 * MiB;
constexpr size_t WS_WODD = 11 * MiB;
constexpr size_t WS_WFI = 13 * MiB;
constexpr size_t WS_WFO = 35 * MiB;
constexpr size_t WS_W2T = 46 * MiB;
constexpr size_t WS_A2T = 46 * MiB + 128 * 1024;
constexpr size_t WS_G2T = 46 * MiB + 256 * 1024;
constexpr size_t WS_WDFT = 46 * MiB + 512 * 1024;
constexpr size_t WS_A2P = 46 * MiB + 768 * 1024;
constexpr size_t WS_XN = 52 * MiB;
constexpr size_t WS_MF = 72 * MiB;
constexpr size_t WS_XB = 92 * MiB;
constexpr size_t WS_BIG = 112 * MiB;
constexpr size_t WS_Q = 216 * MiB;
constexpr size_t WS_KP = 226 * MiB;
constexpr size_t WS_KS = 234 * MiB;
constexpr size_t WS_VTP = 237 * MiB;
constexpr size_t WS_VTS = 245 * MiB;
constexpr size_t WS_BONUS = 24 * MiB;
constexpr size_t WS_ACT = WS_BIG;
constexpr size_t WS_SB = 51 * MiB;
constexpr size_t WS_F32B = WS_MF;
constexpr size_t WS_YTP = WS_BIG;
constexpr size_t WS_YTS = WS_BIG + 32 * MiB;
constexpr size_t WS_MOD1 = WS_CTL + 32768;
constexpr size_t WS_PCNT = WS_CTL + 57344;
constexpr size_t WS_XSLOT = WS_CTL + 65536;
constexpr size_t WS_END = 256 * MiB;
static_assert(WS_ACT + (size_t)NT * DFF * 2 <= WS_END, "ws");

constexpr int RING_BYTES = 131072;
constexpr int ACT_OFF = 147456;
constexpr int MISC_OFF = 160256;
constexpr int PTAB_OFF = 160512;
constexpr int LDS_BYTES = 160768;

__device__ __forceinline__ unsigned pk2(float lo, float hi) { f32x2 v = {lo, hi}; bf16x2_t b = __builtin_convertvector(v, bf16x2_t); return __builtin_bit_cast(unsigned, b); }
__device__ __forceinline__ bf16 f2bf(float f) { return (bf16)(pk2(f, 0.f) & 0xffffu); }
__device__ __forceinline__ float bf2f(unsigned b) { return __uint_as_float(b << 16); }
__device__ __forceinline__ u32x2 pk4(f32x4 v) { u32x2 o; o.x = pk2(v[0], v[1]); o.y = pk2(v[2], v[3]); return o; }
__device__ __forceinline__ f32x4 unpk4(u32x2 w) { f32x4 v; v[0] = __uint_as_float(w.x << 16); v[1] = __uint_as_float(w.x & 0xffff0000u); v[2] = __uint_as_float(w.y << 16); v[3] = __uint_as_float(w.y & 0xffff0000u); return v; }
__device__ __forceinline__ float sigmoidf_(float x) { return __builtin_amdgcn_rcpf(1.f + __expf(-x)); }
__device__ __forceinline__ float wave_sum(float v) {
#pragma unroll
    for (int o = 1; o < 64; o <<= 1) v += __shfl_xor(v, o);
    return v;
}
__device__ __forceinline__ int keypos(int key) { return (key & ~12) | ((key & 4) << 1) | ((key & 8) >> 1); }

#define XB_TMO      128
#define XB_XCNT(j)  (256  + 64 * (j))
#define XB_XSUB(j)  (1280 + 64 * (j))
#define XB_XGEN(j)  (2304 + 64 * (j))
#define XB_TOP      3328
#define XB_TOPGEN   3392
#define XCD_BAR_WORDS 3456
#define XB_SPIN_CAP (1u << 20)
__device__ __forceinline__ unsigned xb_ld(unsigned* p)              { return __hip_atomic_load(p, __ATOMIC_RELAXED, __HIP_MEMORY_SCOPE_AGENT); }
__device__ __forceinline__ unsigned xb_add(unsigned* p, unsigned v) { return __hip_atomic_fetch_add(p, v, __ATOMIC_RELAXED, __HIP_MEMORY_SCOPE_AGENT); }
__device__ __forceinline__ unsigned xb_xcc_id() { return (unsigned)__builtin_amdgcn_s_getreg((3 << 11) | 20) & 0xFu; }
#define XB_SPIN(cond, bar) do { unsigned _sp = 0; while (cond) { __builtin_amdgcn_s_sleep(1); \
    if ((++_sp & 255u) == 0u) { if (xb_ld(&(bar)[XB_TMO])) break; if (_sp > XB_SPIN_CAP) { atomicAdd(&(bar)[XB_TMO], 1u); break; } } } } while (0)
struct XcdBarrier { unsigned* bar; unsigned x; volatile LAS unsigned* st; };
__device__ __forceinline__ XcdBarrier xcd_barrier_post(unsigned* bar, volatile LAS unsigned* st) {
    XcdBarrier b; b.bar = bar; b.x = xb_xcc_id(); b.st = st;
    if (threadIdx.x == 0) (void)xb_add(&bar[XB_XCNT(b.x)], 1u);
    return b;
}
__device__ __forceinline__ void xcd_barrier_complete(unsigned* bar, unsigned x, unsigned& nloc, unsigned& nx) {
    const unsigned G = gridDim.x * gridDim.y * gridDim.z;
    unsigned sum, cnt, mine, sp = 0u;
    for (;;) {
        sum = 0u; cnt = 0u; mine = 0u;
#pragma unroll
        for (unsigned j = 0; j < 16; ++j) { const unsigned c = xb_ld(&bar[XB_XCNT(j)]); sum += c; cnt += (c > 0u) ? 1u : 0u; mine = (j == x) ? c : mine; }
        if (sum == G) break;
        __builtin_amdgcn_s_sleep(1);
        if ((++sp & 255u) == 0u) { if (xb_ld(&bar[XB_TMO])) break; if (sp > XB_SPIN_CAP) { atomicAdd(&bar[XB_TMO], 1u); break; } }
    }
    nloc = mine > 0u ? mine : 1u; nx = cnt > 0u ? cnt : 1u;
}
__device__ __forceinline__ void xcd_barrier(const XcdBarrier& b) {
    asm volatile("s_waitcnt vmcnt(0)" ::: "memory");
    __syncthreads();
    if (threadIdx.x == 0) {
        unsigned* bar = b.bar;
        __builtin_amdgcn_s_waitcnt(0);
        unsigned nloc = b.st[0], nx = b.st[1];
        if (nloc == 0u) { xcd_barrier_complete(bar, b.x, nloc, nx); b.st[0] = nloc; b.st[1] = nx; }
        const unsigned old = xb_add(&bar[XB_XSUB(b.x)], 1u);
        const unsigned gen = old / nloc;
        if (old + 1u == (gen + 1u) * nloc) {
            __builtin_amdgcn_fence(__ATOMIC_RELEASE, "agent");
            asm volatile("s_waitcnt vmcnt(0)" ::: "memory");
            const unsigned og = xb_add(&bar[XB_TOP], 1u);
            const unsigned tg = og / nx;
            if (og + 1u == (tg + 1u) * nx) xb_add(&bar[XB_TOPGEN], 1u);
            else XB_SPIN(xb_ld(&bar[XB_TOPGEN]) == tg, bar);
            xb_add(&bar[XB_XGEN(b.x)], 1u);
            __builtin_amdgcn_fence(__ATOMIC_ACQUIRE, "agent");
            asm volatile("s_waitcnt vmcnt(0)" ::: "memory");
        } else {
            XB_SPIN(xb_ld(&bar[XB_XGEN(b.x)]) == gen, bar);
            __builtin_amdgcn_fence(__ATOMIC_ACQUIRE, "agent");
            asm volatile("s_waitcnt vmcnt(0)" ::: "memory");
        }
    }
    __syncthreads();
}

namespace pg8 {
constexpr int BM = 256, BK = 64, HALF = 128, HTB = HALF * BK * 2, STAGE_BYTES = 8 * HTB, NXCD = 8, WGM = 8;
__host__ __device__ __forceinline__ int lds_byte(int r, int c) { const int st = (r >> 4) * 2 + (c >> 5), rr = r & 15, cc = c & 31, ob = rr * 64 + cc * 2; return st * 1024 + (ob ^ (((ob >> 9) & 1) << 5)); }
__host__ __device__ __forceinline__ void stage_rc(int b, int& R, int& C) { const int st = b / 1024, sb = b % 1024, swz = sb ^ (((sb >> 9) & 1) << 5); R = (st >> 1) * 16 + swz / 64; C = (st & 1) * 32 + (swz % 64) / 2; }

struct Unit { int pm, pn, z; const char* a; const char* b; };
struct Gemm { int lda, ldb, K; };

struct PlainOrder {
    int nM, nN, nwg, G, c; const char* A; const char* Bt; size_t ta, tb;
    __device__ void init(const void* A_, const void* Bt_, int M, int N, int lda, int ldb, int G_, int c_) { A = (const char*)A_; Bt = (const char*)Bt_; nM = M / BM; nN = N / BM; nwg = nM * nN; G = G_; c = c_; ta = (size_t)BM * lda * 2; tb = (size_t)BM * ldb * 2; }
    __device__ __forceinline__ bool next(int i, Unit& u) const {
        const long L = (long)i * G + c; if (L >= nwg) return false;
        int wgid = (int)L; { const int q = nwg / NXCD, r = nwg % NXCD, xcd = wgid % NXCD, off = wgid / NXCD; wgid = (xcd < r ? xcd * (q + 1) : r * (q + 1) + (xcd - r) * q) + off; }
        const int nig = WGM * nN, gid = wgid / nig, fm = gid * WGM, gsz = (nM - fm) < WGM ? (nM - fm) : WGM;
        u.pm = fm + ((wgid % nig) % gsz); u.pn = (wgid % nig) / gsz; u.z = 0;
        u.a = A + (size_t)u.pm * ta; u.b = Bt + (size_t)u.pn * tb; return true;
    }
};

template <class F> __device__ __forceinline__ void epi_each(const f32x4 (&acc)[2][2][4][2], int row0, int col0, F&& f) {
#pragma unroll
    for (int ai = 0; ai < 2; ++ai)
#pragma unroll
        for (int m = 0; m < 4; ++m)
#pragma unroll
            for (int bj = 0; bj < 2; ++bj)
#pragma unroll
                for (int n = 0; n < 2; ++n) f(row0 + ai * HALF + m * 16, col0 + bj * HALF + n * 16, acc[ai][bj][m][n]);
}

template <class Epi, class Sched>
__device__ __forceinline__ void gemm_phase(LAS unsigned char* lds, const Gemm g, const Sched& S, const Epi& E) {
    int tid = threadIdx.x; asm volatile("" : "+v"(tid));
    const int wid = __builtin_amdgcn_readfirstlane(tid >> 6), lane = tid & 63, wr = wid >> 2, wc = wid & 3, fr = lane & 15, fq = lane >> 4;
    const int K = g.K, nt = K / BK;
    unsigned voffA[2], voffB[2];
#pragma unroll
    for (int i = 0; i < 2; ++i) { int R, C; stage_rc(tid * 16 + i * 8192, R, C); voffA[i] = (unsigned)(R * g.lda + C) * 2u; voffB[i] = (unsigned)(R * g.ldb + C) * 2u; }
    const size_t kstep = (size_t)(BK * 2);
    const size_t hstepA = (size_t)HALF * g.lda * 2, hstepB = (size_t)HALF * g.ldb * 2;
    const unsigned ldsw = (unsigned)wid * 1024u;
    const int aoff = lds_byte(wr * 64 + fr, fq * 8), boff = lds_byte(wc * 32 + fr, fq * 8);
#define PG8_SA(b, h) (((b) * 2 + (h)) * HTB)
#define PG8_SB(b, h) ((4 + (b) * 2 + (h)) * HTB)
#define PG8_STAGE(bufoff, gbase, voff) do { _Pragma("unroll") for (int _i = 0; _i < 2; ++_i) \
        __builtin_amdgcn_global_load_lds((const unsigned*)((const char*)(gbase) + (voff)[_i]), (LAS unsigned*)(lds + (bufoff) + ldsw + _i * 8192), 16, 0, 0); } while (0)
#define PG8_LDA(dst, b, h) do { _Pragma("unroll") for (int m = 0; m < 4; ++m) _Pragma("unroll") for (int k = 0; k < 2; ++k) dst[m][k] = *(const LAS bf16x8*)(lds + PG8_SA(b, h) + aoff + m * 2048 + k * 1024); } while (0)
#define PG8_LDB(dst, b, h) do { _Pragma("unroll") for (int n = 0; n < 2; ++n) _Pragma("unroll") for (int k = 0; k < 2; ++k) dst[n][k] = *(const LAS bf16x8*)(lds + PG8_SB(b, h) + boff + n * 2048 + k * 1024); } while (0)
#define PG8_MMA(ai, bj, At, Bt) do { __builtin_amdgcn_s_setprio(1); _Pragma("unroll") for (int m = 0; m < 4; ++m) _Pragma("unroll") for (int n = 0; n < 2; ++n) _Pragma("unroll") for (int k = 0; k < 2; ++k) \
        acc[ai][bj][m][n] = __builtin_amdgcn_mfma_f32_16x16x32_bf16(Bt[n][k], At[m][k], acc[ai][bj][m][n], 0, 0, 0); __builtin_amdgcn_s_setprio(0); } while (0)
#define PG8_WAIT_V(n) asm volatile("s_waitcnt vmcnt(" #n ")" ::: "memory")
#define PG8_WAIT_L(n) asm volatile("s_waitcnt lgkmcnt(" #n ")" ::: "memory")
#define PG8_BAR __builtin_amdgcn_s_barrier()
#define PG8_SCHED __builtin_amdgcn_sched_barrier(0)
    Unit cur, nxt; int ui = 0;
    if (!S.next(0, cur)) return;
    f32x4 acc[2][2][4][2];
#pragma unroll
    for (int a = 0; a < 2; ++a)
#pragma unroll
        for (int b = 0; b < 2; ++b)
#pragma unroll
            for (int m = 0; m < 4; ++m)
#pragma unroll
                for (int n = 0; n < 2; ++n) acc[a][b][m][n] = (f32x4){0.f, 0.f, 0.f, 0.f};
    bf16x8 At[4][2], B0[2][2], B1[2][2];
    const char* cA = cur.a; const char* cB = cur.b;
    PG8_STAGE(PG8_SB(0, 0), cB, voffB); PG8_STAGE(PG8_SA(0, 0), cA, voffA); PG8_STAGE(PG8_SB(0, 1), cB + hstepB, voffB); PG8_STAGE(PG8_SA(0, 1), cA + hstepA, voffA);
    if (wr == 1) PG8_BAR;
    PG8_WAIT_V(4); PG8_BAR;
    PG8_STAGE(PG8_SB(1, 0), cB + kstep, voffB); PG8_STAGE(PG8_SA(1, 0), cA + kstep, voffA); PG8_STAGE(PG8_SB(1, 1), cB + hstepB + kstep, voffB);
    PG8_WAIT_V(6); PG8_BAR;
    for (;;) {
        const bool has_next = S.next(ui + 1, nxt);
        const char* nA = has_next ? nxt.a : cA; const char* nB = has_next ? nxt.b : cB;
        for (int t = 0; t < nt; t += 2) {
            const bool last = (t == nt - 2);
            const char* a1 = cA + (size_t)(t + 1) * kstep;
            const char* a2 = last ? nA : cA + (size_t)(t + 2) * kstep; const char* b2 = last ? nB : cB + (size_t)(t + 2) * kstep;
            const char* a3 = a2 + kstep; const char* b3 = b2 + kstep;
            PG8_LDB(B0, 0, 0); PG8_SCHED; PG8_LDA(At, 0, 0); PG8_STAGE(PG8_SA(1, 1), a1 + hstepA, voffA);
            PG8_WAIT_L(8); PG8_BAR; PG8_WAIT_L(0); PG8_MMA(0, 0, At, B0); PG8_BAR; PG8_SCHED;
            PG8_LDB(B1, 0, 1); PG8_STAGE(PG8_SB(0, 0), b2, voffB);
            PG8_BAR; PG8_WAIT_L(0); PG8_MMA(0, 1, At, B1); PG8_BAR;
            PG8_LDA(At, 0, 1); PG8_STAGE(PG8_SA(0, 0), a2, voffA);
            PG8_BAR; PG8_WAIT_L(0); PG8_MMA(1, 0, At, B0); PG8_BAR; PG8_SCHED;
            PG8_STAGE(PG8_SB(0, 1), b2 + hstepB, voffB);
            PG8_WAIT_V(6); PG8_BAR; PG8_MMA(1, 1, At, B1); PG8_BAR;
            PG8_LDB(B0, 1, 0); PG8_SCHED; PG8_LDA(At, 1, 0); PG8_STAGE(PG8_SA(0, 1), a2 + hstepA, voffA);
            PG8_WAIT_L(8); PG8_BAR; PG8_WAIT_L(0); PG8_MMA(0, 0, At, B0); PG8_BAR; PG8_SCHED;
            PG8_LDB(B1, 1, 1); PG8_STAGE(PG8_SB(1, 0), b3, voffB);
            PG8_BAR; PG8_WAIT_L(0); PG8_MMA(0, 1, At, B1); PG8_BAR;
            PG8_LDA(At, 1, 1); PG8_STAGE(PG8_SA(1, 0), a3, voffA);
            PG8_BAR; PG8_WAIT_L(0); PG8_MMA(1, 0, At, B0); PG8_BAR; PG8_SCHED;
            PG8_STAGE(PG8_SB(1, 1), b3 + hstepB, voffB);
            PG8_WAIT_V(6); PG8_BAR; PG8_MMA(1, 1, At, B1); PG8_BAR;
        }
        if constexpr (Epi::ALIGN) { if (wr == 0) PG8_BAR; }
        E(acc, cur, wr, wc, fr, fq);
        if (!has_next) break;
#pragma unroll
        for (int a = 0; a < 2; ++a)
#pragma unroll
            for (int b = 0; b < 2; ++b)
#pragma unroll
                for (int m = 0; m < 4; ++m)
#pragma unroll
                    for (int n = 0; n < 2; ++n) acc[a][b][m][n] = (f32x4){0.f, 0.f, 0.f, 0.f};
        cur = nxt; cA = nA; cB = nB; ++ui;
        if constexpr (Epi::ALIGN) { if (wr == 1) PG8_BAR; }
    }
    PG8_WAIT_V(0);
    if constexpr (!Epi::ALIGN) { if (wr == 0) PG8_BAR; }
    PG8_BAR;
#undef PG8_SA
#undef PG8_SB
#undef PG8_STAGE
#undef PG8_LDA
#undef PG8_LDB
#undef PG8_MMA
#undef PG8_WAIT_V
#undef PG8_WAIT_L
#undef PG8_BAR
#undef PG8_SCHED
}

struct PlainOrder160 {
    int nM, nN, nwg, G, c; const char* A; const char* Bt; size_t ta, tb;
    __device__ void init(const void* A_, const void* Bt_, int M, int N, int lda, int ldb, int G_, int c_) { A = (const char*)A_; Bt = (const char*)Bt_; nM = M / 160; nN = N / BM; nwg = nM * nN; G = G_; c = c_; ta = (size_t)160 * lda * 2; tb = (size_t)BM * ldb * 2; }
    __device__ __forceinline__ bool next(int i, Unit& u) const {
        const long L = (long)i * G + c; if (L >= nwg) return false;
        int wgid = (int)L; { const int q = nwg / NXCD, r = nwg % NXCD, xcd = wgid % NXCD, off = wgid / NXCD; wgid = (xcd < r ? xcd * (q + 1) : r * (q + 1) + (xcd - r) * q) + off; }
        const int nig = WGM * nN, gid = wgid / nig, fm = gid * WGM, gsz = (nM - fm) < WGM ? (nM - fm) : WGM;
        u.pm = fm + ((wgid % nig) % gsz); u.pn = (wgid % nig) / gsz; u.z = 0;
        u.a = A + (size_t)u.pm * ta; u.b = Bt + (size_t)u.pn * tb; return true;
    }
};
template <class Epi, class Sched>
__device__ __forceinline__ void gemm_phase160(LAS unsigned char* lds, const Gemm g, const Sched& S, const Epi& E) {
    int tid = threadIdx.x; asm volatile("" : "+v"(tid));
    const int wid = __builtin_amdgcn_readfirstlane(tid >> 6), lane = tid & 63, half = wid >> 2, fr = lane & 15, fq = lane >> 4;
    const int K = g.K, nt = K / BK;
    constexpr int HTA = 80 * BK * 2;
    unsigned voffA[2], voffB[2];
    { int R, C; stage_rc(tid * 16, R, C); voffA[0] = (unsigned)(R * g.lda + C) * 2u; stage_rc((512 + (tid & 127)) * 16, R, C); voffA[1] = (unsigned)(R * g.lda + C) * 2u; }
#pragma unroll
    for (int i = 0; i < 2; ++i) { int R, C; stage_rc(tid * 16 + i * 8192, R, C); voffB[i] = (unsigned)(R * g.ldb + C) * 2u; }
    const size_t kstep = (size_t)(BK * 2);
    const size_t hstepA = (size_t)80 * g.lda * 2, hstepB = (size_t)HALF * g.ldb * 2;
    const unsigned ldswA0 = (unsigned)wid * 1024u, ldswA1 = 8192u + (unsigned)(wid & 1) * 1024u, ldswB = (unsigned)wid * 1024u;
    const int aoff = lds_byte(fr, fq * 8), boff = lds_byte(wid * 16 + fr, fq * 8);
#define PG8_SA(b, h) (((b) * 2 + (h)) * HTA)
#define PG8_SB(b, h) (4 * HTA + ((b) * 2 + (h)) * HTB)
#define PG8_STAGEA(bufoff, gbase) do { \
        __builtin_amdgcn_global_load_lds((const unsigned*)((const char*)(gbase) + voffA[0]), (LAS unsigned*)(lds + (bufoff) + ldswA0), 16, 0, 0); \
        __builtin_amdgcn_global_load_lds((const unsigned*)((const char*)(gbase) + voffA[1]), (LAS unsigned*)(lds + (bufoff) + ldswA1), 16, 0, 0); } while (0)
#define PG8_STAGEB(bufoff, gbase) do { _Pragma("unroll") for (int _i = 0; _i < 2; ++_i) \
        __builtin_amdgcn_global_load_lds((const unsigned*)((const char*)(gbase) + voffB[_i]), (LAS unsigned*)(lds + (bufoff) + ldswB + _i * 8192), 16, 0, 0); } while (0)
#define PG8_LDA(dst, b, h) do { _Pragma("unroll") for (int m = 0; m < 5; ++m) _Pragma("unroll") for (int k = 0; k < 2; ++k) dst[m][k] = *(const LAS bf16x8*)(lds + PG8_SA(b, h) + aoff + m * 2048 + k * 1024); } while (0)
#define PG8_LDB(dst, b, h) do { _Pragma("unroll") for (int k = 0; k < 2; ++k) dst[k] = *(const LAS bf16x8*)(lds + PG8_SB(b, h) + boff + k * 1024); } while (0)
#define PG8_MMA(ai, bj, At, Bt) do { __builtin_amdgcn_s_setprio(1); _Pragma("unroll") for (int m = 0; m < 5; ++m) _Pragma("unroll") for (int k = 0; k < 2; ++k) \
        acc[ai][bj][m] = __builtin_amdgcn_mfma_f32_16x16x32_bf16(Bt[k], At[m][k], acc[ai][bj][m], 0, 0, 0); __builtin_amdgcn_s_setprio(0); } while (0)
#define PG8_WAIT_V(n) asm volatile("s_waitcnt vmcnt(" #n ")" ::: "memory")
#define PG8_WAIT_L(n) asm volatile("s_waitcnt lgkmcnt(" #n ")" ::: "memory")
#define PG8_BAR __builtin_amdgcn_s_barrier()
#define PG8_SCHED __builtin_amdgcn_sched_barrier(0)
    Unit cur, nxt; int ui = 0;
    if (!S.next(0, cur)) return;
    f32x4 acc[2][2][5];
#pragma unroll
    for (int a = 0; a < 2; ++a)
#pragma unroll
        for (int b = 0; b < 2; ++b)
#pragma unroll
            for (int m = 0; m < 5; ++m) acc[a][b][m] = (f32x4){0.f, 0.f, 0.f, 0.f};
    bf16x8 At[5][2], B0[2], B1[2];
    const char* cA = cur.a; const char* cB = cur.b;
    PG8_STAGEB(PG8_SB(0, 0), cB); PG8_STAGEA(PG8_SA(0, 0), cA); PG8_STAGEB(PG8_SB(0, 1), cB + hstepB); PG8_STAGEA(PG8_SA(0, 1), cA + hstepA);
    if (half == 1) PG8_BAR;
    PG8_WAIT_V(4); PG8_BAR;
    PG8_STAGEB(PG8_SB(1, 0), cB + kstep); PG8_STAGEA(PG8_SA(1, 0), cA + kstep); PG8_STAGEB(PG8_SB(1, 1), cB + hstepB + kstep);
    PG8_WAIT_V(6); PG8_BAR;
    for (;;) {
        const bool has_next = S.next(ui + 1, nxt);
        const char* nA = has_next ? nxt.a : cA; const char* nB = has_next ? nxt.b : cB;
        for (int t = 0; t < nt; t += 2) {
            const bool last = (t == nt - 2);
            const char* a1 = cA + (size_t)(t + 1) * kstep;
            const char* a2 = last ? nA : cA + (size_t)(t + 2) * kstep; const char* b2 = last ? nB : cB + (size_t)(t + 2) * kstep;
            const char* a3 = a2 + kstep; const char* b3 = b2 + kstep;
            PG8_LDB(B0, 0, 0); PG8_SCHED; PG8_LDA(At, 0, 0); PG8_STAGEA(PG8_SA(1, 1), a1 + hstepA);
            PG8_WAIT_L(10); PG8_BAR; PG8_WAIT_L(0); PG8_MMA(0, 0, At, B0); PG8_BAR; PG8_SCHED;
            PG8_LDB(B1, 0, 1); PG8_STAGEB(PG8_SB(0, 0), b2);
            PG8_BAR; PG8_WAIT_L(0); PG8_MMA(0, 1, At, B1); PG8_BAR;
            PG8_LDA(At, 0, 1); PG8_STAGEA(PG8_SA(0, 0), a2);
            PG8_BAR; PG8_WAIT_L(0); PG8_MMA(1, 0, At, B0); PG8_BAR; PG8_SCHED;
            PG8_STAGEB(PG8_SB(0, 1), b2 + hstepB);
            PG8_WAIT_V(6); PG8_BAR; PG8_MMA(1, 1, At, B1); PG8_BAR;
            PG8_LDB(B0, 1, 0); PG8_SCHED; PG8_LDA(At, 1, 0); PG8_STAGEA(PG8_SA(0, 1), a2 + hstepA);
            PG8_WAIT_L(10); PG8_BAR; PG8_WAIT_L(0); PG8_MMA(0, 0, At, B0); PG8_BAR; PG8_SCHED;
            PG8_LDB(B1, 1, 1); PG8_STAGEB(PG8_SB(1, 0), b3);
            PG8_BAR; PG8_WAIT_L(0); PG8_MMA(0, 1, At, B1); PG8_BAR;
            PG8_LDA(At, 1, 1); PG8_STAGEA(PG8_SA(1, 0), a3);
            PG8_BAR; PG8_WAIT_L(0); PG8_MMA(1, 0, At, B0); PG8_BAR; PG8_SCHED;
            PG8_STAGEB(PG8_SB(1, 1), b3 + hstepB);
            PG8_WAIT_V(6); PG8_BAR; PG8_MMA(1, 1, At, B1); PG8_BAR;
        }
        E(acc, cur, wid, fr, fq);
        if (!has_next) break;
#pragma unroll
        for (int a = 0; a < 2; ++a)
#pragma unroll
            for (int b = 0; b < 2; ++b)
#pragma unroll
                for (int m = 0; m < 5; ++m) acc[a][b][m] = (f32x4){0.f, 0.f, 0.f, 0.f};
        cur = nxt; cA = nA; cB = nB; ++ui;
    }
    PG8_WAIT_V(0);
    if (half == 0) PG8_BAR;
    PG8_BAR;
#undef PG8_SA
#undef PG8_SB
#undef PG8_STAGEA
#undef PG8_STAGEB
#undef PG8_LDA
#undef PG8_LDB
#undef PG8_MMA
#undef PG8_WAIT_V
#undef PG8_WAIT_L
#undef PG8_BAR
#undef PG8_SCHED
}

template <int MF, class Epi, class Sched>
__device__ __forceinline__ void gemm_phase160b_run(LAS unsigned char* lds, const Gemm g, const Sched& S, const Epi& E, int tid, int wid, int lane, int wr, int wc) {
    const int fr = lane & 15, fq = lane >> 4;
    const int K = g.K, nt = K / BK;
    constexpr int HTA = 80 * BK * 2;
    unsigned voffA[2], voffB[2];
    { int R, C; stage_rc(tid * 16, R, C); voffA[0] = (unsigned)(R * g.lda + C) * 2u; stage_rc((512 + (tid & 127)) * 16, R, C); voffA[1] = (unsigned)(R * g.lda + C) * 2u; }
#pragma unroll
    for (int i = 0; i < 2; ++i) { int R, C; stage_rc(tid * 16 + i * 8192, R, C); voffB[i] = (unsigned)(R * g.ldb + C) * 2u; }
    const size_t kstep = (size_t)(BK * 2);
    const size_t hstepA = (size_t)80 * g.lda * 2, hstepB = (size_t)HALF * g.ldb * 2;
    const unsigned ldswA0 = (unsigned)wid * 1024u, ldswA1 = 8192u + (unsigned)(wid & 1) * 1024u, ldswB = (unsigned)wid * 1024u;
    const int aoff = lds_byte(wr * 48 + fr, fq * 8), boff = lds_byte(wc * 32 + fr, fq * 8);
#define PG8_SA(b, h) (((b) * 2 + (h)) * HTA)
#define PG8_SB(b, h) (4 * HTA + ((b) * 2 + (h)) * HTB)
#define PG8_STAGEA(bufoff, gbase) do { \
        __builtin_amdgcn_global_load_lds((const unsigned*)((const char*)(gbase) + voffA[0]), (LAS unsigned*)(lds + (bufoff) + ldswA0), 16, 0, 0); \
        __builtin_amdgcn_global_load_lds((const unsigned*)((const char*)(gbase) + voffA[1]), (LAS unsigned*)(lds + (bufoff) + ldswA1), 16, 0, 0); } while (0)
#define PG8_STAGEB(bufoff, gbase) do { _Pragma("unroll") for (int _i = 0; _i < 2; ++_i) \
        __builtin_amdgcn_global_load_lds((const unsigned*)((const char*)(gbase) + voffB[_i]), (LAS unsigned*)(lds + (bufoff) + ldswB + _i * 8192), 16, 0, 0); } while (0)
#define PG8_LDA(dst, b, h) do { _Pragma("unroll") for (int m = 0; m < MF; ++m) _Pragma("unroll") for (int k = 0; k < 2; ++k) dst[m][k] = *(const LAS bf16x8*)(lds + PG8_SA(b, h) + aoff + m * 2048 + k * 1024); } while (0)
#define PG8_LDB(dst, b, h) do { _Pragma("unroll") for (int n = 0; n < 2; ++n) _Pragma("unroll") for (int k = 0; k < 2; ++k) dst[n][k] = *(const LAS bf16x8*)(lds + PG8_SB(b, h) + boff + n * 2048 + k * 1024); } while (0)
#define PG8_MMA(ai, bj, At, Bt) do { __builtin_amdgcn_s_setprio(1); _Pragma("unroll") for (int m = 0; m < MF; ++m) _Pragma("unroll") for (int n = 0; n < 2; ++n) _Pragma("unroll") for (int k = 0; k < 2; ++k) \
        acc[ai][bj][m][n] = __builtin_amdgcn_mfma_f32_16x16x32_bf16(Bt[n][k], At[m][k], acc[ai][bj][m][n], 0, 0, 0); __builtin_amdgcn_s_setprio(0); } while (0)
#define PG8_WAIT_V(n) asm volatile("s_waitcnt vmcnt(" #n ")" ::: "memory")
#define PG8_WAIT_L(n) asm volatile("s_waitcnt lgkmcnt(" #n ")" ::: "memory")
#define PG8_WAIT_LA() do { if (MF == 3) PG8_WAIT_L(6); else PG8_WAIT_L(4); } while (0)
#define PG8_BAR __builtin_amdgcn_s_barrier()
#define PG8_SCHED __builtin_amdgcn_sched_barrier(0)
    Unit cur, nxt; int ui = 0;
    if (!S.next(0, cur)) return;
    f32x4 acc[2][2][MF][2];
#pragma unroll
    for (int a = 0; a < 2; ++a)
#pragma unroll
        for (int b = 0; b < 2; ++b)
#pragma unroll
            for (int m = 0; m < MF; ++m)
#pragma unroll
                for (int n = 0; n < 2; ++n) acc[a][b][m][n] = (f32x4){0.f, 0.f, 0.f, 0.f};
    bf16x8 At[MF][2], B0[2][2], B1[2][2];
    const char* cA = cur.a; const char* cB = cur.b;
    PG8_STAGEB(PG8_SB(0, 0), cB); PG8_STAGEA(PG8_SA(0, 0), cA); PG8_STAGEB(PG8_SB(0, 1), cB + hstepB); PG8_STAGEA(PG8_SA(0, 1), cA + hstepA);
    if (wr == 1) PG8_BAR;
    PG8_WAIT_V(4); PG8_BAR;
    PG8_STAGEB(PG8_SB(1, 0), cB + kstep); PG8_STAGEA(PG8_SA(1, 0), cA + kstep); PG8_STAGEB(PG8_SB(1, 1), cB + hstepB + kstep);
    PG8_WAIT_V(6); PG8_BAR;
    for (;;) {
        const bool has_next = S.next(ui + 1, nxt);
        const char* nA = has_next ? nxt.a : cA; const char* nB = has_next ? nxt.b : cB;
        for (int t = 0; t < nt; t += 2) {
            const bool last = (t == nt - 2);
            const char* a1 = cA + (size_t)(t + 1) * kstep;
            const char* a2 = last ? nA : cA + (size_t)(t + 2) * kstep; const char* b2 = last ? nB : cB + (size_t)(t + 2) * kstep;
            const char* a3 = a2 + kstep; const char* b3 = b2 + kstep;
            PG8_LDB(B0, 0, 0); PG8_SCHED; PG8_LDA(At, 0, 0); PG8_STAGEA(PG8_SA(1, 1), a1 + hstepA);
            PG8_WAIT_LA(); PG8_BAR; PG8_WAIT_L(0); PG8_MMA(0, 0, At, B0); PG8_BAR; PG8_SCHED;
            PG8_LDB(B1, 0, 1); PG8_STAGEB(PG8_SB(0, 0), b2);
            PG8_BAR; PG8_WAIT_L(0); PG8_MMA(0, 1, At, B1); PG8_BAR;
            PG8_LDA(At, 0, 1); PG8_STAGEA(PG8_SA(0, 0), a2);
            PG8_BAR; PG8_WAIT_L(0); PG8_MMA(1, 0, At, B0); PG8_BAR; PG8_SCHED;
            PG8_STAGEB(PG8_SB(0, 1), b2 + hstepB);
            PG8_WAIT_V(6); PG8_BAR; PG8_MMA(1, 1, At, B1); PG8_BAR;
            PG8_LDB(B0, 1, 0); PG8_SCHED; PG8_LDA(At, 1, 0); PG8_STAGEA(PG8_SA(0, 1), a2 + hstepA);
            PG8_WAIT_LA(); PG8_BAR; PG8_WAIT_L(0); PG8_MMA(0, 0, At, B0); PG8_BAR; PG8_SCHED;
            PG8_LDB(B1, 1, 1); PG8_STAGEB(PG8_SB(1, 0), b3);
            PG8_BAR; PG8_WAIT_L(0); PG8_MMA(0, 1, At, B1); PG8_BAR;
            PG8_LDA(At, 1, 1); PG8_STAGEA(PG8_SA(1, 0), a3);
            PG8_BAR; PG8_WAIT_L(0); PG8_MMA(1, 0, At, B0); PG8_BAR; PG8_SCHED;
            PG8_STAGEB(PG8_SB(1, 1), b3 + hstepB);
            PG8_WAIT_V(6); PG8_BAR; PG8_MMA(1, 1, At, B1); PG8_BAR;
        }
        if constexpr (!Epi::AFTER_DRAIN) E.template tile<MF>(acc, cur, wr, wc, fr, fq);
        if (!has_next) break;
#pragma unroll
        for (int a = 0; a < 2; ++a)
#pragma unroll
            for (int b = 0; b < 2; ++b)
#pragma unroll
                for (int m = 0; m < MF; ++m)
#pragma unroll
                    for (int n = 0; n < 2; ++n) acc[a][b][m][n] = (f32x4){0.f, 0.f, 0.f, 0.f};
        cur = nxt; cA = nA; cB = nB; ++ui;
    }
    PG8_WAIT_V(0);
    if (wr == 0) PG8_BAR;
    PG8_BAR;
    if constexpr (Epi::AFTER_DRAIN) E.template fused<MF>(acc, cur, wr, wc, fr, fq, lds, wid, lane, tid);
#undef PG8_SA
#undef PG8_SB
#undef PG8_STAGEA
#undef PG8_STAGEB
#undef PG8_LDA
#undef PG8_LDB
#undef PG8_MMA
#undef PG8_WAIT_V
#undef PG8_WAIT_L
#undef PG8_WAIT_LA
#undef PG8_BAR
#undef PG8_SCHED
}
template <class Epi, class Sched>
__device__ __forceinline__ void gemm_phase160b(LAS unsigned char* lds, const Gemm g, const Sched& S, const Epi& E) {
    int tid = threadIdx.x; asm volatile("" : "+v"(tid));
    const int wid = __builtin_amdgcn_readfirstlane(tid >> 6), lane = tid & 63, wr = wid >> 2, wc = wid & 3;
    if (wr == 0) gemm_phase160b_run<3>(lds, g, S, E, tid, wid, lane, wr, wc);
    else gemm_phase160b_run<2>(lds, g, S, E, tid, wid, lane, wr, wc);
}
}

struct Args { const void* in[27]; float* out; unsigned char* ws; int ph_lo, ph_hi; };
enum { I_XP = 0, I_XS, I_CK, I_CV, I_ST, I_C, I_CCTX, I_WADA, I_BADA, I_GAINS, I_WIN, I_WOUT, I_LAMBDA, I_SUBLN, I_MU, I_W0, I_W2, I_A0, I_A2, I_G2, I_KVEC, I_LNX, I_WODD, I_WFI, I_CONVW, I_CONVB, I_WFO };
#define FIN(k) ((const float*)a.in[k])
#define WSB(off) ((bf16*)(a.ws + (off)))
#define WSF(off) ((float*)(a.ws + (off)))


__device__ __forceinline__ const void* ptab_ld(LAS unsigned char* lds, int k) {
    const u32x2 w = *(const LAS u32x2*)(lds + PTAB_OFF + 8 * k);
    const unsigned long long v = ((unsigned long long)(unsigned)__builtin_amdgcn_readfirstlane((int)w.y) << 32) | (unsigned)__builtin_amdgcn_readfirstlane((int)w.x);
    return (const void*)(const __attribute__((address_space(1))) void*)v;
}
__device__ __forceinline__ Args load_args(LAS unsigned char* lds, int ph_lo, int ph_hi) {
    Args r;
#pragma unroll
    for (int i = 0; i < 27; ++i) r.in[i] = ptab_ld(lds, i);
    r.out = (float*)ptab_ld(lds, 27); r.ws = (unsigned char*)ptab_ld(lds, 28); r.ph_lo = ph_lo; r.ph_hi = ph_hi;
    return r;
}
__device__ __forceinline__ int row_cond(int row) { return row < NPR ? 0 : 1 + ((row - NPR) >> 10); }

template <bool FFN_PERM = false>
__device__ __forceinline__ void p0_transpose_item(const float* W, int K, int N, bf16* WT, LAS float* scr, int item, int lane) {
    const int nblk = N / 32, kb = item / nblk, nb = item % nblk, k0 = 64 * kb, n0 = 32 * nb;
    const int d0 = FFN_PERM ? (n0 < DFF ? (n0 / 128) * 256 + (n0 % 128) : ((n0 - DFF) / 128) * 256 + 128 + ((n0 - DFF) % 128)) : n0;
#pragma unroll 8
    for (int i = 0; i < 32; ++i) { const int kk = 2 * i + (lane >> 5); scr[kk * 33 + (lane & 31)] = W[(size_t)(k0 + kk) * N + n0 + (lane & 31)]; }
    asm volatile("s_waitcnt lgkmcnt(0)" ::: "memory");
    const int c = lane & 7;
#pragma unroll
    for (int j = 0; j < 4; ++j) { const int n = (lane >> 3) + 8 * j; const LAS float* s = scr + (8 * c) * 33 + n;
        u32x4 o; o.x = pk2(s[0 * 33], s[1 * 33]); o.y = pk2(s[2 * 33], s[3 * 33]); o.z = pk2(s[4 * 33], s[5 * 33]); o.w = pk2(s[6 * 33], s[7 * 33]);
        *(u32x4*)(WT + (size_t)(d0 + n) * K + k0 + 8 * c) = o; }
    asm volatile("s_waitcnt lgkmcnt(0)" ::: "memory");
}

template <int STAGE>
__device__ __forceinline__ void phase_prep(const Args& a, LAS unsigned char* lds, int bid, int G, int vgw = -2, int nmine = 1, int nvw = 0) {
    int tid = threadIdx.x; asm volatile("" : "+v"(tid));
    const int lane = tid & 63, wave = tid >> 6;
    const int gw = bid * 8 + wave, NGW = G * 8;
    const int gt = bid * 512 + tid, NGT = G * 512;
    constexpr int I_IN = (1024 / 64) * (INE / 32), I_SQ = (1024 / 64) * (1024 / 32), I_FI = (1024 / 64) * (DFF2 / 32), I_FO = (DFF / 64) * (1024 / 32), I_L64 = 1 * (512 / 32), I_L128 = 2 * (512 / 32);
    if (STAGE == 1 || STAGE == 3) {
        LAS float* scr = (LAS float*)(lds + wave * 16384);
        constexpr int NITEMS = I_IN + 4 * I_L64 + I_L128;
        for (int it = gw; it < NITEMS; it += NGW) {
            int r = it;
            if (r < I_IN) { p0_transpose_item(FIN(I_WIN), 1024, INE, WSB(WS_WIN), scr, r, lane); continue; } r -= I_IN;
            if (r < 2 * I_L64) { const int d = r / I_L64; p0_transpose_item(FIN(I_W2) + (size_t)d * 64 * 512, 64, 512, WSB(WS_W2T) + (size_t)d * 512 * 64, scr, r % I_L64, lane); continue; } r -= 2 * I_L64;
            if (r < 2 * I_L64) { const int d = r / I_L64; p0_transpose_item(FIN(I_A2) + (size_t)d * 64 * 512, 64, 512, WSB(WS_A2T) + (size_t)d * 512 * 64, scr, r % I_L64, lane); continue; } r -= 2 * I_L64;
            p0_transpose_item(FIN(I_G2), 128, 512, WSB(WS_G2T), scr, r, lane);
        }
        for (int i = gt; i < (INE_PAD - INE) * 1024 / 8; i += NGT) ((u32x4*)(WSB(WS_WIN) + (size_t)INE * 1024))[i] = (u32x4){0u, 0u, 0u, 0u};
    }
    if (STAGE == 2) {
        LAS float* scr = (LAS float*)(lds + wave * 16384);
        constexpr int NITEMS = 2 * I_SQ + I_FI + 2 * I_FO;
        const int s0 = vgw == -2 ? gw : vgw, ns = vgw == -2 ? NGW : nvw;
        for (int sl = 0; sl < nmine; ++sl)
        for (int it = s0 < 0 ? NITEMS : s0 + sl; it < NITEMS; it += ns) {
            int r = it;
            if (r < I_SQ) { p0_transpose_item(FIN(I_WOUT), 1024, 1024, WSB(WS_WO), scr, r, lane); continue; } r -= I_SQ;
            if (r < I_SQ) { p0_transpose_item(FIN(I_WODD), 1024, 1024, WSB(WS_WODD), scr, r, lane); continue; } r -= I_SQ;
            if (r < I_FI) { p0_transpose_item<true>(FIN(I_WFI), 1024, DFF2, WSB(WS_WFI), scr, r, lane); continue; } r -= I_FI;
            const int l = r / I_FO; p0_transpose_item(FIN(I_WFO) + (size_t)l * DFF * 1024, DFF, 1024, WSB(WS_WFO) + (size_t)l * 1024 * DFF, scr, r % I_FO, lane);
        }
    }
    if (STAGE == 0 || STAGE == 3) {
        for (int i = gt; i < 256 * 128; i += NGT) {
            const int n = i >> 7, c = i & 127, m = (c * (n & 127)) & 127; const float x = (float)m * (2.0f / 128.0f);
            WSB(WS_WDFT)[i] = f2bf(n < 128 ? cospif(x) : sinpif(x));
        }
        for (int i = gt; i < 256 * 512; i += NGT) {
            const int lp = i >> 9, k = i & 511, l = k & 255, m = (lp * l) & 255; const float x = (float)m * (2.0f / 256.0f), s = 0.00552427172801990f;
            WSB(WS_A2P)[i] = f2bf(k < 256 ? s * cospif(x) : -s * sinpif(x));
        }
        for (int i = gt; i < 1024 * 32; i += NGT) {
            const int t = i >> 5, f = i & 31; const float inv = powf(10000.0f, -(float)(f & 15) / 16.0f), pos = (float)(f < 16 ? (t >> 6) : (t & 63)), ang = pos * inv;
            WSF(WS_ROPE)[i] = cosf(ang); WSF(WS_ROPE)[1024 * 32 + i] = sinf(ang);
        }
        if (gt == 0) {
            const float* lp = FIN(I_LAMBDA); float s1 = 0.f, s2 = 0.f;
            for (int i = 0; i < 64; ++i) { s1 += lp[i] * lp[64 + i]; s2 += lp[128 + i] * lp[192 + i]; }
            WSF(WS_LAM)[0] = expf(s1) - expf(s2) + 0.2f;
        }
        for (int i = gt; i < 2 * 256 * 512; i += NGT) {
            const int b = i >> 17, t = (i >> 9) & 255, c = i & 511;
            WSB(WS_KS)[((size_t)b * LKS + t) * 512 + c] = f2bf(FIN(I_CK)[i]);
            const int h = c >> 7, d = c & 127;
            WSB(WS_VTS)[((size_t)(b * 4 + h) * 128 + d) * LKS + keypos(t)] = f2bf(FIN(I_CV)[i]);
        }
    }
    if (STAGE == 0 || STAGE == 1 || STAGE == 3) {
        LAS float* sc = (LAS float*)lds;
        LAS float* red = (LAS float*)(lds + 16384);
        __syncthreads();
        for (int i = tid; i < 3 * 1024; i += 512) { const int cd = i >> 10, k = i & 1023; const float x = cd == 0 ? FIN(I_CCTX)[k] : FIN(I_C)[(cd - 1) * 1024 + k]; sc[i] = x / (1.f + __expf(-x)); }
        __syncthreads();
        const int kq = tid >> 3, nl = tid & 7;
        const int it_lo = STAGE == 0 ? 0 : 64, it_hi = STAGE == 0 ? 64 : 2 * 192;
        for (int q = 0; ; ++q) {
            int it;
            if (STAGE == 3) {
                if (G == 256) { if (q == 0) { if (bid >= 64) continue; it = bid; } else if (q == 1) { if (bid < 64) continue; it = bid; } else if (q == 2) { if (bid >= 128) continue; it = 256 + bid; } else break; }
                else { it = bid + q * G; if (it >= 2 * 192) break; }
            } else { it = it_lo + bid + q * G; if (it >= it_hi) break; }
            const int l = it / 192, n0 = (it % 192) * 32;
            const float* W = FIN(I_WADA) + (size_t)l * 1024 * 6144 + n0 + 4 * nl;
            f32x4 s0 = {0.f, 0.f, 0.f, 0.f}, s1 = s0, s2 = s0;
#pragma unroll 4
            for (int kk = 0; kk < 16; ++kk) { const int k = kq * 16 + kk; const f32x4 w = *(const f32x4*)(W + (size_t)k * 6144); s0 += w * sc[k]; s1 += w * sc[1024 + k]; s2 += w * sc[2048 + k]; }
            *(LAS f32x4*)(red + (kq * 3 + 0) * 32 + 4 * nl) = s0; *(LAS f32x4*)(red + (kq * 3 + 1) * 32 + 4 * nl) = s1; *(LAS f32x4*)(red + (kq * 3 + 2) * 32 + 4 * nl) = s2;
            __syncthreads();
            if (tid < 96) { const int cd = tid >> 5, n = tid & 31; float s = FIN(I_BADA)[l * 6144 + n0 + n];
                for (int qq = 0; qq < 64; ++qq) s += red[(qq * 3 + cd) * 32 + n];
                if (STAGE == 3 && it < 64)
                    __hip_atomic_store((unsigned*)(a.ws + WS_MOD1) + cd * 2048 + n0 + n, __float_as_uint(s) | 1u, __ATOMIC_RELAXED, __HIP_MEMORY_SCOPE_AGENT);
                else WSF(WS_MOD)[(size_t)(l * 3 + cd) * 6144 + n0 + n] = s; }
            __syncthreads();
        }
    }
}

__device__ __forceinline__ void phase_first_norm(const Args& a, LAS unsigned char* lds, int bid, int G, const float* gB) {
    int tid = threadIdx.x; asm volatile("" : "+v"(tid));
    const int lane = tid & 63, wave = tid >> 6;
    const int gw = bid * 8 + wave, NGW = G * 8;
    LAS float* modl = (LAS float*)lds;
    __syncthreads();
    {   const unsigned* side = (const unsigned*)(a.ws + WS_MOD1);
        unsigned v[12]; unsigned spins = 0;
        for (;;) { bool ok = true;
#pragma unroll
            for (int i = 0; i < 12; ++i) { v[i] = __hip_atomic_load(side + tid + 512 * i, __ATOMIC_RELAXED, __HIP_MEMORY_SCOPE_AGENT); ok = ok && (v[i] != 0u); }
            if (ok || ++spins > (1u << 20)) break;
            __builtin_amdgcn_s_sleep(2); }
#pragma unroll
        for (int i = 0; i < 12; ++i) modl[tid + 512 * i] = __uint_as_float(v[i]);
    }
    __syncthreads();
    bf16* XN = WSB(WS_XN);
    constexpr int R = 5;
    for (int row0 = gw; row0 < NT; row0 += R * NGW) {
        f32x4 x[R][4];
#pragma unroll
        for (int q = 0; q < R; ++q) { const int row = row0 + q * NGW; if (row < NT) {
            const float* xin = row < NPR ? FIN(I_XP) + (size_t)row * DM : FIN(I_XS) + (size_t)(row - NPR) * DM;
#pragma unroll
            for (int j = 0; j < 4; ++j) x[q][j] = *(const f32x4*)(xin + 4 * lane + 256 * j); } }
#pragma unroll
        for (int q = 0; q < R; ++q) { const int row = row0 + q * NGW; if (row < NT) {
            const LAS float* ml = modl + row_cond(row) * 2048;
            float ss = 0.f;
#pragma unroll
            for (int j = 0; j < 4; ++j) ss += (x[q][j][0] * x[q][j][0] + x[q][j][1] * x[q][j][1]) + (x[q][j][2] * x[q][j][2] + x[q][j][3] * x[q][j][3]);
            const float rinv = rsqrtf(wave_sum(ss) * (1.f / DM) + 1e-6f);
#pragma unroll
            for (int j = 0; j < 4; ++j) { const f32x4 g = *(const f32x4*)(gB + 4 * lane + 256 * j), sc = *(const LAS f32x4*)(ml + 1024 + 4 * lane + 256 * j), sh = *(const LAS f32x4*)(ml + 4 * lane + 256 * j);
                const f32x4 h = (x[q][j] * rinv * g) * (sc + 1.f) + sh; *(u32x2*)(XN + (size_t)row * DM + 4 * lane + 256 * j) = pk4(h); }
        } }
    }
}

__device__ __forceinline__ void phase_transpose_wfi1(const Args& a, LAS unsigned char* lds, int bid, int G) {
    int tid = threadIdx.x; asm volatile("" : "+v"(tid));
    const int lane = tid & 63, wave = tid >> 6;
    LAS float* scr = (LAS float*)(lds + wave * 16384);
    constexpr int I_FI = (1024 / 64) * (DFF2 / 32);
    for (int it = bid * 8 + wave; it < I_FI; it += G * 8) p0_transpose_item<true>(FIN(I_WFI) + (size_t)1024 * DFF2, 1024, DFF2, WSB(WS_WFI) + (size_t)DFF2 * 1024, scr, it, lane);
    __syncthreads();
}
template <bool HAS_RES, bool HAS_H, bool X_FROM_INPUT, bool X_TO_OUTPUT = false>
__device__ __forceinline__ void phase_resnorm(const Args& a, int bid, int G, const bf16* mf, const float* gA, int gate_off, int layer_gate, const float* gB, int shift_off, int scale_off, int layer_mod) {
    int tid = threadIdx.x; asm volatile("" : "+v"(tid));
    const int lane = tid & 63, wave = tid >> 6;
    const int gw = bid * 8 + wave, NGW = G * 8;
    float* X = a.out; bf16* XB = WSB(WS_XB);
    bf16* XN = WSB(WS_XN);
    constexpr int R = 5;
    for (int row0 = gw; row0 < NT; row0 += R * NGW) {
        f32x4 x[R][4], m[R][4];
#pragma unroll
        for (int q = 0; q < R; ++q) { const int row = row0 + q * NGW; if (row < NT) {
            const float* xin = row < NPR ? FIN(I_XP) + (size_t)row * DM : FIN(I_XS) + (size_t)(row - NPR) * DM;
#pragma unroll
            for (int j = 0; j < 4; ++j) { x[q][j] = X_FROM_INPUT ? *(const f32x4*)(xin + 4 * lane + 256 * j) : unpk4(*(const u32x2*)(XB + (size_t)row * DM + 4 * lane + 256 * j)); if (HAS_RES) m[q][j] = unpk4(*(const u32x2*)(mf + (size_t)row * DM + 4 * lane + 256 * j)); } } }
#pragma unroll
        for (int q = 0; q < R; ++q) { const int row = row0 + q * NGW; if (row < NT) {
            const float* mod = WSF(WS_MOD) + (size_t)(layer_mod * 3 + row_cond(row)) * 6144;
            const float* modg = WSF(WS_MOD) + (size_t)(layer_gate * 3 + row_cond(row)) * 6144;
            if (HAS_RES) {
                float ss = 0.f;
#pragma unroll
                for (int j = 0; j < 4; ++j) ss += (m[q][j][0] * m[q][j][0] + m[q][j][1] * m[q][j][1]) + (m[q][j][2] * m[q][j][2] + m[q][j][3] * m[q][j][3]);
                const float rinv = rsqrtf(wave_sum(ss) * (1.f / DM) + 1e-6f);
#pragma unroll
                for (int j = 0; j < 4; ++j) { const f32x4 g = *(const f32x4*)(gA + 4 * lane + 256 * j), gt = *(const f32x4*)(modg + gate_off + 4 * lane + 256 * j);
                    x[q][j] = x[q][j] + gt * (m[q][j] * rinv * g);
                    if (X_TO_OUTPUT) *(f32x4*)(X + (size_t)row * DM + 4 * lane + 256 * j) = x[q][j]; else *(u32x2*)(XB + (size_t)row * DM + 4 * lane + 256 * j) = pk4(x[q][j]); }
            }
            if (HAS_H) {
                float ss = 0.f;
#pragma unroll
                for (int j = 0; j < 4; ++j) ss += (x[q][j][0] * x[q][j][0] + x[q][j][1] * x[q][j][1]) + (x[q][j][2] * x[q][j][2] + x[q][j][3] * x[q][j][3]);
                const float rinv = rsqrtf(wave_sum(ss) * (1.f / DM) + 1e-6f);
#pragma unroll
                for (int j = 0; j < 4; ++j) { const f32x4 g = *(const f32x4*)(gB + 4 * lane + 256 * j), sc = *(const f32x4*)(mod + scale_off + 4 * lane + 256 * j), sh = *(const f32x4*)(mod + shift_off + 4 * lane + 256 * j);
                    const f32x4 h = (x[q][j] * rinv * g) * (sc + 1.f) + sh; *(u32x2*)(XN + (size_t)row * DM + 4 * lane + 256 * j) = pk4(h); }
            }
        } }
    }
}

struct EpiF32 {
    float* C; int ldc;
    static constexpr bool ALIGN = false;
    __device__ __forceinline__ void operator()(const f32x4 (&acc)[2][2][4][2], const pg8::Unit& u, int wr, int wc, int fr, int fq) const {
        pg8::epi_each(acc, u.pm * 256 + wr * 64 + fr, u.pn * 256 + wc * 32 + 4 * fq, [&](int row, int col, const f32x4& v) { *(f32x4*)(C + (size_t)row * ldc + col) = v; });
    }
};
struct EpiBf16 {
    bf16* O; int ldc;
    static constexpr bool ALIGN = false;
    __device__ __forceinline__ void operator()(const f32x4 (&acc)[2][2][4][2], const pg8::Unit& u, int wr, int wc, int fr, int fq) const {
        pg8::epi_each(acc, u.z + u.pm * 256 + wr * 64 + fr, u.pn * 256 + wc * 32 + 4 * fq, [&](int row, int col, const f32x4& v) { *(u32x2*)(O + (size_t)row * ldc + col) = pk4(v); });
    }
};

template <class F> __device__ __forceinline__ void epi_each160(const f32x4 (&acc)[2][2][5], const pg8::Unit& u, int wid, int fr, int fq, F&& f) {
#pragma unroll
    for (int ai = 0; ai < 2; ++ai)
#pragma unroll
        for (int m = 0; m < 5; ++m)
#pragma unroll
            for (int bj = 0; bj < 2; ++bj) f(u.pm * 160 + ai * 80 + m * 16 + fr, u.pn * 256 + bj * 128 + wid * 16 + 4 * fq, acc[ai][bj][m]);
}
struct EpiBf16_160 {
    bf16* O; int ldc;
    static constexpr bool AFTER_DRAIN = false;
    template <int MF> __device__ __forceinline__ void tile(const f32x4 (&acc)[2][2][MF][2], const pg8::Unit& u, int wr, int wc, int fr, int fq) const {
#pragma unroll
        for (int ai = 0; ai < 2; ++ai)
#pragma unroll
            for (int m = 0; m < MF; ++m)
#pragma unroll
                for (int bj = 0; bj < 2; ++bj)
#pragma unroll
                    for (int n = 0; n < 2; ++n) *(u32x2*)(O + (size_t)(u.pm * 160 + ai * 80 + wr * 48 + m * 16 + fr) * ldc + u.pn * 256 + bj * 128 + wc * 32 + n * 16 + 4 * fq) = pk4(acc[ai][bj][m][n]);
    }
    __device__ __forceinline__ void operator()(const f32x4 (&acc)[2][2][5], const pg8::Unit& u, int wid, int fr, int fq) const {
#pragma unroll
        for (int ai = 0; ai < 2; ++ai)
#pragma unroll
            for (int m = 0; m < 5; ++m)
#pragma unroll
                for (int bj = 0; bj < 2; ++bj) *(u32x2*)(O + (size_t)(u.pm * 160 + ai * 80 + m * 16 + fr) * ldc + u.pn * 256 + bj * 128 + wid * 16 + 4 * fq) = pk4(acc[ai][bj][m]);
    }
};

template <bool FROM_INPUT, bool FINAL>
struct EpiResNorm {
    static constexpr bool AFTER_DRAIN = true;
    const float* xin_p; const float* xin_s; const bf16* xb_in;
    bf16* xb_out; float* xf_out; bf16* xn_out;
    const float* gA; const float* gB; const float* mod;
    int gate_off, layer_gate, shift_off, scale_off, layer_mod;
    unsigned* slots; unsigned* cnt;

    template <int MF> __device__ __forceinline__ void exchange(const f32x4 (&v)[2][2][MF][2], int e, int pm, int pn, int wr, int wc, int fr, int fq, LAS float* P, LAS float* R, int wid, int lane, int tid) const {
#pragma unroll
        for (int ai = 0; ai < 2; ++ai)
#pragma unroll
            for (int m = 0; m < MF; ++m) {
                float s = 0.f;
#pragma unroll
                for (int bj = 0; bj < 2; ++bj)
#pragma unroll
                    for (int n = 0; n < 2; ++n) { const f32x4 x = v[ai][bj][m][n]; s += (x[0] * x[0] + x[1] * x[1]) + (x[2] * x[2] + x[3] * x[3]); }
                s += __shfl_xor(s, 16); s += __shfl_xor(s, 32);
                if (fq == 0) P[(80 * ai + 48 * wr + 16 * m + fr) * 4 + wc] = s;
            }
        asm volatile("s_waitcnt lgkmcnt(0)" ::: "memory"); __builtin_amdgcn_s_barrier(); asm volatile("" ::: "memory");
        unsigned long long* sl = (unsigned long long*)(slots + ((size_t)(e * 64 + pm) * 160) * 4);
        if (tid < 160) { const float tot = (P[tid * 4 + 0] + P[tid * 4 + 1]) + (P[tid * 4 + 2] + P[tid * 4 + 3]);
            __hip_atomic_store((unsigned*)sl + tid * 4 + pn, __float_as_uint(tot) | 1u, __ATOMIC_RELAXED, __HIP_MEMORY_SCOPE_AGENT);
            unsigned long long a, b; unsigned spins = 0;
            for (;;) {
                a = __hip_atomic_load(sl + tid * 2 + 0, __ATOMIC_RELAXED, __HIP_MEMORY_SCOPE_AGENT); b = __hip_atomic_load(sl + tid * 2 + 1, __ATOMIC_RELAXED, __HIP_MEMORY_SCOPE_AGENT);
                if (((unsigned)a != 0u && (unsigned)(a >> 32) != 0u && (unsigned)b != 0u && (unsigned)(b >> 32) != 0u) || ++spins > (1u << 20)) break;
                __builtin_amdgcn_s_sleep(1);
            }
            const float q = (__uint_as_float((unsigned)a) + __uint_as_float((unsigned)(a >> 32))) + (__uint_as_float((unsigned)b) + __uint_as_float((unsigned)(b >> 32)));
            R[tid] = rsqrtf(q * (1.f / 1024.f) + 1e-6f); }
        asm volatile("s_waitcnt lgkmcnt(0)" ::: "memory"); __builtin_amdgcn_s_barrier(); asm volatile("" ::: "memory");
    }

    template <int MF> __device__ __forceinline__ void fused(f32x4 (&acc)[2][2][MF][2], const pg8::Unit& u, int wr, int wc, int fr, int fq, LAS unsigned char* lds, int wid, int lane, int tid) const {
        LAS float* P = (LAS float*)lds; LAS float* R = (LAS float*)(lds + 4096);
        const int pm = u.pm, pn = u.pn, row0 = 160 * pm;
        int cb = 256 * pn + 32 * wc + 4 * fq; asm volatile("" : "+v"(cb));
        const int c_lo = row_cond(row0), c_hi = row_cond(row0 + 159);
        f32x4 g[4], gtl[4], gth[4];
        {   const float* ml = mod + (size_t)(layer_gate * 3 + c_lo) * 6144 + gate_off; const float* mh = mod + (size_t)(layer_gate * 3 + c_hi) * 6144 + gate_off;
#pragma unroll
            for (int q = 0; q < 4; ++q) { const int col = cb + 128 * (q >> 1) + 16 * (q & 1); g[q] = *(const f32x4*)(gA + col); gtl[q] = *(const f32x4*)(ml + col); gth[q] = *(const f32x4*)(mh + col); } }
        using XT = typename std::conditional<FROM_INPUT, f32x4, u32x2>::type;
        XT x0[MF * 4], x1[MF * 4];
        auto ldx = [&](XT (&xr)[MF * 4], int ai) {
#pragma unroll
            for (int m = 0; m < MF; ++m) { const int row = row0 + 80 * ai + 48 * wr + 16 * m + fr;
#pragma unroll
                for (int q = 0; q < 4; ++q) { const int col = cb + 128 * (q >> 1) + 16 * (q & 1);
                    if constexpr (FROM_INPUT) xr[m * 4 + q] = *(const f32x4*)((row < NPR ? xin_p + (size_t)row * DM : xin_s + (size_t)(row - NPR) * DM) + col);
                    else xr[m * 4 + q] = *(const u32x2*)(xb_in + (size_t)row * DM + col); } } };
        auto upd = [&](const XT (&xr)[MF * 4], int ai) {
#pragma unroll
            for (int m = 0; m < MF; ++m) { const int rl = 80 * ai + 48 * wr + 16 * m + fr; const float rinv = R[rl]; const bool hi = row_cond(row0 + 80 * ai + 48 * wr + 16 * m) != c_lo;
#pragma unroll
                for (int q = 0; q < 4; ++q) { f32x4 x; if constexpr (FROM_INPUT) x = xr[m * 4 + q]; else x = unpk4(xr[m * 4 + q]);
                    const f32x4 gt = hi ? gth[q] : gtl[q];
                    acc[ai][q >> 1][m][q & 1] = x + gt * (acc[ai][q >> 1][m][q & 1] * rinv * g[q]); } } };
        ldx(x0, 0);
        if constexpr (!FROM_INPUT) ldx(x1, 1);
        asm volatile("" ::: "memory");
        exchange<MF>(acc, 0, pm, pn, wr, wc, fr, fq, P, R, wid, lane, tid);
        upd(x0, 0);
        if constexpr (FROM_INPUT) { asm volatile("" ::: "memory"); ldx(x1, 1); }
        upd(x1, 1);
#pragma unroll
        for (int ai = 0; ai < 2; ++ai)
#pragma unroll
            for (int m = 0; m < MF; ++m) { const int row = row0 + 80 * ai + 48 * wr + 16 * m + fr;
#pragma unroll
                for (int q = 0; q < 4; ++q) { const int col = cb + 128 * (q >> 1) + 16 * (q & 1); const f32x4 x = acc[ai][q >> 1][m][q & 1];
                    if constexpr (FINAL) *(f32x4*)(xf_out + (size_t)row * DM + col) = x; else *(u32x2*)(xb_out + (size_t)row * DM + col) = pk4(x); } }
        if constexpr (!FINAL) {
            f32x4 al[4], ah[4], sl[4], sh[4];
            {   const float* ml = mod + (size_t)(layer_mod * 3 + c_lo) * 6144; const float* mh = mod + (size_t)(layer_mod * 3 + c_hi) * 6144;
#pragma unroll
                for (int q = 0; q < 4; ++q) { const int col = cb + 128 * (q >> 1) + 16 * (q & 1); const f32x4 gb = *(const f32x4*)(gB + col);
                    al[q] = gb * (*(const f32x4*)(ml + scale_off + col) + 1.f); ah[q] = gb * (*(const f32x4*)(mh + scale_off + col) + 1.f);
                    sl[q] = *(const f32x4*)(ml + shift_off + col); sh[q] = *(const f32x4*)(mh + shift_off + col); } }
            asm volatile("" ::: "memory");
            exchange<MF>(acc, 1, pm, pn, wr, wc, fr, fq, P, R, wid, lane, tid);
#pragma unroll
            for (int ai = 0; ai < 2; ++ai)
#pragma unroll
                for (int m = 0; m < MF; ++m) { const int rl = 80 * ai + 48 * wr + 16 * m + fr, row = row0 + rl; const float rinv = R[rl]; const bool hi = row_cond(row0 + 80 * ai + 48 * wr + 16 * m) != c_lo;
#pragma unroll
                    for (int q = 0; q < 4; ++q) { const int col = cb + 128 * (q >> 1) + 16 * (q & 1);
                        const f32x4 h = (acc[ai][q >> 1][m][q & 1] * rinv) * (hi ? ah[q] : al[q]) + (hi ? sh[q] : sl[q]);
                        *(u32x2*)(xn_out + (size_t)row * DM + col) = pk4(h); } }
        }
    }
};

struct EpiProj {
    bf16 *Q, *KP, *KS, *VTP, *VTS, *FB; float *ock, *ocv; const float* rope;
    static constexpr bool ALIGN = false, AFTER_DRAIN = false;
    __device__ __forceinline__ f32x4 do_rope(f32x4 v, int t, int col) const {
        const int i0 = (col & 63) >> 1;
        const f32x2 c = *(const f32x2*)(rope + t * 32 + i0), s = *(const f32x2*)(rope + 1024 * 32 + t * 32 + i0);
        f32x4 o; o[0] = v[0] * c[0] - v[1] * s[0]; o[1] = v[0] * s[0] + v[1] * c[0]; o[2] = v[2] * c[1] - v[3] * s[1]; o[3] = v[2] * s[1] + v[3] * c[1]; return o;
    }
    __device__ __forceinline__ void operator()(const f32x4 (&acc)[2][2][4][2], const pg8::Unit& u, int wr, int wc, int fr, int fq) const {
        pg8::epi_each(acc, u.pm * 256 + wr * 64 + fr, u.pn * 256 + wc * 32 + 4 * fq, [&](int row, int col, const f32x4& v) { elem(row, col, v); });
    }
    __device__ __forceinline__ void operator()(const f32x4 (&acc)[2][2][5], const pg8::Unit& u, int wid, int fr, int fq) const {
        epi_each160(acc, u, wid, fr, fq, [&](int row, int col, const f32x4& v) { elem(row, col, v); });
    }
    template <int MF> __device__ __forceinline__ void tile(const f32x4 (&acc)[2][2][MF][2], const pg8::Unit& u, int wr, int wc, int fr, int fq) const {
#pragma unroll
        for (int ai = 0; ai < 2; ++ai)
#pragma unroll
            for (int m = 0; m < MF; ++m)
#pragma unroll
                for (int bj = 0; bj < 2; ++bj)
#pragma unroll
                    for (int n = 0; n < 2; ++n) elem(u.pm * 160 + ai * 80 + wr * 48 + m * 16 + fr, u.pn * 256 + bj * 128 + wc * 32 + n * 16 + 4 * fq, acc[ai][bj][m][n]);
    }
    __device__ __forceinline__ void elem(int row, int col, const f32x4& v) const {
        {
            const bool smp = row >= NPR; const int sr = row - NPR, sb = sr >> 10, st = sr & 1023;
            if (col < 512) {
                f32x4 o = v; if (smp) o = do_rope(v, st, col);
                *(u32x2*)(Q + (size_t)row * 512 + col) = pk4(o);
            } else if (col < 1024) {
                const int c = col - 512;
                if (!smp) { *(f32x4*)(ock + (size_t)row * 512 + c) = v; *(u32x2*)(KP + (size_t)row * 512 + c) = pk4(v); }
                else { const f32x4 o = do_rope(v, st, c); *(u32x2*)(KS + ((size_t)sb * LKS + PAST + st) * 512 + c) = pk4(o); }
            } else if (col < 1536) {
                const int c = col - 1024, h = c >> 7, d = c & 127;
                if (!smp) { *(f32x4*)(ocv + (size_t)row * 512 + c) = v; const int b = row >> 8, t = row & 255; bf16* p = VTP + ((size_t)(b * 4 + h) * 128 + d) * SEQ + keypos(t);
#pragma unroll
                    for (int e = 0; e < 4; ++e) p[(size_t)e * SEQ] = f2bf(v[e]); }
                else { bf16* p = VTS + ((size_t)(sb * 4 + h) * 128 + d) * LKS + keypos(PAST + st);
#pragma unroll
                    for (int e = 0; e < 4; ++e) p[(size_t)e * LKS] = f2bf(v[e]); }
            } else if (col < INE) {
                *(u32x2*)(FB + (size_t)row * INB + (col - 1536)) = pk4(v);
            }
        }
    }
};


template <int CTRL> __device__ __forceinline__ float dpp_mv(float old, float src) { return __int_as_float(__builtin_amdgcn_update_dpp(__float_as_int(old), __float_as_int(src), CTRL, 0xf, 0xf, false)); }
template <int CTRL> __device__ __forceinline__ float dpp_rot(float src) { return __int_as_float(__builtin_amdgcn_mov_dpp(__float_as_int(src), CTRL, 0xf, 0xf, true)); }
__device__ __forceinline__ float silu_mul(float x, float u) { return x * __builtin_amdgcn_rcpf(1.f + __expf(-x)) * u; }
struct EpiFfnConv {
    static constexpr bool ALIGN = true;
    bf16* ACT; const float* cw; const float* cb; float* SB; LAS float* xch;
    __device__ __forceinline__ void operator()(const f32x4 (&acc)[2][2][4][2], const pg8::Unit& u, int wr, int wc, int fr, int fq) const {
        const int pm = u.pm, pn = u.pn;
        const bool smp = pm >= 32; const int sidx = pm - 32, sq = sidx & 3;
        const bool has_prev = smp && sq > 0, has_next = smp && sq < 3;
#pragma unroll
        for (int ai = 0; ai < 2; ++ai)
#pragma unroll
            for (int n = 0; n < 2; ++n) { const int c = 32 * wc + 16 * n + 4 * fq, blk = 2 * ai + wr;
                if (fr == 0) *(LAS f32x4*)(xch + (blk * 2 + 0) * 128 + c) = acc[ai][1][0][n];
                if (fr == 15) *(LAS f32x4*)(xch + (blk * 2 + 1) * 128 + c) = acc[ai][1][3][n]; }
        asm volatile("s_waitcnt lgkmcnt(0)" ::: "memory"); __builtin_amdgcn_s_barrier(); asm volatile("" ::: "memory");
#pragma unroll
        for (int n = 0; n < 2; ++n) {
            const int c = 32 * wc + 16 * n + 4 * fq, f = 128 * pn + c;
            const f32x4 c0 = *(const f32x4*)(cw + f), c1 = *(const f32x4*)(cw + DFF + f), c2 = *(const f32x4*)(cw + 2 * DFF + f), cbv = *(const f32x4*)(cb + f);
#pragma unroll
            for (int ai = 0; ai < 2; ++ai) {
                const int blk = 2 * ai + wr;
                f32x4 gabove = {0.f, 0.f, 0.f, 0.f}, gbelow = gabove;
                if (blk > 0) gabove = *(const LAS f32x4*)(xch + ((blk - 1) * 2 + 1) * 128 + c);
                if (blk < 3) gbelow = *(const LAS f32x4*)(xch + ((blk + 1) * 2 + 0) * 128 + c);
#pragma unroll
                for (int m = 0; m < 4; ++m) {
                    const f32x4 g = acc[ai][1][m][n], uu = acc[ai][0][m][n];
                    f32x4 o, xs;
#pragma unroll
                    for (int e = 0; e < 4; ++e) {
                        const float pold = m > 0 ? dpp_rot<0x121>(acc[ai][1][m - 1][n][e]) : gabove[e];
                        const float prev = dpp_mv<0x111>(pold, g[e]);
                        const float nold = m < 3 ? dpp_rot<0x12F>(acc[ai][1][m + 1][n][e]) : gbelow[e];
                        const float next = dpp_mv<0x101>(nold, g[e]);
                        const float x = c0[e] * prev + (c1[e] * g[e] + (c2[e] * next + cbv[e]));
                        xs[e] = x; o[e] = silu_mul(x, uu[e]);
                    }
                    const int r = 128 * ai + 64 * wr + 16 * m + fr;
                    *(u32x2*)(ACT + (size_t)(256 * pm + r) * DFF + f) = pk4(o);
                    if (smp) {
                        if (r == 0) { *(f32x4*)(SB + (size_t)(0 * 8 + sidx) * DFF + f) = g; if (has_prev) { *(f32x4*)(SB + (size_t)(2 * 8 + sidx) * DFF + f) = xs; *(f32x4*)(SB + (size_t)(3 * 8 + sidx) * DFF + f) = uu; } }
                        if (r == 255) { *(f32x4*)(SB + (size_t)(1 * 8 + sidx) * DFF + f) = g; if (has_next) { *(f32x4*)(SB + (size_t)(4 * 8 + sidx) * DFF + f) = xs; *(f32x4*)(SB + (size_t)(5 * 8 + sidx) * DFF + f) = uu; } }
                    }
                }
            }
        }
    }
};
template <class Sched>
__device__ __forceinline__ void ffn_seam_fixup(const Sched& S, int rows_per_unit, bf16* ACT, const float* cw, const float* SB) {
    pg8::Unit u;
    for (int i = 0; S.next(i, u); ++i) {
        const int lo = u.pm * rows_per_unit, hi = lo + rows_per_unit;
        if (hi <= NPR) continue;
        int t0 = threadIdx.x; asm volatile("" : "+v"(t0));
        for (int sidx = 0; sidx < 8; ++sidx) {
            const int sq = sidx & 3, r0 = 256 * (32 + sidx), r1 = r0 + 255;
            const bool fix0 = sq > 0 && r0 >= lo && r0 < hi, fix1 = sq < 3 && r1 >= lo && r1 < hi;
            if (!fix0 && !fix1) continue;
            for (int f = t0; f < DFF; f += 512) {
                if (fix0) { const float x = SB[(size_t)(2 * 8 + sidx) * DFF + f] + cw[f] * SB[(size_t)(1 * 8 + sidx - 1) * DFF + f]; ACT[(size_t)r0 * DFF + f] = f2bf(silu_mul(x, SB[(size_t)(3 * 8 + sidx) * DFF + f])); }
                if (fix1) { const float x = SB[(size_t)(4 * 8 + sidx) * DFF + f] + cw[2 * DFF + f] * SB[(size_t)(0 * 8 + sidx + 1) * DFF + f]; ACT[(size_t)r1 * DFF + f] = f2bf(silu_mul(x, SB[(size_t)(5 * 8 + sidx) * DFF + f])); }
            }
        }
    }
    asm volatile("s_waitcnt vmcnt(0)" ::: "memory");
    __syncthreads();
}

struct DftOrder {
    int G, c; const char* A; const char* BtS; const char* BtP;
    __device__ bool next(int i, pg8::Unit& u) const {
        const int j = i * G + c; if (j >= 160) return false;
        u.pm = 0; u.a = A;
        if (j < 32) { const int b = j >> 4, p = (j >> 2) & 3, pn = j & 3; u.pn = pn; u.z = NPR + b * 1024 + p; u.b = BtS + ((size_t)(b * 4 + p) * 1024 + pn * 256) * 512 * 2; }
        else { const int q = j - 32, b = q >> 2, pn = q & 3; u.pn = pn; u.z = b * 256; u.b = BtP + ((size_t)b * 1024 + pn * 256) * 512 * 2; }
        return true;
    }
};
struct EpiDft {
    bf16* O;
    static constexpr bool ALIGN = false;
    __device__ __forceinline__ void operator()(const f32x4 (&acc)[2][2][4][2], const pg8::Unit& u, int wr, int wc, int fr, int fq) const {
        const int st = u.z >= NPR ? 4 : 1;
        pg8::epi_each(acc, wr * 64 + fr, u.pn * 256 + wc * 32 + 4 * fq, [&](int r, int col, const f32x4& v) { *(u32x2*)(O + (size_t)(u.z + st * r) * 1024 + col) = pk4(v); });
    }
};

__device__ __forceinline__ f32x16 mfma32(bf16x8 x, bf16x8 y, f32x16 c) { return __builtin_amdgcn_mfma_f32_32x32x16_bf16(x, y, c, 0, 0, 0); }
__device__ __forceinline__ void phase_attention(const Args& a, LAS unsigned char* lds, int bid, int G) {
    int tid = threadIdx.x; asm volatile("" : "+v"(tid));
    const int lane = tid & 63, wave = __builtin_amdgcn_readfirstlane(tid >> 6), tk = lane & 31, hh = lane >> 5;
    const float cs = 0.125f * 1.4426950408889634f;
    const bf16* Q = WSB(WS_Q);
    bf16* AB = WSB(WS_XN);
    const float* subln = FIN(I_SUBLN);
    constexpr int KST = 136, VST = 40;
    LAS bf16* Kl = (LAS bf16*)lds;
    LAS bf16* Vl = (LAS bf16*)(lds + 2 * 32 * KST * 2);
    LAS bf16* Ql = (LAS bf16*)(lds + 40960 + wave * 8192);
    const int lkey = tid >> 4, lkc = tid & 15, lvd = tid >> 2, lvc = tid & 3;
    for (int ai = 0; ai < 2; ++ai) {
        int item;
        if (G == 256) {
            if (bid >= 224) item = ai == 0 ? bid - 224 : -1;
            else if (bid >= 160) item = 32 + 2 * (bid - 160) + ai;
            else item = -1;
        } else item = bid + ai * G;
        if (item < 0 || item >= 160) continue;
        int b, h, nkeys, qrow0; const bf16 *Kb, *VT;
        if (item < 32) { b = item >> 4; h = (item >> 2) & 3; const int qb = item & 3; nkeys = LKS; qrow0 = NPR + b * 1024 + qb * 256 + wave * 32; Kb = WSB(WS_KS) + (size_t)b * LKS * 512; VT = WSB(WS_VTS) + (size_t)(b * 4 + h) * 128 * LKS; }
        else { const int j = item - 32; b = j >> 2; h = j & 3; nkeys = SEQ; qrow0 = b * 256 + wave * 32; Kb = WSB(WS_KP) + (size_t)b * 256 * 512; VT = WSB(WS_VTP) + (size_t)(b * 4 + h) * 128 * SEQ; }
        f32x16 O[2][4];
#pragma unroll
        for (int m = 0; m < 2; ++m)
#pragma unroll
            for (int mt = 0; mt < 4; ++mt)
#pragma unroll
                for (int r = 0; r < 16; ++r) O[m][mt][r] = 0.f;
        float mx[2] = {-1e30f, -1e30f}, ls[2] = {0.f, 0.f};
        const bf16* kg = Kb + (size_t)lkey * 512 + h * 128 + lkc * 8;
        const bf16* vg = VT + (size_t)lvd * nkeys + lvc * 8;
        __syncthreads();
#pragma unroll
        for (int m = 0; m < 2; ++m)
#pragma unroll
            for (int s = 0; s < 4; ++s) *(LAS bf16x8*)(Ql + ((m * 4 + s) * 64 + lane) * 8) = *(const bf16x8*)(Q + (size_t)(qrow0 + tk) * 512 + h * 128 + m * 64 + 16 * s + 8 * hh);
        { const u32x4 k0v = *(const u32x4*)kg, v0v = *(const u32x4*)vg;
          *(LAS u32x4*)(Kl + lkey * KST + lkc * 8) = k0v; *(LAS u32x4*)(Vl + lvd * VST + lvc * 8) = v0v; }
        const int nt = nkeys / 32;
        for (int t = 0; t < nt; ++t) {
            const int cur = t & 1;
            const bool more = t + 1 < nt;
            u32x4 kn = {0u, 0u, 0u, 0u}, vn = kn;
            if (more) { kn = *(const u32x4*)(kg + (size_t)(t + 1) * 32 * 512); vn = *(const u32x4*)(vg + (t + 1) * 32); }
            __syncthreads();
            const LAS bf16* Kc = Kl + cur * 32 * KST + tk * KST + 8 * hh;
            const LAS bf16* Vc = Vl + cur * 128 * VST + tk * VST + 8 * hh;
            bf16x8 pb[2][2];
#pragma unroll
            for (int m = 0; m < 2; ++m) {
                f32x16 S;
#pragma unroll
                for (int r = 0; r < 16; ++r) S[r] = 0.f;
#pragma unroll
                for (int s = 0; s < 4; ++s) { const bf16x8 kf = *(const LAS bf16x8*)(Kc + m * 64 + 16 * s); const bf16x8 qfr = *(const LAS bf16x8*)(Ql + ((m * 4 + s) * 64 + lane) * 8); S = mfma32(kf, qfr, S); }
                float tm = S[0];
#pragma unroll
                for (int r = 1; r < 16; ++r) tm = fmaxf(tm, S[r]);
                tm = fmaxf(tm, __shfl_xor(tm, 32));
                if (__any(tm > mx[m] + 44.0f)) {
                    const float mn = fmaxf(mx[m], tm), alpha = __builtin_amdgcn_exp2f((mx[m] - mn) * cs); mx[m] = mn;
                    ls[m] *= alpha;
#pragma unroll
                    for (int mt = 0; mt < 4; ++mt)
#pragma unroll
                        for (int r = 0; r < 16; ++r) O[m][mt][r] *= alpha;
                }
                const float mcur = mx[m];
                float ps = 0.f;
#pragma unroll
                for (int r = 0; r < 16; ++r) { S[r] = __builtin_amdgcn_exp2f((S[r] - mcur) * cs); ps += S[r]; }
                ls[m] += ps;
#pragma unroll
                for (int s2 = 0; s2 < 2; ++s2) { u32x4 w; w.x = pk2(S[8 * s2 + 0], S[8 * s2 + 1]); w.y = pk2(S[8 * s2 + 2], S[8 * s2 + 3]); w.z = pk2(S[8 * s2 + 4], S[8 * s2 + 5]); w.w = pk2(S[8 * s2 + 6], S[8 * s2 + 7]); pb[m][s2] = __builtin_bit_cast(bf16x8, w); }
            }
#pragma unroll
            for (int mt = 0; mt < 4; ++mt) {
#pragma unroll
                for (int s2 = 0; s2 < 2; ++s2) { const bf16x8 vf = *(const LAS bf16x8*)(Vc + 32 * mt * VST + 16 * s2);
                    O[0][mt] = mfma32(vf, pb[0][s2], O[0][mt]); O[1][mt] = mfma32(vf, pb[1][s2], O[1][mt]); }
            }
            if (more) { *(LAS u32x4*)(Kl + (cur ^ 1) * 32 * KST + lkey * KST + lkc * 8) = kn; *(LAS u32x4*)(Vl + (cur ^ 1) * 128 * VST + lvd * VST + lvc * 8) = vn; }
        }
        const float l0 = ls[0] + __shfl_xor(ls[0], 32), l1 = ls[1] + __shfl_xor(ls[1], 32);
        const float lam = WSF(WS_LAM)[0];
        const float i0 = 1.f / l0, i1 = lam / l1;
        float ss = 0.f;
#pragma unroll
        for (int mt = 0; mt < 4; ++mt)
#pragma unroll
            for (int r = 0; r < 16; ++r) { const float o = O[0][mt][r] * i0 - O[1][mt][r] * i1; O[0][mt][r] = o; ss += o * o; }
        ss += __shfl_xor(ss, 32);
        const float rinv = rsqrtf(ss * (1.f / 128.f) + 1e-6f) * 0.8f;
        bf16* dst = AB + (size_t)(qrow0 + tk) * 1024 + h * 128;
#pragma unroll
        for (int mt = 0; mt < 4; ++mt)
#pragma unroll
            for (int rq = 0; rq < 4; ++rq) { const int d = 32 * mt + 8 * rq + 4 * hh; const f32x4 g = *(const f32x4*)(subln + d);
                f32x4 o; o[0] = O[0][mt][4 * rq + 0] * rinv * g[0]; o[1] = O[0][mt][4 * rq + 1] * rinv * g[1]; o[2] = O[0][mt][4 * rq + 2] * rinv * g[2]; o[3] = O[0][mt][4 * rq + 3] * rinv * g[3];
                *(u32x2*)(dst + d) = pk4(o); }
    }
}

__device__ __forceinline__ float allred4(float x) {
    { auto r = __builtin_amdgcn_permlane16_swap(__float_as_uint(x), __float_as_uint(x), false, false); x = __uint_as_float(r[0]) + __uint_as_float(r[1]); }
    { auto r = __builtin_amdgcn_permlane32_swap(__float_as_uint(x), __float_as_uint(x), false, false); x = __uint_as_float(r[0]) + __uint_as_float(r[1]); }
    return x;
}

constexpr int OPS_KGRG = 0, OPS_KDBD = 4096, OPS_CINIT = 8192, OPS_VIMG = 12288, OPS_GAM = 14336, OPS_ITEM = 14592;
constexpr size_t WS_OPS = WS_MF;
static_assert(WS_OPS + (size_t)2 * 5120 * OPS_ITEM <= WS_Q, "ws ops");
__device__ __forceinline__ f32x4 mfma16(bf16x8 x, bf16x8 y, f32x4 c) { return __builtin_amdgcn_mfma_f32_16x16x32_bf16(x, y, c, 0, 0, 0); }
__device__ __forceinline__ bf16x8 frag_lo(f32x4 v) { u32x4 w; w.x = pk2(v[0], v[1]); w.y = pk2(v[2], v[3]); w.z = 0u; w.w = 0u; return __builtin_bit_cast(bf16x8, w); }
__device__ __forceinline__ void wave_lds_sync() { __syncthreads(); }


template <bool REV>
__device__ __forceinline__ void wkv_chunk_ops(unsigned char* ops, LAS unsigned char* wl, int lane, const float (&kkn)[16], const float (&wv)[16], const float (&kraw)[16], const float (&ad)[16], const float ka_, const float (&rr)[16], const unsigned (&vp)[8]) {
    int lane_ = lane; asm volatile("" : "+v"(lane_));
    const int lr = lane_ & 15, lg = lane_ >> 4, j = lane_;
    LAS bf16* KgR = (LAS bf16*)wl; LAS bf16* RgR = KgR + 16 * 72; LAS bf16* KiR = RgR + 16 * 72; LAS bf16* BiR = KiR + 16 * 72;
    LAS bf16* KgT = (LAS bf16*)(wl + 9216); LAS float* RgT = (LAS float*)(wl + 9216 + 2048); LAS bf16* VT = (LAS bf16*)(wl + 9216 + 2048 + 5120);
    LAS float* NL = (LAS float*)wl; LAS float* TL = (LAS float*)(wl + 2304);
    float gall = 1.f;
#pragma unroll
    for (int t = 0; t < 16; ++t) gall *= wv[t];
    *(float*)(ops + OPS_GAM + 4 * j) = gall;
    float grun = 1.f;
#pragma unroll
    for (int g = 0; g < 4; ++g) {
        float kdv[4], bdv[4]; unsigned vb4[4];
#pragma unroll
        for (int e = 0; e < 4; ++e) {
            const int tau = 4 * g + e, t = REV ? 15 - tau : tau;
            const float gprev = grun; grun *= wv[t];
            const float inv = __builtin_amdgcn_rcpf(grun);
            const float kg = kkn[t] * gprev, rg = rr[t] * grun, ki = kraw[t] * (1.f + (ad[t] - 1.f) * ka_) * inv, bi = kkn[t] * ad[t] * inv;
            kdv[e] = ki * gall; bdv[e] = -bi * gall; vb4[e] = (vp[t >> 1] >> (16 * (t & 1))) & 0xffffu;
            KgR[tau * 72 + j] = f2bf(kg); RgR[tau * 72 + j] = f2bf(rg); KiR[tau * 72 + j] = f2bf(ki); BiR[tau * 72 + j] = f2bf(bi);
            KgT[(g * 64 + j) * 4 + e] = f2bf(kg); RgT[j * 20 + tau] = rg; VT[(g * 64 + j) * 4 + e] = (bf16)vb4[e];
        }
        u32x4 w; w.x = pk2(kdv[0], kdv[1]); w.y = pk2(kdv[2], kdv[3]); w.z = pk2(bdv[0], bdv[1]); w.w = pk2(bdv[2], bdv[3]);
        *(u32x4*)(ops + OPS_KDBD + (((j >> 4) * 64 + (j & 15) + 16 * g) * 16)) = w;
        u32x2 vw; vw.x = vb4[0] | (vb4[1] << 16); vw.y = vb4[2] | (vb4[3] << 16);
        *(u32x2*)(ops + OPS_VIMG + (((j >> 4) * 64 + (j & 15) + 16 * g) * 8)) = vw;
    }
    wave_lds_sync();
    f32x4 akk = {0.f, 0.f, 0.f, 0.f}, akb = akk, ark = akk, arb = akk;
#pragma unroll
    for (int ks = 0; ks < 2; ++ks) {
        const bf16x8 fki = *(const LAS bf16x8*)(KiR + lr * 72 + 32 * ks + 8 * lg), fbi = *(const LAS bf16x8*)(BiR + lr * 72 + 32 * ks + 8 * lg);
        const bf16x8 fkg = *(const LAS bf16x8*)(KgR + lr * 72 + 32 * ks + 8 * lg), frg = *(const LAS bf16x8*)(RgR + lr * 72 + 32 * ks + 8 * lg);
        akk = mfma16(fki, fkg, akk); akb = mfma16(fbi, fkg, akb); ark = mfma16(fki, frg, ark); arb = mfma16(fbi, frg, arb);
    }
#pragma unroll
    for (int e = 0; e < 4; ++e) { const int s = 4 * lg + e; if (!(s < lr)) { akk[e] = 0.f; akb[e] = 0.f; } if (!(s <= lr)) { ark[e] = 0.f; arb[e] = 0.f; } }
    asm volatile("" : "+v"(akk), "+v"(akb), "+v"(ark), "+v"(arb));
    wave_lds_sync();
    *(LAS f32x4*)(NL + lr * 16 + 4 * lg) = akb;
    wave_lds_sync();
    {
        float Tc[16];
#pragma unroll
        for (int t = 0; t < 16; ++t) {
            float acc = (t == lr) ? 1.f : 0.f;
#pragma unroll
            for (int q4 = 0; q4 < (t + 3) / 4; ++q4) { const f32x4 nv = *(const LAS f32x4*)(NL + t * 16 + 4 * q4);
#pragma unroll
                for (int e = 0; e < 4; ++e) if (4 * q4 + e < t) acc -= nv[e] * Tc[4 * q4 + e]; }
            Tc[t] = acc;
        }
        if (lg == 0) {
#pragma unroll
            for (int t = 0; t < 16; ++t) TL[t * 16 + lr] = Tc[t];
        }
    }
    wave_lds_sync();
    const bf16x8 aT = frag_lo(*(const LAS f32x4*)(TL + lr * 16 + 4 * lg));
    const bf16x8 aKK = frag_lo(akk), aRK = frag_lo(ark), aRBn = frag_lo(-arb);
    const f32x4 z4 = {0.f, 0.f, 0.f, 0.f};
#pragma unroll
    for (int it = 0; it < 4; ++it) {
        const u32x2 vq = *(const LAS u32x2*)(VT + (lg * 64 + 16 * it + lr) * 4);
        const bf16x8 bV = __builtin_bit_cast(bf16x8, (u32x4){vq.x, vq.y, 0u, 0u});
        const f32x4 x1 = mfma16(aKK, bV, z4);
        const f32x4 vd = mfma16(aT, frag_lo(x1), z4);
        f32x4 yl = mfma16(aRK, bV, z4); yl = mfma16(aRBn, frag_lo(vd), yl);
        *(u32x2*)(ops + OPS_CINIT + ((0 * 4 + it) * 64 + lane) * 8) = pk4(vd);
        *(u32x2*)(ops + OPS_CINIT + ((1 * 4 + it) * 64 + lane) * 8) = pk4(yl);
    }
#pragma unroll
    for (int jt = 0; jt < 4; ++jt) {
        const u32x2 kq = *(const LAS u32x2*)(KgT + (lg * 64 + 16 * jt + lr) * 4);
        const bf16x8 bK = __builtin_bit_cast(bf16x8, (u32x4){kq.x, kq.y, 0u, 0u});
        const f32x4 kgp = mfma16(aT, bK, z4);
        const f32x4 rgp = mfma16(aRBn, frag_lo(kgp), *(const LAS f32x4*)(RgT + (16 * jt + lr) * 20 + 4 * lg));
        bf16* img = (bf16*)(ops + OPS_KGRG);
#pragma unroll
        for (int e = 0; e < 4; ++e) { const int t = 4 * lg + e; const int off = (((jt >> 1)) * 64 + t + 16 * (lr >> 2)) * 8 + 4 * (jt & 1) + (lr & 3);
            img[off] = f2bf(kgp[e]); img[2 * 64 * 8 + off] = f2bf(rgp[e]); }
    }
    wave_lds_sync();
}

__device__ __forceinline__ void phase_wkv_front(const Args& a, LAS unsigned char* lds, int bid, int G) {
    int tid = threadIdx.x; asm volatile("" : "+v"(tid));
    const int lane = tid & 63, wave = __builtin_amdgcn_readfirstlane(tid >> 6);
    constexpr int AST = 392;
    typedef const __attribute__((address_space(1))) bf16* gcb;
    const bf16* FB = (const bf16*)a.out;
    LAS bf16* act = (LAS bf16*)(lds + ACT_OFF);
    LAS unsigned char* wl = lds + wave * 18432;
    LAS float* TR = (LAS float*)wl;
    const float* mu = FIN(I_MU); const float* kvec = FIN(I_KVEC); const float* w0 = FIN(I_W0); const float* a0 = FIN(I_A0);
    bf16* AB = WSB(WS_XN); bf16* BON = WSB(WS_BONUS);
    int it_lo, it_n;
    if (G == 256) { if (bid < 160) { it_lo = 3 * bid; it_n = 3; } else if (bid < 224) { it_lo = 480 + 2 * (bid - 160); it_n = 2; } else { it_lo = 608 + (bid - 224); it_n = 1; } }
    else { it_lo = bid; it_n = (640 - bid + G - 1) / G; }
    for (int ii = 0; ii < it_n; ++ii) {
        const int item = (G == 256) ? it_lo + ii : it_lo + ii * G;
        int smp, sq, c, L, rowbase, nc;
        if (item < 128) { smp = 1; sq = item >> 6; c = item & 63; L = DSEQ; rowbase = NPR + sq * DSEQ; nc = 64; }
        else { const int p = item - 128; smp = 0; sq = p >> 4; c = p & 15; L = SEQ; rowbase = sq * SEQ; nc = 16; }
        const int row0 = rowbase + 16 * c, tp0 = 16 * c;
        __syncthreads();
        int tq = tid; asm volatile("" : "+v"(tq));
        for (int idx = tq; idx < 16 * 96; idx += 512) {
            const int tl = idx / 96, cg = idx - tl * 96, col = 1536 + 4 * cg, row = row0 + tl, tp = tp0 + tl;
            const f32x4 f = unpk4(*(const u32x2*)(FB + (size_t)row * INB + col));
            const f32x4 p = unpk4(*(const u32x2*)(FB + (size_t)(tp > 0 ? row - 1 : row) * INB + col)) * (tp > 0 ? 1.f : 0.f);
            const f32x4 n = unpk4(*(const u32x2*)(FB + (size_t)(tp < L - 1 ? row + 1 : row) * INB + col)) * (tp < L - 1 ? 1.f : 0.f);
            const f32x4 m0 = *(const f32x4*)(mu + col), m1 = *(const f32x4*)(mu + INB + col);
            f32x4 s = f + m0 * (p - f) + m1 * (n - f);
            const int kind = cg >> 5;
            if (kind == 0) { s[0] = tanhf(s[0]); s[1] = tanhf(s[1]); s[2] = tanhf(s[2]); s[3] = tanhf(s[3]); }
            else if (kind == 2) { s[0] = sigmoidf_(s[0]); s[1] = sigmoidf_(s[1]); s[2] = sigmoidf_(s[2]); s[3] = sigmoidf_(s[3]); }
            *(LAS u32x2*)(act + tl * AST + 4 * cg) = pk4(s);
        }
        __syncthreads();
        int j = lane; asm volatile("" : "+v"(j));
        const int lr = j & 15, lg = j >> 4;
        const int h = wave, col = h * 64 + j;
        auto lora_mma = [&](const bf16* WT, int ldk, int k0, int nks, f32x4 (&acc)[4]) {
            gcb wb = (gcb)(WT + (size_t)(h * 64 + lr) * ldk + 8 * lg);
            const LAS bf16* ab = act + lr * AST + k0 + 8 * lg;
            asm volatile("" : "+v"(wb), "+v"(ab));
#pragma unroll
            for (int jt = 0; jt < 4; ++jt) acc[jt] = (f32x4){0.f, 0.f, 0.f, 0.f};
            for (int ks = 0; ks < nks; ++ks) {
                const bf16x8 fa = *(const LAS bf16x8*)(ab + 32 * ks);
#pragma unroll
                for (int jt = 0; jt < 4; ++jt) { const bf16x8 fb = *(const __attribute__((address_space(1))) bf16x8*)(wb + (size_t)(16 * jt) * ldk + 32 * ks); acc[jt] = mfma16(fa, fb, acc[jt]); }
            }
        };
        auto tr_put = [&](int b, const f32x4 (&acc)[4]) {
#pragma unroll
            for (int jt = 0; jt < 4; ++jt) *(LAS f32x4*)(TR + b * 1280 + (16 * jt + lr) * 20 + 4 * lg) = acc[jt];
        };
        auto tr_get = [&](int b, float (&out)[16]) {
#pragma unroll
            for (int q = 0; q < 4; ++q) { const f32x4 x = *(const LAS f32x4*)(TR + b * 1280 + j * 20 + 4 * q); out[4 * q] = x[0]; out[4 * q + 1] = x[1]; out[4 * q + 2] = x[2]; out[4 * q + 3] = x[3]; }
        };
        f32x4 accG[4], accA0[4], accA1[4], accW0[4];
        lora_mma(WSB(WS_G2T), 128, 256, 4, accG);
        lora_mma(WSB(WS_A2T), 64, 128, 2, accA0);
        lora_mma(WSB(WS_A2T) + 512 * 64, 64, 192, 2, accA1);
        lora_mma(WSB(WS_W2T), 64, 0, 2, accW0);
        float r[16], k[16]; unsigned vp[8];
        {
            unsigned raw[3][18]; float v[16];
#pragma unroll
            for (int x = 0; x < 3; ++x)
#pragma unroll
                for (int q = 0; q < 18; ++q) { const int tp = tp0 - 1 + q; const int rw = row0 - 1 + q + (tp < 0 ? 1 : 0) - (tp > L - 1 ? 1 : 0); raw[x][q] = FB[(size_t)rw * INB + 512 * x + col]; }
            const float pm = tp0 > 0 ? 1.f : 0.f, nm = tp0 + 16 < L ? 1.f : 0.f;
            const float mr0 = mu[col], mr1 = mu[INB + col], mk0 = mu[512 + col], mk1 = mu[INB + 512 + col], mv0 = mu[1024 + col], mv1 = mu[INB + 1024 + col];
#pragma unroll
            for (int t = 0; t < 16; ++t) {
                const float pmask = t == 0 ? pm : 1.f, nmask = t == 15 ? nm : 1.f;
                { const float f = bf2f(raw[0][t + 1]), p = bf2f(raw[0][t]) * pmask, n = bf2f(raw[0][t + 2]) * nmask; r[t] = f + mr0 * (p - f) + mr1 * (n - f); }
                { const float f = bf2f(raw[1][t + 1]), p = bf2f(raw[1][t]) * pmask, n = bf2f(raw[1][t + 2]) * nmask; k[t] = f + mk0 * (p - f) + mk1 * (n - f); }
                { const float f = bf2f(raw[2][t + 1]), p = bf2f(raw[2][t]) * pmask, n = bf2f(raw[2][t + 2]) * nmask; v[t] = f + mv0 * (p - f) + mv1 * (n - f); }
            }
#pragma unroll
            for (int q = 0; q < 8; ++q) vp[q] = pk2(v[2 * q], v[2 * q + 1]);
        }
        float av0[16], av1[16];
        {
            float graw[16];
            tr_put(0, accG); tr_put(1, accA0); tr_put(2, accA1);
            wave_lds_sync();
            tr_get(0, graw); tr_get(1, av0); tr_get(2, av1);
            wave_lds_sync();
#pragma unroll
            for (int t = 0; t < 16; ++t) AB[(size_t)(row0 + t) * 1024 + 512 + col] = f2bf(graw[t]);
        }
        float wv0[16];
        {
            tr_put(0, accW0);
            wave_lds_sync();
            tr_get(0, wv0);
            wave_lds_sync();
            const float w00 = w0[col];
#pragma unroll
            for (int t = 0; t < 16; ++t) wv0[t] = __expf(-0.60653065971f * sigmoidf_(w00 + wv0[t]));
        }
        const float kk_ = kvec[col], ka_ = kvec[512 + col], rk_ = kvec[1024 + col], a00 = a0[col], a01 = a0[512 + col];
        float kkn[16];
        {
            LAS float* RED1 = (LAS float*)wl; LAS float* RED2 = RED1 + 64 * 17; LAS float* TOT = RED2 + 64 * 17;
#pragma unroll
            for (int t = 0; t < 16; ++t) {
                av0[t] = sigmoidf_(a00 + av0[t]); av1[t] = sigmoidf_(a01 + av1[t]);
                const float kr = k[t] * kk_; kkn[t] = kr;
                RED1[j * 17 + t] = kr * kr; RED2[j * 17 + t] = r[t] * rk_ * k[t] * (2.f + (av0[t] + av1[t] - 2.f) * ka_);
            }
            wave_lds_sync();
            float s1 = 0.f, s2 = 0.f;
#pragma unroll
            for (int jj = 0; jj < 16; ++jj) { s1 += RED1[(16 * lg + jj) * 17 + lr]; s2 += RED2[(16 * lg + jj) * 17 + lr]; }
            s1 = allred4(s1); s2 = allred4(s2);
            if (lg == 0) { TOT[lr] = rsqrtf(s1 + 1e-12f); TOT[16 + lr] = s2; }
            wave_lds_sync();
#pragma unroll
            for (int q = 0; q < 4; ++q) { const f32x4 ri = *(const LAS f32x4*)(TOT + 4 * q), rs = *(const LAS f32x4*)(TOT + 16 + 4 * q);
#pragma unroll
                for (int e = 0; e < 4; ++e) { const int t = 4 * q + e; kkn[t] *= ri[e]; BON[(size_t)(row0 + t) * 512 + col] = f2bf(rs[e] * __uint_as_float((t & 1) ? (vp[t >> 1] & 0xffff0000u) : (vp[t >> 1] << 16))); } }
            wave_lds_sync();
        }
        {
            const int oi = smp ? 4096 + (sq * 8 + h) * 64 + c : (sq * 8 + h) * 16 + c;
            wkv_chunk_ops<false>(a.ws + WS_OPS + (size_t)oi * OPS_ITEM, wl, lane, kkn, wv0, k, av0, ka_, r, vp);
        }
        {
            float wv1[16];
            { f32x4 accW1[4]; lora_mma(WSB(WS_W2T) + 512 * 64, 64, 64, 2, accW1); tr_put(0, accW1); wave_lds_sync(); tr_get(0, wv1); wave_lds_sync();
              const float w01 = w0[512 + col];
#pragma unroll
              for (int t = 0; t < 16; ++t) wv1[t] = __expf(-0.60653065971f * sigmoidf_(w01 + wv1[t])); }
            const int cc = nc - 1 - c;
            const int oi = 5120 + (smp ? 4096 + (sq * 8 + h) * 64 + cc : (sq * 8 + h) * 16 + cc);
            wkv_chunk_ops<true>(a.ws + WS_OPS + (size_t)oi * OPS_ITEM, wl, lane, kkn, wv1, k, av1, ka_, r, vp);
        }
    }
}

struct ChainOps { bf16x8 kgrg[2][2]; u32x2 cinit[2]; bf16x8 kdbd[4]; u32x2 vimg; f32x4 gam[4]; };
__device__ __forceinline__ void chain_load(ChainOps& o, const unsigned char* ops, int lane, int it) {
    const int lg = lane >> 4;
#pragma unroll
    for (int rt = 0; rt < 2; ++rt) {
#pragma unroll
        for (int ks = 0; ks < 2; ++ks) o.kgrg[rt][ks] = *(const bf16x8*)(ops + OPS_KGRG + ((rt * 2 + ks) * 64 + lane) * 16);
        o.cinit[rt] = *(const u32x2*)(ops + OPS_CINIT + ((rt * 4 + it) * 64 + lane) * 8);
    }
#pragma unroll
    for (int jt = 0; jt < 4; ++jt) { o.kdbd[jt] = *(const bf16x8*)(ops + OPS_KDBD + (jt * 64 + lane) * 16); o.gam[jt] = *(const f32x4*)(ops + OPS_GAM + (16 * jt + 4 * lg) * 4); }
    o.vimg = *(const u32x2*)(ops + OPS_VIMG + (it * 64 + lane) * 8);
}
__device__ __forceinline__ void wkv_sample_wave(const Args& a, LAS float* ybuf, int idx, int lane) {
    const int lr = lane & 15, lg = lane >> 4;
    const int dir = idx >> 6, ch = (idx >> 2) & 15, it = idx & 3;
    const int b = ch >> 3, h = ch & 7, nc = 64, L = DSEQ, rowbase = NPR + b * DSEQ, opsbase = 4096 + ch * 64;
    float* Y = a.out;
    f32x4 H[4];
    { const float* sp = FIN(I_ST) + (size_t)((b * 2 + dir) * 8 + h) * 4096;
#pragma unroll
      for (int jt = 0; jt < 4; ++jt) H[jt] = *(const f32x4*)(sp + (16 * it + lr) * 64 + 16 * jt + 4 * lg); }
    const unsigned char* opsp = a.ws + WS_OPS + (size_t)(dir * 5120 + opsbase) * OPS_ITEM;
    float* yg = Y + ((size_t)dir * NT + rowbase) * 512 + h * 64 + 16 * it + 4 * (lane & 3);
    ChainOps o0, o1;
    chain_load(o0, opsp, lane, it);
    chain_load(o1, opsp + OPS_ITEM, lane, it);
    auto step = [&](const ChainOps& cur, int c) {
        bf16x8 bh[2];
#pragma unroll
        for (int ks = 0; ks < 2; ++ks) { const u32x2 p0 = pk4(H[2 * ks]), p1 = pk4(H[2 * ks + 1]); bh[ks] = __builtin_bit_cast(bf16x8, (u32x4){p0.x, p0.y, p1.x, p1.y}); }
        f32x4 u = unpk4(cur.cinit[0]), y = unpk4(cur.cinit[1]);
#pragma unroll
        for (int ks = 0; ks < 2; ++ks) { u = mfma16(cur.kgrg[0][ks], bh[ks], u); y = mfma16(cur.kgrg[1][ks], bh[ks], y); }
#pragma unroll
        for (int e = 0; e < 4; ++e) ybuf[(16 * (c & 15) + 4 * lg + e) * 16 + lr] = y[e];
        const u32x2 up = pk4(u);
        const bf16x8 bvu = __builtin_bit_cast(bf16x8, (u32x4){cur.vimg.x, cur.vimg.y, up.x, up.y});
#pragma unroll
        for (int jt = 0; jt < 4; ++jt) H[jt] = mfma16(cur.kdbd[jt], bvu, H[jt] * cur.gam[jt]);
    };
    auto flush = [&](int c) {
        if ((c & 15) == 15) {
            asm volatile("s_waitcnt lgkmcnt(0)" ::: "memory");
            const int base = 256 * (c >> 4);
#pragma unroll 1
            for (int r0 = 0; r0 < 256; r0 += 16) { const int lt = base + r0 + (lane >> 2);
                *(f32x4*)(yg + (size_t)(dir ? L - 1 - lt : lt) * 512) = *(const LAS f32x4*)(ybuf + (r0 + (lane >> 2)) * 16 + 4 * (lane & 3)); }
            asm volatile("s_waitcnt lgkmcnt(0)" ::: "memory");
        }
    };
    ChainOps o2; chain_load(o2, opsp + 2 * OPS_ITEM, lane, it);
    int c = 0;
#pragma unroll 1
    for (; c + 2 < nc; c += 3) {
        step(o0, c); chain_load(o0, opsp + (size_t)(c + 3 < nc ? c + 3 : nc - 1) * OPS_ITEM, lane, it); flush(c);
        step(o1, c + 1); chain_load(o1, opsp + (size_t)(c + 4 < nc ? c + 4 : nc - 1) * OPS_ITEM, lane, it); flush(c + 1);
        step(o2, c + 2); chain_load(o2, opsp + (size_t)(c + 5 < nc ? c + 5 : nc - 1) * OPS_ITEM, lane, it); flush(c + 2);
    }
    for (; c < nc; ++c) { step(o0, c); flush(c); }
    asm volatile("s_waitcnt vmcnt(0) lgkmcnt(0)" ::: "memory");
}

struct ChainSh { bf16x8 kg, kd; float gm; };
struct ChainPr { u32x2 ci0, ci1, vi; };
__device__ __forceinline__ void chain_sh(ChainSh& o, const unsigned char* ops, int lane, int it) {
    o.kg = *(const bf16x8*)(ops + OPS_KGRG + (it * 64 + lane) * 16);
    o.kd = *(const bf16x8*)(ops + OPS_KDBD + (it * 64 + lane) * 16);
    o.gm = *(const float*)(ops + OPS_GAM + (16 * it + (lane & 15)) * 4);
}
__device__ __forceinline__ void chain_pr(ChainPr& o, const unsigned char* ops, int lane, int it) {
    o.ci0 = *(const u32x2*)(ops + OPS_CINIT + ((0 * 4 + it) * 64 + lane) * 8);
    o.ci1 = *(const u32x2*)(ops + OPS_CINIT + ((1 * 4 + it) * 64 + lane) * 8);
    o.vi = *(const u32x2*)(ops + OPS_VIMG + (it * 64 + lane) * 8);
}
template <bool DRY = false>
__device__ __forceinline__ void phase_wkv_chain(const Args& a, LAS unsigned char* lds, int bid, int G) {
    int tid = threadIdx.x; asm volatile("" : "+v"(tid));
    const int lane = tid & 63, wave = __builtin_amdgcn_readfirstlane(tid >> 6);
    const int lr = lane & 15, lg = lane >> 4;
    float* Y = a.out;
    LAS float* ybuf = (LAS float*)(lds + wave * 16384);
    const int dir = wave >> 2, it = wave & 3;
    LAS unsigned char* slot = lds + 131072 + dir * 8448;
    const bf16* BON = WSB(WS_BONUS); bf16* AB = WSB(WS_XN);
    const float* lnx = FIN(I_LNX);
    if (G == 256 && bid < 128) {
        if (wave == 0) wkv_sample_wave(a, (LAS float*)lds, bid, lane);
        return;
    }
#pragma unroll 1
    for (int jrep = 0; ; ++jrep) {
        int k;
        if (G == 256) { if (jrep < 2) k = 16 + 2 * (bid - 128) + jrep; else break; }
        else { k = bid + jrep * G; if (k >= 272) break; }
        int smp, b, h, nc, L, rowbase, opsbase;
        if (k < 16) { smp = 1; b = k >> 3; h = k & 7; nc = 64; L = DSEQ; rowbase = NPR + b * DSEQ; opsbase = 4096 + k * 64; }
        else { const int p = k - 16; smp = 0; b = p >> 3; h = p & 7; nc = 16; L = SEQ; rowbase = b * SEQ; opsbase = p * 16; }
        f32x4 H[4];
        if (smp) {
            const float* sp = FIN(I_ST) + (size_t)((b * 2 + dir) * 8 + h) * 4096;
#pragma unroll
            for (int jt = 0; jt < 4; ++jt) H[jt] = *(const f32x4*)(sp + (16 * it + lr) * 64 + 16 * jt + 4 * lg);
        } else {
#pragma unroll
            for (int jt = 0; jt < 4; ++jt) H[jt] = (f32x4){0.f, 0.f, 0.f, 0.f};
        }
        const unsigned char* opsp = a.ws + WS_OPS + (size_t)(dir * 5120 + opsbase) * OPS_ITEM;
        float* yg = Y + ((size_t)dir * NT + rowbase) * 512 + h * 64 + 16 * it + 4 * (lane & 3);
        constexpr int D = 8;
        ChainSh sh[D]; ChainPr pr[D];
#pragma unroll
        for (int i = 0; i < D; ++i) { chain_sh(sh[i], opsp + (size_t)i * OPS_ITEM, lane, it); chain_pr(pr[i], opsp + (size_t)i * OPS_ITEM, lane, it); }
        auto put = [&](const ChainSh& o) {
            *(LAS bf16x8*)(slot + it * 1024 + lane * 16) = o.kg; *(LAS bf16x8*)(slot + 4096 + it * 1024 + lane * 16) = o.kd;
            if (lane < 16) *(LAS float*)(slot + 8192 + (16 * it + lane) * 4) = o.gm; };
        put(sh[0]);
        chain_sh(sh[0], opsp + (size_t)(D < nc ? D : nc - 1) * OPS_ITEM, lane, it);
        asm volatile("s_waitcnt lgkmcnt(0)" ::: "memory"); __builtin_amdgcn_s_barrier(); asm volatile("" ::: "memory");
#pragma unroll 1
        for (int c = 0; c < nc; c += D) {
#pragma unroll
            for (int i = 0; i < D; ++i) {
                const int cc = c + i;
                bf16x8 kgrg[2][2], kdbd[4]; f32x4 gam[4];
#pragma unroll
                for (int q = 0; q < 4; ++q) { kgrg[q >> 1][q & 1] = *(const LAS bf16x8*)(slot + q * 1024 + lane * 16); kdbd[q] = *(const LAS bf16x8*)(slot + 4096 + q * 1024 + lane * 16); gam[q] = *(const LAS f32x4*)(slot + 8192 + (16 * q + 4 * lg) * 4); }
                asm volatile("s_waitcnt lgkmcnt(0)" ::: "memory"); __builtin_amdgcn_s_barrier(); asm volatile("" ::: "memory");
                put(sh[(i + 1) % D]);
                chain_sh(sh[(i + 1) % D], opsp + (size_t)(cc + 1 + D < nc ? cc + 1 + D : nc - 1) * OPS_ITEM, lane, it);
                const u32x2 c0 = pr[i].ci0, c1 = pr[i].ci1, cv = pr[i].vi;
                bf16x8 bh[2];
#pragma unroll
                for (int ks = 0; ks < 2; ++ks) { const u32x2 p0 = pk4(H[2 * ks]), p1 = pk4(H[2 * ks + 1]); bh[ks] = __builtin_bit_cast(bf16x8, (u32x4){p0.x, p0.y, p1.x, p1.y}); }
                f32x4 u = unpk4(c0), y = unpk4(c1);
#pragma unroll
                for (int ks = 0; ks < 2; ++ks) { u = mfma16(kgrg[0][ks], bh[ks], u); y = mfma16(kgrg[1][ks], bh[ks], y); }
#pragma unroll
                for (int e = 0; e < 4; ++e) ybuf[(16 * (cc & 15) + 4 * lg + e) * 16 + lr] = y[e];
                const u32x2 up = pk4(u);
                const bf16x8 bvu = __builtin_bit_cast(bf16x8, (u32x4){cv.x, cv.y, up.x, up.y});
#pragma unroll
                for (int jt = 0; jt < 4; ++jt) H[jt] = mfma16(kdbd[jt], bvu, H[jt] * gam[jt]);
                chain_pr(pr[i], opsp + (size_t)(cc + D < nc ? cc + D : nc - 1) * OPS_ITEM, lane, it);
                if (smp && (cc & 15) == 15) {
                    asm volatile("s_waitcnt lgkmcnt(0)" ::: "memory");
                    const int base = 256 * (cc >> 4);
#pragma unroll 1
                    for (int r0 = 0; r0 < 256; r0 += 16) { const int lt = base + r0 + (lane >> 2);
                        *(f32x4*)(yg + (size_t)(dir ? L - 1 - lt : lt) * 512) = *(const LAS f32x4*)(ybuf + (r0 + (lane >> 2)) * 16 + 4 * (lane & 3)); }
                }
                asm volatile("s_waitcnt lgkmcnt(0)" ::: "memory"); __builtin_amdgcn_s_barrier(); asm volatile("" ::: "memory");
            }
        }
        if (!smp) { float* op = a.out + OUT_ST + (size_t)((b * 2 + dir) * 8 + h) * 4096;
#pragma unroll
            for (int jt = 0; jt < 4; ++jt) *(f32x4*)(op + (16 * it + lr) * 64 + 16 * jt + 4 * lg) = H[jt]; }
        asm volatile("s_waitcnt vmcnt(0) lgkmcnt(0)" ::: "memory");
        __syncthreads();
        if (smp) continue;
        {
            const int hf = tid & 1;
            const float* l0p = lnx + h * 64 + 32 * hf; const float* l1p = lnx + 512 + h * 64 + 32 * hf;
            for (int t = tid >> 1; t < L; t += 256) {
                float x[32];
#pragma unroll
                for (int q = 0; q < 8; ++q) { const int itq = 2 * hf + (q >> 2);
                    const f32x4 f = *(const LAS f32x4*)(lds + itq * 16384 + (t * 16 + 4 * (q & 3)) * 4), g = *(const LAS f32x4*)(lds + (4 + itq) * 16384 + ((L - 1 - t) * 16 + 4 * (q & 3)) * 4);
                    x[4 * q] = f[0] + g[0]; x[4 * q + 1] = f[1] + g[1]; x[4 * q + 2] = f[2] + g[2]; x[4 * q + 3] = f[3] + g[3]; }
                float s = 0.f;
#pragma unroll
                for (int e = 0; e < 32; ++e) s += x[e];
                s += __shfl_xor(s, 1);
                const float mu = s * (1.f / 64.f);
                float v = 0.f;
#pragma unroll
                for (int e = 0; e < 32; ++e) { x[e] -= mu; v += x[e] * x[e]; }
                v += __shfl_xor(v, 1);
                const float rstd = rsqrtf(v * (1.f / 64.f) + 64e-5f);
                const size_t row = (size_t)rowbase + t;
                const bf16* bp = BON + row * 512 + h * 64 + 32 * hf; bf16* gp = AB + row * 1024 + 512 + h * 64 + 32 * hf;
#pragma unroll
                for (int q = 0; q < 4; ++q) {
                    const u32x4 bw = *(const u32x4*)(bp + 8 * q), gw4 = *(const u32x4*)(gp + 8 * q);
                    const f32x4 bo0 = unpk4((u32x2){bw.x, bw.y}), bo1 = unpk4((u32x2){bw.z, bw.w}), gg0 = unpk4((u32x2){gw4.x, gw4.y}), gg1 = unpk4((u32x2){gw4.z, gw4.w});
                    const f32x4 l00 = *(const f32x4*)(l0p + 8 * q), l01 = *(const f32x4*)(l0p + 8 * q + 4), l10 = *(const f32x4*)(l1p + 8 * q), l11 = *(const f32x4*)(l1p + 8 * q + 4);
                    f32x4 o0, o1;
#pragma unroll
                    for (int e = 0; e < 4; ++e) { o0[e] = (x[8 * q + e] * rstd * l00[e] + l10[e] + bo0[e]) * gg0[e]; o1[e] = (x[8 * q + 4 + e] * rstd * l01[e] + l11[e] + bo1[e]) * gg1[e]; }
                    const u32x2 p0 = pk4(o0), p1 = pk4(o1);
                    *(u32x4*)((DRY ? (bf16*)(a.ws + 248 * MiB) + row * 512 + h * 64 + 32 * hf : gp) + 8 * q) = (u32x4){p0.x, p0.y, p1.x, p1.y};
                }
            }
        }
        __syncthreads();
    }
}

template <bool WT = false>
__device__ __forceinline__ void phase_combine(const Args& a, int bid, int G) {
    int tid = threadIdx.x; asm volatile("" : "+v"(tid));
    const int lane = tid & 63, wave = tid >> 6;
    const int gw = bid * 8 + wave, NGW = G * 8;
    const float* Y = a.out; const bf16* BON = WSB(WS_BONUS); bf16* AB = WSB(WS_XN);
    const float* lnx = FIN(I_LNX);
    const int c = lane * 8;
    constexpr int R = 1;
    for (int row0 = NPR + gw; row0 < NT; row0 += R * NGW) {
        f32x4 f0[R], f1[R], g0[R], g1[R]; u32x4 bw[R], gw4[R];
#pragma unroll
        for (int q = 0; q < R; ++q) { const int row = row0 + q * NGW; if (row < NT) {
            f0[q] = *(const f32x4*)(Y + (size_t)row * 512 + c); f1[q] = *(const f32x4*)(Y + (size_t)row * 512 + c + 4);
            g0[q] = *(const f32x4*)(Y + (size_t)(NT + row) * 512 + c); g1[q] = *(const f32x4*)(Y + (size_t)(NT + row) * 512 + c + 4);
            bw[q] = *(const u32x4*)(BON + (size_t)row * 512 + c); gw4[q] = *(const u32x4*)(AB + (size_t)row * 1024 + 512 + c); } }
        const f32x4 l00 = *(const f32x4*)(lnx + c), l01 = *(const f32x4*)(lnx + c + 4), l10 = *(const f32x4*)(lnx + 512 + c), l11 = *(const f32x4*)(lnx + 512 + c + 4);
#pragma unroll
        for (int q = 0; q < R; ++q) { const int row = row0 + q * NGW; if (row < NT) {
            float x[8];
#pragma unroll
            for (int e = 0; e < 4; ++e) { x[e] = f0[q][e] + g0[q][e]; x[4 + e] = f1[q][e] + g1[q][e]; }
            float s = 0.f;
#pragma unroll
            for (int e = 0; e < 8; ++e) s += x[e];
            s += __shfl_xor(s, 1); s += __shfl_xor(s, 2); s += __shfl_xor(s, 4);
            const float mu = s * (1.f / 64.f);
            float v = 0.f;
#pragma unroll
            for (int e = 0; e < 8; ++e) { x[e] -= mu; v += x[e] * x[e]; }
            v += __shfl_xor(v, 1); v += __shfl_xor(v, 2); v += __shfl_xor(v, 4);
            const float rstd = rsqrtf(v * (1.f / 64.f) + 64e-5f);
            const f32x4 bo0 = unpk4((u32x2){bw[q].x, bw[q].y}), bo1 = unpk4((u32x2){bw[q].z, bw[q].w}), gg0 = unpk4((u32x2){gw4[q].x, gw4[q].y}), gg1 = unpk4((u32x2){gw4[q].z, gw4[q].w});
            f32x4 o0, o1;
#pragma unroll
            for (int e = 0; e < 4; ++e) { o0[e] = (x[e] * rstd * l00[e] + l10[e] + bo0[e]) * gg0[e]; o1[e] = (x[4 + e] * rstd * l01[e] + l11[e] + bo1[e]) * gg1[e]; }
            const u32x2 p0 = pk4(o0), p1 = pk4(o1);
            const u32x4 ov = {p0.x, p0.y, p1.x, p1.y};
            if (WT) {
                bf16* dst = AB + (size_t)row * 1024 + 512 + c;
                asm volatile("global_store_dwordx4 %0, %1, off sc0 sc1" :: "v"(dst), "v"(ov) : "memory");
                asm volatile("s_waitcnt vmcnt(0)" ::: "memory");
                if (lane == 0) __hip_atomic_fetch_add((unsigned*)(a.ws + WS_PCNT) + (row / 160) * 16, 1u, __ATOMIC_RELAXED, __HIP_MEMORY_SCOPE_AGENT);
            } else *(u32x4*)(AB + (size_t)row * 1024 + 512 + c) = ov;
        } }
    }
}

__device__ __forceinline__ void phase_chdft(const Args& a, LAS unsigned char* lds, int bid, int G) {
    int tid = threadIdx.x; asm volatile("" : "+v"(tid));
    const int lane = tid & 63, wave = tid >> 6, tk = lane & 31, hh = lane >> 5;
    const int gw = bid * 8 + wave, NGW = G * 8;
    constexpr int WST = 136;
    LAS bf16* Wd = (LAS bf16*)lds;
    const bf16* WDFT = WSB(WS_WDFT); const bf16* XN = WSB(WS_XN);
    __syncthreads();
    for (int i = tid; i < 256 * 16; i += 512) { const int r = i >> 4, c8 = i & 15; *(LAS u32x4*)(Wd + r * WST + 8 * c8) = *(const u32x4*)(WDFT + r * 128 + 8 * c8); }
    __syncthreads();
    for (int it8 = gw; it8 < 1024; it8 += NGW) {
        const int it = it8 >> 3, mtp2 = it8 & 7;
        const int b = it >> 6, g = (it >> 3) & 7, lt = it & 7, l2 = 32 * lt + tk;
        float twc[4], tws[4]; twc[0] = 1.f; tws[0] = 0.f;
#pragma unroll
        for (int p = 1; p < 4; ++p) { const float x = (float)(l2 * p) * (2.0f / 1024.0f); twc[p] = cospif(x); tws[p] = sinpif(x); }
        const bf16* xin = XN + (size_t)(NPR + b * 1024 + 32 * lt + tk) * 1024 + g * 128 + 8 * hh;
        bf16* zt = WSB(WS_YTS) + (size_t)b * 4 * 1024 * 512 + (size_t)(g * 128 + 4 * hh) * 512 + l2;
        {
            const int mtp = mtp2 >> 1, ph = mtp2 & 1;
            f32x16 Zr[2], Zi[2];
#pragma unroll
            for (int p = 0; p < 2; ++p)
#pragma unroll
                for (int r = 0; r < 16; ++r) { Zr[p][r] = 0.f; Zi[p][r] = 0.f; }
#pragma unroll
            for (int l1 = 0; l1 < 4; ++l1) {
                f32x16 yc, ys;
#pragma unroll
                for (int r = 0; r < 16; ++r) { yc[r] = 0.f; ys[r] = 0.f; }
#pragma unroll
                for (int s = 0; s < 8; ++s) {
                    const bf16x8 hbv = *(const bf16x8*)(xin + (size_t)(256 * l1) * 1024 + 16 * s);
                    const bf16x8 ac = *(const LAS bf16x8*)(Wd + (32 * mtp + tk) * WST + 16 * s + 8 * hh), as = *(const LAS bf16x8*)(Wd + (128 + 32 * mtp + tk) * WST + 16 * s + 8 * hh);
                    yc = mfma32(ac, hbv, yc); ys = mfma32(as, hbv, ys);
                }
                if (ph == 0) { Zr[0] += yc; Zi[0] -= ys; if (l1 & 1) { Zr[1] -= yc; Zi[1] += ys; } else { Zr[1] += yc; Zi[1] -= ys; } }
                else {
                    if (l1 == 0) { Zr[0] += yc; Zi[0] -= ys; Zr[1] += yc; Zi[1] -= ys; }
                    else if (l1 == 1) { Zr[0] -= ys; Zi[0] -= yc; Zr[1] += ys; Zi[1] += yc; }
                    else if (l1 == 2) { Zr[0] -= yc; Zi[0] += ys; Zr[1] -= yc; Zi[1] += ys; }
                    else { Zr[0] += ys; Zi[0] += yc; Zr[1] -= ys; Zi[1] -= yc; }
                }
                asm volatile("" : "+v"(Zr[0]), "+v"(Zi[0]), "+v"(Zr[1]), "+v"(Zi[1]));
            }
            typedef __attribute__((address_space(1))) bf16* gbp;
#pragma unroll
            for (int pi = 0; pi < 2; ++pi) {
                const int p = ph + 2 * pi;
                const float c = 0.5f * (p == 0 ? twc[0] : p == 1 ? twc[1] : p == 2 ? twc[2] : twc[3]), s = 0.5f * (p == 0 ? tws[0] : p == 1 ? tws[1] : p == 2 ? tws[2] : tws[3]);
#pragma unroll
                for (int rq = 0; rq < 4; ++rq) {
                    gbp pp = (gbp)(zt + (size_t)p * 1024 * 512 + (size_t)(32 * mtp + 8 * rq) * 512);
                    asm volatile("" : "+v"(pp));
#pragma unroll
                    for (int e = 0; e < 4; ++e) { const float zr = Zr[pi][4 * rq + e], zi = Zi[pi][4 * rq + e];
                        pp[(size_t)e * 512] = f2bf(zr * c + zi * s); pp[(size_t)e * 512 + 256] = f2bf(zr * s - zi * c); }
                }
            }
        }
    }
    for (int it2 = gw; it2 < (NPR / 32) * 16; it2 += NGW) {
        const int it = it2 >> 1, hsel = it2 & 1;
        const int r0 = (it >> 3) * 32, g = it & 7;
        bf16x8 hb[8];
#pragma unroll
        for (int s = 0; s < 8; ++s) hb[s] = *(const bf16x8*)(XN + (size_t)(r0 + tk) * 1024 + g * 128 + 16 * s + 8 * hh);
        bf16* dst; int ld, Lh, l;
        if (r0 < NPR) { const int b = r0 >> 8; l = (r0 & 255) + tk; dst = WSB(WS_YTP) + (size_t)b * 1024 * 512; ld = 512; Lh = 256; }
        else { const int sb = (r0 - NPR) >> 10; l = ((r0 - NPR) & 1023) + tk; dst = WSB(WS_YTS) + (size_t)sb * 1024 * 2048; ld = 2048; Lh = 1024; }
#pragma unroll 1
        for (int half = hsel; half <= hsel; ++half) {
            f32x16 acc[4];
#pragma unroll
            for (int mt = 0; mt < 4; ++mt)
#pragma unroll
                for (int r = 0; r < 16; ++r) acc[mt][r] = 0.f;
#pragma unroll
            for (int s = 0; s < 8; ++s)
#pragma unroll
                for (int mt = 0; mt < 4; ++mt) { const bf16x8 af = *(const LAS bf16x8*)(Wd + (32 * (4 * half + mt) + tk) * WST + 16 * s + 8 * hh); acc[mt] = mfma32(af, hb[s], acc[mt]);
                    if (mt == 3 && (s & 1)) asm volatile("" : "+v"(acc[0]), "+v"(acc[1]), "+v"(acc[2]), "+v"(acc[3]) :: "memory"); }
            typedef __attribute__((address_space(1))) bf16* gbp;
            gbp p0 = (gbp)(dst + (size_t)(g * 128 + 4 * hh) * ld + half * Lh + l);
#pragma unroll
            for (int mt = 0; mt < 4; ++mt) {
#pragma unroll
                for (int rq = 0; rq < 4; ++rq) {
                    gbp p = p0 + (size_t)(32 * mt + 8 * rq) * ld;
                    asm volatile("" : "+v"(p));
#pragma unroll
                    for (int e = 0; e < 4; ++e) p[(size_t)e * ld] = f2bf(acc[mt][4 * rq + e]);
                }
            }
        }
    }
}

constexpr int NPHASE = 20;
__global__ void __launch_bounds__(512, 2) mk_fwd(Args a0) {
    extern __shared__ __attribute__((aligned(16))) unsigned char lds_raw[];
    LAS unsigned char* lds = (LAS unsigned char*)lds_raw;
    const int tid = threadIdx.x, bid = blockIdx.x, G = gridDim.x;
    volatile LAS unsigned* MISC = (volatile LAS unsigned*)(lds + MISC_OFF);
    if (tid < 32) MISC[tid] = 0u;
    if (tid < 29) *(LAS unsigned long long*)(lds + PTAB_OFF + 8 * tid) = (unsigned long long)(tid < 27 ? a0.in[tid] : tid == 27 ? (const void*)a0.out : (const void*)a0.ws);
    __syncthreads();
    const int ph_lo = a0.ph_lo, ph_hi = a0.ph_hi;
    unsigned char* const ws_ctl = a0.ws;
    const bool one_launch = (ph_hi - ph_lo) > 1;
    XcdBarrier bar; bar.bar = (unsigned*)(ws_ctl + WS_CTL) + 4096; bar.x = 0; bar.st = nullptr;
    if (one_launch) bar = xcd_barrier_post((unsigned*)(ws_ctl + WS_CTL) + 4096, MISC + 8);
#ifndef DUP_PHASE
#define DUP_PHASE -1
#endif
#ifndef DUP_N
#define DUP_N 2
#endif
#ifndef ONLY_PHASE
#define ONLY_PHASE -1
#endif
#define XSL(i) ((unsigned*)(a.ws + WS_XSLOT) + (size_t)(i) * 2 * 64 * 160 * 4)
#define XCN(i) ((unsigned*)(a.ws + WS_CTL) + 8192 + (i) * 2 * 64 * 16)
#define IN(k) ((ONLY_PHASE < 0 || ONLY_PHASE == (k)) && ph_lo <= (k) && (k) < ph_hi)
#define SEAM(k) do { if (IN(k) && IN((k) + 1)) xcd_barrier(bar); } while (0)
    if (IN(1)) { const Args a = load_args(lds, ph_lo, ph_hi); const float* gains = FIN(I_GAINS); phase_prep<3>(a, lds, bid, G); phase_first_norm(a, lds, bid, G, gains + 0 * 1024); } SEAM(1);
    if (IN(2)) for (int rep_ = 0; rep_ < (DUP_PHASE == 2 ? DUP_N : 1); ++rep_) { if (rep_) xcd_barrier(bar); const Args a = load_args(lds, ph_lo, ph_hi); const float* gains = FIN(I_GAINS); (void)gains;
        pg8::Gemm g{1024, 1024, 1024}; pg8::PlainOrder160 S; S.init(WSB(WS_XN), WSB(WS_WIN), NT, INE_PAD, 1024, 1024, G, bid);
        EpiProj E{WSB(WS_Q), WSB(WS_KP), WSB(WS_KS), WSB(WS_VTP), WSB(WS_VTS), (bf16*)a.out, a.out + OUT_CK, a.out + OUT_CV, WSF(WS_ROPE)};
        pg8::gemm_phase160b(lds, g, S, E);
    } SEAM(2);
    if (IN(3)) for (int rep_ = 0; rep_ < (DUP_PHASE == 3 ? DUP_N : 1); ++rep_) { if (rep_) xcd_barrier(bar); const Args a = load_args(lds, ph_lo, ph_hi); const float* gains = FIN(I_GAINS); (void)gains;
#ifndef NO_FRONT
        phase_wkv_front(a, lds, bid, G);
#endif
#ifdef DUP_FRONT
        __syncthreads(); phase_wkv_front(a, lds, bid, G);
#endif
        __syncthreads();
#ifndef NO_ATT
        phase_attention(a, lds, bid, G);
#endif
#ifdef DUP_ATT
        __syncthreads(); phase_attention(a, lds, bid, G);
#endif
    } SEAM(3);
    if (IN(4)) for (int rep_ = 0; rep_ < (DUP_PHASE == 4 ? DUP_N : 1); ++rep_) { if (rep_) xcd_barrier(bar); const Args a = load_args(lds, ph_lo, ph_hi); const float* gains = FIN(I_GAINS); (void)gains;
#if defined(DUP_P4)
        phase_wkv_chain<true>(a, lds, bid, G); phase_prep<2>(a, lds, bid, G); xcd_barrier(bar);
#elif defined(DUP_CHAIN)
        phase_wkv_chain<true>(a, lds, bid, G); xcd_barrier(bar);
#elif defined(DUP_PREP2)
        phase_prep<2>(a, lds, bid, G); xcd_barrier(bar);
#endif
        phase_wkv_chain(a, lds, bid, G);
        if (G == 256) {
            const int wv_ = __builtin_amdgcn_readfirstlane(threadIdx.x >> 6);
            if (bid < 128) phase_prep<2>(a, lds, bid, G, wv_ == 0 ? -1 : (bid * 7 + wv_ - 1) * 7, 7, 6272);
        } else phase_prep<2>(a, lds, bid, G);
    } SEAM(4);
    if (IN(6)) for (int rep_ = 0; rep_ < (DUP_PHASE == 6 ? DUP_N : 1); ++rep_) { if (rep_) xcd_barrier(bar); const Args a = load_args(lds, ph_lo, ph_hi); const float* gains = FIN(I_GAINS); (void)gains;
        phase_combine<true>(a, bid, G);
        pg8::Gemm g{1024, 1024, 1024}; pg8::PlainOrder160 S; S.init(WSB(WS_XN), WSB(WS_WO), NT, 1024, 1024, 1024, G, bid);
        {
            pg8::Unit u0;
            if (S.next(0, u0) && u0.pm * 160 + 160 > NPR) {
                const unsigned want = (unsigned)(u0.pm * 160 + 160 - (u0.pm * 160 > NPR ? u0.pm * 160 : NPR));
                if (threadIdx.x == 0) { unsigned* pc = (unsigned*)(a.ws + WS_PCNT) + u0.pm * 16; unsigned spins = 0;
                    while (__hip_atomic_load(pc, __ATOMIC_RELAXED, __HIP_MEMORY_SCOPE_AGENT) < want) { __builtin_amdgcn_s_sleep(2); if (++spins > (1u << 20)) break; } }
            }
            __syncthreads();
        }
        EpiResNorm<true, false> E{FIN(I_XP), FIN(I_XS), nullptr, WSB(WS_XB), nullptr, WSB(WS_XN), gains + 1 * 1024, gains + 2 * 1024, WSF(WS_MOD), 2048, 0, 3072, 4096, 0, XSL(0), XCN(0)}; pg8::gemm_phase160b(lds, g, S, E);
    } SEAM(6);
    if (IN(8)) for (int rep_ = 0; rep_ < (DUP_PHASE == 8 ? DUP_N : 1); ++rep_) { if (rep_) xcd_barrier(bar); const Args a = load_args(lds, ph_lo, ph_hi); const float* gains = FIN(I_GAINS); (void)gains;
        pg8::Gemm g{1024, 1024, 1024}; pg8::PlainOrder S; S.init(WSB(WS_XN), WSB(WS_WFI), NT, DFF2, 1024, 1024, G, bid);
        EpiFfnConv E{WSB(WS_ACT), FIN(I_CONVW), FIN(I_CONVB), WSF(WS_SB), (LAS float*)(lds + 131072)}; pg8::gemm_phase(lds, g, S, E);
        { const int nun = (NT / 256) * (DFF2 / 256), nfull = nun % G;
          if (nfull == 0) phase_transpose_wfi1(a, lds, bid, G); else if (bid >= nfull) phase_transpose_wfi1(a, lds, bid - nfull, G - nfull); }
    }
    SEAM(8);
    if (IN(10)) for (int rep_ = 0; rep_ < (DUP_PHASE == 10 ? DUP_N : 1); ++rep_) { if (rep_) xcd_barrier(bar); const Args a = load_args(lds, ph_lo, ph_hi); const float* gains = FIN(I_GAINS); (void)gains;
        pg8::Gemm g{DFF, DFF, DFF}; pg8::PlainOrder160 S; S.init(WSB(WS_ACT), WSB(WS_WFO), NT, 1024, DFF, DFF, G, bid);
        ffn_seam_fixup(S, 160, WSB(WS_ACT), FIN(I_CONVW), WSF(WS_SB));
        EpiResNorm<false, false> E{nullptr, nullptr, WSB(WS_XB), WSB(WS_XB), nullptr, WSB(WS_XN), gains + 3 * 1024, gains + 4 * 1024, WSF(WS_MOD), 5120, 0, 0, 1024, 1, XSL(1), XCN(1)}; pg8::gemm_phase160b(lds, g, S, E);
    } SEAM(10);
    if (IN(12)) for (int rep_ = 0; rep_ < (DUP_PHASE == 12 ? DUP_N : 1); ++rep_) { if (rep_) xcd_barrier(bar); const Args a = load_args(lds, ph_lo, ph_hi); const float* gains = FIN(I_GAINS); (void)gains; phase_chdft(a, lds, bid, G); } SEAM(12);
    if (IN(13)) for (int rep_ = 0; rep_ < (DUP_PHASE == 13 ? DUP_N : 1); ++rep_) { if (rep_) xcd_barrier(bar); const Args a = load_args(lds, ph_lo, ph_hi); const float* gains = FIN(I_GAINS); (void)gains;
        { pg8::Gemm g{512, 512, 512}; DftOrder S{G, bid, (const char*)WSB(WS_A2P), (const char*)WSB(WS_YTS), (const char*)WSB(WS_YTP)}; EpiDft E{WSB(WS_XN)}; pg8::gemm_phase(lds, g, S, E); }
    } SEAM(13);
    if (IN(14)) for (int rep_ = 0; rep_ < (DUP_PHASE == 14 ? DUP_N : 1); ++rep_) { if (rep_) xcd_barrier(bar); const Args a = load_args(lds, ph_lo, ph_hi); const float* gains = FIN(I_GAINS); (void)gains;
        pg8::Gemm g{1024, 1024, 1024}; pg8::PlainOrder160 S; S.init(WSB(WS_XN), WSB(WS_WODD), NT, 1024, 1024, 1024, G, bid);
        EpiResNorm<false, false> E{nullptr, nullptr, WSB(WS_XB), WSB(WS_XB), nullptr, WSB(WS_XN), gains + 5 * 1024, gains + 6 * 1024, WSF(WS_MOD), 2048, 1, 3072, 4096, 1, XSL(2), XCN(2)}; pg8::gemm_phase160b(lds, g, S, E);
    } SEAM(14);
    if (IN(16)) for (int rep_ = 0; rep_ < (DUP_PHASE == 16 ? DUP_N : 1); ++rep_) { if (rep_) xcd_barrier(bar); const Args a = load_args(lds, ph_lo, ph_hi); const float* gains = FIN(I_GAINS); (void)gains;
        pg8::Gemm g{1024, 1024, 1024}; pg8::PlainOrder S; S.init(WSB(WS_XN), WSB(WS_WFI) + (size_t)DFF2 * 1024, NT, DFF2, 1024, 1024, G, bid);
        EpiFfnConv E{WSB(WS_ACT), FIN(I_CONVW) + 3 * DFF, FIN(I_CONVB) + DFF, WSF(WS_SB), (LAS float*)(lds + 131072)}; pg8::gemm_phase(lds, g, S, E);
    }
    SEAM(16);
    if (IN(18)) for (int rep_ = 0; rep_ < (DUP_PHASE == 18 ? DUP_N : 1); ++rep_) { if (rep_) xcd_barrier(bar); const Args a = load_args(lds, ph_lo, ph_hi); const float* gains = FIN(I_GAINS); (void)gains;
        pg8::Gemm g{DFF, DFF, DFF}; pg8::PlainOrder160 S; S.init(WSB(WS_ACT), WSB(WS_WFO) + (size_t)1024 * DFF, NT, 1024, DFF, DFF, G, bid);
        ffn_seam_fixup(S, 160, WSB(WS_ACT), FIN(I_CONVW) + 3 * DFF, WSF(WS_SB));
        EpiResNorm<false, true> E{nullptr, nullptr, WSB(WS_XB), nullptr, a.out, nullptr, gains + 7 * 1024, nullptr, WSF(WS_MOD), 5120, 1, 0, 0, 1, XSL(3), XCN(3)}; pg8::gemm_phase160b(lds, g, S, E);
    }
#undef IN
#undef SEAM
#undef XSL
#undef XCN
}

extern "C" void kernel_launch(void* const* d_in, const int* in_sizes, int n_in, void* d_out, int out_size, void* d_ws, size_t ws_size, hipStream_t stream) {
    static int grid = 0;
    if (grid == 0) {
        if (n_in != 27 || ws_size < WS_END) { fprintf(stderr, "kernel_launch: unexpected n_in %d / ws %zu\n", n_in, ws_size); grid = -1; return; }
        int dev = 0, cus = 0;
        if (hipGetDevice(&dev) != hipSuccess || hipDeviceGetAttribute(&cus, hipDeviceAttributeMultiprocessorCount, dev) != hipSuccess) { grid = -1; return; }
        if (hipFuncSetAttribute((const void*)mk_fwd, hipFuncAttributeMaxDynamicSharedMemorySize, LDS_BYTES) != hipSuccess) { fprintf(stderr, "kernel_launch: hipFuncSetAttribute failed\n"); grid = -1; return; }
        (void)hipGetLastError();
        if (cus < 256) { fprintf(stderr, "kernel_launch: needs 256 CUs (one workgroup per CU, 256 GEMM units per fused-norm phase), found %d\n", cus); grid = -1; return; }
        grid = 256;
    }
    if (grid < 0) return;
    (void)hipMemsetAsync((char*)d_ws + WS_CTL, 0, CTL_ZERO_BYTES, stream);
    Args a{};
    for (int i = 0; i < 27; ++i) a.in[i] = d_in[i];
    a.out = (float*)d_out; a.ws = (unsigned char*)d_ws;
#if MK_N_LAUNCHES == 1
    a.ph_lo = 0; a.ph_hi = NPHASE;
    hipLaunchKernelGGL(mk_fwd, dim3(grid), dim3(512), LDS_BYTES, stream, a);
#else
    for (int ph = 0; ph < NPHASE; ++ph) { a.ph_lo = ph; a.ph_hi = ph + 1; hipLaunchKernelGGL(mk_fwd, dim3(grid), dim3(512), LDS_BYTES, stream, a); }
#endif
}
```

```cpp
#include <hip/hip_runtime.h>
#include <type_traits>
#include <cstdio>
#include <cstdint>

#ifndef MK_N_LAUNCHES
#define MK_N_LAUNCHES 1
#endif

#define LAS __attribute__((address_space(3)))
typedef unsigned short bf16;
typedef short bf16x8 __attribute__((ext_vector_type(8)));
typedef float f32x4 __attribute__((ext_vector_type(4)));
typedef float f32x2 __attribute__((ext_vector_type(2)));
typedef float f32x16 __attribute__((ext_vector_type(16)));
typedef unsigned u32x4 __attribute__((ext_vector_type(4)));
typedef unsigned u32x2 __attribute__((ext_vector_type(2)));
typedef __bf16 bf16x2_t __attribute__((ext_vector_type(2)));

constexpr int DM = 1024;
constexpr int NPR = 8192, NSA = 2048, NT = 10240;
constexpr int SEQ = 256, DSEQ = 1024, PAST = 256, LKS = 1280;
constexpr int INE = 3456, INE_PAD = 3584, INB = 1920, DFF = 2816, DFF2 = 5632;
constexpr int OUT_YP = 0, OUT_CK = 10485760, OUT_CV = 14680064, OUT_ST = 18874368;

constexpr size_t MiB = 1u << 20;
constexpr size_t WS_CTL = 252 * MiB, CTL_ZERO_BYTES = 65536 + 1310720;
constexpr size_t WS_MOD = 1 * MiB;
constexpr size_t WS_ROPE = 1 * MiB + 256 * 1024;
constexpr size_t WS_LAM = 1 * MiB + 768 * 1024;
constexpr size_t WS_WIN = 2 * MiB;
constexpr size_t WS_WO = 9 * MiB;
constexpr size_t WS_WODD = 11 * MiB;
constexpr size_t WS_WFI = 13 * MiB;
constexpr size_t WS_WFO = 35 * MiB;
constexpr size_t WS_W2T = 46 * MiB;
constexpr size_t WS_A2T = 46 * MiB + 128 * 1024;
constexpr size_t WS_G2T = 46 * MiB + 256 * 1024;
constexpr size_t WS_WDFT = 46 * MiB + 512 * 1024;
constexpr size_t WS_A2P = 46 * MiB + 768 * 1024;
constexpr size_t WS_XN = 52 * MiB;
constexpr size_t WS_MF = 72 * MiB;
constexpr size_t WS_XB = 92 * MiB;
constexpr size_t WS_BIG = 112 * MiB;
constexpr size_t WS_Q = 216 * MiB;
constexpr size_t WS_KP = 226 * MiB;
constexpr size_t WS_KS = 234 * MiB;
constexpr size_t WS_VTP = 237 * MiB;
constexpr size_t WS_VTS = 245 * MiB;
constexpr size_t WS_BONUS = 24 * MiB;
constexpr size_t WS_ACT = WS_BIG;
constexpr size_t WS_SB = 51 * MiB;
constexpr size_t WS_F32B = WS_MF;
constexpr size_t WS_YTP = WS_BIG;
constexpr size_t WS_YTS = WS_BIG + 32 * MiB;
constexpr size_t WS_MOD1 = WS_CTL + 32768;
constexpr size_t WS_PCNT = WS_CTL + 57344;
constexpr size_t WS_XSLOT = WS_CTL + 65536;
constexpr size_t WS_END = 256 * MiB;
static_assert(WS_ACT + (size_t)NT * DFF * 2 <= WS_END, "ws");

constexpr int RING_BYTES = 131072;
constexpr int ACT_OFF = 147456;
constexpr int MISC_OFF = 160256;
constexpr int PTAB_OFF = 160512;
constexpr int LDS_BYTES = 160768;

__device__ __forceinline__ unsigned pk2(float lo, float hi) { f32x2 v = {lo, hi}; bf16x2_t b = __builtin_convertvector(v, bf16x2_t); return __builtin_bit_cast(unsigned, b); }
__device__ __forceinline__ bf16 f2bf(float f) { return (bf16)(pk2(f, 0.f) & 0xffffu); }
__device__ __forceinline__ float bf2f(unsigned b) { return __uint_as_float(b << 16); }
__device__ __forceinline__ u32x2 pk4(f32x4 v) { u32x2 o; o.x = pk2(v[0], v[1]); o.y = pk2(v[2], v[3]); return o; }
__device__ __forceinline__ f32x4 unpk4(u32x2 w) { f32x4 v; v[0] = __uint_as_float(w.x << 16); v[1] = __uint_as_float(w.x & 0xffff0000u); v[2] = __uint_as_float(w.y << 16); v[3] = __uint_as_float(w.y & 0xffff0000u); return v; }
__device__ __forceinline__ float sigmoidf_(float x) { return __builtin_amdgcn_rcpf(1.f + __expf(-x)); }
__device__ __forceinline__ float wave_sum(float v) {
#pragma unroll
    for (int o = 1; o < 64; o <<= 1) v += __shfl_xor(v, o);
    return v;
}
__device__ __forceinline__ int keypos(int key) { return (key & ~12) | ((key & 4) << 1) | ((key & 8) >> 1); }

#define XB_TMO      128
#define XB_XCNT(j)  (256  + 64 * (j))
#define XB_XSUB(j)  (1280 + 64 * (j))
#define XB_XGEN(j)  (2304 + 64 * (j))
#define XB_TOP      3328
#define XB_TOPGEN   3392
#define XCD_BAR_WORDS 3456
#define XB_SPIN_CAP (1u << 20)
__device__ __forceinline__ unsigned xb_ld(unsigned* p)              { return __hip_atomic_load(p, __ATOMIC_RELAXED, __HIP_MEMORY_SCOPE_AGENT); }
__device__ __forceinline__ unsigned xb_add(unsigned* p, unsigned v) { return __hip_atomic_fetch_add(p, v, __ATOMIC_RELAXED, __HIP_MEMORY_SCOPE_AGENT); }
__device__ __forceinline__ unsigned xb_xcc_id() { return (unsigned)__builtin_amdgcn_s_getreg((3 << 11) | 20) & 0xFu; }
#define XB_SPIN(cond, bar) do { unsigned _sp = 0; while (cond) { __builtin_amdgcn_s_sleep(1); \
    if ((++_sp & 255u) == 0u) { if (xb_ld(&(bar)[XB_TMO])) break; if (_sp > XB_SPIN_CAP) { atomicAdd(&(bar)[XB_TMO], 1u); break; } } } } while (0)
struct XcdBarrier { unsigned* bar; unsigned x; volatile LAS unsigned* st; };
__device__ __forceinline__ XcdBarrier xcd_barrier_post(unsigned* bar, volatile LAS unsigned* st) {
    XcdBarrier b; b.bar = bar; b.x = xb_xcc_id(); b.st = st;
    if (threadIdx.x == 0) (void)xb_add(&bar[XB_XCNT(b.x)], 1u);
    return b;
}
__device__ __forceinline__ void xcd_barrier_complete(unsigned* bar, unsigned x, unsigned& nloc, unsigned& nx) {
    const unsigned G = gridDim.x * gridDim.y * gridDim.z;
    unsigned sum, cnt, mine, sp = 0u;
    for (;;) {
        sum = 0u; cnt = 0u; mine = 0u;
#pragma unroll
        for (unsigned j = 0; j < 16; ++j) { const unsigned c = xb_ld(&bar[XB_XCNT(j)]); sum += c; cnt += (c > 0u) ? 1u : 0u; mine = (j == x) ? c : mine; }
        if (sum == G) break;
        __builtin_amdgcn_s_sleep(1);
        if ((++sp & 255u) == 0u) { if (xb_ld(&bar[XB_TMO])) break; if (sp > XB_SPIN_CAP) { atomicAdd(&bar[XB_TMO], 1u); break; } }
    }
    nloc = mine > 0u ? mine : 1u; nx = cnt > 0u ? cnt : 1u;
}
__device__ __forceinline__ void xcd_barrier(const XcdBarrier& b) {
    asm volatile("s_waitcnt vmcnt(0)" ::: "memory");
    __syncthreads();
    if (threadIdx.x == 0) {
        unsigned* bar = b.bar;
        __builtin_amdgcn_s_waitcnt(0);
        unsigned nloc = b.st[0], nx = b.st[1];
        if (nloc == 0u) { xcd_barrier_complete(bar, b.x, nloc, nx); b.st[0] = nloc; b.st[1] = nx; }
        const unsigned old = xb_add(&bar[XB_XSUB(b.x)], 1u);
        const unsigned gen = old / nloc;
        if (old + 1u == (gen + 1u) * nloc) {
            __builtin_amdgcn_fence(__ATOMIC_RELEASE, "agent");
            asm volatile("s_waitcnt vmcnt(0)" ::: "memory");
            const unsigned og = xb_add(&bar[XB_TOP], 1u);
            const unsigned tg = og / nx;
            if (og + 1u == (tg + 1u) * nx) xb_add(&bar[XB_TOPGEN], 1u);
            else XB_SPIN(xb_ld(&bar[XB_TOPGEN]) == tg, bar);
            xb_add(&bar[XB_XGEN(b.x)], 1u);
            __builtin_amdgcn_fence(__ATOMIC_ACQUIRE, "agent");
            asm volatile("s_waitcnt vmcnt(0)" ::: "memory");
        } else {
            XB_SPIN(xb_ld(&bar[XB_XGEN(b.x)]) == gen, bar);
            __builtin_amdgcn_fence(__ATOMIC_ACQUIRE, "agent");
            asm volatile("s_waitcnt vmcnt(0)" ::: "memory");
        }
    }
    __syncthreads();
}

namespace pg8 {
constexpr int BM = 256, BK = 64, HALF = 128, HTB = HALF * BK * 2, STAGE_BYTES = 8 * HTB, NXCD = 8, WGM = 8;
__host__ __device__ __forceinline__ int lds_byte(int r, int c) { const int st = (r >> 4) * 2 + (c >> 5), rr = r & 15, cc = c & 31, ob = rr * 64 + cc * 2; return st * 1024 + (ob ^ (((ob >> 9) & 1) << 5)); }
__host__ __device__ __forceinline__ void stage_rc(int b, int& R, int& C) { const int st = b / 1024, sb = b % 1024, swz = sb ^ (((sb >> 9) & 1) << 5); R = (st >> 1) * 16 + swz / 64; C = (st & 1) * 32 + (swz % 64) / 2; }

struct Unit { int pm, pn, z; const char* a; const char* b; };
struct Gemm { int lda, ldb, K; };

struct PlainOrder {
    int nM, nN, nwg, G, c; const char* A; const char* Bt; size_t ta, tb;
    __device__ void init(const void* A_, const void* Bt_, int M, int N, int lda, int ldb, int G_, int c_) { A = (const char*)A_; Bt = (const char*)Bt_; nM = M / BM; nN = N / BM; nwg = nM * nN; G = G_; c = c_; ta = (size_t)BM * lda * 2; tb = (size_t)BM * ldb * 2; }
    __device__ __forceinline__ bool next(int i, Unit& u) const {
        const long L = (long)i * G + c; if (L >= nwg) return false;
        int wgid = (int)L; { const int q = nwg / NXCD, r = nwg % NXCD, xcd = wgid % NXCD, off = wgid / NXCD; wgid = (xcd < r ? xcd * (q + 1) : r * (q + 1) + (xcd - r) * q) + off; }
        const int nig = WGM * nN, gid = wgid / nig, fm = gid * WGM, gsz = (nM - fm) < WGM ? (nM - fm) : WGM;
        u.pm = fm + ((wgid % nig) % gsz); u.pn = (wgid % nig) / gsz; u.z = 0;
        u.a = A + (size_t)u.pm * ta; u.b = Bt + (size_t)u.pn * tb; return true;
    }
};

template <class F> __device__ __forceinline__ void epi_each(const f32x4 (&acc)[2][2][4][2], int row0, int col0, F&& f) {
#pragma unroll
    for (int ai = 0; ai < 2; ++ai)
#pragma unroll
        for (int m = 0; m < 4; ++m)
#pragma unroll
            for (int bj = 0; bj < 2; ++bj)
#pragma unroll
                for (int n = 0; n < 2; ++n) f(row0 + ai * HALF + m * 16, col0 + bj * HALF + n * 16, acc[ai][bj][m][n]);
}

template <class Epi, class Sched>
__device__ __forceinline__ void gemm_phase(LAS unsigned char* lds, const Gemm g, const Sched& S, const Epi& E) {
    int tid = threadIdx.x; asm volatile("" : "+v"(tid));
    const int wid = __builtin_amdgcn_readfirstlane(tid >> 6), lane = tid & 63, wr = wid >> 2, wc = wid & 3, fr = lane & 15, fq = lane >> 4;
    const int K = g.K, nt = K / BK;
    unsigned voffA[2], voffB[2];
#pragma unroll
    for (int i = 0; i < 2; ++i) { int R, C; stage_rc(tid * 16 + i * 8192, R, C); voffA[i] = (unsigned)(R * g.lda + C) * 2u; voffB[i] = (unsigned)(R * g.ldb + C) * 2u; }
    const size_t kstep = (size_t)(BK * 2);
    const size_t hstepA = (size_t)HALF * g.lda * 2, hstepB = (size_t)HALF * g.ldb * 2;
    const unsigned ldsw = (unsigned)wid * 1024u;
    const int aoff = lds_byte(wr * 64 + fr, fq * 8), boff = lds_byte(wc * 32 + fr, fq * 8);
#define PG8_SA(b, h) (((b) * 2 + (h)) * HTB)
#define PG8_SB(b, h) ((4 + (b) * 2 + (h)) * HTB)
#define PG8_STAGE(bufoff, gbase, voff) do { _Pragma("unroll") for (int _i = 0; _i < 2; ++_i) \
        __builtin_amdgcn_global_load_lds((const unsigned*)((const char*)(gbase) + (voff)[_i]), (LAS unsigned*)(lds + (bufoff) + ldsw + _i * 8192), 16, 0, 0); } while (0)
#define PG8_LDA(dst, b, h) do { _Pragma("unroll") for (int m = 0; m < 4; ++m) _Pragma("unroll") for (int k = 0; k < 2; ++k) dst[m][k] = *(const LAS bf16x8*)(lds + PG8_SA(b, h) + aoff + m * 2048 + k * 1024); } while (0)
#define PG8_LDB(dst, b, h) do { _Pragma("unroll") for (int n = 0; n < 2; ++n) _Pragma("unroll") for (int k = 0; k < 2; ++k) dst[n][k] = *(const LAS bf16x8*)(lds + PG8_SB(b, h) + boff + n * 2048 + k * 1024); } while (0)
#define PG8_MMA(ai, bj, At, Bt) do { __builtin_amdgcn_s_setprio(1); _Pragma("unroll") for (int m = 0; m < 4; ++m) _Pragma("unroll") for (int n = 0; n < 2; ++n) _Pragma("unroll") for (int k = 0; k < 2; ++k) \
        acc[ai][bj][m][n] = __builtin_amdgcn_mfma_f32_16x16x32_bf16(Bt[n][k], At[m][k], acc[ai][bj][m][n], 0, 0, 0); __builtin_amdgcn_s_setprio(0); } while (0)
#define PG8_WAIT_V(n) asm volatile("s_waitcnt vmcnt(" #n ")" ::: "memory")
#define PG8_WAIT_L(n) asm volatile("s_waitcnt lgkmcnt(" #n ")" ::: "memory")
#define PG8_BAR __builtin_amdgcn_s_barrier()
#define PG8_SCHED __builtin_amdgcn_sched_barrier(0)
    Unit cur, nxt; int ui = 0;
    if (!S.next(0, cur)) return;
    f32x4 acc[2][2][4][2];
#pragma unroll
    for (int a = 0; a < 2; ++a)
#pragma unroll
        for (int b = 0; b < 2; ++b)
#pragma unroll
            for (int m = 0; m < 4; ++m)
#pragma unroll
                for (int n = 0; n < 2; ++n) acc[a][b][m][n] = (f32x4){0.f, 0.f, 0.f, 0.f};
    bf16x8 At[4][2], B0[2][2], B1[2][2];
    const char* cA = cur.a; const char* cB = cur.b;
    PG8_STAGE(PG8_SB(0, 0), cB, voffB); PG8_STAGE(PG8_SA(0, 0), cA, voffA); PG8_STAGE(PG8_SB(0, 1), cB + hstepB, voffB); PG8_STAGE(PG8_SA(0, 1), cA + hstepA, voffA);
    if (wr == 1) PG8_BAR;
    PG8_WAIT_V(4); PG8_BAR;
    PG8_STAGE(PG8_SB(1, 0), cB + kstep, voffB); PG8_STAGE(PG8_SA(1, 0), cA + kstep, voffA); PG8_STAGE(PG8_SB(1, 1), cB + hstepB + kstep, voffB);
    PG8_WAIT_V(6); PG8_BAR;
    for (;;) {
        const bool has_next = S.next(ui + 1, nxt);
        const char* nA = has_next ? nxt.a : cA; const char* nB = has_next ? nxt.b : cB;
        for (int t = 0; t < nt; t += 2) {
            const bool last = (t == nt - 2);
            const char* a1 = cA + (size_t)(t + 1) * kstep;
            const char* a2 = last ? nA : cA + (size_t)(t + 2) * kstep; const char* b2 = last ? nB : cB + (size_t)(t + 2) * kstep;
            const char* a3 = a2 + kstep; const char* b3 = b2 + kstep;
            PG8_LDB(B0, 0, 0); PG8_SCHED; PG8_LDA(At, 0, 0); PG8_STAGE(PG8_SA(1, 1), a1 + hstepA, voffA);
            PG8_WAIT_L(8); PG8_BAR; PG8_WAIT_L(0); PG8_MMA(0, 0, At, B0); PG8_BAR; PG8_SCHED;
            PG8_LDB(B1, 0, 1); PG8_STAGE(PG8_SB(0, 0), b2, voffB);
            PG8_BAR; PG8_WAIT_L(0); PG8_MMA(0, 1, At, B1); PG8_BAR;
            PG8_LDA(At, 0, 1); PG8_STAGE(PG8_SA(0, 0), a2, voffA);
            PG8_BAR; PG8_WAIT_L(0); PG8_MMA(1, 0, At, B0); PG8_BAR; PG8_SCHED;
            PG8_STAGE(PG8_SB(0, 1), b2 + hstepB, voffB);
            PG8_WAIT_V(6); PG8_BAR; PG8_MMA(1, 1, At, B1); PG8_BAR;
            PG8_LDB(B0, 1, 0); PG8_SCHED; PG8_LDA(At, 1, 0); PG8_STAGE(PG8_SA(0, 1), a2 + hstepA, voffA);
            PG8_WAIT_L(8); PG8_BAR; PG8_WAIT_L(0); PG8_MMA(0, 0, At, B0); PG8_BAR; PG8_SCHED;
            PG8_LDB(B1, 1, 1); PG8_STAGE(PG8_SB(1, 0), b3, voffB);
            PG8_BAR; PG8_WAIT_L(0); PG8_MMA(0, 1, At, B1); PG8_BAR;
            PG8_LDA(At, 1, 1); PG8_STAGE(PG8_SA(1, 0), a3, voffA);
            PG8_BAR; PG8_WAIT_L(0); PG8_MMA(1, 0, At, B0); PG8_BAR; PG8_SCHED;
            PG8_STAGE(PG8_SB(1, 1), b3 + hstepB, voffB);
            PG8_WAIT_V(6); PG8_BAR; PG8_MMA(1, 1, At, B1); PG8_BAR;
        }
        if constexpr (Epi::ALIGN) { if (wr == 0) PG8_BAR; }
        E(acc, cur, wr, wc, fr, fq);
        if (!has_next) break;
#pragma unroll
        for (int a = 0; a < 2; ++a)
#pragma unroll
            for (int b = 0; b < 2; ++b)
#pragma unroll
                for (int m = 0; m < 4; ++m)
#pragma unroll
                    for (int n = 0; n < 2; ++n) acc[a][b][m][n] = (f32x4){0.f, 0.f, 0.f, 0.f};
        cur = nxt; cA = nA; cB = nB; ++ui;
        if constexpr (Epi::ALIGN) { if (wr == 1) PG8_BAR; }
    }
    PG8_WAIT_V(0);
    if constexpr (!Epi::ALIGN) { if (wr == 0) PG8_BAR; }
    PG8_BAR;
#undef PG8_SA
#undef PG8_SB
#undef PG8_STAGE
#undef PG8_LDA
#undef PG8_LDB
#undef PG8_MMA
#undef PG8_WAIT_V
#undef PG8_WAIT_L
#undef PG8_BAR
#undef PG8_SCHED
}

struct PlainOrder160 {
    int nM, nN, nwg, G, c; const char* A; const char* Bt; size_t ta, tb;
    __device__ void init(const void* A_, const void* Bt_, int M, int N, int lda, int ldb, int G_, int c_) { A = (const char*)A_; Bt = (const char*)Bt_; nM = M / 160; nN = N / BM; nwg = nM * nN; G = G_; c = c_; ta = (size_t)160 * lda * 2; tb = (size_t)BM * ldb * 2; }
    __device__ __forceinline__ bool next(int i, Unit& u) const {
        const long L = (long)i * G + c; if (L >= nwg) return false;
        int wgid = (int)L; { const int q = nwg / NXCD, r = nwg % NXCD, xcd = wgid % NXCD, off = wgid / NXCD; wgid = (xcd < r ? xcd * (q + 1) : r * (q + 1) + (xcd - r) * q) + off; }
        const int nig = WGM * nN, gid = wgid / nig, fm = gid * WGM, gsz = (nM - fm) < WGM ? (nM - fm) : WGM;
        u.pm = fm + ((wgid % nig) % gsz); u.pn = (wgid % nig) / gsz; u.z = 0;
        u.a = A + (size_t)u.pm * ta; u.b = Bt + (size_t)u.pn * tb; return true;
    }
};
template <class Epi, class Sched>
__device__ __forceinline__ void gemm_phase160(LAS unsigned char* lds, const Gemm g, const Sched& S, const Epi& E) {
    int tid = threadIdx.x; asm volatile("" : "+v"(tid));
    const int wid = __builtin_amdgcn_readfirstlane(tid >> 6), lane = tid & 63, half = wid >> 2, fr = lane & 15, fq = lane >> 4;
    const int K = g.K, nt = K / BK;
    constexpr int HTA = 80 * BK * 2;
    unsigned voffA[2], voffB[2];
    { int R, C; stage_rc(tid * 16, R, C); voffA[0] = (unsigned)(R * g.lda + C) * 2u; stage_rc((512 + (tid & 127)) * 16, R, C); voffA[1] = (unsigned)(R * g.lda + C) * 2u; }
#pragma unroll
    for (int i = 0; i < 2; ++i) { int R, C; stage_rc(tid * 16 + i * 8192, R, C); voffB[i] = (unsigned)(R * g.ldb + C) * 2u; }
    const size_t kstep = (size_t)(BK * 2);
    const size_t hstepA = (size_t)80 * g.lda * 2, hstepB = (size_t)HALF * g.ldb * 2;
    const unsigned ldswA0 = (unsigned)wid * 1024u, ldswA1 = 8192u + (unsigned)(wid & 1) * 1024u, ldswB = (unsigned)wid * 1024u;
    const int aoff = lds_byte(fr, fq * 8), boff = lds_byte(wid * 16 + fr, fq * 8);
#define PG8_SA(b, h) (((b) * 2 + (h)) * HTA)
#define PG8_SB(b, h) (4 * HTA + ((b) * 2 + (h)) * HTB)
#define PG8_STAGEA(bufoff, gbase) do { \
        __builtin_amdgcn_global_load_lds((const unsigned*)((const char*)(gbase) + voffA[0]), (LAS unsigned*)(lds + (bufoff) + ldswA0), 16, 0, 0); \
        __builtin_amdgcn_global_load_lds((const unsigned*)((const char*)(gbase) + voffA[1]), (LAS unsigned*)(lds + (bufoff) + ldswA1), 16, 0, 0); } while (0)
#define PG8_STAGEB(bufoff, gbase) do { _Pragma("unroll") for (int _i = 0; _i < 2; ++_i) \
        __builtin_amdgcn_global_load_lds((const unsigned*)((const char*)(gbase) + voffB[_i]), (LAS unsigned*)(lds + (bufoff) + ldswB + _i * 8192), 16, 0, 0); } while (0)
#define PG8_LDA(dst, b, h) do { _Pragma("unroll") for (int m = 0; m < 5; ++m) _Pragma("unroll") for (int k = 0; k < 2; ++k) dst[m][k] = *(const LAS bf16x8*)(lds + PG8_SA(b, h) + aoff + m * 2048 + k * 1024); } while (0)
#define PG8_LDB(dst, b, h) do { _Pragma("unroll") for (int k = 0; k < 2; ++k) dst[k] = *(const LAS bf16x8*)(lds + PG8_SB(b, h) + boff + k * 1024); } while (0)
#define PG8_MMA(ai, bj, At, Bt) do { __builtin_amdgcn_s_setprio(1); _Pragma("unroll") for (int m = 0; m < 5; ++m) _Pragma("unroll") for (int k = 0; k < 2; ++k) \
        acc[ai][bj][m] = __builtin_amdgcn_mfma_f32_16x16x32_bf16(Bt[k], At[m][k], acc[ai][bj][m], 0, 0, 0); __builtin_amdgcn_s_setprio(0); } while (0)
#define PG8_WAIT_V(n) asm volatile("s_waitcnt vmcnt(" #n ")" ::: "memory")
#define PG8_WAIT_L(n) asm volatile("s_waitcnt lgkmcnt(" #n ")" ::: "memory")
#define PG8_BAR __builtin_amdgcn_s_barrier()
#define PG8_SCHED __builtin_amdgcn_sched_barrier(0)
    Unit cur, nxt; int ui = 0;
    if (!S.next(0, cur)) return;
    f32x4 acc[2][2][5];
#pragma unroll
    for (int a = 0; a < 2; ++a)
#pragma unroll
        for (int b = 0; b < 2; ++b)
#pragma unroll
            for (int m = 0; m < 5; ++m) acc[a][b][m] = (f32x4){0.f, 0.f, 0.f, 0.f};
    bf16x8 At[5][2], B0[2], B1[2];
    const char* cA = cur.a; const char* cB = cur.b;
    PG8_STAGEB(PG8_SB(0, 0), cB); PG8_STAGEA(PG8_SA(0, 0), cA); PG8_STAGEB(PG8_SB(0, 1), cB + hstepB); PG8_STAGEA(PG8_SA(0, 1), cA + hstepA);
    if (half == 1) PG8_BAR;
    PG8_WAIT_V(4); PG8_BAR;
    PG8_STAGEB(PG8_SB(1, 0), cB + kstep); PG8_STAGEA(PG8_SA(1, 0), cA + kstep); PG8_STAGEB(PG8_SB(1, 1), cB + hstepB + kstep);
    PG8_WAIT_V(6); PG8_BAR;
    for (;;) {
        const bool has_next = S.next(ui + 1, nxt);
        const char* nA = has_next ? nxt.a : cA; const char* nB = has_next ? nxt.b : cB;
        for (int t = 0; t < nt; t += 2) {
            const bool last = (t == nt - 2);
            const char* a1 = cA + (size_t)(t + 1) * kstep;
            const char* a2 = last ? nA : cA + (size_t)(t + 2) * kstep; const char* b2 = last ? nB : cB + (size_t)(t + 2) * kstep;
            const char* a3 = a2 + kstep; const char* b3 = b2 + kstep;
            PG8_LDB(B0, 0, 0); PG8_SCHED; PG8_LDA(At, 0, 0); PG8_STAGEA(PG8_SA(1, 1), a1 + hstepA);
            PG8_WAIT_L(10); PG8_BAR; PG8_WAIT_L(0); PG8_MMA(0, 0, At, B0); PG8_BAR; PG8_SCHED;
            PG8_LDB(B1, 0, 1); PG8_STAGEB(PG8_SB(0, 0), b2);
            PG8_BAR; PG8_WAIT_L(0); PG8_MMA(0, 1, At, B1); PG8_BAR;
            PG8_LDA(At, 0, 1); PG8_STAGEA(PG8_SA(0, 0), a2);
            PG8_BAR; PG8_WAIT_L(0); PG8_MMA(1, 0, At, B0); PG8_BAR; PG8_SCHED;
            PG8_STAGEB(PG8_SB(0, 1), b2 + hstepB);
            PG8_WAIT_V(6); PG8_BAR; PG8_MMA(1, 1, At, B1); PG8_BAR;
            PG8_LDB(B0, 1, 0); PG8_SCHED; PG8_LDA(At, 1, 0); PG8_STAGEA(PG8_SA(0, 1), a2 + hstepA);
            PG8_WAIT_L(10); PG8_BAR; PG8_WAIT_L(0); PG8_MMA(0, 0, At, B0); PG8_BAR; PG8_SCHED;
            PG8_LDB(B1, 1, 1); PG8_STAGEB(PG8_SB(1, 0), b3);
            PG8_BAR; PG8_WAIT_L(0); PG8_MMA(0, 1, At, B1); PG8_BAR;
            PG8_LDA(At, 1, 1); PG8_STAGEA(PG8_SA(1, 0), a3);
            PG8_BAR; PG8_WAIT_L(0); PG8_MMA(1, 0, At, B0); PG8_BAR; PG8_SCHED;
            PG8_STAGEB(PG8_SB(1, 1), b3 + hstepB);
            PG8_WAIT_V(6); PG8_BAR; PG8_MMA(1, 1, At, B1); PG8_BAR;
        }
        E(acc, cur, wid, fr, fq);
        if (!has_next) break;
#pragma unroll
        for (int a = 0; a < 2; ++a)
#pragma unroll
            for (int b = 0; b < 2; ++b)
#pragma unroll
                for (int m = 0; m < 5; ++m) acc[a][b][m] = (f32x4){0.f, 0.f, 0.f, 0.f};
        cur = nxt; cA = nA; cB = nB; ++ui;
    }
    PG8_WAIT_V(0);
    if (half == 0) PG8_BAR;
    PG8_BAR;
#undef PG8_SA
#undef PG8_SB
#undef PG8_STAGEA
#undef PG8_STAGEB
#undef PG8_LDA
#undef PG8_LDB
#undef PG8_MMA
#undef PG8_WAIT_V
#undef PG8_WAIT_L
#undef PG8_BAR
#undef PG8_SCHED
}

template <int MF, class Epi, class Sched>
__device__ __forceinline__ void gemm_phase160b_run(LAS unsigned char* lds, const Gemm g, const Sched& S, const Epi& E, int tid, int wid, int lane, int wr, int wc) {
    const int fr = lane & 15, fq = lane >> 4;
    const int K = g.K, nt = K / BK;
    constexpr int HTA = 80 * BK * 2;
    unsigned voffA[2], voffB[2];
    { int R, C; stage_rc(tid * 16, R, C); voffA[0] = (unsigned)(R * g.lda + C) * 2u; stage_rc((512 + (tid & 127)) * 16, R, C); voffA[1] = (unsigned)(R * g.lda + C) * 2u; }
#pragma unroll
    for (int i = 0; i < 2; ++i) { int R, C; stage_rc(tid * 16 + i * 8192, R, C); voffB[i] = (unsigned)(R * g.ldb + C) * 2u; }
    const size_t kstep = (size_t)(BK * 2);
    const size_t hstepA = (size_t)80 * g.lda * 2, hstepB = (size_t)HALF * g.ldb * 2;
    const unsigned ldswA0 = (unsigned)wid * 1024u, ldswA1 = 8192u + (unsigned)(wid & 1) * 1024u, ldswB = (unsigned)wid * 1024u;
    const int aoff = lds_byte(wr * 48 + fr, fq * 8), boff = lds_byte(wc * 32 + fr, fq * 8);
#define PG8_SA(b, h) (((b) * 2 + (h)) * HTA)
#define PG8_SB(b, h) (4 * HTA + ((b) * 2 + (h)) * HTB)
#define PG8_STAGEA(bufoff, gbase) do { \
        __builtin_amdgcn_global_load_lds((const unsigned*)((const char*)(gbase) + voffA[0]), (LAS unsigned*)(lds + (bufoff) + ldswA0), 16, 0, 0); \
        __builtin_amdgcn_global_load_lds((const unsigned*)((const char*)(gbase) + voffA[1]), (LAS unsigned*)(lds + (bufoff) + ldswA1), 16, 0, 0); } while (0)
#define PG8_STAGEB(bufoff, gbase) do { _Pragma("unroll") for (int _i = 0; _i < 2; ++_i) \
        __builtin_amdgcn_global_load_lds((const unsigned*)((const char*)(gbase) + voffB[_i]), (LAS unsigned*)(lds + (bufoff) + ldswB + _i * 8192), 16, 0, 0); } while (0)
#define PG8_LDA(dst, b, h) do { _Pragma("unroll") for (int m = 0; m < MF; ++m) _Pragma("unroll") for (int k = 0; k < 2; ++k) dst[m][k] = *(const LAS bf16x8*)(lds + PG8_SA(b, h) + aoff + m * 2048 + k * 1024); } while (0)
#define PG8_LDB(dst, b, h) do { _Pragma("unroll") for (int n = 0; n < 2; ++n) _Pragma("unroll") for (int k = 0; k < 2; ++k) dst[n][k] = *(const LAS bf16x8*)(lds + PG8_SB(b, h) + boff + n * 2048 + k * 1024); } while (0)
#define PG8_MMA(ai, bj, At, Bt) do { __builtin_amdgcn_s_setprio(1); _Pragma("unroll") for (int m = 0; m < MF; ++m) _Pragma("unroll") for (int n = 0; n < 2; ++n) _Pragma("unroll") for (int k = 0; k < 2; ++k) \
        acc[ai][bj][m][n] = __builtin_amdgcn_mfma_f32_16x16x32_bf16(Bt[n][k], At[m][k], acc[ai][bj][m][n], 0, 0, 0); __builtin_amdgcn_s_setprio(0); } while (0)
#define PG8_WAIT_V(n) asm volatile("s_waitcnt vmcnt(" #n ")" ::: "memory")
#define PG8_WAIT_L(n) asm volatile("s_waitcnt lgkmcnt(" #n ")" ::: "memory")
#define PG8_WAIT_LA() do { if (MF == 3) PG8_WAIT_L(6); else PG8_WAIT_L(4); } while (0)
#define PG8_BAR __builtin_amdgcn_s_barrier()
#define PG8_SCHED __builtin_amdgcn_sched_barrier(0)
    Unit cur, nxt; int ui = 0;
    if (!S.next(0, cur)) return;
    f32x4 acc[2][2][MF][2];
#pragma unroll
    for (int a = 0; a < 2; ++a)
#pragma unroll
        for (int b = 0; b < 2; ++b)
#pragma unroll
            for (int m = 0; m < MF; ++m)
#pragma unroll
                for (int n = 0; n < 2; ++n) acc[a][b][m][n] = (f32x4){0.f, 0.f, 0.f, 0.f};
    bf16x8 At[MF][2], B0[2][2], B1[2][2];
    const char* cA = cur.a; const char* cB = cur.b;
    PG8_STAGEB(PG8_SB(0, 0), cB); PG8_STAGEA(PG8_SA(0, 0), cA); PG8_STAGEB(PG8_SB(0, 1), cB + hstepB); PG8_STAGEA(PG8_SA(0, 1), cA + hstepA);
    if (wr == 1) PG8_BAR;
    PG8_WAIT_V(4); PG8_BAR;
    PG8_STAGEB(PG8_SB(1, 0), cB + kstep); PG8_STAGEA(PG8_SA(1, 0), cA + kstep); PG8_STAGEB(PG8_SB(1, 1), cB + hstepB + kstep);
    PG8_WAIT_V(6); PG8_BAR;
    for (;;) {
        const bool has_next = S.next(ui + 1, nxt);
        const char* nA = has_next ? nxt.a : cA; const char* nB = has_next ? nxt.b : cB;
        for (int t = 0; t < nt; t += 2) {
            const bool last = (t == nt - 2);
            const char* a1 = cA + (size_t)(t + 1) * kstep;
            const char* a2 = last ? nA : cA + (size_t)(t + 2) * kstep; const char* b2 = last ? nB : cB + (size_t)(t + 2) * kstep;
            const char* a3 = a2 + kstep; const char* b3 = b2 + kstep;
            PG8_LDB(B0, 0, 0); PG8_SCHED; PG8_LDA(At, 0, 0); PG8_STAGEA(PG8_SA(1, 1), a1 + hstepA);
            PG8_WAIT_LA(); PG8_BAR; PG8_WAIT_L(0); PG8_MMA(0, 0, At, B0); PG8_BAR; PG8_SCHED;
            PG8_LDB(B1, 0, 1); PG8_STAGEB(PG8_SB(0, 0), b2);
            PG8_BAR; PG8_WAIT_L(0); PG8_MMA(0, 1, At, B1); PG8_BAR;
            PG8_LDA(At, 0, 1); PG8_STAGEA(PG8_SA(0, 0), a2);
            PG8_BAR; PG8_WAIT_L(0); PG8_MMA(1, 0, At, B0); PG8_BAR; PG8_SCHED;
            PG8_STAGEB(PG8_SB(0, 1), b2 + hstepB);
            PG8_WAIT_V(6); PG8_BAR; PG8_MMA(1, 1, At, B1); PG8_BAR;
            PG8_LDB(B0, 1, 0); PG8_SCHED; PG8_LDA(At, 1, 0); PG8_STAGEA(PG8_SA(0, 1), a2 + hstepA);
            PG8_WAIT_LA(); PG8_BAR; PG8_WAIT_L(0); PG8_MMA(0, 0, At, B0); PG8_BAR; PG8_SCHED;
            PG8_LDB(B1, 1, 1); PG8_STAGEB(PG8_SB(1, 0), b3);
            PG8_BAR; PG8_WAIT_L(0); PG8_MMA(0, 1, At, B1); PG8_BAR;
            PG8_LDA(At, 1, 1); PG8_STAGEA(PG8_SA(1, 0), a3);
            PG8_BAR; PG8_WAIT_L(0); PG8_MMA(1, 0, At, B0); PG8_BAR; PG8_SCHED;
            PG8_STAGEB(PG8_SB(1, 1), b3 + hstepB);
            PG8_WAIT_V(6); PG8_BAR; PG8_MMA(1, 1, At, B1); PG8_BAR;
        }
        if constexpr (!Epi::AFTER_DRAIN) E.template tile<MF>(acc, cur, wr, wc, fr, fq);
        if (!has_next) break;
#pragma unroll
        for (int a = 0; a < 2; ++a)
#pragma unroll
            for (int b = 0; b < 2; ++b)
#pragma unroll
                for (int m = 0; m < MF; ++m)
#pragma unroll
                    for (int n = 0; n < 2; ++n) acc[a][b][m][n] = (f32x4){0.f, 0.f, 0.f, 0.f};
        cur = nxt; cA = nA; cB = nB; ++ui;
    }
    PG8_WAIT_V(0);
    if (wr == 0) PG8_BAR;
    PG8_BAR;
    if constexpr (Epi::AFTER_DRAIN) E.template fused<MF>(acc, cur, wr, wc, fr, fq, lds, wid, lane, tid);
#undef PG8_SA
#undef PG8_SB
#undef PG8_STAGEA
#undef PG8_STAGEB
#undef PG8_LDA
#undef PG8_LDB
#undef PG8_MMA
#undef PG8_WAIT_V
#undef PG8_WAIT_L
#undef PG8_WAIT_LA
#undef PG8_BAR
#undef PG8_SCHED
}
template <class Epi, class Sched>
__device__ __forceinline__ void gemm_phase160b(LAS unsigned char* lds, const Gemm g, const Sched& S, const Epi& E) {
    int tid = threadIdx.x; asm volatile("" : "+v"(tid));
    const int wid = __builtin_amdgcn_readfirstlane(tid >> 6), lane = tid & 63, wr = wid >> 2, wc = wid & 3;
    if (wr == 0) gemm_phase160b_run<3>(lds, g, S, E, tid, wid, lane, wr, wc);
    else gemm_phase160b_run<2>(lds, g, S, E, tid, wid, lane, wr, wc);
}
}

struct Args { const void* in[27]; float* out; unsigned char* ws; int ph_lo, ph_hi; };
enum { I_XP = 0, I_XS, I_CK, I_CV, I_ST, I_C, I_CCTX, I_WADA, I_BADA, I_GAINS, I_WIN, I_WOUT, I_LAMBDA, I_SUBLN, I_MU, I_W0, I_W2, I_A0, I_A2, I_G2, I_KVEC, I_LNX, I_WODD, I_WFI, I_CONVW, I_CONVB, I_WFO };
#define FIN(k) ((const float*)a.in[k])
#define WSB(off) ((bf16*)(a.ws + (off)))
#define WSF(off) ((float*)(a.ws + (off)))


__device__ __forceinline__ const void* ptab_ld(LAS unsigned char* lds, int k) {
    const u32x2 w = *(const LAS u32x2*)(lds + PTAB_OFF + 8 * k);
    const unsigned long long v = ((unsigned long long)(unsigned)__builtin_amdgcn_readfirstlane((int)w.y) << 32) | (unsigned)__builtin_amdgcn_readfirstlane((int)w.x);
    return (const void*)(const __attribute__((address_space(1))) void*)v;
}
__device__ __forceinline__ Args load_args(LAS unsigned char* lds, int ph_lo, int ph_hi) {
    Args r;
#pragma unroll
    for (int i = 0; i < 27; ++i) r.in[i] = ptab_ld(lds, i);
    r.out = (float*)ptab_ld(lds, 27); r.ws = (unsigned char*)ptab_ld(lds, 28); r.ph_lo = ph_lo; r.ph_hi = ph_hi;
    return r;
}
__device__ __forceinline__ int row_cond(int row) { return row < NPR ? 0 : 1 + ((row - NPR) >> 10); }

template <bool FFN_PERM = false>
__device__ __forceinline__ void p0_transpose_item(const float* W, int K, int N, bf16* WT, LAS float* scr, int item, int lane) {
    const int nblk = N / 64, kb = item / nblk, nb = item % nblk, k0 = 64 * kb, n0 = 64 * nb;
    const int d0 = FFN_PERM ? (n0 < DFF ? (n0 / 128) * 256 + (n0 % 128) : ((n0 - DFF) / 128) * 256 + 128 + ((n0 - DFF) % 128)) : n0;
    const int c2 = 2 * (lane & 31);
#pragma unroll 8
    for (int i = 0; i < 32; ++i) { const int kk = 2 * i + (lane >> 5); const f32x2 v = *(const f32x2*)(W + (size_t)(k0 + kk) * N + n0 + c2); scr[kk * 65 + c2] = v[0]; scr[kk * 65 + c2 + 1] = v[1]; }
    asm volatile("s_waitcnt lgkmcnt(0)" ::: "memory");
    const int c = lane & 7;
#pragma unroll
    for (int j = 0; j < 8; ++j) { const int n = (lane >> 3) + 8 * j; const LAS float* s = scr + (8 * c) * 65 + n;
        u32x4 o; o.x = pk2(s[0 * 65], s[1 * 65]); o.y = pk2(s[2 * 65], s[3 * 65]); o.z = pk2(s[4 * 65], s[5 * 65]); o.w = pk2(s[6 * 65], s[7 * 65]);
        *(u32x4*)(WT + (size_t)(d0 + n) * K + k0 + 8 * c) = o; }
    asm volatile("s_waitcnt lgkmcnt(0)" ::: "memory");
}

template <int STAGE>
__device__ __forceinline__ void phase_prep(const Args& a, LAS unsigned char* lds, int bid, int G, int vgw = -2, int nmine = 1, int nvw = 0) {
    int tid = threadIdx.x; asm volatile("" : "+v"(tid));
    const int lane = tid & 63, wave = tid >> 6;
    const int gw = bid * 8 + wave, NGW = G * 8;
    const int gt = bid * 512 + tid, NGT = G * 512;
    constexpr int I_IN = (1024 / 64) * (INE / 64), I_SQ = (1024 / 64) * (1024 / 64), I_FI = (1024 / 64) * (DFF2 / 64), I_FO = (DFF / 64) * (1024 / 64), I_L64 = 1 * (512 / 64), I_L128 = 2 * (512 / 64);
    if (STAGE == 1 || STAGE == 3) {
        LAS float* scr = (LAS float*)(lds + wave * 18432);
        constexpr int NITEMS = I_IN + 4 * I_L64 + I_L128;
        for (int it = gw; it < NITEMS; it += NGW) {
            int r = it;
            if (r < I_IN) { p0_transpose_item(FIN(I_WIN), 1024, INE, WSB(WS_WIN), scr, r, lane); continue; } r -= I_IN;
            if (r < 2 * I_L64) { const int d = r / I_L64; p0_transpose_item(FIN(I_W2) + (size_t)d * 64 * 512, 64, 512, WSB(WS_W2T) + (size_t)d * 512 * 64, scr, r % I_L64, lane); continue; } r -= 2 * I_L64;
            if (r < 2 * I_L64) { const int d = r / I_L64; p0_transpose_item(FIN(I_A2) + (size_t)d * 64 * 512, 64, 512, WSB(WS_A2T) + (size_t)d * 512 * 64, scr, r % I_L64, lane); continue; } r -= 2 * I_L64;
            p0_transpose_item(FIN(I_G2), 128, 512, WSB(WS_G2T), scr, r, lane);
        }
        for (int i = gt; i < (INE_PAD - INE) * 1024 / 8; i += NGT) ((u32x4*)(WSB(WS_WIN) + (size_t)INE * 1024))[i] = (u32x4){0u, 0u, 0u, 0u};
    }
    if (STAGE == 2) {
        LAS float* scr = (LAS float*)(lds + wave * 18432);
        constexpr int NITEMS = 2 * I_SQ + I_FI + 2 * I_FO;
        const int s0 = vgw == -2 ? gw : vgw, ns = vgw == -2 ? NGW : nvw;
        for (int sl = 0; sl < nmine; ++sl)
        for (int it = s0 < 0 ? NITEMS : s0 + sl; it < NITEMS; it += ns) {
            int r = it;
            if (r < I_SQ) { p0_transpose_item(FIN(I_WOUT), 1024, 1024, WSB(WS_WO), scr, r, lane); continue; } r -= I_SQ;
            if (r < I_SQ) { p0_transpose_item(FIN(I_WODD), 1024, 1024, WSB(WS_WODD), scr, r, lane); continue; } r -= I_SQ;
            if (r < I_FI) { p0_transpose_item<true>(FIN(I_WFI), 1024, DFF2, WSB(WS_WFI), scr, r, lane); continue; } r -= I_FI;
            const int l = r / I_FO; p0_transpose_item(FIN(I_WFO) + (size_t)l * DFF * 1024, DFF, 1024, WSB(WS_WFO) + (size_t)l * 1024 * DFF, scr, r % I_FO, lane);
        }
    }
    if (STAGE == 0 || STAGE == 3) {
        for (int i = gt; i < 256 * 128; i += NGT) {
            const int n = i >> 7, c = i & 127, m = (c * (n & 127)) & 127; const float x = (float)m * (2.0f / 128.0f);
            WSB(WS_WDFT)[i] = f2bf(n < 128 ? cospif(x) : sinpif(x));
        }
        for (int i = gt; i < 256 * 512; i += NGT) {
            const int lp = i >> 9, k = i & 511, l = k & 255, m = (lp * l) & 255; const float x = (float)m * (2.0f / 256.0f), s = 0.00552427172801990f;
            WSB(WS_A2P)[i] = f2bf(k < 256 ? s * cospif(x) : -s * sinpif(x));
        }
        for (int i = gt; i < 1024 * 32; i += NGT) {
            const int t = i >> 5, f = i & 31; const float inv = powf(10000.0f, -(float)(f & 15) / 16.0f), pos = (float)(f < 16 ? (t >> 6) : (t & 63)), ang = pos * inv;
            WSF(WS_ROPE)[i] = cosf(ang); WSF(WS_ROPE)[1024 * 32 + i] = sinf(ang);
        }
        if (gt == 0) {
            const float* lp = FIN(I_LAMBDA); float s1 = 0.f, s2 = 0.f;
            for (int i = 0; i < 64; ++i) { s1 += lp[i] * lp[64 + i]; s2 += lp[128 + i] * lp[192 + i]; }
            WSF(WS_LAM)[0] = expf(s1) - expf(s2) + 0.2f;
        }
        for (int i = gt; i < 2 * 256 * 512; i += NGT) {
            const int b = i >> 17, t = (i >> 9) & 255, c = i & 511;
            WSB(WS_KS)[((size_t)b * LKS + t) * 512 + c] = f2bf(FIN(I_CK)[i]);
            const int h = c >> 7, d = c & 127;
            WSB(WS_VTS)[((size_t)(b * 4 + h) * 128 + d) * LKS + keypos(t)] = f2bf(FIN(I_CV)[i]);
        }
    }
    if (STAGE == 0 || STAGE == 1 || STAGE == 3) {
        LAS float* sc = (LAS float*)lds;
        LAS float* red = (LAS float*)(lds + 16384);
        __syncthreads();
        for (int i = tid; i < 3 * 1024; i += 512) { const int cd = i >> 10, k = i & 1023; const float x = cd == 0 ? FIN(I_CCTX)[k] : FIN(I_C)[(cd - 1) * 1024 + k]; sc[i] = x / (1.f + __expf(-x)); }
        __syncthreads();
        const int kq = tid >> 3, nl = tid & 7;
        const int it_lo = STAGE == 0 ? 0 : 64, it_hi = STAGE == 0 ? 64 : 2 * 192;
        for (int q = 0; ; ++q) {
            int it;
            if (STAGE == 3) {
                if (G == 256) { if (q == 0) { if (bid >= 64) continue; it = bid; } else if (q == 1) { if (bid < 64) continue; it = bid; } else if (q == 2) { if (bid >= 128) continue; it = 256 + bid; } else break; }
                else { it = bid + q * G; if (it >= 2 * 192) break; }
            } else { it = it_lo + bid + q * G; if (it >= it_hi) break; }
            const int l = it / 192, n0 = (it % 192) * 32;
            const float* W = FIN(I_WADA) + (size_t)l * 1024 * 6144 + n0 + 4 * nl;
            f32x4 s0 = {0.f, 0.f, 0.f, 0.f}, s1 = s0, s2 = s0;
#pragma unroll 4
            for (int kk = 0; kk < 16; ++kk) { const int k = kq * 16 + kk; const f32x4 w = *(const f32x4*)(W + (size_t)k * 6144); s0 += w * sc[k]; s1 += w * sc[1024 + k]; s2 += w * sc[2048 + k]; }
            *(LAS f32x4*)(red + (kq * 3 + 0) * 32 + 4 * nl) = s0; *(LAS f32x4*)(red + (kq * 3 + 1) * 32 + 4 * nl) = s1; *(LAS f32x4*)(red + (kq * 3 + 2) * 32 + 4 * nl) = s2;
            __syncthreads();
            if (tid < 96) { const int cd = tid >> 5, n = tid & 31; float s = FIN(I_BADA)[l * 6144 + n0 + n];
                for (int qq = 0; qq < 64; ++qq) s += red[(qq * 3 + cd) * 32 + n];
                if (STAGE == 3 && it < 64)
                    __hip_atomic_store((unsigned*)(a.ws + WS_MOD1) + cd * 2048 + n0 + n, __float_as_uint(s) | 1u, __ATOMIC_RELAXED, __HIP_MEMORY_SCOPE_AGENT);
                else WSF(WS_MOD)[(size_t)(l * 3 + cd) * 6144 + n0 + n] = s; }
            __syncthreads();
        }
    }
}

__device__ __forceinline__ void phase_first_norm(const Args& a, LAS unsigned char* lds, int bid, int G, const float* gB) {
    int tid = threadIdx.x; asm volatile("" : "+v"(tid));
    const int lane = tid & 63, wave = tid >> 6;
    const int gw = bid * 8 + wave, NGW = G * 8;
    LAS float* modl = (LAS float*)lds;
    __syncthreads();
    {   const unsigned* side = (const unsigned*)(a.ws + WS_MOD1);
        unsigned v[12]; unsigned spins = 0;
        for (;;) { bool ok = true;
#pragma unroll
            for (int i = 0; i < 12; ++i) { v[i] = __hip_atomic_load(side + tid + 512 * i, __ATOMIC_RELAXED, __HIP_MEMORY_SCOPE_AGENT); ok = ok && (v[i] != 0u); }
            if (ok || ++spins > (1u << 20)) break;
            __builtin_amdgcn_s_sleep(2); }
#pragma unroll
        for (int i = 0; i < 12; ++i) modl[tid + 512 * i] = __uint_as_float(v[i]);
    }
    __syncthreads();
    bf16* XN = WSB(WS_XN);
    constexpr int R = 5;
    for (int row0 = gw; row0 < NT; row0 += R * NGW) {
        f32x4 x[R][4];
#pragma unroll
        for (int q = 0; q < R; ++q) { const int row = row0 + q * NGW; if (row < NT) {
            const float* xin = row < NPR ? FIN(I_XP) + (size_t)row * DM : FIN(I_XS) + (size_t)(row - NPR) * DM;
#pragma unroll
            for (int j = 0; j < 4; ++j) x[q][j] = *(const f32x4*)(xin + 4 * lane + 256 * j); } }
#pragma unroll
        for (int q = 0; q < R; ++q) { const int row = row0 + q * NGW; if (row < NT) {
            const LAS float* ml = modl + row_cond(row) * 2048;
            float ss = 0.f;
#pragma unroll
            for (int j = 0; j < 4; ++j) ss += (x[q][j][0] * x[q][j][0] + x[q][j][1] * x[q][j][1]) + (x[q][j][2] * x[q][j][2] + x[q][j][3] * x[q][j][3]);
            const float rinv = rsqrtf(wave_sum(ss) * (1.f / DM) + 1e-6f);
#pragma unroll
            for (int j = 0; j < 4; ++j) { const f32x4 g = *(const f32x4*)(gB + 4 * lane + 256 * j), sc = *(const LAS f32x4*)(ml + 1024 + 4 * lane + 256 * j), sh = *(const LAS f32x4*)(ml + 4 * lane + 256 * j);
                const f32x4 h = (x[q][j] * rinv * g) * (sc + 1.f) + sh; *(u32x2*)(XN + (size_t)row * DM + 4 * lane + 256 * j) = pk4(h); }
        } }
    }
}

__device__ __forceinline__ void phase_transpose_wfi1(const Args& a, LAS unsigned char* lds, int bid, int G) {
    int tid = threadIdx.x; asm volatile("" : "+v"(tid));
    const int lane = tid & 63, wave = tid >> 6;
    LAS float* scr = (LAS float*)(lds + wave * 18432);
    constexpr int I_FI = (1024 / 64) * (DFF2 / 64);
    for (int it = bid * 8 + wave; it < I_FI; it += G * 8) p0_transpose_item<true>(FIN(I_WFI) + (size_t)1024 * DFF2, 1024, DFF2, WSB(WS_WFI) + (size_t)DFF2 * 1024, scr, it, lane);
    __syncthreads();
}
template <bool HAS_RES, bool HAS_H, bool X_FROM_INPUT, bool X_TO_OUTPUT = false>
__device__ __forceinline__ void phase_resnorm(const Args& a, int bid, int G, const bf16* mf, const float* gA, int gate_off, int layer_gate, const float* gB, int shift_off, int scale_off, int layer_mod) {
    int tid = threadIdx.x; asm volatile("" : "+v"(tid));
    const int lane = tid & 63, wave = tid >> 6;
    const int gw = bid * 8 + wave, NGW = G * 8;
    float* X = a.out; bf16* XB = WSB(WS_XB);
    bf16* XN = WSB(WS_XN);
    constexpr int R = 5;
    for (int row0 = gw; row0 < NT; row0 += R * NGW) {
        f32x4 x[R][4], m[R][4];
#pragma unroll
        for (int q = 0; q < R; ++q) { const int row = row0 + q * NGW; if (row < NT) {
            const float* xin = row < NPR ? FIN(I_XP) + (size_t)row * DM : FIN(I_XS) + (size_t)(row - NPR) * DM;
#pragma unroll
            for (int j = 0; j < 4; ++j) { x[q][j] = X_FROM_INPUT ? *(const f32x4*)(xin + 4 * lane + 256 * j) : unpk4(*(const u32x2*)(XB + (size_t)row * DM + 4 * lane + 256 * j)); if (HAS_RES) m[q][j] = unpk4(*(const u32x2*)(mf + (size_t)row * DM + 4 * lane + 256 * j)); } } }
#pragma unroll
        for (int q = 0; q < R; ++q) { const int row = row0 + q * NGW; if (row < NT) {
            const float* mod = WSF(WS_MOD) + (size_t)(layer_mod * 3 + row_cond(row)) * 6144;
            const float* modg = WSF(WS_MOD) + (size_t)(layer_gate * 3 + row_cond(row)) * 6144;
            if (HAS_RES) {
                float ss = 0.f;
#pragma unroll
                for (int j = 0; j < 4; ++j) ss += (m[q][j][0] * m[q][j][0] + m[q][j][1] * m[q][j][1]) + (m[q][j][2] * m[q][j][2] + m[q][j][3] * m[q][j][3]);
                const float rinv = rsqrtf(wave_sum(ss) * (1.f / DM) + 1e-6f);
#pragma unroll
                for (int j = 0; j < 4; ++j) { const f32x4 g = *(const f32x4*)(gA + 4 * lane + 256 * j), gt = *(const f32x4*)(modg + gate_off + 4 * lane + 256 * j);
                    x[q][j] = x[q][j] + gt * (m[q][j] * rinv * g);
                    if (X_TO_OUTPUT) *(f32x4*)(X + (size_t)row * DM + 4 * lane + 256 * j) = x[q][j]; else *(u32x2*)(XB + (size_t)row * DM + 4 * lane + 256 * j) = pk4(x[q][j]); }
            }
            if (HAS_H) {
                float ss = 0.f;
#pragma unroll
                for (int j = 0; j < 4; ++j) ss += (x[q][j][0] * x[q][j][0] + x[q][j][1] * x[q][j][1]) + (x[q][j][2] * x[q][j][2] + x[q][j][3] * x[q][j][3]);
                const float rinv = rsqrtf(wave_sum(ss) * (1.f / DM) + 1e-6f);
#pragma unroll
                for (int j = 0; j < 4; ++j) { const f32x4 g = *(const f32x4*)(gB + 4 * lane + 256 * j), sc = *(const f32x4*)(mod + scale_off + 4 * lane + 256 * j), sh = *(const f32x4*)(mod + shift_off + 4 * lane + 256 * j);
                    const f32x4 h = (x[q][j] * rinv * g) * (sc + 1.f) + sh; *(u32x2*)(XN + (size_t)row * DM + 4 * lane + 256 * j) = pk4(h); }
            }
        } }
    }
}

struct EpiF32 {
    float* C; int ldc;
    static constexpr bool ALIGN = false;
    __device__ __forceinline__ void operator()(const f32x4 (&acc)[2][2][4][2], const pg8::Unit& u, int wr, int wc, int fr, int fq) const {
        pg8::epi_each(acc, u.pm * 256 + wr * 64 + fr, u.pn * 256 + wc * 32 + 4 * fq, [&](int row, int col, const f32x4& v) { *(f32x4*)(C + (size_t)row * ldc + col) = v; });
    }
};
struct EpiBf16 {
    bf16* O; int ldc;
    static constexpr bool ALIGN = false;
    __device__ __forceinline__ void operator()(const f32x4 (&acc)[2][2][4][2], const pg8::Unit& u, int wr, int wc, int fr, int fq) const {
        pg8::epi_each(acc, u.z + u.pm * 256 + wr * 64 + fr, u.pn * 256 + wc * 32 + 4 * fq, [&](int row, int col, const f32x4& v) { *(u32x2*)(O + (size_t)row * ldc + col) = pk4(v); });
    }
};

template <class F> __device__ __forceinline__ void epi_each160(const f32x4 (&acc)[2][2][5], const pg8::Unit& u, int wid, int fr, int fq, F&& f) {
#pragma unroll
    for (int ai = 0; ai < 2; ++ai)
#pragma unroll
        for (int m = 0; m < 5; ++m)
#pragma unroll
            for (int bj = 0; bj < 2; ++bj) f(u.pm * 160 + ai * 80 + m * 16 + fr, u.pn * 256 + bj * 128 + wid * 16 + 4 * fq, acc[ai][bj][m]);
}
struct EpiBf16_160 {
    bf16* O; int ldc;
    static constexpr bool AFTER_DRAIN = false;
    template <int MF> __device__ __forceinline__ void tile(const f32x4 (&acc)[2][2][MF][2], const pg8::Unit& u, int wr, int wc, int fr, int fq) const {
#pragma unroll
        for (int ai = 0; ai < 2; ++ai)
#pragma unroll
            for (int m = 0; m < MF; ++m)
#pragma unroll
                for (int bj = 0; bj < 2; ++bj)
#pragma unroll
                    for (int n = 0; n < 2; ++n) *(u32x2*)(O + (size_t)(u.pm * 160 + ai * 80 + wr * 48 + m * 16 + fr) * ldc + u.pn * 256 + bj * 128 + wc * 32 + n * 16 + 4 * fq) = pk4(acc[ai][bj][m][n]);
    }
    __device__ __forceinline__ void operator()(const f32x4 (&acc)[2][2][5], const pg8::Unit& u, int wid, int fr, int fq) const {
#pragma unroll
        for (int ai = 0; ai < 2; ++ai)
#pragma unroll
            for (int m = 0; m < 5; ++m)
#pragma unroll
                for (int bj = 0; bj < 2; ++bj) *(u32x2*)(O + (size_t)(u.pm * 160 + ai * 80 + m * 16 + fr) * ldc + u.pn * 256 + bj * 128 + wid * 16 + 4 * fq) = pk4(acc[ai][bj][m]);
    }
};

template <bool FROM_INPUT, bool FINAL>
struct EpiResNorm {
    static constexpr bool AFTER_DRAIN = true;
    const float* xin_p; const float* xin_s; const bf16* xb_in;
    bf16* xb_out; float* xf_out; bf16* xn_out;
    const float* gA; const float* gB; const float* mod;
    int gate_off, layer_gate, shift_off, scale_off, layer_mod;
    unsigned* slots; unsigned* cnt;

    template <int MF> __device__ __forceinline__ void exchange(const f32x4 (&v)[2][2][MF][2], int e, int pm, int pn, int wr, int wc, int fr, int fq, LAS float* P, LAS float* R, int wid, int lane, int tid) const {
#pragma unroll
        for (int ai = 0; ai < 2; ++ai)
#pragma unroll
            for (int m = 0; m < MF; ++m) {
                float s = 0.f;
#pragma unroll
                for (int bj = 0; bj < 2; ++bj)
#pragma unroll
                    for (int n = 0; n < 2; ++n) { const f32x4 x = v[ai][bj][m][n]; s += (x[0] * x[0] + x[1] * x[1]) + (x[2] * x[2] + x[3] * x[3]); }
                s += __shfl_xor(s, 16); s += __shfl_xor(s, 32);
                if (fq == 0) P[(80 * ai + 48 * wr + 16 * m + fr) * 4 + wc] = s;
            }
        asm volatile("s_waitcnt lgkmcnt(0)" ::: "memory"); __builtin_amdgcn_s_barrier(); asm volatile("" ::: "memory");
        unsigned long long* sl = (unsigned long long*)(slots + ((size_t)(e * 64 + pm) * 160) * 4);
        if (tid < 160) { const float tot = (P[tid * 4 + 0] + P[tid * 4 + 1]) + (P[tid * 4 + 2] + P[tid * 4 + 3]);
            __hip_atomic_store((unsigned*)sl + tid * 4 + pn, __float_as_uint(tot) | 1u, __ATOMIC_RELAXED, __HIP_MEMORY_SCOPE_AGENT);
            unsigned long long a, b; unsigned spins = 0;
            for (;;) {
                a = __hip_atomic_load(sl + tid * 2 + 0, __ATOMIC_RELAXED, __HIP_MEMORY_SCOPE_AGENT); b = __hip_atomic_load(sl + tid * 2 + 1, __ATOMIC_RELAXED, __HIP_MEMORY_SCOPE_AGENT);
                if (((unsigned)a != 0u && (unsigned)(a >> 32) != 0u && (unsigned)b != 0u && (unsigned)(b >> 32) != 0u) || ++spins > (1u << 20)) break;
                __builtin_amdgcn_s_sleep(1);
            }
            const float q = (__uint_as_float((unsigned)a) + __uint_as_float((unsigned)(a >> 32))) + (__uint_as_float((unsigned)b) + __uint_as_float((unsigned)(b >> 32)));
            R[tid] = rsqrtf(q * (1.f / 1024.f) + 1e-6f); }
        asm volatile("s_waitcnt lgkmcnt(0)" ::: "memory"); __builtin_amdgcn_s_barrier(); asm volatile("" ::: "memory");
    }

    template <int MF> __device__ __forceinline__ void fused(f32x4 (&acc)[2][2][MF][2], const pg8::Unit& u, int wr, int wc, int fr, int fq, LAS unsigned char* lds, int wid, int lane, int tid) const {
        LAS float* P = (LAS float*)lds; LAS float* R = (LAS float*)(lds + 4096);
        const int pm = u.pm, pn = u.pn, row0 = 160 * pm;
        int cb = 256 * pn + 32 * wc + 4 * fq; asm volatile("" : "+v"(cb));
        const int c_lo = row_cond(row0), c_hi = row_cond(row0 + 159);
        f32x4 g[4], gtl[4], gth[4];
        {   const float* ml = mod + (size_t)(layer_gate * 3 + c_lo) * 6144 + gate_off; const float* mh = mod + (size_t)(layer_gate * 3 + c_hi) * 6144 + gate_off;
#pragma unroll
            for (int q = 0; q < 4; ++q) { const int col = cb + 128 * (q >> 1) + 16 * (q & 1); g[q] = *(const f32x4*)(gA + col); gtl[q] = *(const f32x4*)(ml + col); gth[q] = *(const f32x4*)(mh + col); } }
        using XT = typename std::conditional<FROM_INPUT, f32x4, u32x2>::type;
        XT x0[MF * 4], x1[MF * 4];
        auto ldx = [&](XT (&xr)[MF * 4], int ai) {
#pragma unroll
            for (int m = 0; m < MF; ++m) { const int row = row0 + 80 * ai + 48 * wr + 16 * m + fr;
#pragma unroll
                for (int q = 0; q < 4; ++q) { const int col = cb + 128 * (q >> 1) + 16 * (q & 1);
                    if constexpr (FROM_INPUT) xr[m * 4 + q] = *(const f32x4*)((row < NPR ? xin_p + (size_t)row * DM : xin_s + (size_t)(row - NPR) * DM) + col);
                    else xr[m * 4 + q] = *(const u32x2*)(xb_in + (size_t)row * DM + col); } } };
        auto upd = [&](const XT (&xr)[MF * 4], int ai) {
#pragma unroll
            for (int m = 0; m < MF; ++m) { const int rl = 80 * ai + 48 * wr + 16 * m + fr; const float rinv = R[rl]; const bool hi = row_cond(row0 + 80 * ai + 48 * wr + 16 * m) != c_lo;
#pragma unroll
                for (int q = 0; q < 4; ++q) { f32x4 x; if constexpr (FROM_INPUT) x = xr[m * 4 + q]; else x = unpk4(xr[m * 4 + q]);
                    const f32x4 gt = hi ? gth[q] : gtl[q];
                    acc[ai][q >> 1][m][q & 1] = x + gt * (acc[ai][q >> 1][m][q & 1] * rinv * g[q]); } } };
        ldx(x0, 0);
        if constexpr (!FROM_INPUT) ldx(x1, 1);
        asm volatile("" ::: "memory");
        exchange<MF>(acc, 0, pm, pn, wr, wc, fr, fq, P, R, wid, lane, tid);
        upd(x0, 0);
        if constexpr (FROM_INPUT) { asm volatile("" ::: "memory"); ldx(x1, 1); }
        upd(x1, 1);
#pragma unroll
        for (int ai = 0; ai < 2; ++ai)
#pragma unroll
            for (int m = 0; m < MF; ++m) { const int row = row0 + 80 * ai + 48 * wr + 16 * m + fr;
#pragma unroll
                for (int q = 0; q < 4; ++q) { const int col = cb + 128 * (q >> 1) + 16 * (q & 1); const f32x4 x = acc[ai][q >> 1][m][q & 1];
                    if constexpr (FINAL) *(f32x4*)(xf_out + (size_t)row * DM + col) = x; else *(u32x2*)(xb_out + (size_t)row * DM + col) = pk4(x); } }
        if constexpr (!FINAL) {
            f32x4 al[4], ah[4], sl[4], sh[4];
            {   const float* ml = mod + (size_t)(layer_mod * 3 + c_lo) * 6144; const float* mh = mod + (size_t)(layer_mod * 3 + c_hi) * 6144;
#pragma unroll
                for (int q = 0; q < 4; ++q) { const int col = cb + 128 * (q >> 1) + 16 * (q & 1); const f32x4 gb = *(const f32x4*)(gB + col);
                    al[q] = gb * (*(const f32x4*)(ml + scale_off + col) + 1.f); ah[q] = gb * (*(const f32x4*)(mh + scale_off + col) + 1.f);
                    sl[q] = *(const f32x4*)(ml + shift_off + col); sh[q] = *(const f32x4*)(mh + shift_off + col); } }
            asm volatile("" ::: "memory");
            exchange<MF>(acc, 1, pm, pn, wr, wc, fr, fq, P, R, wid, lane, tid);
#pragma unroll
            for (int ai = 0; ai < 2; ++ai)
#pragma unroll
                for (int m = 0; m < MF; ++m) { const int rl = 80 * ai + 48 * wr + 16 * m + fr, row = row0 + rl; const float rinv = R[rl]; const bool hi = row_cond(row0 + 80 * ai + 48 * wr + 16 * m) != c_lo;
#pragma unroll
                    for (int q = 0; q < 4; ++q) { const int col = cb + 128 * (q >> 1) + 16 * (q & 1);
                        const f32x4 h = (acc[ai][q >> 1][m][q & 1] * rinv) * (hi ? ah[q] : al[q]) + (hi ? sh[q] : sl[q]);
                        *(u32x2*)(xn_out + (size_t)row * DM + col) = pk4(h); } }
        }
    }
};

struct EpiProj {
    bf16 *Q, *KP, *KS, *VTP, *VTS, *FB; float *ock, *ocv; const float* rope;
    static constexpr bool ALIGN = false, AFTER_DRAIN = false;
    __device__ __forceinline__ f32x4 do_rope(f32x4 v, int t, int col) const {
        const int i0 = (col & 63) >> 1;
        const f32x2 c = *(const f32x2*)(rope + t * 32 + i0), s = *(const f32x2*)(rope + 1024 * 32 + t * 32 + i0);
        f32x4 o; o[0] = v[0] * c[0] - v[1] * s[0]; o[1] = v[0] * s[0] + v[1] * c[0]; o[2] = v[2] * c[1] - v[3] * s[1]; o[3] = v[2] * s[1] + v[3] * c[1]; return o;
    }
    __device__ __forceinline__ void operator()(const f32x4 (&acc)[2][2][4][2], const pg8::Unit& u, int wr, int wc, int fr, int fq) const {
        pg8::epi_each(acc, u.pm * 256 + wr * 64 + fr, u.pn * 256 + wc * 32 + 4 * fq, [&](int row, int col, const f32x4& v) { elem(row, col, v); });
    }
    __device__ __forceinline__ void operator()(const f32x4 (&acc)[2][2][5], const pg8::Unit& u, int wid, int fr, int fq) const {
        epi_each160(acc, u, wid, fr, fq, [&](int row, int col, const f32x4& v) { elem(row, col, v); });
    }
    template <int MF> __device__ __forceinline__ void tile(const f32x4 (&acc)[2][2][MF][2], const pg8::Unit& u, int wr, int wc, int fr, int fq) const {
#pragma unroll
        for (int ai = 0; ai < 2; ++ai)
#pragma unroll
            for (int m = 0; m < MF; ++m)
#pragma unroll
                for (int bj = 0; bj < 2; ++bj)
#pragma unroll
                    for (int n = 0; n < 2; ++n) elem(u.pm * 160 + ai * 80 + wr * 48 + m * 16 + fr, u.pn * 256 + bj * 128 + wc * 32 + n * 16 + 4 * fq, acc[ai][bj][m][n]);
    }
    __device__ __forceinline__ void elem(int row, int col, const f32x4& v) const {
        {
            const bool smp = row >= NPR; const int sr = row - NPR, sb = sr >> 10, st = sr & 1023;
            if (col < 512) {
                f32x4 o = v; if (smp) o = do_rope(v, st, col);
                *(u32x2*)(Q + (size_t)row * 512 + col) = pk4(o);
            } else if (col < 1024) {
                const int c = col - 512;
                if (!smp) { *(f32x4*)(ock + (size_t)row * 512 + c) = v; *(u32x2*)(KP + (size_t)row * 512 + c) = pk4(v); }
                else { const f32x4 o = do_rope(v, st, c); *(u32x2*)(KS + ((size_t)sb * LKS + PAST + st) * 512 + c) = pk4(o); }
            } else if (col < 1536) {
                const int c = col - 1024, h = c >> 7, d = c & 127;
                if (!smp) { *(f32x4*)(ocv + (size_t)row * 512 + c) = v; const int b = row >> 8, t = row & 255; bf16* p = VTP + ((size_t)(b * 4 + h) * 128 + d) * SEQ + keypos(t);
#pragma unroll
                    for (int e = 0; e < 4; ++e) p[(size_t)e * SEQ] = f2bf(v[e]); }
                else { bf16* p = VTS + ((size_t)(sb * 4 + h) * 128 + d) * LKS + keypos(PAST + st);
#pragma unroll
                    for (int e = 0; e < 4; ++e) p[(size_t)e * LKS] = f2bf(v[e]); }
            } else if (col < INE) {
                *(u32x2*)(FB + (size_t)row * INB + (col - 1536)) = pk4(v);
            }
        }
    }
};


template <int CTRL> __device__ __forceinline__ float dpp_mv(float old, float src) { return __int_as_float(__builtin_amdgcn_update_dpp(__float_as_int(old), __float_as_int(src), CTRL, 0xf, 0xf, false)); }
template <int CTRL> __device__ __forceinline__ float dpp_rot(float src) { return __int_as_float(__builtin_amdgcn_mov_dpp(__float_as_int(src), CTRL, 0xf, 0xf, true)); }
__device__ __forceinline__ float silu_mul(float x, float u) { return x * __builtin_amdgcn_rcpf(1.f + __expf(-x)) * u; }
struct EpiFfnConv {
    static constexpr bool ALIGN = true;
    bf16* ACT; const float* cw; const float* cb; float* SB; LAS float* xch;
    __device__ __forceinline__ void operator()(const f32x4 (&acc)[2][2][4][2], const pg8::Unit& u, int wr, int wc, int fr, int fq) const {
        const int pm = u.pm, pn = u.pn;
        const bool smp = pm >= 32; const int sidx = pm - 32, sq = sidx & 3;
        const bool has_prev = smp && sq > 0, has_next = smp && sq < 3;
#pragma unroll
        for (int ai = 0; ai < 2; ++ai)
#pragma unroll
            for (int n = 0; n < 2; ++n) { const int c = 32 * wc + 16 * n + 4 * fq, blk = 2 * ai + wr;
                if (fr == 0) *(LAS f32x4*)(xch + (blk * 2 + 0) * 128 + c) = acc[ai][1][0][n];
                if (fr == 15) *(LAS f32x4*)(xch + (blk * 2 + 1) * 128 + c) = acc[ai][1][3][n]; }
        asm volatile("s_waitcnt lgkmcnt(0)" ::: "memory"); __builtin_amdgcn_s_barrier(); asm volatile("" ::: "memory");
#pragma unroll
        for (int n = 0; n < 2; ++n) {
            const int c = 32 * wc + 16 * n + 4 * fq, f = 128 * pn + c;
            const f32x4 c0 = *(const f32x4*)(cw + f), c1 = *(const f32x4*)(cw + DFF + f), c2 = *(const f32x4*)(cw + 2 * DFF + f), cbv = *(const f32x4*)(cb + f);
#pragma unroll
            for (int ai = 0; ai < 2; ++ai) {
                const int blk = 2 * ai + wr;
                f32x4 gabove = {0.f, 0.f, 0.f, 0.f}, gbelow = gabove;
                if (blk > 0) gabove = *(const LAS f32x4*)(xch + ((blk - 1) * 2 + 1) * 128 + c);
                if (blk < 3) gbelow = *(const LAS f32x4*)(xch + ((blk + 1) * 2 + 0) * 128 + c);
#pragma unroll
                for (int m = 0; m < 4; ++m) {
                    const f32x4 g = acc[ai][1][m][n], uu = acc[ai][0][m][n];
                    f32x4 o, xs;
#pragma unroll
                    for (int e = 0; e < 4; ++e) {
                        const float pold = m > 0 ? dpp_rot<0x121>(acc[ai][1][m - 1][n][e]) : gabove[e];
                        const float prev = dpp_mv<0x111>(pold, g[e]);
                        const float nold = m < 3 ? dpp_rot<0x12F>(acc[ai][1][m + 1][n][e]) : gbelow[e];
                        const float next = dpp_mv<0x101>(nold, g[e]);
                        const float x = c0[e] * prev + (c1[e] * g[e] + (c2[e] * next + cbv[e]));
                        xs[e] = x; o[e] = silu_mul(x, uu[e]);
                    }
                    const int r = 128 * ai + 64 * wr + 16 * m + fr;
                    *(u32x2*)(ACT + (size_t)(256 * pm + r) * DFF + f) = pk4(o);
                    if (smp) {
                        if (r == 0) { *(f32x4*)(SB + (size_t)(0 * 8 + sidx) * DFF + f) = g; if (has_prev) { *(f32x4*)(SB + (size_t)(2 * 8 + sidx) * DFF + f) = xs; *(f32x4*)(SB + (size_t)(3 * 8 + sidx) * DFF + f) = uu; } }
                        if (r == 255) { *(f32x4*)(SB + (size_t)(1 * 8 + sidx) * DFF + f) = g; if (has_next) { *(f32x4*)(SB + (size_t)(4 * 8 + sidx) * DFF + f) = xs; *(f32x4*)(SB + (size_t)(5 * 8 + sidx) * DFF + f) = uu; } }
                    }
                }
            }
        }
    }
};
template <class Sched>
__device__ __forceinline__ void ffn_seam_fixup(const Sched& S, int rows_per_unit, bf16* ACT, const float* cw, const float* SB) {
    pg8::Unit u;
    for (int i = 0; S.next(i, u); ++i) {
        const int lo = u.pm * rows_per_unit, hi = lo + rows_per_unit;
        if (hi <= NPR) continue;
        int t0 = threadIdx.x; asm volatile("" : "+v"(t0));
        for (int sidx = 0; sidx < 8; ++sidx) {
            const int sq = sidx & 3, r0 = 256 * (32 + sidx), r1 = r0 + 255;
            const bool fix0 = sq > 0 && r0 >= lo && r0 < hi, fix1 = sq < 3 && r1 >= lo && r1 < hi;
            if (!fix0 && !fix1) continue;
            for (int f = t0; f < DFF; f += 512) {
                if (fix0) { const float x = SB[(size_t)(2 * 8 + sidx) * DFF + f] + cw[f] * SB[(size_t)(1 * 8 + sidx - 1) * DFF + f]; ACT[(size_t)r0 * DFF + f] = f2bf(silu_mul(x, SB[(size_t)(3 * 8 + sidx) * DFF + f])); }
                if (fix1) { const float x = SB[(size_t)(4 * 8 + sidx) * DFF + f] + cw[2 * DFF + f] * SB[(size_t)(0 * 8 + sidx + 1) * DFF + f]; ACT[(size_t)r1 * DFF + f] = f2bf(silu_mul(x, SB[(size_t)(5 * 8 + sidx) * DFF + f])); }
            }
        }
    }
    asm volatile("s_waitcnt vmcnt(0)" ::: "memory");
    __syncthreads();
}

struct DftOrder {
    int G, c; const char* A; const char* BtS; const char* BtP;
    __device__ bool next(int i, pg8::Unit& u) const {
        const int j = i * G + c; if (j >= 160) return false;
        u.pm = 0; u.a = A;
        if (j < 32) { const int b = j >> 4, p = (j >> 2) & 3, pn = j & 3; u.pn = pn; u.z = NPR + b * 1024 + p; u.b = BtS + ((size_t)(b * 4 + p) * 1024 + pn * 256) * 512 * 2; }
        else { const int q = j - 32, b = q >> 2, pn = q & 3; u.pn = pn; u.z = b * 256; u.b = BtP + ((size_t)b * 1024 + pn * 256) * 512 * 2; }
        return true;
    }
};
struct EpiDft {
    bf16* O;
    static constexpr bool ALIGN = false;
    __device__ __forceinline__ void operator()(const f32x4 (&acc)[2][2][4][2], const pg8::Unit& u, int wr, int wc, int fr, int fq) const {
        const int st = u.z >= NPR ? 4 : 1;
        pg8::epi_each(acc, wr * 64 + fr, u.pn * 256 + wc * 32 + 4 * fq, [&](int r, int col, const f32x4& v) { *(u32x2*)(O + (size_t)(u.z + st * r) * 1024 + col) = pk4(v); });
    }
};

__device__ __forceinline__ f32x16 mfma32(bf16x8 x, bf16x8 y, f32x16 c) { return __builtin_amdgcn_mfma_f32_32x32x16_bf16(x, y, c, 0, 0, 0); }
__device__ __forceinline__ void phase_attention(const Args& a, LAS unsigned char* lds, int bid, int G) {
    int tid = threadIdx.x; asm volatile("" : "+v"(tid));
    const int lane = tid & 63, wave = __builtin_amdgcn_readfirstlane(tid >> 6), tk = lane & 31, hh = lane >> 5;
    const float cs = 0.125f * 1.4426950408889634f;
    const bf16* Q = WSB(WS_Q);
    bf16* AB = WSB(WS_XN);
    const float* subln = FIN(I_SUBLN);
    constexpr int KST = 136, VST = 40;
    LAS bf16* Kl = (LAS bf16*)lds;
    LAS bf16* Vl = (LAS bf16*)(lds + 2 * 32 * KST * 2);
    LAS bf16* Ql = (LAS bf16*)(lds + 40960 + wave * 8192);
    const int lkey = tid >> 4, lkc = tid & 15, lvd = tid >> 2, lvc = tid & 3;
    for (int ai = 0; ai < 2; ++ai) {
        int item;
        if (G == 256) {
            if (bid >= 224) item = ai == 0 ? bid - 224 : -1;
            else if (bid >= 160) item = 32 + 2 * (bid - 160) + ai;
            else item = -1;
        } else item = bid + ai * G;
        if (item < 0 || item >= 160) continue;
        int b, h, nkeys, qrow0; const bf16 *Kb, *VT;
        if (item < 32) { b = item >> 4; h = (item >> 2) & 3; const int qb = item & 3; nkeys = LKS; qrow0 = NPR + b * 1024 + qb * 256 + wave * 32; Kb = WSB(WS_KS) + (size_t)b * LKS * 512; VT = WSB(WS_VTS) + (size_t)(b * 4 + h) * 128 * LKS; }
        else { const int j = item - 32; b = j >> 2; h = j & 3; nkeys = SEQ; qrow0 = b * 256 + wave * 32; Kb = WSB(WS_KP) + (size_t)b * 256 * 512; VT = WSB(WS_VTP) + (size_t)(b * 4 + h) * 128 * SEQ; }
        f32x16 O[2][4];
#pragma unroll
        for (int m = 0; m < 2; ++m)
#pragma unroll
            for (int mt = 0; mt < 4; ++mt)
#pragma unroll
                for (int r = 0; r < 16; ++r) O[m][mt][r] = 0.f;
        float mx[2] = {-1e30f, -1e30f}, ls[2] = {0.f, 0.f};
        const bf16* kg = Kb + (size_t)lkey * 512 + h * 128 + lkc * 8;
        const bf16* vg = VT + (size_t)lvd * nkeys + lvc * 8;
        __syncthreads();
#pragma unroll
        for (int m = 0; m < 2; ++m)
#pragma unroll
            for (int s = 0; s < 4; ++s) *(LAS bf16x8*)(Ql + ((m * 4 + s) * 64 + lane) * 8) = *(const bf16x8*)(Q + (size_t)(qrow0 + tk) * 512 + h * 128 + m * 64 + 16 * s + 8 * hh);
        { const u32x4 k0v = *(const u32x4*)kg, v0v = *(const u32x4*)vg;
          *(LAS u32x4*)(Kl + lkey * KST + lkc * 8) = k0v; *(LAS u32x4*)(Vl + lvd * VST + lvc * 8) = v0v; }
        const int nt = nkeys / 32;
        for (int t = 0; t < nt; ++t) {
            const int cur = t & 1;
            const bool more = t + 1 < nt;
            u32x4 kn = {0u, 0u, 0u, 0u}, vn = kn;
            if (more) { kn = *(const u32x4*)(kg + (size_t)(t + 1) * 32 * 512); vn = *(const u32x4*)(vg + (t + 1) * 32); }
            __syncthreads();
            const LAS bf16* Kc = Kl + cur * 32 * KST + tk * KST + 8 * hh;
            const LAS bf16* Vc = Vl + cur * 128 * VST + tk * VST + 8 * hh;
            bf16x8 pb[2][2];
#pragma unroll
            for (int m = 0; m < 2; ++m) {
                f32x16 S;
#pragma unroll
                for (int r = 0; r < 16; ++r) S[r] = 0.f;
#pragma unroll
                for (int s = 0; s < 4; ++s) { const bf16x8 kf = *(const LAS bf16x8*)(Kc + m * 64 + 16 * s); const bf16x8 qfr = *(const LAS bf16x8*)(Ql + ((m * 4 + s) * 64 + lane) * 8); S = mfma32(kf, qfr, S); }
                float tm = S[0];
#pragma unroll
                for (int r = 1; r < 16; ++r) tm = fmaxf(tm, S[r]);
                tm = fmaxf(tm, __shfl_xor(tm, 32));
                if (__any(tm > mx[m] + 44.0f)) {
                    const float mn = fmaxf(mx[m], tm), alpha = __builtin_amdgcn_exp2f((mx[m] - mn) * cs); mx[m] = mn;
                    ls[m] *= alpha;
#pragma unroll
                    for (int mt = 0; mt < 4; ++mt)
#pragma unroll
                        for (int r = 0; r < 16; ++r) O[m][mt][r] *= alpha;
                }
                const float mcur = mx[m];
                float ps = 0.f;
#pragma unroll
                for (int r = 0; r < 16; ++r) { S[r] = __builtin_amdgcn_exp2f((S[r] - mcur) * cs); ps += S[r]; }
                ls[m] += ps;
#pragma unroll
                for (int s2 = 0; s2 < 2; ++s2) { u32x4 w; w.x = pk2(S[8 * s2 + 0], S[8 * s2 + 1]); w.y = pk2(S[8 * s2 + 2], S[8 * s2 + 3]); w.z = pk2(S[8 * s2 + 4], S[8 * s2 + 5]); w.w = pk2(S[8 * s2 + 6], S[8 * s2 + 7]); pb[m][s2] = __builtin_bit_cast(bf16x8, w); }
            }
#pragma unroll
            for (int mt = 0; mt < 4; ++mt) {
#pragma unroll
                for (int s2 = 0; s2 < 2; ++s2) { const bf16x8 vf = *(const LAS bf16x8*)(Vc + 32 * mt * VST + 16 * s2);
                    O[0][mt] = mfma32(vf, pb[0][s2], O[0][mt]); O[1][mt] = mfma32(vf, pb[1][s2], O[1][mt]); }
            }
            if (more) { *(LAS u32x4*)(Kl + (cur ^ 1) * 32 * KST + lkey * KST + lkc * 8) = kn; *(LAS u32x4*)(Vl + (cur ^ 1) * 128 * VST + lvd * VST + lvc * 8) = vn; }
        }
        const float l0 = ls[0] + __shfl_xor(ls[0], 32), l1 = ls[1] + __shfl_xor(ls[1], 32);
        const float lam = WSF(WS_LAM)[0];
        const float i0 = 1.f / l0, i1 = lam / l1;
        float ss = 0.f;
#pragma unroll
        for (int mt = 0; mt < 4; ++mt)
#pragma unroll
            for (int r = 0; r < 16; ++r) { const float o = O[0][mt][r] * i0 - O[1][mt][r] * i1; O[0][mt][r] = o; ss += o * o; }
        ss += __shfl_xor(ss, 32);
        const float rinv = rsqrtf(ss * (1.f / 128.f) + 1e-6f) * 0.8f;
        bf16* dst = AB + (size_t)(qrow0 + tk) * 1024 + h * 128;
#pragma unroll
        for (int mt = 0; mt < 4; ++mt)
#pragma unroll
            for (int rq = 0; rq < 4; ++rq) { const int d = 32 * mt + 8 * rq + 4 * hh; const f32x4 g = *(const f32x4*)(subln + d);
                f32x4 o; o[0] = O[0][mt][4 * rq + 0] * rinv * g[0]; o[1] = O[0][mt][4 * rq + 1] * rinv * g[1]; o[2] = O[0][mt][4 * rq + 2] * rinv * g[2]; o[3] = O[0][mt][4 * rq + 3] * rinv * g[3];
                *(u32x2*)(dst + d) = pk4(o); }
    }
}

__device__ __forceinline__ float allred4(float x) {
    { auto r = __builtin_amdgcn_permlane16_swap(__float_as_uint(x), __float_as_uint(x), false, false); x = __uint_as_float(r[0]) + __uint_as_float(r[1]); }
    { auto r = __builtin_amdgcn_permlane32_swap(__float_as_uint(x), __float_as_uint(x), false, false); x = __uint_as_float(r[0]) + __uint_as_float(r[1]); }
    return x;
}

constexpr int OPS_KGRG = 0, OPS_KDBD = 4096, OPS_CINIT = 8192, OPS_VIMG = 12288, OPS_GAM = 14336, OPS_ITEM = 14592;
constexpr size_t WS_OPS = WS_MF;
static_assert(WS_OPS + (size_t)2 * 5120 * OPS_ITEM <= WS_Q, "ws ops");
__device__ __forceinline__ f32x4 mfma16(bf16x8 x, bf16x8 y, f32x4 c) { return __builtin_amdgcn_mfma_f32_16x16x32_bf16(x, y, c, 0, 0, 0); }
__device__ __forceinline__ bf16x8 frag_lo(f32x4 v) { u32x4 w; w.x = pk2(v[0], v[1]); w.y = pk2(v[2], v[3]); w.z = 0u; w.w = 0u; return __builtin_bit_cast(bf16x8, w); }
__device__ __forceinline__ void wave_lds_sync() { __syncthreads(); }


template <bool REV>
__device__ __forceinline__ void wkv_chunk_ops(unsigned char* ops, LAS unsigned char* wl, int lane, const float (&kkn)[16], const float (&wv)[16], const float (&kraw)[16], const float (&ad)[16], const float ka_, const float (&rr)[16], const unsigned (&vp)[8]) {
    int lane_ = lane; asm volatile("" : "+v"(lane_));
    const int lr = lane_ & 15, lg = lane_ >> 4, j = lane_;
    LAS bf16* KgR = (LAS bf16*)wl; LAS bf16* RgR = KgR + 16 * 72; LAS bf16* KiR = RgR + 16 * 72; LAS bf16* BiR = KiR + 16 * 72;
    LAS bf16* KgT = (LAS bf16*)(wl + 9216); LAS float* RgT = (LAS float*)(wl + 9216 + 2048); LAS bf16* VT = (LAS bf16*)(wl + 9216 + 2048 + 5120);
    LAS float* NL = (LAS float*)wl; LAS float* TL = (LAS float*)(wl + 2304);
    float gall = 1.f;
#pragma unroll
    for (int t = 0; t < 16; ++t) gall *= wv[t];
    *(float*)(ops + OPS_GAM + 4 * j) = gall;
    float grun = 1.f;
#pragma unroll
    for (int g = 0; g < 4; ++g) {
        float kdv[4], bdv[4]; unsigned vb4[4];
#pragma unroll
        for (int e = 0; e < 4; ++e) {
            const int tau = 4 * g + e, t = REV ? 15 - tau : tau;
            const float gprev = grun; grun *= wv[t];
            const float inv = __builtin_amdgcn_rcpf(grun);
            const float kg = kkn[t] * gprev, rg = rr[t] * grun, ki = kraw[t] * (1.f + (ad[t] - 1.f) * ka_) * inv, bi = kkn[t] * ad[t] * inv;
            kdv[e] = ki * gall; bdv[e] = -bi * gall; vb4[e] = (vp[t >> 1] >> (16 * (t & 1))) & 0xffffu;
            KgR[tau * 72 + j] = f2bf(kg); RgR[tau * 72 + j] = f2bf(rg); KiR[tau * 72 + j] = f2bf(ki); BiR[tau * 72 + j] = f2bf(bi);
            KgT[(g * 64 + j) * 4 + e] = f2bf(kg); RgT[j * 20 + tau] = rg; VT[(g * 64 + j) * 4 + e] = (bf16)vb4[e];
        }
        u32x4 w; w.x = pk2(kdv[0], kdv[1]); w.y = pk2(kdv[2], kdv[3]); w.z = pk2(bdv[0], bdv[1]); w.w = pk2(bdv[2], bdv[3]);
        *(u32x4*)(ops + OPS_KDBD + (((j >> 4) * 64 + (j & 15) + 16 * g) * 16)) = w;
        u32x2 vw; vw.x = vb4[0] | (vb4[1] << 16); vw.y = vb4[2] | (vb4[3] << 16);
        *(u32x2*)(ops + OPS_VIMG + (((j >> 4) * 64 + (j & 15) + 16 * g) * 8)) = vw;
    }
    wave_lds_sync();
    f32x4 akk = {0.f, 0.f, 0.f, 0.f}, akb = akk, ark = akk, arb = akk;
#pragma unroll
    for (int ks = 0; ks < 2; ++ks) {
        const bf16x8 fki = *(const LAS bf16x8*)(KiR + lr * 72 + 32 * ks + 8 * lg), fbi = *(const LAS bf16x8*)(BiR + lr * 72 + 32 * ks + 8 * lg);
        const bf16x8 fkg = *(const LAS bf16x8*)(KgR + lr * 72 + 32 * ks + 8 * lg), frg = *(const LAS bf16x8*)(RgR + lr * 72 + 32 * ks + 8 * lg);
        akk = mfma16(fki, fkg, akk); akb = mfma16(fbi, fkg, akb); ark = mfma16(fki, frg, ark); arb = mfma16(fbi, frg, arb);
    }
#pragma unroll
    for (int e = 0; e < 4; ++e) { const int s = 4 * lg + e; if (!(s < lr)) { akk[e] = 0.f; akb[e] = 0.f; } if (!(s <= lr)) { ark[e] = 0.f; arb[e] = 0.f; } }
    asm volatile("" : "+v"(akk), "+v"(akb), "+v"(ark), "+v"(arb));
    wave_lds_sync();
    *(LAS f32x4*)(NL + lr * 16 + 4 * lg) = akb;
    wave_lds_sync();
    {
        float Tc[16];
#pragma unroll
        for (int t = 0; t < 16; ++t) {
            float acc = (t == lr) ? 1.f : 0.f;
#pragma unroll
            for (int q4 = 0; q4 < (t + 3) / 4; ++q4) { const f32x4 nv = *(const LAS f32x4*)(NL + t * 16 + 4 * q4);
#pragma unroll
                for (int e = 0; e < 4; ++e) if (4 * q4 + e < t) acc -= nv[e] * Tc[4 * q4 + e]; }
            Tc[t] = acc;
        }
        if (lg == 0) {
#pragma unroll
            for (int t = 0; t < 16; ++t) TL[t * 16 + lr] = Tc[t];
        }
    }
    wave_lds_sync();
    const bf16x8 aT = frag_lo(*(const LAS f32x4*)(TL + lr * 16 + 4 * lg));
    const bf16x8 aKK = frag_lo(akk), aRK = frag_lo(ark), aRBn = frag_lo(-arb);
    const f32x4 z4 = {0.f, 0.f, 0.f, 0.f};
#pragma unroll
    for (int it = 0; it < 4; ++it) {
        const u32x2 vq = *(const LAS u32x2*)(VT + (lg * 64 + 16 * it + lr) * 4);
        const bf16x8 bV = __builtin_bit_cast(bf16x8, (u32x4){vq.x, vq.y, 0u, 0u});
        const f32x4 x1 = mfma16(aKK, bV, z4);
        const f32x4 vd = mfma16(aT, frag_lo(x1), z4);
        f32x4 yl = mfma16(aRK, bV, z4); yl = mfma16(aRBn, frag_lo(vd), yl);
        *(u32x2*)(ops + OPS_CINIT + ((0 * 4 + it) * 64 + lane) * 8) = pk4(vd);
        *(u32x2*)(ops + OPS_CINIT + ((1 * 4 + it) * 64 + lane) * 8) = pk4(yl);
    }
#pragma unroll
    for (int jt = 0; jt < 4; ++jt) {
        const u32x2 kq = *(const LAS u32x2*)(KgT + (lg * 64 + 16 * jt + lr) * 4);
        const bf16x8 bK = __builtin_bit_cast(bf16x8, (u32x4){kq.x, kq.y, 0u, 0u});
        const f32x4 kgp = mfma16(aT, bK, z4);
        const f32x4 rgp = mfma16(aRBn, frag_lo(kgp), *(const LAS f32x4*)(RgT + (16 * jt + lr) * 20 + 4 * lg));
        bf16* img = (bf16*)(ops + OPS_KGRG);
#pragma unroll
        for (int e = 0; e < 4; ++e) { const int t = 4 * lg + e; const int off = (((jt >> 1)) * 64 + t + 16 * (lr >> 2)) * 8 + 4 * (jt & 1) + (lr & 3);
            img[off] = f2bf(kgp[e]); img[2 * 64 * 8 + off] = f2bf(rgp[e]); }
    }
    wave_lds_sync();
}

__device__ __forceinline__ void phase_wkv_front(const Args& a, LAS unsigned char* lds, int bid, int G) {
    int tid = threadIdx.x; asm volatile("" : "+v"(tid));
    const int lane = tid & 63, wave = __builtin_amdgcn_readfirstlane(tid >> 6);
    constexpr int AST = 392;
    typedef const __attribute__((address_space(1))) bf16* gcb;
    const bf16* FB = (const bf16*)a.out;
    LAS bf16* act = (LAS bf16*)(lds + ACT_OFF);
    LAS unsigned char* wl = lds + wave * 18432;
    LAS float* TR = (LAS float*)wl;
    const float* mu = FIN(I_MU); const float* kvec = FIN(I_KVEC); const float* w0 = FIN(I_W0); const float* a0 = FIN(I_A0);
    bf16* AB = WSB(WS_XN); bf16* BON = WSB(WS_BONUS);
    int it_lo, it_n;
    if (G == 256) { if (bid < 160) { it_lo = 3 * bid; it_n = 3; } else if (bid < 224) { it_lo = 480 + 2 * (bid - 160); it_n = 2; } else { it_lo = 608 + (bid - 224); it_n = 1; } }
    else { it_lo = bid; it_n = (640 - bid + G - 1) / G; }
    for (int ii = 0; ii < it_n; ++ii) {
        const int item = (G == 256) ? it_lo + ii : it_lo + ii * G;
        int smp, sq, c, L, rowbase, nc;
        if (item < 128) { smp = 1; sq = item >> 6; c = item & 63; L = DSEQ; rowbase = NPR + sq * DSEQ; nc = 64; }
        else { const int p = item - 128; smp = 0; sq = p >> 4; c = p & 15; L = SEQ; rowbase = sq * SEQ; nc = 16; }
        const int row0 = rowbase + 16 * c, tp0 = 16 * c;
        __syncthreads();
        int tq = tid; asm volatile("" : "+v"(tq));
        for (int idx = tq; idx < 16 * 96; idx += 512) {
            const int tl = idx / 96, cg = idx - tl * 96, col = 1536 + 4 * cg, row = row0 + tl, tp = tp0 + tl;
            const f32x4 f = unpk4(*(const u32x2*)(FB + (size_t)row * INB + col));
            const f32x4 p = unpk4(*(const u32x2*)(FB + (size_t)(tp > 0 ? row - 1 : row) * INB + col)) * (tp > 0 ? 1.f : 0.f);
            const f32x4 n = unpk4(*(const u32x2*)(FB + (size_t)(tp < L - 1 ? row + 1 : row) * INB + col)) * (tp < L - 1 ? 1.f : 0.f);
            const f32x4 m0 = *(const f32x4*)(mu + col), m1 = *(const f32x4*)(mu + INB + col);
            f32x4 s = f + m0 * (p - f) + m1 * (n - f);
            const int kind = cg >> 5;
            if (kind == 0) { s[0] = tanhf(s[0]); s[1] = tanhf(s[1]); s[2] = tanhf(s[2]); s[3] = tanhf(s[3]); }
            else if (kind == 2) { s[0] = sigmoidf_(s[0]); s[1] = sigmoidf_(s[1]); s[2] = sigmoidf_(s[2]); s[3] = sigmoidf_(s[3]); }
            *(LAS u32x2*)(act + tl * AST + 4 * cg) = pk4(s);
        }
        __syncthreads();
        int j = lane; asm volatile("" : "+v"(j));
        const int lr = j & 15, lg = j >> 4;
        const int h = wave, col = h * 64 + j;
        auto lora_mma = [&](const bf16* WT, int ldk, int k0, int nks, f32x4 (&acc)[4]) {
            gcb wb = (gcb)(WT + (size_t)(h * 64 + lr) * ldk + 8 * lg);
            const LAS bf16* ab = act + lr * AST + k0 + 8 * lg;
            asm volatile("" : "+v"(wb), "+v"(ab));
#pragma unroll
            for (int jt = 0; jt < 4; ++jt) acc[jt] = (f32x4){0.f, 0.f, 0.f, 0.f};
            for (int ks = 0; ks < nks; ++ks) {
                const bf16x8 fa = *(const LAS bf16x8*)(ab + 32 * ks);
#pragma unroll
                for (int jt = 0; jt < 4; ++jt) { const bf16x8 fb = *(const __attribute__((address_space(1))) bf16x8*)(wb + (size_t)(16 * jt) * ldk + 32 * ks); acc[jt] = mfma16(fa, fb, acc[jt]); }
            }
        };
        auto tr_put = [&](int b, const f32x4 (&acc)[4]) {
#pragma unroll
            for (int jt = 0; jt < 4; ++jt) *(LAS f32x4*)(TR + b * 1280 + (16 * jt + lr) * 20 + 4 * lg) = acc[jt];
        };
        auto tr_get = [&](int b, float (&out)[16]) {
#pragma unroll
            for (int q = 0; q < 4; ++q) { const f32x4 x = *(const LAS f32x4*)(TR + b * 1280 + j * 20 + 4 * q); out[4 * q] = x[0]; out[4 * q + 1] = x[1]; out[4 * q + 2] = x[2]; out[4 * q + 3] = x[3]; }
        };
        f32x4 accG[4], accA0[4], accA1[4], accW0[4];
        lora_mma(WSB(WS_G2T), 128, 256, 4, accG);
        lora_mma(WSB(WS_A2T), 64, 128, 2, accA0);
        lora_mma(WSB(WS_A2T) + 512 * 64, 64, 192, 2, accA1);
        lora_mma(WSB(WS_W2T), 64, 0, 2, accW0);
        float r[16], k[16]; unsigned vp[8];
        {
            unsigned raw[3][18]; float v[16];
#pragma unroll
            for (int x = 0; x < 3; ++x)
#pragma unroll
                for (int q = 0; q < 18; ++q) { const int tp = tp0 - 1 + q; const int rw = row0 - 1 + q + (tp < 0 ? 1 : 0) - (tp > L - 1 ? 1 : 0); raw[x][q] = FB[(size_t)rw * INB + 512 * x + col]; }
            const float pm = tp0 > 0 ? 1.f : 0.f, nm = tp0 + 16 < L ? 1.f : 0.f;
            const float mr0 = mu[col], mr1 = mu[INB + col], mk0 = mu[512 + col], mk1 = mu[INB + 512 + col], mv0 = mu[1024 + col], mv1 = mu[INB + 1024 + col];
#pragma unroll
            for (int t = 0; t < 16; ++t) {
                const float pmask = t == 0 ? pm : 1.f, nmask = t == 15 ? nm : 1.f;
                { const float f = bf2f(raw[0][t + 1]), p = bf2f(raw[0][t]) * pmask, n = bf2f(raw[0][t + 2]) * nmask; r[t] = f + mr0 * (p - f) + mr1 * (n - f); }
                { const float f = bf2f(raw[1][t + 1]), p = bf2f(raw[1][t]) * pmask, n = bf2f(raw[1][t + 2]) * nmask; k[t] = f + mk0 * (p - f) + mk1 * (n - f); }
                { const float f = bf2f(raw[2][t + 1]), p = bf2f(raw[2][t]) * pmask, n = bf2f(raw[2][t + 2]) * nmask; v[t] = f + mv0 * (p - f) + mv1 * (n - f); }
            }
#pragma unroll
            for (int q = 0; q < 8; ++q) vp[q] = pk2(v[2 * q], v[2 * q + 1]);
        }
        float av0[16], av1[16];
        {
            float graw[16];
            tr_put(0, accG); tr_put(1, accA0); tr_put(2, accA1);
            wave_lds_sync();
            tr_get(0, graw); tr_get(1, av0); tr_get(2, av1);
            wave_lds_sync();
#pragma unroll
            for (int t = 0; t < 16; ++t) AB[(size_t)(row0 + t) * 1024 + 512 + col] = f2bf(graw[t]);
        }
        float wv0[16];
        {
            tr_put(0, accW0);
            wave_lds_sync();
            tr_get(0, wv0);
            wave_lds_sync();
            const float w00 = w0[col];
#pragma unroll
            for (int t = 0; t < 16; ++t) wv0[t] = __expf(-0.60653065971f * sigmoidf_(w00 + wv0[t]));
        }
        const float kk_ = kvec[col], ka_ = kvec[512 + col], rk_ = kvec[1024 + col], a00 = a0[col], a01 = a0[512 + col];
        float kkn[16];
        {
            LAS float* RED1 = (LAS float*)wl; LAS float* RED2 = RED1 + 64 * 17; LAS float* TOT = RED2 + 64 * 17;
#pragma unroll
            for (int t = 0; t < 16; ++t) {
                av0[t] = sigmoidf_(a00 + av0[t]); av1[t] = sigmoidf_(a01 + av1[t]);
                const float kr = k[t] * kk_; kkn[t] = kr;
                RED1[j * 17 + t] = kr * kr; RED2[j * 17 + t] = r[t] * rk_ * k[t] * (2.f + (av0[t] + av1[t] - 2.f) * ka_);
            }
            wave_lds_sync();
            float s1 = 0.f, s2 = 0.f;
#pragma unroll
            for (int jj = 0; jj < 16; ++jj) { s1 += RED1[(16 * lg + jj) * 17 + lr]; s2 += RED2[(16 * lg + jj) * 17 + lr]; }
            s1 = allred4(s1); s2 = allred4(s2);
            if (lg == 0) { TOT[lr] = rsqrtf(s1 + 1e-12f); TOT[16 + lr] = s2; }
            wave_lds_sync();
#pragma unroll
            for (int q = 0; q < 4; ++q) { const f32x4 ri = *(const LAS f32x4*)(TOT + 4 * q), rs = *(const LAS f32x4*)(TOT + 16 + 4 * q);
#pragma unroll
                for (int e = 0; e < 4; ++e) { const int t = 4 * q + e; kkn[t] *= ri[e]; BON[(size_t)(row0 + t) * 512 + col] = f2bf(rs[e] * __uint_as_float((t & 1) ? (vp[t >> 1] & 0xffff0000u) : (vp[t >> 1] << 16))); } }
            wave_lds_sync();
        }
        {
            const int oi = smp ? 4096 + (sq * 8 + h) * 64 + c : (sq * 8 + h) * 16 + c;
            wkv_chunk_ops<false>(a.ws + WS_OPS + (size_t)oi * OPS_ITEM, wl, lane, kkn, wv0, k, av0, ka_, r, vp);
        }
        {
            float wv1[16];
            { f32x4 accW1[4]; lora_mma(WSB(WS_W2T) + 512 * 64, 64, 64, 2, accW1); tr_put(0, accW1); wave_lds_sync(); tr_get(0, wv1); wave_lds_sync();
              const float w01 = w0[512 + col];
#pragma unroll
              for (int t = 0; t < 16; ++t) wv1[t] = __expf(-0.60653065971f * sigmoidf_(w01 + wv1[t])); }
            const int cc = nc - 1 - c;
            const int oi = 5120 + (smp ? 4096 + (sq * 8 + h) * 64 + cc : (sq * 8 + h) * 16 + cc);
            wkv_chunk_ops<true>(a.ws + WS_OPS + (size_t)oi * OPS_ITEM, wl, lane, kkn, wv1, k, av1, ka_, r, vp);
        }
    }
}

struct ChainOps { bf16x8 kgrg[2][2]; u32x2 cinit[2]; bf16x8 kdbd[4]; u32x2 vimg; f32x4 gam[4]; };
__device__ __forceinline__ void chain_load(ChainOps& o, const unsigned char* ops, int lane, int it) {
    const int lg = lane >> 4;
#pragma unroll
    for (int rt = 0; rt < 2; ++rt) {
#pragma unroll
        for (int ks = 0; ks < 2; ++ks) o.kgrg[rt][ks] = *(const bf16x8*)(ops + OPS_KGRG + ((rt * 2 + ks) * 64 + lane) * 16);
        o.cinit[rt] = *(const u32x2*)(ops + OPS_CINIT + ((rt * 4 + it) * 64 + lane) * 8);
    }
#pragma unroll
    for (int jt = 0; jt < 4; ++jt) { o.kdbd[jt] = *(const bf16x8*)(ops + OPS_KDBD + (jt * 64 + lane) * 16); o.gam[jt] = *(const f32x4*)(ops + OPS_GAM + (16 * jt + 4 * lg) * 4); }
    o.vimg = *(const u32x2*)(ops + OPS_VIMG + (it * 64 + lane) * 8);
}
__device__ __forceinline__ void wkv_sample_wave(const Args& a, LAS float* ybuf, int idx, int lane) {
    const int lr = lane & 15, lg = lane >> 4;
    const int dir = idx >> 6, ch = (idx >> 2) & 15, it = idx & 3;
    const int b = ch >> 3, h = ch & 7, nc = 64, L = DSEQ, rowbase = NPR + b * DSEQ, opsbase = 4096 + ch * 64;
    float* Y = a.out;
    f32x4 H[4];
    { const float* sp = FIN(I_ST) + (size_t)((b * 2 + dir) * 8 + h) * 4096;
#pragma unroll
      for (int jt = 0; jt < 4; ++jt) H[jt] = *(const f32x4*)(sp + (16 * it + lr) * 64 + 16 * jt + 4 * lg); }
    const unsigned char* opsp = a.ws + WS_OPS + (size_t)(dir * 5120 + opsbase) * OPS_ITEM;
    float* yg = Y + ((size_t)dir * NT + rowbase) * 512 + h * 64 + 16 * it + 4 * (lane & 3);
    ChainOps o0, o1;
    chain_load(o0, opsp, lane, it);
    chain_load(o1, opsp + OPS_ITEM, lane, it);
    auto step = [&](const ChainOps& cur, int c) {
        bf16x8 bh[2];
#pragma unroll
        for (int ks = 0; ks < 2; ++ks) { const u32x2 p0 = pk4(H[2 * ks]), p1 = pk4(H[2 * ks + 1]); bh[ks] = __builtin_bit_cast(bf16x8, (u32x4){p0.x, p0.y, p1.x, p1.y}); }
        f32x4 u = unpk4(cur.cinit[0]), y = unpk4(cur.cinit[1]);
#pragma unroll
        for (int ks = 0; ks < 2; ++ks) { u = mfma16(cur.kgrg[0][ks], bh[ks], u); y = mfma16(cur.kgrg[1][ks], bh[ks], y); }
#pragma unroll
        for (int e = 0; e < 4; ++e) ybuf[(16 * (c & 15) + 4 * lg + e) * 16 + lr] = y[e];
        const u32x2 up = pk4(u);
        const bf16x8 bvu = __builtin_bit_cast(bf16x8, (u32x4){cur.vimg.x, cur.vimg.y, up.x, up.y});
#pragma unroll
        for (int jt = 0; jt < 4; ++jt) H[jt] = mfma16(cur.kdbd[jt], bvu, H[jt] * cur.gam[jt]);
    };
    auto flush = [&](int c) {
        if ((c & 15) == 15) {
            asm volatile("s_waitcnt lgkmcnt(0)" ::: "memory");
            const int base = 256 * (c >> 4);
#pragma unroll 1
            for (int r0 = 0; r0 < 256; r0 += 16) { const int lt = base + r0 + (lane >> 2);
                *(f32x4*)(yg + (size_t)(dir ? L - 1 - lt : lt) * 512) = *(const LAS f32x4*)(ybuf + (r0 + (lane >> 2)) * 16 + 4 * (lane & 3)); }
            asm volatile("s_waitcnt lgkmcnt(0)" ::: "memory");
        }
    };
    ChainOps o2; chain_load(o2, opsp + 2 * OPS_ITEM, lane, it);
    int c = 0;
#pragma unroll 1
    for (; c + 2 < nc; c += 3) {
        step(o0, c); chain_load(o0, opsp + (size_t)(c + 3 < nc ? c + 3 : nc - 1) * OPS_ITEM, lane, it); flush(c);
        step(o1, c + 1); chain_load(o1, opsp + (size_t)(c + 4 < nc ? c + 4 : nc - 1) * OPS_ITEM, lane, it); flush(c + 1);
        step(o2, c + 2); chain_load(o2, opsp + (size_t)(c + 5 < nc ? c + 5 : nc - 1) * OPS_ITEM, lane, it); flush(c + 2);
    }
    for (; c < nc; ++c) { step(o0, c); flush(c); }
    asm volatile("s_waitcnt vmcnt(0) lgkmcnt(0)" ::: "memory");
}

struct ChainSh { bf16x8 kg, kd; float gm; };
struct ChainPr { u32x2 ci0, ci1, vi; };
__device__ __forceinline__ void chain_sh(ChainSh& o, const unsigned char* ops, int lane, int it) {
    o.kg = *(const bf16x8*)(ops + OPS_KGRG + (it * 64 + lane) * 16);
    o.kd = *(const bf16x8*)(ops + OPS_KDBD + (it * 64 + lane) * 16);
    o.gm = *(const float*)(ops + OPS_GAM + (16 * it + (lane & 15)) * 4);
}
__device__ __forceinline__ void chain_pr(ChainPr& o, const unsigned char* ops, int lane, int it) {
    o.ci0 = *(const u32x2*)(ops + OPS_CINIT + ((0 * 4 + it) * 64 + lane) * 8);
    o.ci1 = *(const u32x2*)(ops + OPS_CINIT + ((1 * 4 + it) * 64 + lane) * 8);
    o.vi = *(const u32x2*)(ops + OPS_VIMG + (it * 64 + lane) * 8);
}
template <bool DRY = false>
__device__ __forceinline__ void phase_wkv_chain(const Args& a, LAS unsigned char* lds, int bid, int G) {
    int tid = threadIdx.x; asm volatile("" : "+v"(tid));
    const int lane = tid & 63, wave = __builtin_amdgcn_readfirstlane(tid >> 6);
    const int lr = lane & 15, lg = lane >> 4;
    float* Y = a.out;
    LAS float* ybuf = (LAS float*)(lds + wave * 16384);
    const int dir = wave >> 2, it = wave & 3;
    LAS unsigned char* slot = lds + 131072 + dir * 8448;
    const bf16* BON = WSB(WS_BONUS); bf16* AB = WSB(WS_XN);
    const float* lnx = FIN(I_LNX);
    if (G == 256 && bid < 128) {
        if (wave == 0) wkv_sample_wave(a, (LAS float*)lds, bid, lane);
        return;
    }
#pragma unroll 1
    for (int jrep = 0; ; ++jrep) {
        int k;
        if (G == 256) { if (jrep < 2) k = 16 + 2 * (bid - 128) + jrep; else break; }
        else { k = bid + jrep * G; if (k >= 272) break; }
        int smp, b, h, nc, L, rowbase, opsbase;
        if (k < 16) { smp = 1; b = k >> 3; h = k & 7; nc = 64; L = DSEQ; rowbase = NPR + b * DSEQ; opsbase = 4096 + k * 64; }
        else { const int p = k - 16; smp = 0; b = p >> 3; h = p & 7; nc = 16; L = SEQ; rowbase = b * SEQ; opsbase = p * 16; }
        f32x4 H[4];
        if (smp) {
            const float* sp = FIN(I_ST) + (size_t)((b * 2 + dir) * 8 + h) * 4096;
#pragma unroll
            for (int jt = 0; jt < 4; ++jt) H[jt] = *(const f32x4*)(sp + (16 * it + lr) * 64 + 16 * jt + 4 * lg);
        } else {
#pragma unroll
            for (int jt = 0; jt < 4; ++jt) H[jt] = (f32x4){0.f, 0.f, 0.f, 0.f};
        }
        const unsigned char* opsp = a.ws + WS_OPS + (size_t)(dir * 5120 + opsbase) * OPS_ITEM;
        float* yg = Y + ((size_t)dir * NT + rowbase) * 512 + h * 64 + 16 * it + 4 * (lane & 3);
        constexpr int D = 8;
        ChainSh sh[D]; ChainPr pr[D];
#pragma unroll
        for (int i = 0; i < D; ++i) { chain_sh(sh[i], opsp + (size_t)i * OPS_ITEM, lane, it); chain_pr(pr[i], opsp + (size_t)i * OPS_ITEM, lane, it); }
        auto put = [&](const ChainSh& o) {
            *(LAS bf16x8*)(slot + it * 1024 + lane * 16) = o.kg; *(LAS bf16x8*)(slot + 4096 + it * 1024 + lane * 16) = o.kd;
            if (lane < 16) *(LAS float*)(slot + 8192 + (16 * it + lane) * 4) = o.gm; };
        put(sh[0]);
        chain_sh(sh[0], opsp + (size_t)(D < nc ? D : nc - 1) * OPS_ITEM, lane, it);
        asm volatile("s_waitcnt lgkmcnt(0)" ::: "memory"); __builtin_amdgcn_s_barrier(); asm volatile("" ::: "memory");
#pragma unroll 1
        for (int c = 0; c < nc; c += D) {
#pragma unroll
            for (int i = 0; i < D; ++i) {
                const int cc = c + i;
                bf16x8 kgrg[2][2], kdbd[4]; f32x4 gam[4];
#pragma unroll
                for (int q = 0; q < 4; ++q) { kgrg[q >> 1][q & 1] = *(const LAS bf16x8*)(slot + q * 1024 + lane * 16); kdbd[q] = *(const LAS bf16x8*)(slot + 4096 + q * 1024 + lane * 16); gam[q] = *(const LAS f32x4*)(slot + 8192 + (16 * q + 4 * lg) * 4); }
                asm volatile("s_waitcnt lgkmcnt(0)" ::: "memory"); __builtin_amdgcn_s_barrier(); asm volatile("" ::: "memory");
                put(sh[(i + 1) % D]);
                chain_sh(sh[(i + 1) % D], opsp + (size_t)(cc + 1 + D < nc ? cc + 1 + D : nc - 1) * OPS_ITEM, lane, it);
                const u32x2 c0 = pr[i].ci0, c1 = pr[i].ci1, cv = pr[i].vi;
                bf16x8 bh[2];
#pragma unroll
                for (int ks = 0; ks < 2; ++ks) { const u32x2 p0 = pk4(H[2 * ks]), p1 = pk4(H[2 * ks + 1]); bh[ks] = __builtin_bit_cast(bf16x8, (u32x4){p0.x, p0.y, p1.x, p1.y}); }
                f32x4 u = unpk4(c0), y = unpk4(c1);
#pragma unroll
                for (int ks = 0; ks < 2; ++ks) { u = mfma16(kgrg[0][ks], bh[ks], u); y = mfma16(kgrg[1][ks], bh[ks], y); }
#pragma unroll
                for (int e = 0; e < 4; ++e) ybuf[(16 * (cc & 15) + 4 * lg + e) * 16 + lr] = y[e];
                const u32x2 up = pk4(u);
                const bf16x8 bvu = __builtin_bit_cast(bf16x8, (u32x4){cv.x, cv.y, up.x, up.y});
#pragma unroll
                for (int jt = 0; jt < 4; ++jt) H[jt] = mfma16(kdbd[jt], bvu, H[jt] * gam[jt]);
                chain_pr(pr[i], opsp + (size_t)(cc + D < nc ? cc + D : nc - 1) * OPS_ITEM, lane, it);
                if (smp && (cc & 15) == 15) {
                    asm volatile("s_waitcnt lgkmcnt(0)" ::: "memory");
                    const int base = 256 * (cc >> 4);
#pragma unroll 1
                    for (int r0 = 0; r0 < 256; r0 += 16) { const int lt = base + r0 + (lane >> 2);
                        *(f32x4*)(yg + (size_t)(dir ? L - 1 - lt : lt) * 512) = *(const LAS f32x4*)(ybuf + (r0 + (lane >> 2)) * 16 + 4 * (lane & 3)); }
                }
                asm volatile("s_waitcnt lgkmcnt(0)" ::: "memory"); __builtin_amdgcn_s_barrier(); asm volatile("" ::: "memory");
            }
        }
        if (!smp) { float* op = a.out + OUT_ST + (size_t)((b * 2 + dir) * 8 + h) * 4096;
#pragma unroll
            for (int jt = 0; jt < 4; ++jt) *(f32x4*)(op + (16 * it + lr) * 64 + 16 * jt + 4 * lg) = H[jt]; }
        asm volatile("s_waitcnt vmcnt(0) lgkmcnt(0)" ::: "memory");
        __syncthreads();
        if (smp) continue;
        {
            const int hf = tid & 1;
            const float* l0p = lnx + h * 64 + 32 * hf; const float* l1p = lnx + 512 + h * 64 + 32 * hf;
            for (int t = tid >> 1; t < L; t += 256) {
                float x[32];
#pragma unroll
                for (int q = 0; q < 8; ++q) { const int itq = 2 * hf + (q >> 2);
                    const f32x4 f = *(const LAS f32x4*)(lds + itq * 16384 + (t * 16 + 4 * (q & 3)) * 4), g = *(const LAS f32x4*)(lds + (4 + itq) * 16384 + ((L - 1 - t) * 16 + 4 * (q & 3)) * 4);
                    x[4 * q] = f[0] + g[0]; x[4 * q + 1] = f[1] + g[1]; x[4 * q + 2] = f[2] + g[2]; x[4 * q + 3] = f[3] + g[3]; }
                float s = 0.f;
#pragma unroll
                for (int e = 0; e < 32; ++e) s += x[e];
                s += __shfl_xor(s, 1);
                const float mu = s * (1.f / 64.f);
                float v = 0.f;
#pragma unroll
                for (int e = 0; e < 32; ++e) { x[e] -= mu; v += x[e] * x[e]; }
                v += __shfl_xor(v, 1);
                const float rstd = rsqrtf(v * (1.f / 64.f) + 64e-5f);
                const size_t row = (size_t)rowbase + t;
                const bf16* bp = BON + row * 512 + h * 64 + 32 * hf; bf16* gp = AB + row * 1024 + 512 + h * 64 + 32 * hf;
#pragma unroll
                for (int q = 0; q < 4; ++q) {
                    const u32x4 bw = *(const u32x4*)(bp + 8 * q), gw4 = *(const u32x4*)(gp + 8 * q);
                    const f32x4 bo0 = unpk4((u32x2){bw.x, bw.y}), bo1 = unpk4((u32x2){bw.z, bw.w}), gg0 = unpk4((u32x2){gw4.x, gw4.y}), gg1 = unpk4((u32x2){gw4.z, gw4.w});
                    const f32x4 l00 = *(const f32x4*)(l0p + 8 * q), l01 = *(const f32x4*)(l0p + 8 * q + 4), l10 = *(const f32x4*)(l1p + 8 * q), l11 = *(const f32x4*)(l1p + 8 * q + 4);
                    f32x4 o0, o1;
#pragma unroll
                    for (int e = 0; e < 4; ++e) { o0[e] = (x[8 * q + e] * rstd * l00[e] + l10[e] + bo0[e]) * gg0[e]; o1[e] = (x[8 * q + 4 + e] * rstd * l01[e] + l11[e] + bo1[e]) * gg1[e]; }
                    const u32x2 p0 = pk4(o0), p1 = pk4(o1);
                    *(u32x4*)((DRY ? (bf16*)(a.ws + 248 * MiB) + row * 512 + h * 64 + 32 * hf : gp) + 8 * q) = (u32x4){p0.x, p0.y, p1.x, p1.y};
                }
            }
        }
        __syncthreads();
    }
}

template <bool WT = false>
__device__ __forceinline__ void phase_combine(const Args& a, int bid, int G) {
    int tid = threadIdx.x; asm volatile("" : "+v"(tid));
    const int lane = tid & 63, wave = tid >> 6;
    const int gw = bid * 8 + wave, NGW = G * 8;
    const float* Y = a.out; const bf16* BON = WSB(WS_BONUS); bf16* AB = WSB(WS_XN);
    const float* lnx = FIN(I_LNX);
    const int c = lane * 8;
    constexpr int R = 1;
    for (int row0 = NPR + gw; row0 < NT; row0 += R * NGW) {
        f32x4 f0[R], f1[R], g0[R], g1[R]; u32x4 bw[R], gw4[R];
#pragma unroll
        for (int q = 0; q < R; ++q) { const int row = row0 + q * NGW; if (row < NT) {
            f0[q] = *(const f32x4*)(Y + (size_t)row * 512 + c); f1[q] = *(const f32x4*)(Y + (size_t)row * 512 + c + 4);
            g0[q] = *(const f32x4*)(Y + (size_t)(NT + row) * 512 + c); g1[q] = *(const f32x4*)(Y + (size_t)(NT + row) * 512 + c + 4);
            bw[q] = *(const u32x4*)(BON + (size_t)row * 512 + c); gw4[q] = *(const u32x4*)(AB + (size_t)row * 1024 + 512 + c); } }
        const f32x4 l00 = *(const f32x4*)(lnx + c), l01 = *(const f32x4*)(lnx + c + 4), l10 = *(const f32x4*)(lnx + 512 + c), l11 = *(const f32x4*)(lnx + 512 + c + 4);
#pragma unroll
        for (int q = 0; q < R; ++q) { const int row = row0 + q * NGW; if (row < NT) {
            float x[8];
#pragma unroll
            for (int e = 0; e < 4; ++e) { x[e] = f0[q][e] + g0[q][e]; x[4 + e] = f1[q][e] + g1[q][e]; }
            float s = 0.f;
#pragma unroll
            for (int e = 0; e < 8; ++e) s += x[e];
            s += __shfl_xor(s, 1); s += __shfl_xor(s, 2); s += __shfl_xor(s, 4);
            const float mu = s * (1.f / 64.f);
            float v = 0.f;
#pragma unroll
            for (int e = 0; e < 8; ++e) { x[e] -= mu; v += x[e] * x[e]; }
            v += __shfl_xor(v, 1); v += __shfl_xor(v, 2); v += __shfl_xor(v, 4);
            const float rstd = rsqrtf(v * (1.f / 64.f) + 64e-5f);
            const f32x4 bo0 = unpk4((u32x2){bw[q].x, bw[q].y}), bo1 = unpk4((u32x2){bw[q].z, bw[q].w}), gg0 = unpk4((u32x2){gw4[q].x, gw4[q].y}), gg1 = unpk4((u32x2){gw4[q].z, gw4[q].w});
            f32x4 o0, o1;
#pragma unroll
            for (int e = 0; e < 4; ++e) { o0[e] = (x[e] * rstd * l00[e] + l10[e] + bo0[e]) * gg0[e]; o1[e] = (x[4 + e] * rstd * l01[e] + l11[e] + bo1[e]) * gg1[e]; }
            const u32x2 p0 = pk4(o0), p1 = pk4(o1);
            const u32x4 ov = {p0.x, p0.y, p1.x, p1.y};
            if (WT) {
                bf16* dst = AB + (size_t)row * 1024 + 512 + c;
                asm volatile("global_store_dwordx4 %0, %1, off sc0 sc1" :: "v"(dst), "v"(ov) : "memory");
                asm volatile("s_waitcnt vmcnt(0)" ::: "memory");
                if (lane == 0) __hip_atomic_fetch_add((unsigned*)(a.ws + WS_PCNT) + (row / 160) * 16, 1u, __ATOMIC_RELAXED, __HIP_MEMORY_SCOPE_AGENT);
            } else *(u32x4*)(AB + (size_t)row * 1024 + 512 + c) = ov;
        } }
    }
}

__device__ __forceinline__ void phase_chdft(const Args& a, LAS unsigned char* lds, int bid, int G) {
    int tid = threadIdx.x; asm volatile("" : "+v"(tid));
    const int lane = tid & 63, wave = tid >> 6, tk = lane & 31, hh = lane >> 5;
    const int gw = bid * 8 + wave, NGW = G * 8;
    constexpr int WST = 136;
    LAS bf16* Wd = (LAS bf16*)lds;
    const bf16* WDFT = WSB(WS_WDFT); const bf16* XN = WSB(WS_XN);
    __syncthreads();
    for (int i = tid; i < 256 * 16; i += 512) { const int r = i >> 4, c8 = i & 15; *(LAS u32x4*)(Wd + r * WST + 8 * c8) = *(const u32x4*)(WDFT + r * 128 + 8 * c8); }
    __syncthreads();
    for (int it8 = gw; it8 < 1024; it8 += NGW) {
        const int it = it8 >> 3, mtp2 = it8 & 7;
        const int b = it >> 6, g = (it >> 3) & 7, lt = it & 7, l2 = 32 * lt + tk;
        float twc[4], tws[4]; twc[0] = 1.f; tws[0] = 0.f;
#pragma unroll
        for (int p = 1; p < 4; ++p) { const float x = (float)(l2 * p) * (2.0f / 1024.0f); twc[p] = cospif(x); tws[p] = sinpif(x); }
        const bf16* xin = XN + (size_t)(NPR + b * 1024 + 32 * lt + tk) * 1024 + g * 128 + 8 * hh;
        bf16* zt = WSB(WS_YTS) + (size_t)b * 4 * 1024 * 512 + (size_t)(g * 128 + 4 * hh) * 512 + l2;
        {
            const int mtp = mtp2 >> 1, ph = mtp2 & 1;
            f32x16 Zr[2], Zi[2];
#pragma unroll
            for (int p = 0; p < 2; ++p)
#pragma unroll
                for (int r = 0; r < 16; ++r) { Zr[p][r] = 0.f; Zi[p][r] = 0.f; }
#pragma unroll
            for (int l1 = 0; l1 < 4; ++l1) {
                f32x16 yc, ys;
#pragma unroll
                for (int r = 0; r < 16; ++r) { yc[r] = 0.f; ys[r] = 0.f; }
#pragma unroll
                for (int s = 0; s < 8; ++s) {
                    const bf16x8 hbv = *(const bf16x8*)(xin + (size_t)(256 * l1) * 1024 + 16 * s);
                    const bf16x8 ac = *(const LAS bf16x8*)(Wd + (32 * mtp + tk) * WST + 16 * s + 8 * hh), as = *(const LAS bf16x8*)(Wd + (128 + 32 * mtp + tk) * WST + 16 * s + 8 * hh);
                    yc = mfma32(ac, hbv, yc); ys = mfma32(as, hbv, ys);
                }
                if (ph == 0) { Zr[0] += yc; Zi[0] -= ys; if (l1 & 1) { Zr[1] -= yc; Zi[1] += ys; } else { Zr[1] += yc; Zi[1] -= ys; } }
                else {
                    if (l1 == 0) { Zr[0] += yc; Zi[0] -= ys; Zr[1] += yc; Zi[1] -= ys; }
                    else if (l1 == 1) { Zr[0] -= ys; Zi[0] -= yc; Zr[1] += ys; Zi[1] += yc; }
                    else if (l1 == 2) { Zr[0] -= yc; Zi[0] += ys; Zr[1] -= yc; Zi[1] += ys; }
                    else { Zr[0] += ys; Zi[0] += yc; Zr[1] -= ys; Zi[1] -= yc; }
                }
                asm volatile("" : "+v"(Zr[0]), "+v"(Zi[0]), "+v"(Zr[1]), "+v"(Zi[1]));
            }
            typedef __attribute__((address_space(1))) bf16* gbp;
#pragma unroll
            for (int pi = 0; pi < 2; ++pi) {
                const int p = ph + 2 * pi;
                const float c = 0.5f * (p == 0 ? twc[0] : p == 1 ? twc[1] : p == 2 ? twc[2] : twc[3]), s = 0.5f * (p == 0 ? tws[0] : p == 1 ? tws[1] : p == 2 ? tws[2] : tws[3]);
#pragma unroll
                for (int rq = 0; rq < 4; ++rq) {
                    gbp pp = (gbp)(zt + (size_t)p * 1024 * 512 + (size_t)(32 * mtp + 8 * rq) * 512);
                    asm volatile("" : "+v"(pp));
#pragma unroll
                    for (int e = 0; e < 4; ++e) { const float zr = Zr[pi][4 * rq + e], zi = Zi[pi][4 * rq + e];
                        pp[(size_t)e * 512] = f2bf(zr * c + zi * s); pp[(size_t)e * 512 + 256] = f2bf(zr * s - zi * c); }
                }
            }
        }
    }
    for (int it2 = gw; it2 < (NPR / 32) * 16; it2 += NGW) {
        const int it = it2 >> 1, hsel = it2 & 1;
        const int r0 = (it >> 3) * 32, g = it & 7;
        bf16x8 hb[8];
#pragma unroll
        for (int s = 0; s < 8; ++s) hb[s] = *(const bf16x8*)(XN + (size_t)(r0 + tk) * 1024 + g * 128 + 16 * s + 8 * hh);
        bf16* dst; int ld, Lh, l;
        if (r0 < NPR) { const int b = r0 >> 8; l = (r0 & 255) + tk; dst = WSB(WS_YTP) + (size_t)b * 1024 * 512; ld = 512; Lh = 256; }
        else { const int sb = (r0 - NPR) >> 10; l = ((r0 - NPR) & 1023) + tk; dst = WSB(WS_YTS) + (size_t)sb * 1024 * 2048; ld = 2048; Lh = 1024; }
#pragma unroll 1
        for (int half = hsel; half <= hsel; ++half) {
            f32x16 acc[4];
#pragma unroll
            for (int mt = 0; mt < 4; ++mt)
#pragma unroll
                for (int r = 0; r < 16; ++r) acc[mt][r] = 0.f;
#pragma unroll
            for (int s = 0; s < 8; ++s)
#pragma unroll
                for (int mt = 0; mt < 4; ++mt) { const bf16x8 af = *(const LAS bf16x8*)(Wd + (32 * (4 * half + mt) + tk) * WST + 16 * s + 8 * hh); acc[mt] = mfma32(af, hb[s], acc[mt]);
                    if (mt == 3 && (s & 1)) asm volatile("" : "+v"(acc[0]), "+v"(acc[1]), "+v"(acc[2]), "+v"(acc[3]) :: "memory"); }
            typedef __attribute__((address_space(1))) bf16* gbp;
            gbp p0 = (gbp)(dst + (size_t)(g * 128 + 4 * hh) * ld + half * Lh + l);
#pragma unroll
            for (int mt = 0; mt < 4; ++mt) {
#pragma unroll
                for (int rq = 0; rq < 4; ++rq) {
                    gbp p = p0 + (size_t)(32 * mt + 8 * rq) * ld;
                    asm volatile("" : "+v"(p));
#pragma unroll
                    for (int e = 0; e < 4; ++e) p[(size_t)e * ld] = f2bf(acc[mt][4 * rq + e]);
                }
            }
        }
    }
}

constexpr int NPHASE = 20;
__global__ void __launch_bounds__(512, 2) mk_fwd(Args a0) {
    extern __shared__ __attribute__((aligned(16))) unsigned char lds_raw[];
    LAS unsigned char* lds = (LAS unsigned char*)lds_raw;
    const int tid = threadIdx.x, bid = blockIdx.x, G = gridDim.x;
    volatile LAS unsigned* MISC = (volatile LAS unsigned*)(lds + MISC_OFF);
    if (tid < 32) MISC[tid] = 0u;
    if (tid < 29) *(LAS unsigned long long*)(lds + PTAB_OFF + 8 * tid) = (unsigned long long)(tid < 27 ? a0.in[tid] : tid == 27 ? (const void*)a0.out : (const void*)a0.ws);
    __syncthreads();
    const int ph_lo = a0.ph_lo, ph_hi = a0.ph_hi;
    unsigned char* const ws_ctl = a0.ws;
    const bool one_launch = (ph_hi - ph_lo) > 1;
    XcdBarrier bar; bar.bar = (unsigned*)(ws_ctl + WS_CTL) + 4096; bar.x = 0; bar.st = nullptr;
    if (one_launch) bar = xcd_barrier_post((unsigned*)(ws_ctl + WS_CTL) + 4096, MISC + 8);
#ifndef DUP_PHASE
#define DUP_PHASE -1
#endif
#ifndef DUP_N
#define DUP_N 2
#endif
#ifndef ONLY_PHASE
#define ONLY_PHASE -1
#endif
#define XSL(i) ((unsigned*)(a.ws + WS_XSLOT) + (size_t)(i) * 2 * 64 * 160 * 4)
#define XCN(i) ((unsigned*)(a.ws + WS_CTL) + 8192 + (i) * 2 * 64 * 16)
#define IN(k) ((ONLY_PHASE < 0 || ONLY_PHASE == (k)) && ph_lo <= (k) && (k) < ph_hi)
#define SEAM(k) do { if (IN(k) && IN((k) + 1)) xcd_barrier(bar); } while (0)
    if (IN(1)) { const Args a = load_args(lds, ph_lo, ph_hi); const float* gains = FIN(I_GAINS); phase_prep<3>(a, lds, bid, G); phase_first_norm(a, lds, bid, G, gains + 0 * 1024); } SEAM(1);
    if (IN(2)) for (int rep_ = 0; rep_ < (DUP_PHASE == 2 ? DUP_N : 1); ++rep_) { if (rep_) xcd_barrier(bar); const Args a = load_args(lds, ph_lo, ph_hi); const float* gains = FIN(I_GAINS); (void)gains;
        pg8::Gemm g{1024, 1024, 1024}; pg8::PlainOrder160 S; S.init(WSB(WS_XN), WSB(WS_WIN), NT, INE_PAD, 1024, 1024, G, bid);
        EpiProj E{WSB(WS_Q), WSB(WS_KP), WSB(WS_KS), WSB(WS_VTP), WSB(WS_VTS), (bf16*)a.out, a.out + OUT_CK, a.out + OUT_CV, WSF(WS_ROPE)};
        pg8::gemm_phase160b(lds, g, S, E);
    } SEAM(2);
    if (IN(3)) for (int rep_ = 0; rep_ < (DUP_PHASE == 3 ? DUP_N : 1); ++rep_) { if (rep_) xcd_barrier(bar); const Args a = load_args(lds, ph_lo, ph_hi); const float* gains = FIN(I_GAINS); (void)gains;
#ifndef NO_FRONT
        phase_wkv_front(a, lds, bid, G);
#endif
#ifdef DUP_FRONT
        __syncthreads(); phase_wkv_front(a, lds, bid, G);
#endif
        __syncthreads();
#ifndef NO_ATT
        phase_attention(a, lds, bid, G);
#endif
#ifdef DUP_ATT
        __syncthreads(); phase_attention(a, lds, bid, G);
#endif
    } SEAM(3);
    if (IN(4)) for (int rep_ = 0; rep_ < (DUP_PHASE == 4 ? DUP_N : 1); ++rep_) { if (rep_) xcd_barrier(bar); const Args a = load_args(lds, ph_lo, ph_hi); const float* gains = FIN(I_GAINS); (void)gains;
#if defined(DUP_P4)
        phase_wkv_chain<true>(a, lds, bid, G); phase_prep<2>(a, lds, bid, G); xcd_barrier(bar);
#elif defined(DUP_CHAIN)
        phase_wkv_chain<true>(a, lds, bid, G); xcd_barrier(bar);
#elif defined(DUP_PREP2)
        phase_prep<2>(a, lds, bid, G); xcd_barrier(bar);
#endif
        phase_wkv_chain(a, lds, bid, G);
        if (G == 256) {
            const int wv_ = __builtin_amdgcn_readfirstlane(threadIdx.x >> 6);
            if (bid < 128) phase_prep<2>(a, lds, bid, G, wv_ == 0 ? -1 : (bid * 7 + wv_ - 1) * 4, 4, 3584);
        } else phase_prep<2>(a, lds, bid, G);
    } SEAM(4);
    if (IN(6)) for (int rep_ = 0; rep_ < (DUP_PHASE == 6 ? DUP_N : 1); ++rep_) { if (rep_) xcd_barrier(bar); const Args a = load_args(lds, ph_lo, ph_hi); const float* gains = FIN(I_GAINS); (void)gains;
        phase_combine<true>(a, bid, G);
        pg8::Gemm g{1024, 1024, 1024}; pg8::PlainOrder160 S; S.init(WSB(WS_XN), WSB(WS_WO), NT, 1024, 1024, 1024, G, bid);
        {
            pg8::Unit u0;
            if (S.next(0, u0) && u0.pm * 160 + 160 > NPR) {
                const unsigned want = (unsigned)(u0.pm * 160 + 160 - (u0.pm * 160 > NPR ? u0.pm * 160 : NPR));
                if (threadIdx.x == 0) { unsigned* pc = (unsigned*)(a.ws + WS_PCNT) + u0.pm * 16; unsigned spins = 0;
                    while (__hip_atomic_load(pc, __ATOMIC_RELAXED, __HIP_MEMORY_SCOPE_AGENT) < want) { __builtin_amdgcn_s_sleep(2); if (++spins > (1u << 20)) break; } }
            }
            __syncthreads();
        }
        EpiResNorm<true, false> E{FIN(I_XP), FIN(I_XS), nullptr, WSB(WS_XB), nullptr, WSB(WS_XN), gains + 1 * 1024, gains + 2 * 1024, WSF(WS_MOD), 2048, 0, 3072, 4096, 0, XSL(0), XCN(0)}; pg8::gemm_phase160b(lds, g, S, E);
    } SEAM(6);
    if (IN(8)) for (int rep_ = 0; rep_ < (DUP_PHASE == 8 ? DUP_N : 1); ++rep_) { if (rep_) xcd_barrier(bar); const Args a = load_args(lds, ph_lo, ph_hi); const float* gains = FIN(I_GAINS); (void)gains;
        pg8::Gemm g{1024, 1024, 1024}; pg8::PlainOrder S; S.init(WSB(WS_XN), WSB(WS_WFI), NT, DFF2, 1024, 1024, G, bid);
        EpiFfnConv E{WSB(WS_ACT), FIN(I_CONVW), FIN(I_CONVB), WSF(WS_SB), (LAS float*)(lds + 131072)}; pg8::gemm_phase(lds, g, S, E);
        { const int nun = (NT / 256) * (DFF2 / 256), nfull = nun % G;
          if (nfull == 0) phase_transpose_wfi1(a, lds, bid, G); else if (bid >= nfull) phase_transpose_wfi1(a, lds, bid - nfull, G - nfull); }
    }
    SEAM(8);
    if (IN(10)) for (int rep_ = 0; rep_ < (DUP_PHASE == 10 ? DUP_N : 1); ++rep_) { if (rep_) xcd_barrier(bar); const Args a = load_args(lds, ph_lo, ph_hi); const float* gains = FIN(I_GAINS); (void)gains;
        pg8::Gemm g{DFF, DFF, DFF}; pg8::PlainOrder160 S; S.init(WSB(WS_ACT), WSB(WS_WFO), NT, 1024, DFF, DFF, G, bid);
        ffn_seam_fixup(S, 160, WSB(WS_ACT), FIN(I_CONVW), WSF(WS_SB));
        EpiResNorm<false, false> E{nullptr, nullptr, WSB(WS_XB), WSB(WS_XB), nullptr, WSB(WS_XN), gains + 3 * 1024, gains + 4 * 1024, WSF(WS_MOD), 5120, 0, 0, 1024, 1, XSL(1), XCN(1)}; pg8::gemm_phase160b(lds, g, S, E);
    } SEAM(10);
    if (IN(12)) for (int rep_ = 0; rep_ < (DUP_PHASE == 12 ? DUP_N : 1); ++rep_) { if (rep_) xcd_barrier(bar); const Args a = load_args(lds, ph_lo, ph_hi); const float* gains = FIN(I_GAINS); (void)gains; phase_chdft(a, lds, bid, G); } SEAM(12);
    if (IN(13)) for (int rep_ = 0; rep_ < (DUP_PHASE == 13 ? DUP_N : 1); ++rep_) { if (rep_) xcd_barrier(bar); const Args a = load_args(lds, ph_lo, ph_hi); const float* gains = FIN(I_GAINS); (void)gains;
        { pg8::Gemm g{512, 512, 512}; DftOrder S{G, bid, (const char*)WSB(WS_A2P), (const char*)WSB(WS_YTS), (const char*)WSB(WS_YTP)}; EpiDft E{WSB(WS_XN)}; pg8::gemm_phase(lds, g, S, E); }
    } SEAM(13);
    if (IN(14)) for (int rep_ = 0; rep_ < (DUP_PHASE == 14 ? DUP_N : 1); ++rep_) { if (rep_) xcd_barrier(bar); const Args a = load_args(lds, ph_lo, ph_hi); const float* gains = FIN(I_GAINS); (void)gains;
        pg8::Gemm g{1024, 1024, 1024}; pg8::PlainOrder160 S; S.init(WSB(WS_XN), WSB(WS_WODD), NT, 1024, 1024, 1024, G, bid);
        EpiResNorm<false, false> E{nullptr, nullptr, WSB(WS_XB), WSB(WS_XB), nullptr, WSB(WS_XN), gains + 5 * 1024, gains + 6 * 1024, WSF(WS_MOD), 2048, 1, 3072, 4096, 1, XSL(2), XCN(2)}; pg8::gemm_phase160b(lds, g, S, E);
    } SEAM(14);
    if (IN(16)) for (int rep_ = 0; rep_ < (DUP_PHASE == 16 ? DUP_N : 1); ++rep_) { if (rep_) xcd_barrier(bar); const Args a = load_args(lds, ph_lo, ph_hi); const float* gains = FIN(I_GAINS); (void)gains;
        pg8::Gemm g{1024, 1024, 1024}; pg8::PlainOrder S; S.init(WSB(WS_XN), WSB(WS_WFI) + (size_t)DFF2 * 1024, NT, DFF2, 1024, 1024, G, bid);
        EpiFfnConv E{WSB(WS_ACT), FIN(I_CONVW) + 3 * DFF, FIN(I_CONVB) + DFF, WSF(WS_SB), (LAS float*)(lds + 131072)}; pg8::gemm_phase(lds, g, S, E);
    }
    SEAM(16);
    if (IN(18)) for (int rep_ = 0; rep_ < (DUP_PHASE == 18 ? DUP_N : 1); ++rep_) { if (rep_) xcd_barrier(bar); const Args a = load_args(lds, ph_lo, ph_hi); const float* gains = FIN(I_GAINS); (void)gains;
        pg8::Gemm g{DFF, DFF, DFF}; pg8::PlainOrder160 S; S.init(WSB(WS_ACT), WSB(WS_WFO) + (size_t)1024 * DFF, NT, 1024, DFF, DFF, G, bid);
        ffn_seam_fixup(S, 160, WSB(WS_ACT), FIN(I_CONVW) + 3 * DFF, WSF(WS_SB));
        EpiResNorm<false, true> E{nullptr, nullptr, WSB(WS_XB), nullptr, a.out, nullptr, gains + 7 * 1024, nullptr, WSF(WS_MOD), 5120, 1, 0, 0, 1, XSL(3), XCN(3)}; pg8::gemm_phase160b(lds, g, S, E);
    }
#undef IN
#undef SEAM
#undef XSL
#undef XCN
}

extern "C" void kernel_launch(void* const* d_in, const int* in_sizes, int n_in, void* d_out, int out_size, void* d_ws, size_t ws_size, hipStream_t stream) {
    static int grid = 0;
    if (grid == 0) {
        if (n_in != 27 || ws_size < WS_END) { fprintf(stderr, "kernel_launch: unexpected n_in %d / ws %zu\n", n_in, ws_size); grid = -1; return; }
        int dev = 0, cus = 0;
        if (hipGetDevice(&dev) != hipSuccess || hipDeviceGetAttribute(&cus, hipDeviceAttributeMultiprocessorCount, dev) != hipSuccess) { grid = -1; return; }
        if (hipFuncSetAttribute((const void*)mk_fwd, hipFuncAttributeMaxDynamicSharedMemorySize, LDS_BYTES) != hipSuccess) { fprintf(stderr, "kernel_launch: hipFuncSetAttribute failed\n"); grid = -1; return; }
        (void)hipGetLastError();
        if (cus < 256) { fprintf(stderr, "kernel_launch: needs 256 CUs (one workgroup per CU, 256 GEMM units per fused-norm phase), found %d\n", cus); grid = -1; return; }
        grid = 256;
    }
    if (grid < 0) return;
    (void)hipMemsetAsync((char*)d_ws + WS_CTL, 0, CTL_ZERO_BYTES, stream);
    Args a{};
    for (int i = 0; i < 27; ++i) a.in[i] = d_in[i];
    a.out = (float*)d_out; a.ws = (unsigned char*)d_ws;
#if MK_N_LAUNCHES == 1
    a.ph_lo = 0; a.ph_hi = NPHASE;
    hipLaunchKernelGGL(mk_fwd, dim3(grid), dim3(512), LDS_BYTES, stream, a);
#else
    for (int ph = 0; ph < NPHASE; ++ph) { a.ph_lo = ph; a.ph_hi = ph + 1; hipLaunchKernelGGL(mk_fwd, dim3(grid), dim3(512), LDS_BYTES, stream, a); }
#endif
}
```

```cpp
#include <hip/hip_runtime.h>
#include <type_traits>
#include <cstdio>
#include <cstdint>

#ifndef MK_N_LAUNCHES
#define MK_N_LAUNCHES 1
#endif

#define LAS __attribute__((address_space(3)))
typedef unsigned short bf16;
typedef short bf16x8 __attribute__((ext_vector_type(8)));
typedef float f32x4 __attribute__((ext_vector_type(4)));
typedef float f32x2 __attribute__((ext_vector_type(2)));
typedef float f32x16 __attribute__((ext_vector_type(16)));
typedef unsigned u32x4 __attribute__((ext_vector_type(4)));
typedef unsigned u32x2 __attribute__((ext_vector_type(2)));
typedef __bf16 bf16x2_t __attribute__((ext_vector_type(2)));

constexpr int DM = 1024;
constexpr int NPR = 8192, NSA = 2048, NT = 10240;
constexpr int SEQ = 256, DSEQ = 1024, PAST = 256, LKS = 1280;
constexpr int INE = 3456, INE_PAD = 3584, INB = 1920, DFF = 2816, DFF2 = 5632;
constexpr int OUT_YP = 0, OUT_CK = 10485760, OUT_CV = 14680064, OUT_ST = 18874368;

constexpr size_t MiB = 1u << 20;
constexpr size_t WS_CTL = 252 * MiB, CTL_ZERO_BYTES = 65536 + 1310720;
constexpr size_t WS_MOD = 1 * MiB;
constexpr size_t WS_ROPE = 1 * MiB + 256 * 1024;
constexpr size_t WS_LAM = 1 * MiB + 768 * 1024;
constexpr size_t WS_WIN = 2 * MiB;
constexpr size_t WS_WO = 9 * MiB;
constexpr size_t WS_WODD = 11 * MiB;
constexpr size_t WS_WFI = 13 * MiB;
constexpr size_t WS_WFO = 35 * MiB;
constexpr size_t WS_W2T = 46 * MiB;
constexpr size_t WS_A2T = 46 * MiB + 128 * 1024;
constexpr size_t WS_G2T = 46 * MiB + 256 * 1024;
constexpr size_t WS_WDFT = 46 * MiB + 512 * 1024;
constexpr size_t WS_A2P = 46 * MiB + 768 * 1024;
constexpr size_t WS_XN = 52 * MiB;
constexpr size_t WS_MF = 72 * MiB;
constexpr size_t WS_XB = 92 * MiB;
constexpr size_t WS_BIG = 112 * MiB;
constexpr size_t WS_Q = 216 * MiB;
constexpr size_t WS_KP = 226 * MiB;
constexpr size_t WS_KS = 234 * MiB;
constexpr size_t WS_VTP = 237 * MiB;
constexpr size_t WS_VTS = 245 * MiB;
constexpr size_t WS_BONUS = 24 * MiB;
constexpr size_t WS_ACT = WS_BIG;
constexpr size_t WS_SB = 51 * MiB;
constexpr size_t WS_F32B = WS_MF;
constexpr size_t WS_YTP = WS_BIG;
constexpr size_t WS_YTS = WS_BIG + 32 * MiB;
constexpr size_t WS_MOD1 = WS_CTL + 32768;
constexpr size_t WS_PCNT = WS_CTL + 57344;
constexpr size_t WS_XSLOT = WS_CTL + 65536;
constexpr size_t WS_END = 256 * MiB;
static_assert(WS_ACT + (size_t)NT * DFF * 2 <= WS_END, "ws");

constexpr int RING_BYTES = 131072;
constexpr int ACT_OFF = 147456;
constexpr int MISC_OFF = 160256;
constexpr int PTAB_OFF = 160512;
constexpr int LDS_BYTES = 160768;

__device__ __forceinline__ unsigned pk2(float lo, float hi) { f32x2 v = {lo, hi}; bf16x2_t b = __builtin_convertvector(v, bf16x2_t); return __builtin_bit_cast(unsigned, b); }
__device__ __forceinline__ bf16 f2bf(float f) { return (bf16)(pk2(f, 0.f) & 0xffffu); }
__device__ __forceinline__ float bf2f(unsigned b) { return __uint_as_float(b << 16); }
__device__ __forceinline__ u32x2 pk4(f32x4 v) { u32x2 o; o.x = pk2(v[0], v[1]); o.y = pk2(v[2], v[3]); return o; }
__device__ __forceinline__ f32x4 unpk4(u32x2 w) { f32x4 v; v[0] = __uint_as_float(w.x << 16); v[1] = __uint_as_float(w.x & 0xffff0000u); v[2] = __uint_as_float(w.y << 16); v[3] = __uint_as_float(w.y & 0xffff0000u); return v; }
__device__ __forceinline__ float sigmoidf_(float x) { return __builtin_amdgcn_rcpf(1.f + __expf(-x)); }
__device__ __forceinline__ float wave_sum(float v) {
#pragma unroll
    for (int o = 1; o < 64; o <<= 1) v += __shfl_xor(v, o);
    return v;
}
__device__ __forceinline__ int keypos(int key) { return (key & ~12) | ((key & 4) << 1) | ((key & 8) >> 1); }

#define XB_TMO      128
#define XB_XCNT(j)  (256  + 64 * (j))
#define XB_XSUB(j)  (1280 + 64 * (j))
#define XB_XGEN(j)  (2304 + 64 * (j))
#define XB_TOP      3328
#define XB_TOPGEN   3392
#define XCD_BAR_WORDS 3456
#define XB_SPIN_CAP (1u << 20)
__device__ __forceinline__ unsigned xb_ld(unsigned* p)              { return __hip_atomic_load(p, __ATOMIC_RELAXED, __HIP_MEMORY_SCOPE_AGENT); }
__device__ __forceinline__ unsigned xb_add(unsigned* p, unsigned v) { return __hip_atomic_fetch_add(p, v, __ATOMIC_RELAXED, __HIP_MEMORY_SCOPE_AGENT); }
__device__ __forceinline__ unsigned xb_xcc_id() { return (unsigned)__builtin_amdgcn_s_getreg((3 << 11) | 20) & 0xFu; }
#define XB_SPIN(cond, bar) do { unsigned _sp = 0; while (cond) { __builtin_amdgcn_s_sleep(1); \
    if ((++_sp & 255u) == 0u) { if (xb_ld(&(bar)[XB_TMO])) break; if (_sp > XB_SPIN_CAP) { atomicAdd(&(bar)[XB_TMO], 1u); break; } } } } while (0)
struct XcdBarrier { unsigned* bar; unsigned x; volatile LAS unsigned* st; };
__device__ __forceinline__ XcdBarrier xcd_barrier_post(unsigned* bar, volatile LAS unsigned* st) {
    XcdBarrier b; b.bar = bar; b.x = xb_xcc_id(); b.st = st;
    if (threadIdx.x == 0) (void)xb_add(&bar[XB_XCNT(b.x)], 1u);
    return b;
}
__device__ __forceinline__ void xcd_barrier_complete(unsigned* bar, unsigned x, unsigned& nloc, unsigned& nx) {
    const unsigned G = gridDim.x * gridDim.y * gridDim.z;
    unsigned sum, cnt, mine, sp = 0u;
    for (;;) {
        sum = 0u; cnt = 0u; mine = 0u;
#pragma unroll
        for (unsigned j = 0; j < 16; ++j) { const unsigned c = xb_ld(&bar[XB_XCNT(j)]); sum += c; cnt += (c > 0u) ? 1u : 0u; mine = (j == x) ? c : mine; }
        if (sum == G) break;
        __builtin_amdgcn_s_sleep(1);
        if ((++sp & 255u) == 0u) { if (xb_ld(&bar[XB_TMO])) break; if (sp > XB_SPIN_CAP) { atomicAdd(&bar[XB_TMO], 1u); break; } }
    }
    nloc = mine > 0u ? mine : 1u; nx = cnt > 0u ? cnt : 1u;
}
__device__ __forceinline__ void xcd_barrier(const XcdBarrier& b) {
    asm volatile("s_waitcnt vmcnt(0)" ::: "memory");
    __syncthreads();
    if (threadIdx.x == 0) {
        unsigned* bar = b.bar;
        __builtin_amdgcn_s_waitcnt(0);
        unsigned nloc = b.st[0], nx = b.st[1];
        if (nloc == 0u) { xcd_barrier_complete(bar, b.x, nloc, nx); b.st[0] = nloc; b.st[1] = nx; }
        const unsigned old = xb_add(&bar[XB_XSUB(b.x)], 1u);
        const unsigned gen = old / nloc;
        if (old + 1u == (gen + 1u) * nloc) {
            __builtin_amdgcn_fence(__ATOMIC_RELEASE, "agent");
            asm volatile("s_waitcnt vmcnt(0)" ::: "memory");
            const unsigned og = xb_add(&bar[XB_TOP], 1u);
            const unsigned tg = og / nx;
            if (og + 1u == (tg + 1u) * nx) xb_add(&bar[XB_TOPGEN], 1u);
            else XB_SPIN(xb_ld(&bar[XB_TOPGEN]) == tg, bar);
            xb_add(&bar[XB_XGEN(b.x)], 1u);
            __builtin_amdgcn_fence(__ATOMIC_ACQUIRE, "agent");
            asm volatile("s_waitcnt vmcnt(0)" ::: "memory");
        } else {
            XB_SPIN(xb_ld(&bar[XB_XGEN(b.x)]) == gen, bar);
            __builtin_amdgcn_fence(__ATOMIC_ACQUIRE, "agent");
            asm volatile("s_waitcnt vmcnt(0)" ::: "memory");
        }
    }
    __syncthreads();
}

namespace pg8 {
constexpr int BM = 256, BK = 64, HALF = 128, HTB = HALF * BK * 2, STAGE_BYTES = 8 * HTB, NXCD = 8, WGM = 8;
__host__ __device__ __forceinline__ int lds_byte(int r, int c) { const int st = (r >> 4) * 2 + (c >> 5), rr = r & 15, cc = c & 31, ob = rr * 64 + cc * 2; return st * 1024 + (ob ^ (((ob >> 9) & 1) << 5)); }
__host__ __device__ __forceinline__ void stage_rc(int b, int& R, int& C) { const int st = b / 1024, sb = b % 1024, swz = sb ^ (((sb >> 9) & 1) << 5); R = (st >> 1) * 16 + swz / 64; C = (st & 1) * 32 + (swz % 64) / 2; }

struct Unit { int pm, pn, z; const char* a; const char* b; };
struct Gemm { int lda, ldb, K; };

struct PlainOrder {
    int nM, nN, nwg, G, c; const char* A; const char* Bt; size_t ta, tb;
    __device__ void init(const void* A_, const void* Bt_, int M, int N, int lda, int ldb, int G_, int c_) { A = (const char*)A_; Bt = (const char*)Bt_; nM = M / BM; nN = N / BM; nwg = nM * nN; G = G_; c = c_; ta = (size_t)BM * lda * 2; tb = (size_t)BM * ldb * 2; }
    __device__ __forceinline__ bool next(int i, Unit& u) const {
        const long L = (long)i * G + c; if (L >= nwg) return false;
        int wgid = (int)L; { const int q = nwg / NXCD, r = nwg % NXCD, xcd = wgid % NXCD, off = wgid / NXCD; wgid = (xcd < r ? xcd * (q + 1) : r * (q + 1) + (xcd - r) * q) + off; }
        const int nig = WGM * nN, gid = wgid / nig, fm = gid * WGM, gsz = (nM - fm) < WGM ? (nM - fm) : WGM;
        u.pm = fm + ((wgid % nig) % gsz); u.pn = (wgid % nig) / gsz; u.z = 0;
        u.a = A + (size_t)u.pm * ta; u.b = Bt + (size_t)u.pn * tb; return true;
    }
};

template <class F> __device__ __forceinline__ void epi_each(const f32x4 (&acc)[2][2][4][2], int row0, int col0, F&& f) {
#pragma unroll
    for (int ai = 0; ai < 2; ++ai)
#pragma unroll
        for (int m = 0; m < 4; ++m)
#pragma unroll
            for (int bj = 0; bj < 2; ++bj)
#pragma unroll
                for (int n = 0; n < 2; ++n) f(row0 + ai * HALF + m * 16, col0 + bj * HALF + n * 16, acc[ai][bj][m][n]);
}

template <class Epi, class Sched>
__device__ __forceinline__ void gemm_phase(LAS unsigned char* lds, const Gemm g, const Sched& S, const Epi& E) {
    int tid = threadIdx.x; asm volatile("" : "+v"(tid));
    const int wid = __builtin_amdgcn_readfirstlane(tid >> 6), lane = tid & 63, wr = wid >> 2, wc = wid & 3, fr = lane & 15, fq = lane >> 4;
    const int K = g.K, nt = K / BK;
    unsigned voffA[2], voffB[2];
#pragma unroll
    for (int i = 0; i < 2; ++i) { int R, C; stage_rc(tid * 16 + i * 8192, R, C); voffA[i] = (unsigned)(R * g.lda + C) * 2u; voffB[i] = (unsigned)(R * g.ldb + C) * 2u; }
    const size_t kstep = (size_t)(BK * 2);
    const size_t hstepA = (size_t)HALF * g.lda * 2, hstepB = (size_t)HALF * g.ldb * 2;
    const unsigned ldsw = (unsigned)wid * 1024u;
    const int aoff = lds_byte(wr * 64 + fr, fq * 8), boff = lds_byte(wc * 32 + fr, fq * 8);
#define PG8_SA(b, h) (((b) * 2 + (h)) * HTB)
#define PG8_SB(b, h) ((4 + (b) * 2 + (h)) * HTB)
#define PG8_STAGE(bufoff, gbase, voff) do { _Pragma("unroll") for (int _i = 0; _i < 2; ++_i) \
        __builtin_amdgcn_global_load_lds((const unsigned*)((const char*)(gbase) + (voff)[_i]), (LAS unsigned*)(lds + (bufoff) + ldsw + _i * 8192), 16, 0, 0); } while (0)
#define PG8_LDA(dst, b, h) do { _Pragma("unroll") for (int m = 0; m < 4; ++m) _Pragma("unroll") for (int k = 0; k < 2; ++k) dst[m][k] = *(const LAS bf16x8*)(lds + PG8_SA(b, h) + aoff + m * 2048 + k * 1024); } while (0)
#define PG8_LDB(dst, b, h) do { _Pragma("unroll") for (int n = 0; n < 2; ++n) _Pragma("unroll") for (int k = 0; k < 2; ++k) dst[n][k] = *(const LAS bf16x8*)(lds + PG8_SB(b, h) + boff + n * 2048 + k * 1024); } while (0)
#define PG8_MMA(ai, bj, At, Bt) do { __builtin_amdgcn_s_setprio(1); _Pragma("unroll") for (int m = 0; m < 4; ++m) _Pragma("unroll") for (int n = 0; n < 2; ++n) _Pragma("unroll") for (int k = 0; k < 2; ++k) \
        acc[ai][bj][m][n] = __builtin_amdgcn_mfma_f32_16x16x32_bf16(Bt[n][k], At[m][k], acc[ai][bj][m][n], 0, 0, 0); __builtin_amdgcn_s_setprio(0); } while (0)
#define PG8_WAIT_V(n) asm volatile("s_waitcnt vmcnt(" #n ")" ::: "memory")
#define PG8_WAIT_L(n) asm volatile("s_waitcnt lgkmcnt(" #n ")" ::: "memory")
#define PG8_BAR __builtin_amdgcn_s_barrier()
#define PG8_SCHED __builtin_amdgcn_sched_barrier(0)
    Unit cur, nxt; int ui = 0;
    if (!S.next(0, cur)) return;
    f32x4 acc[2][2][4][2];
#pragma unroll
    for (int a = 0; a < 2; ++a)
#pragma unroll
        for (int b = 0; b < 2; ++b)
#pragma unroll
            for (int m = 0; m < 4; ++m)
#pragma unroll
                for (int n = 0; n < 2; ++n) acc[a][b][m][n] = (f32x4){0.f, 0.f, 0.f, 0.f};
    bf16x8 At[4][2], B0[2][2], B1[2][2];
    const char* cA = cur.a; const char* cB = cur.b;
    PG8_STAGE(PG8_SB(0, 0), cB, voffB); PG8_STAGE(PG8_SA(0, 0), cA, voffA); PG8_STAGE(PG8_SB(0, 1), cB + hstepB, voffB); PG8_STAGE(PG8_SA(0, 1), cA + hstepA, voffA);
    if (wr == 1) PG8_BAR;
    PG8_WAIT_V(4); PG8_BAR;
    PG8_STAGE(PG8_SB(1, 0), cB + kstep, voffB); PG8_STAGE(PG8_SA(1, 0), cA + kstep, voffA); PG8_STAGE(PG8_SB(1, 1), cB + hstepB + kstep, voffB);
    PG8_WAIT_V(6); PG8_BAR;
    for (;;) {
        const bool has_next = S.next(ui + 1, nxt);
        const char* nA = has_next ? nxt.a : cA; const char* nB = has_next ? nxt.b : cB;
        for (int t = 0; t < nt; t += 2) {
            const bool last = (t == nt - 2);
            const char* a1 = cA + (size_t)(t + 1) * kstep;
            const char* a2 = last ? nA : cA + (size_t)(t + 2) * kstep; const char* b2 = last ? nB : cB + (size_t)(t + 2) * kstep;
            const char* a3 = a2 + kstep; const char* b3 = b2 + kstep;
            PG8_LDB(B0, 0, 0); PG8_SCHED; PG8_LDA(At, 0, 0); PG8_STAGE(PG8_SA(1, 1), a1 + hstepA, voffA);
            PG8_WAIT_L(8); PG8_BAR; PG8_WAIT_L(0); PG8_MMA(0, 0, At, B0); PG8_BAR; PG8_SCHED;
            PG8_LDB(B1, 0, 1); PG8_STAGE(PG8_SB(0, 0), b2, voffB);
            PG8_BAR; PG8_WAIT_L(0); PG8_MMA(0, 1, At, B1); PG8_BAR;
            PG8_LDA(At, 0, 1); PG8_STAGE(PG8_SA(0, 0), a2, voffA);
            PG8_BAR; PG8_WAIT_L(0); PG8_MMA(1, 0, At, B0); PG8_BAR; PG8_SCHED;
            PG8_STAGE(PG8_SB(0, 1), b2 + hstepB, voffB);
            PG8_WAIT_V(6); PG8_BAR; PG8_MMA(1, 1, At, B1); PG8_BAR;
            PG8_LDB(B0, 1, 0); PG8_SCHED; PG8_LDA(At, 1, 0); PG8_STAGE(PG8_SA(0, 1), a2 + hstepA, voffA);
            PG8_WAIT_L(8); PG8_BAR; PG8_WAIT_L(0); PG8_MMA(0, 0, At, B0); PG8_BAR; PG8_SCHED;
            PG8_LDB(B1, 1, 1); PG8_STAGE(PG8_SB(1, 0), b3, voffB);
            PG8_BAR; PG8_WAIT_L(0); PG8_MMA(0, 1, At, B1); PG8_BAR;
            PG8_LDA(At, 1, 1); PG8_STAGE(PG8_SA(1, 0), a3, voffA);
            PG8_BAR; PG8_WAIT_L(0); PG8_MMA(1, 0, At, B0); PG8_BAR; PG8_SCHED;
            PG8_STAGE(PG8_SB(1, 1), b3 + hstepB, voffB);
            PG8_WAIT_V(6); PG8_BAR; PG8_MMA(1, 1, At, B1); PG8_BAR;
        }
        if constexpr (Epi::ALIGN) { if (wr == 0) PG8_BAR; }
        E(acc, cur, wr, wc, fr, fq);
        if (!has_next) break;
#pragma unroll
        for (int a = 0; a < 2; ++a)
#pragma unroll
            for (int b = 0; b < 2; ++b)
#pragma unroll
                for (int m = 0; m < 4; ++m)
#pragma unroll
                    for (int n = 0; n < 2; ++n) acc[a][b][m][n] = (f32x4){0.f, 0.f, 0.f, 0.f};
        cur = nxt; cA = nA; cB = nB; ++ui;
        if constexpr (Epi::ALIGN) { if (wr == 1) PG8_BAR; }
    }
    PG8_WAIT_V(0);
    if constexpr (!Epi::ALIGN) { if (wr == 0) PG8_BAR; }
    PG8_BAR;
#undef PG8_SA
#undef PG8_SB
#undef PG8_STAGE
#undef PG8_LDA
#undef PG8_LDB
#undef PG8_MMA
#undef PG8_WAIT_V
#undef PG8_WAIT_L
#undef PG8_BAR
#undef PG8_SCHED
}

struct PlainOrder160 {
    int nM, nN, nwg, G, c; const char* A; const char* Bt; size_t ta, tb;
    __device__ void init(const void* A_, const void* Bt_, int M, int N, int lda, int ldb, int G_, int c_) { A = (const char*)A_; Bt = (const char*)Bt_; nM = M / 160; nN = N / BM; nwg = nM * nN; G = G_; c = c_; ta = (size_t)160 * lda * 2; tb = (size_t)BM * ldb * 2; }
    __device__ __forceinline__ bool next(int i, Unit& u) const {
        const long L = (long)i * G + c; if (L >= nwg) return false;
        int wgid = (int)L; { const int q = nwg / NXCD, r = nwg % NXCD, xcd = wgid % NXCD, off = wgid / NXCD; wgid = (xcd < r ? xcd * (q + 1) : r * (q + 1) + (xcd - r) * q) + off; }
        const int nig = WGM * nN, gid = wgid / nig, fm = gid * WGM, gsz = (nM - fm) < WGM ? (nM - fm) : WGM;
        u.pm = fm + ((wgid % nig) % gsz); u.pn = (wgid % nig) / gsz; u.z = 0;
        u.a = A + (size_t)u.pm * ta; u.b = Bt + (size_t)u.pn * tb; return true;
    }
};
template <class Epi, class Sched>
__device__ __forceinline__ void gemm_phase160(LAS unsigned char* lds, const Gemm g, const Sched& S, const Epi& E) {
    int tid = threadIdx.x; asm volatile("" : "+v"(tid));
    const int wid = __builtin_amdgcn_readfirstlane(tid >> 6), lane = tid & 63, half = wid >> 2, fr = lane & 15, fq = lane >> 4;
    const int K = g.K, nt = K / BK;
    constexpr int HTA = 80 * BK * 2;
    unsigned voffA[2], voffB[2];
    { int R, C; stage_rc(tid * 16, R, C); voffA[0] = (unsigned)(R * g.lda + C) * 2u; stage_rc((512 + (tid & 127)) * 16, R, C); voffA[1] = (unsigned)(R * g.lda + C) * 2u; }
#pragma unroll
    for (int i = 0; i < 2; ++i) { int R, C; stage_rc(tid * 16 + i * 8192, R, C); voffB[i] = (unsigned)(R * g.ldb + C) * 2u; }
    const size_t kstep = (size_t)(BK * 2);
    const size_t hstepA = (size_t)80 * g.lda * 2, hstepB = (size_t)HALF * g.ldb * 2;
    const unsigned ldswA0 = (unsigned)wid * 1024u, ldswA1 = 8192u + (unsigned)(wid & 1) * 1024u, ldswB = (unsigned)wid * 1024u;
    const int aoff = lds_byte(fr, fq * 8), boff = lds_byte(wid * 16 + fr, fq * 8);
#define PG8_SA(b, h) (((b) * 2 + (h)) * HTA)
#define PG8_SB(b, h) (4 * HTA + ((b) * 2 + (h)) * HTB)
#define PG8_STAGEA(bufoff, gbase) do { \
        __builtin_amdgcn_global_load_lds((const unsigned*)((const char*)(gbase) + voffA[0]), (LAS unsigned*)(lds + (bufoff) + ldswA0), 16, 0, 0); \
        __builtin_amdgcn_global_load_lds((const unsigned*)((const char*)(gbase) + voffA[1]), (LAS unsigned*)(lds + (bufoff) + ldswA1), 16, 0, 0); } while (0)
#define PG8_STAGEB(bufoff, gbase) do { _Pragma("unroll") for (int _i = 0; _i < 2; ++_i) \
        __builtin_amdgcn_global_load_lds((const unsigned*)((const char*)(gbase) + voffB[_i]), (LAS unsigned*)(lds + (bufoff) + ldswB + _i * 8192), 16, 0, 0); } while (0)
#define PG8_LDA(dst, b, h) do { _Pragma("unroll") for (int m = 0; m < 5; ++m) _Pragma("unroll") for (int k = 0; k < 2; ++k) dst[m][k] = *(const LAS bf16x8*)(lds + PG8_SA(b, h) + aoff + m * 2048 + k * 1024); } while (0)
#define PG8_LDB(dst, b, h) do { _Pragma("unroll") for (int k = 0; k < 2; ++k) dst[k] = *(const LAS bf16x8*)(lds + PG8_SB(b, h) + boff + k * 1024); } while (0)
#define PG8_MMA(ai, bj, At, Bt) do { __builtin_amdgcn_s_setprio(1); _Pragma("unroll") for (int m = 0; m < 5; ++m) _Pragma("unroll") for (int k = 0; k < 2; ++k) \
        acc[ai][bj][m] = __builtin_amdgcn_mfma_f32_16x16x32_bf16(Bt[k], At[m][k], acc[ai][bj][m], 0, 0, 0); __builtin_amdgcn_s_setprio(0); } while (0)
#define PG8_WAIT_V(n) asm volatile("s_waitcnt vmcnt(" #n ")" ::: "memory")
#define PG8_WAIT_L(n) asm volatile("s_waitcnt lgkmcnt(" #n ")" ::: "memory")
#define PG8_BAR __builtin_amdgcn_s_barrier()
#define PG8_SCHED __builtin_amdgcn_sched_barrier(0)
    Unit cur, nxt; int ui = 0;
    if (!S.next(0, cur)) return;
    f32x4 acc[2][2][5];
#pragma unroll
    for (int a = 0; a < 2; ++a)
#pragma unroll
        for (int b = 0; b < 2; ++b)
#pragma unroll
            for (int m = 0; m < 5; ++m) acc[a][b][m] = (f32x4){0.f, 0.f, 0.f, 0.f};
    bf16x8 At[5][2], B0[2], B1[2];
    const char* cA = cur.a; const char* cB = cur.b;
    PG8_STAGEB(PG8_SB(0, 0), cB); PG8_STAGEA(PG8_SA(0, 0), cA); PG8_STAGEB(PG8_SB(0, 1), cB + hstepB); PG8_STAGEA(PG8_SA(0, 1), cA + hstepA);
    if (half == 1) PG8_BAR;
    PG8_WAIT_V(4); PG8_BAR;
    PG8_STAGEB(PG8_SB(1, 0), cB + kstep); PG8_STAGEA(PG8_SA(1, 0), cA + kstep); PG8_STAGEB(PG8_SB(1, 1), cB + hstepB + kstep);
    PG8_WAIT_V(6); PG8_BAR;
    for (;;) {
        const bool has_next = S.next(ui + 1, nxt);
        const char* nA = has_next ? nxt.a : cA; const char* nB = has_next ? nxt.b : cB;
        for (int t = 0; t < nt; t += 2) {
            const bool last = (t == nt - 2);
            const char* a1 = cA + (size_t)(t + 1) * kstep;
            const char* a2 = last ? nA : cA + (size_t)(t + 2) * kstep; const char* b2 = last ? nB : cB + (size_t)(t + 2) * kstep;
            const char* a3 = a2 + kstep; const char* b3 = b2 + kstep;
            PG8_LDB(B0, 0, 0); PG8_SCHED; PG8_LDA(At, 0, 0); PG8_STAGEA(PG8_SA(1, 1), a1 + hstepA);
            PG8_WAIT_L(10); PG8_BAR; PG8_WAIT_L(0); PG8_MMA(0, 0, At, B0); PG8_BAR; PG8_SCHED;
            PG8_LDB(B1, 0, 1); PG8_STAGEB(PG8_SB(0, 0), b2);
            PG8_BAR; PG8_WAIT_L(0); PG8_MMA(0, 1, At, B1); PG8_BAR;
            PG8_LDA(At, 0, 1); PG8_STAGEA(PG8_SA(0, 0), a2);
            PG8_BAR; PG8_WAIT_L(0); PG8_MMA(1, 0, At, B0); PG8_BAR; PG8_SCHED;
            PG8_STAGEB(PG8_SB(0, 1), b2 + hstepB);
            PG8_WAIT_V(6); PG8_BAR; PG8_MMA(1, 1, At, B1); PG8_BAR;
            PG8_LDB(B0, 1, 0); PG8_SCHED; PG8_LDA(At, 1, 0); PG8_STAGEA(PG8_SA(0, 1), a2 + hstepA);
            PG8_WAIT_L(10); PG8_BAR; PG8_WAIT_L(0); PG8_MMA(0, 0, At, B0); PG8_BAR; PG8_SCHED;
            PG8_LDB(B1, 1, 1); PG8_STAGEB(PG8_SB(1, 0), b3);
            PG8_BAR; PG8_WAIT_L(0); PG8_MMA(0, 1, At, B1); PG8_BAR;
            PG8_LDA(At, 1, 1); PG8_STAGEA(PG8_SA(1, 0), a3);
            PG8_BAR; PG8_WAIT_L(0); PG8_MMA(1, 0, At, B0); PG8_BAR; PG8_SCHED;
            PG8_STAGEB(PG8_SB(1, 1), b3 + hstepB);
            PG8_WAIT_V(6); PG8_BAR; PG8_MMA(1, 1, At, B1); PG8_BAR;
        }
        E(acc, cur, wid, fr, fq);
        if (!has_next) break;
#pragma unroll
        for (int a = 0; a < 2; ++a)
#pragma unroll
            for (int b = 0; b < 2; ++b)
#pragma unroll
                for (int m = 0; m < 5; ++m) acc[a][b][m] = (f32x4){0.f, 0.f, 0.f, 0.f};
        cur = nxt; cA = nA; cB = nB; ++ui;
    }
    PG8_WAIT_V(0);
    if (half == 0) PG8_BAR;
    PG8_BAR;
#undef PG8_SA
#undef PG8_SB
#undef PG8_STAGEA
#undef PG8_STAGEB
#undef PG8_LDA
#undef PG8_LDB
#undef PG8_MMA
#undef PG8_WAIT_V
#undef PG8_WAIT_L
#undef PG8_BAR
#undef PG8_SCHED
}

template <int MF, class Epi, class Sched>
__device__ __forceinline__ void gemm_phase160b_run(LAS unsigned char* lds, const Gemm g, const Sched& S, const Epi& E, int tid, int wid, int lane, int wr, int wc) {
    const int fr = lane & 15, fq = lane >> 4;
    const int K = g.K, nt = K / BK;
    constexpr int HTA = 80 * BK * 2;
    unsigned voffA[2], voffB[2];
    { int R, C; stage_rc(tid * 16, R, C); voffA[0] = (unsigned)(R * g.lda + C) * 2u; stage_rc((512 + (tid & 127)) * 16, R, C); voffA[1] = (unsigned)(R * g.lda + C) * 2u; }
#pragma unroll
    for (int i = 0; i < 2; ++i) { int R, C; stage_rc(tid * 16 + i * 8192, R, C); voffB[i] = (unsigned)(R * g.ldb + C) * 2u; }
    const size_t kstep = (size_t)(BK * 2);
    const size_t hstepA = (size_t)80 * g.lda * 2, hstepB = (size_t)HALF * g.ldb * 2;
    const unsigned ldswA0 = (unsigned)wid * 1024u, ldswA1 = 8192u + (unsigned)(wid & 1) * 1024u, ldswB = (unsigned)wid * 1024u;
    const int aoff = lds_byte(wr * 48 + fr, fq * 8), boff = lds_byte(wc * 32 + fr, fq * 8);
#define PG8_SA(b, h) (((b) * 2 + (h)) * HTA)
#define PG8_SB(b, h) (4 * HTA + ((b) * 2 + (h)) * HTB)
#define PG8_STAGEA(bufoff, gbase) do { \
        __builtin_amdgcn_global_load_lds((const unsigned*)((const char*)(gbase) + voffA[0]), (LAS unsigned*)(lds + (bufoff) + ldswA0), 16, 0, 0); \
        __builtin_amdgcn_global_load_lds((const unsigned*)((const char*)(gbase) + voffA[1]), (LAS unsigned*)(lds + (bufoff) + ldswA1), 16, 0, 0); } while (0)
#define PG8_STAGEB(bufoff, gbase) do { _Pragma("unroll") for (int _i = 0; _i < 2; ++_i) \
        __builtin_amdgcn_global_load_lds((const unsigned*)((const char*)(gbase) + voffB[_i]), (LAS unsigned*)(lds + (bufoff) + ldswB + _i * 8192), 16, 0, 0); } while (0)
#define PG8_LDA(dst, b, h) do { _Pragma("unroll") for (int m = 0; m < MF; ++m) _Pragma("unroll") for (int k = 0; k < 2; ++k) dst[m][k] = *(const LAS bf16x8*)(lds + PG8_SA(b, h) + aoff + m * 2048 + k * 1024); } while (0)
#define PG8_LDB(dst, b, h) do { _Pragma("unroll") for (int n = 0; n < 2; ++n) _Pragma("unroll") for (int k = 0; k < 2; ++k) dst[n][k] = *(const LAS bf16x8*)(lds + PG8_SB(b, h) + boff + n * 2048 + k * 1024); } while (0)
#define PG8_MMA(ai, bj, At, Bt) do { __builtin_amdgcn_s_setprio(1); _Pragma("unroll") for (int m = 0; m < MF; ++m) _Pragma("unroll") for (int n = 0; n < 2; ++n) _Pragma("unroll") for (int k = 0; k < 2; ++k) \
        acc[ai][bj][m][n] = __builtin_amdgcn_mfma_f32_16x16x32_bf16(Bt[n][k], At[m][k], acc[ai][bj][m][n], 0, 0, 0); __builtin_amdgcn_s_setprio(0); } while (0)
#define PG8_WAIT_V(n) asm volatile("s_waitcnt vmcnt(" #n ")" ::: "memory")
#define PG8_WAIT_L(n) asm volatile("s_waitcnt lgkmcnt(" #n ")" ::: "memory")
#define PG8_WAIT_LA() do { if (MF == 3) PG8_WAIT_L(6); else PG8_WAIT_L(4); } while (0)
#define PG8_BAR __builtin_amdgcn_s_barrier()
#define PG8_SCHED __builtin_amdgcn_sched_barrier(0)
    Unit cur, nxt; int ui = 0;
    if (!S.next(0, cur)) return;
    f32x4 acc[2][2][MF][2];
#pragma unroll
    for (int a = 0; a < 2; ++a)
#pragma unroll
        for (int b = 0; b < 2; ++b)
#pragma unroll
            for (int m = 0; m < MF; ++m)
#pragma unroll
                for (int n = 0; n < 2; ++n) acc[a][b][m][n] = (f32x4){0.f, 0.f, 0.f, 0.f};
    bf16x8 At[MF][2], B0[2][2], B1[2][2];
    const char* cA = cur.a; const char* cB = cur.b;
    PG8_STAGEB(PG8_SB(0, 0), cB); PG8_STAGEA(PG8_SA(0, 0), cA); PG8_STAGEB(PG8_SB(0, 1), cB + hstepB); PG8_STAGEA(PG8_SA(0, 1), cA + hstepA);
    if (wr == 1) PG8_BAR;
    PG8_WAIT_V(4); PG8_BAR;
    PG8_STAGEB(PG8_SB(1, 0), cB + kstep); PG8_STAGEA(PG8_SA(1, 0), cA + kstep); PG8_STAGEB(PG8_SB(1, 1), cB + hstepB + kstep);
    PG8_WAIT_V(6); PG8_BAR;
    for (;;) {
        const bool has_next = S.next(ui + 1, nxt);
        const char* nA = has_next ? nxt.a : cA; const char* nB = has_next ? nxt.b : cB;
        for (int t = 0; t < nt; t += 2) {
            const bool last = (t == nt - 2);
            const char* a1 = cA + (size_t)(t + 1) * kstep;
            const char* a2 = last ? nA : cA + (size_t)(t + 2) * kstep; const char* b2 = last ? nB : cB + (size_t)(t + 2) * kstep;
            const char* a3 = a2 + kstep; const char* b3 = b2 + kstep;
            PG8_LDB(B0, 0, 0); PG8_SCHED; PG8_LDA(At, 0, 0); PG8_STAGEA(PG8_SA(1, 1), a1 + hstepA);
            PG8_WAIT_LA(); PG8_BAR; PG8_WAIT_L(0); PG8_MMA(0, 0, At, B0); PG8_BAR; PG8_SCHED;
            PG8_LDB(B1, 0, 1); PG8_STAGEB(PG8_SB(0, 0), b2);
            PG8_BAR; PG8_WAIT_L(0); PG8_MMA(0, 1, At, B1); PG8_BAR;
            PG8_LDA(At, 0, 1); PG8_STAGEA(PG8_SA(0, 0), a2);
            PG8_BAR; PG8_WAIT_L(0); PG8_MMA(1, 0, At, B0); PG8_BAR; PG8_SCHED;
            PG8_STAGEB(PG8_SB(0, 1), b2 + hstepB);
            PG8_WAIT_V(6); PG8_BAR; PG8_MMA(1, 1, At, B1); PG8_BAR;
            PG8_LDB(B0, 1, 0); PG8_SCHED; PG8_LDA(At, 1, 0); PG8_STAGEA(PG8_SA(0, 1), a2 + hstepA);
            PG8_WAIT_LA(); PG8_BAR; PG8_WAIT_L(0); PG8_MMA(0, 0, At, B0); PG8_BAR; PG8_SCHED;
            PG8_LDB(B1, 1, 1); PG8_STAGEB(PG8_SB(1, 0), b3);
            PG8_BAR; PG8_WAIT_L(0); PG8_MMA(0, 1, At, B1); PG8_BAR;
            PG8_LDA(At, 1, 1); PG8_STAGEA(PG8_SA(1, 0), a3);
            PG8_BAR; PG8_WAIT_L(0); PG8_MMA(1, 0, At, B0); PG8_BAR; PG8_SCHED;
            PG8_STAGEB(PG8_SB(1, 1), b3 + hstepB);
            PG8_WAIT_V(6); PG8_BAR; PG8_MMA(1, 1, At, B1); PG8_BAR;
        }
        if constexpr (!Epi::AFTER_DRAIN) E.template tile<MF>(acc, cur, wr, wc, fr, fq);
        if (!has_next) break;
#pragma unroll
        for (int a = 0; a < 2; ++a)
#pragma unroll
            for (int b = 0; b < 2; ++b)
#pragma unroll
                for (int m = 0; m < MF; ++m)
#pragma unroll
                    for (int n = 0; n < 2; ++n) acc[a][b][m][n] = (f32x4){0.f, 0.f, 0.f, 0.f};
        cur = nxt; cA = nA; cB = nB; ++ui;
    }
    PG8_WAIT_V(0);
    if (wr == 0) PG8_BAR;
    PG8_BAR;
    if constexpr (Epi::AFTER_DRAIN) E.template fused<MF>(acc, cur, wr, wc, fr, fq, lds, wid, lane, tid);
#undef PG8_SA
#undef PG8_SB
#undef PG8_STAGEA
#undef PG8_STAGEB
#undef PG8_LDA
#undef PG8_LDB
#undef PG8_MMA
#undef PG8_WAIT_V
#undef PG8_WAIT_L
#undef PG8_WAIT_LA
#undef PG8_BAR
#undef PG8_SCHED
}
template <class Epi, class Sched>
__device__ __forceinline__ void gemm_phase160b(LAS unsigned char* lds, const Gemm g, const Sched& S, const Epi& E) {
    int tid = threadIdx.x; asm volatile("" : "+v"(tid));
    const int wid = __builtin_amdgcn_readfirstlane(tid >> 6), lane = tid & 63, wr = wid >> 2, wc = wid & 3;
    if (wr == 0) gemm_phase160b_run<3>(lds, g, S, E, tid, wid, lane, wr, wc);
    else gemm_phase160b_run<2>(lds, g, S, E, tid, wid, lane, wr, wc);
}
}

struct Args { const void* in[27]; float* out; unsigned char* ws; int ph_lo, ph_hi; };
enum { I_XP = 0, I_XS, I_CK, I_CV, I_ST, I_C, I_CCTX, I_WADA, I_BADA, I_GAINS, I_WIN, I_WOUT, I_LAMBDA, I_SUBLN, I_MU, I_W0, I_W2, I_A0, I_A2, I_G2, I_KVEC, I_LNX, I_WODD, I_WFI, I_CONVW, I_CONVB, I_WFO };
#define FIN(k) ((const float*)a.in[k])
#define WSB(off) ((bf16*)(a.ws + (off)))
#define WSF(off) ((float*)(a.ws + (off)))


__device__ __forceinline__ const void* ptab_ld(LAS unsigned char* lds, int k) {
    const u32x2 w = *(const LAS u32x2*)(lds + PTAB_OFF + 8 * k);
    const unsigned long long v = ((unsigned long long)(unsigned)__builtin_amdgcn_readfirstlane((int)w.y) << 32) | (unsigned)__builtin_amdgcn_readfirstlane((int)w.x);
    return (const void*)(const __attribute__((address_space(1))) void*)v;
}
__device__ __forceinline__ Args load_args(LAS unsigned char* lds, int ph_lo, int ph_hi) {
    Args r;
#pragma unroll
    for (int i = 0; i < 27; ++i) r.in[i] = ptab_ld(lds, i);
    r.out = (float*)ptab_ld(lds, 27); r.ws = (unsigned char*)ptab_ld(lds, 28); r.ph_lo = ph_lo; r.ph_hi = ph_hi;
    return r;
}
__device__ __forceinline__ int row_cond(int row) { return row < NPR ? 0 : 1 + ((row - NPR) >> 10); }

template <bool FFN_PERM = false>
__device__ __forceinline__ void p0_transpose_item(const float* W, int K, int N, bf16* WT, LAS float* scr, int item, int lane) {
    const int nblk = N / 64, kb = item / nblk, nb = item % nblk, k0 = 64 * kb, n0 = 64 * nb;
    const int d0 = FFN_PERM ? (n0 < DFF ? (n0 / 128) * 256 + (n0 % 128) : ((n0 - DFF) / 128) * 256 + 128 + ((n0 - DFF) % 128)) : n0;
    const int c2 = 2 * (lane & 31);
#pragma unroll 8
    for (int i = 0; i < 32; ++i) { const int kk = 2 * i + (lane >> 5); const f32x2 v = *(const f32x2*)(W + (size_t)(k0 + kk) * N + n0 + c2); scr[kk * 65 + c2] = v[0]; scr[kk * 65 + c2 + 1] = v[1]; }
    asm volatile("s_waitcnt lgkmcnt(0)" ::: "memory");
    const int c = lane & 7;
#pragma unroll
    for (int j = 0; j < 8; ++j) { const int n = (lane >> 3) + 8 * j; const LAS float* s = scr + (8 * c) * 65 + n;
        u32x4 o; o.x = pk2(s[0 * 65], s[1 * 65]); o.y = pk2(s[2 * 65], s[3 * 65]); o.z = pk2(s[4 * 65], s[5 * 65]); o.w = pk2(s[6 * 65], s[7 * 65]);
        *(u32x4*)(WT + (size_t)(d0 + n) * K + k0 + 8 * c) = o; }
    asm volatile("s_waitcnt lgkmcnt(0)" ::: "memory");
}

template <int STAGE>
__device__ __forceinline__ void phase_prep(const Args& a, LAS unsigned char* lds, int bid, int G, int vgw = -2, int nmine = 1, int nvw = 0) {
    int tid = threadIdx.x; asm volatile("" : "+v"(tid));
    const int lane = tid & 63, wave = tid >> 6;
    const int gw = bid * 8 + wave, NGW = G * 8;
    const int gt = bid * 512 + tid, NGT = G * 512;
    constexpr int I_IN = (1024 / 64) * (INE / 64), I_SQ = (1024 / 64) * (1024 / 64), I_FI = (1024 / 64) * (DFF2 / 64), I_FO = (DFF / 64) * (1024 / 64), I_L64 = 1 * (512 / 64), I_L128 = 2 * (512 / 64);
    if (STAGE == 1 || STAGE == 3) {
        LAS float* scr = (LAS float*)(lds + wave * 18432);
        constexpr int NITEMS = I_IN + 4 * I_L64 + I_L128;
        for (int it = gw; it < NITEMS; it += NGW) {
            int r = it;
            if (r < I_IN) { p0_transpose_item(FIN(I_WIN), 1024, INE, WSB(WS_WIN), scr, r, lane); continue; } r -= I_IN;
            if (r < 2 * I_L64) { const int d = r / I_L64; p0_transpose_item(FIN(I_W2) + (size_t)d * 64 * 512, 64, 512, WSB(WS_W2T) + (size_t)d * 512 * 64, scr, r % I_L64, lane); continue; } r -= 2 * I_L64;
            if (r < 2 * I_L64) { const int d = r / I_L64; p0_transpose_item(FIN(I_A2) + (size_t)d * 64 * 512, 64, 512, WSB(WS_A2T) + (size_t)d * 512 * 64, scr, r % I_L64, lane); continue; } r -= 2 * I_L64;
            p0_transpose_item(FIN(I_G2), 128, 512, WSB(WS_G2T), scr, r, lane);
        }
        for (int i = gt; i < (INE_PAD - INE) * 1024 / 8; i += NGT) ((u32x4*)(WSB(WS_WIN) + (size_t)INE * 1024))[i] = (u32x4){0u, 0u, 0u, 0u};
    }
    if (STAGE == 2) {
        LAS float* scr = (LAS float*)(lds + wave * 18432);
        constexpr int NITEMS = I_SQ + I_FI + I_FO;
        const int s0 = vgw == -2 ? gw : vgw, ns = vgw == -2 ? NGW : nvw;
        for (int sl = 0; sl < nmine; ++sl)
        for (int it = s0 < 0 ? NITEMS : s0 + sl; it < NITEMS; it += ns) {
            int r = it;
            if (r < I_SQ) { p0_transpose_item(FIN(I_WOUT), 1024, 1024, WSB(WS_WO), scr, r, lane); continue; } r -= I_SQ;
            if (r < I_FI) { p0_transpose_item<true>(FIN(I_WFI), 1024, DFF2, WSB(WS_WFI), scr, r, lane); continue; } r -= I_FI;
            p0_transpose_item(FIN(I_WFO), DFF, 1024, WSB(WS_WFO), scr, r, lane);
        }
    }
    if (STAGE == 0 || STAGE == 3) {
        for (int i = gt; i < 256 * 128; i += NGT) {
            const int n = i >> 7, c = i & 127, m = (c * (n & 127)) & 127; const float x = (float)m * (2.0f / 128.0f);
            WSB(WS_WDFT)[i] = f2bf(n < 128 ? cospif(x) : sinpif(x));
        }
        for (int i = gt; i < 256 * 512; i += NGT) {
            const int lp = i >> 9, k = i & 511, l = k & 255, m = (lp * l) & 255; const float x = (float)m * (2.0f / 256.0f), s = 0.00552427172801990f;
            WSB(WS_A2P)[i] = f2bf(k < 256 ? s * cospif(x) : -s * sinpif(x));
        }
        for (int i = gt; i < 1024 * 32; i += NGT) {
            const int t = i >> 5, f = i & 31; const float inv = powf(10000.0f, -(float)(f & 15) / 16.0f), pos = (float)(f < 16 ? (t >> 6) : (t & 63)), ang = pos * inv;
            WSF(WS_ROPE)[i] = cosf(ang); WSF(WS_ROPE)[1024 * 32 + i] = sinf(ang);
        }
        if (gt == 0) {
            const float* lp = FIN(I_LAMBDA); float s1 = 0.f, s2 = 0.f;
            for (int i = 0; i < 64; ++i) { s1 += lp[i] * lp[64 + i]; s2 += lp[128 + i] * lp[192 + i]; }
            WSF(WS_LAM)[0] = expf(s1) - expf(s2) + 0.2f;
        }
        for (int i = gt; i < 2 * 256 * 512; i += NGT) {
            const int b = i >> 17, t = (i >> 9) & 255, c = i & 511;
            WSB(WS_KS)[((size_t)b * LKS + t) * 512 + c] = f2bf(FIN(I_CK)[i]);
            const int h = c >> 7, d = c & 127;
            WSB(WS_VTS)[((size_t)(b * 4 + h) * 128 + d) * LKS + keypos(t)] = f2bf(FIN(I_CV)[i]);
        }
    }
    if (STAGE == 0 || STAGE == 1 || STAGE == 3) {
        LAS float* sc = (LAS float*)lds;
        LAS float* red = (LAS float*)(lds + 16384);
        __syncthreads();
        for (int i = tid; i < 3 * 1024; i += 512) { const int cd = i >> 10, k = i & 1023; const float x = cd == 0 ? FIN(I_CCTX)[k] : FIN(I_C)[(cd - 1) * 1024 + k]; sc[i] = x / (1.f + __expf(-x)); }
        __syncthreads();
        const int kq = tid >> 3, nl = tid & 7;
        const int it_lo = STAGE == 0 ? 0 : 64, it_hi = STAGE == 0 ? 64 : 2 * 192;
        for (int q = 0; ; ++q) {
            int it;
            if (STAGE == 3) {
                if (G == 256) { if (q == 0) { if (bid >= 64) continue; it = bid; } else if (q == 1) { if (bid < 64) continue; it = bid; } else if (q == 2) { if (bid >= 128) continue; it = 256 + bid; } else break; }
                else { it = bid + q * G; if (it >= 2 * 192) break; }
            } else { it = it_lo + bid + q * G; if (it >= it_hi) break; }
            const int l = it / 192, n0 = (it % 192) * 32;
            const float* W = FIN(I_WADA) + (size_t)l * 1024 * 6144 + n0 + 4 * nl;
            f32x4 s0 = {0.f, 0.f, 0.f, 0.f}, s1 = s0, s2 = s0;
#pragma unroll 4
            for (int kk = 0; kk < 16; ++kk) { const int k = kq * 16 + kk; const f32x4 w = *(const f32x4*)(W + (size_t)k * 6144); s0 += w * sc[k]; s1 += w * sc[1024 + k]; s2 += w * sc[2048 + k]; }
            *(LAS f32x4*)(red + (kq * 3 + 0) * 32 + 4 * nl) = s0; *(LAS f32x4*)(red + (kq * 3 + 1) * 32 + 4 * nl) = s1; *(LAS f32x4*)(red + (kq * 3 + 2) * 32 + 4 * nl) = s2;
            __syncthreads();
            if (tid < 96) { const int cd = tid >> 5, n = tid & 31; float s = FIN(I_BADA)[l * 6144 + n0 + n];
                for (int qq = 0; qq < 64; ++qq) s += red[(qq * 3 + cd) * 32 + n];
                if (STAGE == 3 && it < 64)
                    __hip_atomic_store((unsigned*)(a.ws + WS_MOD1) + cd * 2048 + n0 + n, __float_as_uint(s) | 1u, __ATOMIC_RELAXED, __HIP_MEMORY_SCOPE_AGENT);
                else WSF(WS_MOD)[(size_t)(l * 3 + cd) * 6144 + n0 + n] = s; }
            __syncthreads();
        }
    }
}

__device__ __forceinline__ void phase_first_norm(const Args& a, LAS unsigned char* lds, int bid, int G, const float* gB) {
    int tid = threadIdx.x; asm volatile("" : "+v"(tid));
    const int lane = tid & 63, wave = tid >> 6;
    const int gw = bid * 8 + wave, NGW = G * 8;
    LAS float* modl = (LAS float*)lds;
    __syncthreads();
    {   const unsigned* side = (const unsigned*)(a.ws + WS_MOD1);
        unsigned v[12]; unsigned spins = 0;
        for (;;) { bool ok = true;
#pragma unroll
            for (int i = 0; i < 12; ++i) { v[i] = __hip_atomic_load(side + tid + 512 * i, __ATOMIC_RELAXED, __HIP_MEMORY_SCOPE_AGENT); ok = ok && (v[i] != 0u); }
            if (ok || ++spins > (1u << 20)) break;
            __builtin_amdgcn_s_sleep(2); }
#pragma unroll
        for (int i = 0; i < 12; ++i) modl[tid + 512 * i] = __uint_as_float(v[i]);
    }
    __syncthreads();
    bf16* XN = WSB(WS_XN);
    constexpr int R = 5;
    for (int row0 = gw; row0 < NT; row0 += R * NGW) {
        f32x4 x[R][4];
#pragma unroll
        for (int q = 0; q < R; ++q) { const int row = row0 + q * NGW; if (row < NT) {
            const float* xin = row < NPR ? FIN(I_XP) + (size_t)row * DM : FIN(I_XS) + (size_t)(row - NPR) * DM;
#pragma unroll
            for (int j = 0; j < 4; ++j) x[q][j] = *(const f32x4*)(xin + 4 * lane + 256 * j); } }
#pragma unroll
        for (int q = 0; q < R; ++q) { const int row = row0 + q * NGW; if (row < NT) {
            const LAS float* ml = modl + row_cond(row) * 2048;
            float ss = 0.f;
#pragma unroll
            for (int j = 0; j < 4; ++j) ss += (x[q][j][0] * x[q][j][0] + x[q][j][1] * x[q][j][1]) + (x[q][j][2] * x[q][j][2] + x[q][j][3] * x[q][j][3]);
            const float rinv = rsqrtf(wave_sum(ss) * (1.f / DM) + 1e-6f);
#pragma unroll
            for (int j = 0; j < 4; ++j) { const f32x4 g = *(const f32x4*)(gB + 4 * lane + 256 * j), sc = *(const LAS f32x4*)(ml + 1024 + 4 * lane + 256 * j), sh = *(const LAS f32x4*)(ml + 4 * lane + 256 * j);
                const f32x4 h = (x[q][j] * rinv * g) * (sc + 1.f) + sh; *(u32x2*)(XN + (size_t)row * DM + 4 * lane + 256 * j) = pk4(h); }
        } }
    }
}

template <int SEL>
__device__ __forceinline__ void phase_transpose_wfi1(const Args& a, LAS unsigned char* lds, int bid, int G) {
    int tid = threadIdx.x; asm volatile("" : "+v"(tid));
    const int lane = tid & 63, wave = tid >> 6;
    LAS float* scr = (LAS float*)(lds + wave * 18432);
    constexpr int I_FI = (1024 / 64) * (DFF2 / 64), I_SQ = (1024 / 64) * (1024 / 64), I_FO = (DFF / 64) * (1024 / 64);
    if (SEL == 0) {
        for (int it = bid * 8 + wave; it < I_FI + I_SQ; it += G * 8) {
            if (it < I_FI) p0_transpose_item<true>(FIN(I_WFI) + (size_t)1024 * DFF2, 1024, DFF2, WSB(WS_WFI) + (size_t)DFF2 * 1024, scr, it, lane);
            else p0_transpose_item(FIN(I_WODD), 1024, 1024, WSB(WS_WODD), scr, it - I_FI, lane); }
    } else {
        for (int it = bid * 8 + wave; it < I_FO; it += G * 8) p0_transpose_item(FIN(I_WFO) + (size_t)DFF * 1024, DFF, 1024, WSB(WS_WFO) + (size_t)1024 * DFF, scr, it, lane);
    }
    __syncthreads();
}
template <bool HAS_RES, bool HAS_H, bool X_FROM_INPUT, bool X_TO_OUTPUT = false>
__device__ __forceinline__ void phase_resnorm(const Args& a, int bid, int G, const bf16* mf, const float* gA, int gate_off, int layer_gate, const float* gB, int shift_off, int scale_off, int layer_mod) {
    int tid = threadIdx.x; asm volatile("" : "+v"(tid));
    const int lane = tid & 63, wave = tid >> 6;
    const int gw = bid * 8 + wave, NGW = G * 8;
    float* X = a.out; bf16* XB = WSB(WS_XB);
    bf16* XN = WSB(WS_XN);
    constexpr int R = 5;
    for (int row0 = gw; row0 < NT; row0 += R * NGW) {
        f32x4 x[R][4], m[R][4];
#pragma unroll
        for (int q = 0; q < R; ++q) { const int row = row0 + q * NGW; if (row < NT) {
            const float* xin = row < NPR ? FIN(I_XP) + (size_t)row * DM : FIN(I_XS) + (size_t)(row - NPR) * DM;
#pragma unroll
            for (int j = 0; j < 4; ++j) { x[q][j] = X_FROM_INPUT ? *(const f32x4*)(xin + 4 * lane + 256 * j) : unpk4(*(const u32x2*)(XB + (size_t)row * DM + 4 * lane + 256 * j)); if (HAS_RES) m[q][j] = unpk4(*(const u32x2*)(mf + (size_t)row * DM + 4 * lane + 256 * j)); } } }
#pragma unroll
        for (int q = 0; q < R; ++q) { const int row = row0 + q * NGW; if (row < NT) {
            const float* mod = WSF(WS_MOD) + (size_t)(layer_mod * 3 + row_cond(row)) * 6144;
            const float* modg = WSF(WS_MOD) + (size_t)(layer_gate * 3 + row_cond(row)) * 6144;
            if (HAS_RES) {
                float ss = 0.f;
#pragma unroll
                for (int j = 0; j < 4; ++j) ss += (m[q][j][0] * m[q][j][0] + m[q][j][1] * m[q][j][1]) + (m[q][j][2] * m[q][j][2] + m[q][j][3] * m[q][j][3]);
                const float rinv = rsqrtf(wave_sum(ss) * (1.f / DM) + 1e-6f);
#pragma unroll
                for (int j = 0; j < 4; ++j) { const f32x4 g = *(const f32x4*)(gA + 4 * lane + 256 * j), gt = *(const f32x4*)(modg + gate_off + 4 * lane + 256 * j);
                    x[q][j] = x[q][j] + gt * (m[q][j] * rinv * g);
                    if (X_TO_OUTPUT) *(f32x4*)(X + (size_t)row * DM + 4 * lane + 256 * j) = x[q][j]; else *(u32x2*)(XB + (size_t)row * DM + 4 * lane + 256 * j) = pk4(x[q][j]); }
            }
            if (HAS_H) {
                float ss = 0.f;
#pragma unroll
                for (int j = 0; j < 4; ++j) ss += (x[q][j][0] * x[q][j][0] + x[q][j][1] * x[q][j][1]) + (x[q][j][2] * x[q][j][2] + x[q][j][3] * x[q][j][3]);
                const float rinv = rsqrtf(wave_sum(ss) * (1.f / DM) + 1e-6f);
#pragma unroll
                for (int j = 0; j < 4; ++j) { const f32x4 g = *(const f32x4*)(gB + 4 * lane + 256 * j), sc = *(const f32x4*)(mod + scale_off + 4 * lane + 256 * j), sh = *(const f32x4*)(mod + shift_off + 4 * lane + 256 * j);
                    const f32x4 h = (x[q][j] * rinv * g) * (sc + 1.f) + sh; *(u32x2*)(XN + (size_t)row * DM + 4 * lane + 256 * j) = pk4(h); }
            }
        } }
    }
}

struct EpiF32 {
    float* C; int ldc;
    static constexpr bool ALIGN = false;
    __device__ __forceinline__ void operator()(const f32x4 (&acc)[2][2][4][2], const pg8::Unit& u, int wr, int wc, int fr, int fq) const {
        pg8::epi_each(acc, u.pm * 256 + wr * 64 + fr, u.pn * 256 + wc * 32 + 4 * fq, [&](int row, int col, const f32x4& v) { *(f32x4*)(C + (size_t)row * ldc + col) = v; });
    }
};
struct EpiBf16 {
    bf16* O; int ldc;
    static constexpr bool ALIGN = false;
    __device__ __forceinline__ void operator()(const f32x4 (&acc)[2][2][4][2], const pg8::Unit& u, int wr, int wc, int fr, int fq) const {
        pg8::epi_each(acc, u.z + u.pm * 256 + wr * 64 + fr, u.pn * 256 + wc * 32 + 4 * fq, [&](int row, int col, const f32x4& v) { *(u32x2*)(O + (size_t)row * ldc + col) = pk4(v); });
    }
};

template <class F> __device__ __forceinline__ void epi_each160(const f32x4 (&acc)[2][2][5], const pg8::Unit& u, int wid, int fr, int fq, F&& f) {
#pragma unroll
    for (int ai = 0; ai < 2; ++ai)
#pragma unroll
        for (int m = 0; m < 5; ++m)
#pragma unroll
            for (int bj = 0; bj < 2; ++bj) f(u.pm * 160 + ai * 80 + m * 16 + fr, u.pn * 256 + bj * 128 + wid * 16 + 4 * fq, acc[ai][bj][m]);
}
struct EpiBf16_160 {
    bf16* O; int ldc;
    static constexpr bool AFTER_DRAIN = false;
    template <int MF> __device__ __forceinline__ void tile(const f32x4 (&acc)[2][2][MF][2], const pg8::Unit& u, int wr, int wc, int fr, int fq) const {
#pragma unroll
        for (int ai = 0; ai < 2; ++ai)
#pragma unroll
            for (int m = 0; m < MF; ++m)
#pragma unroll
                for (int bj = 0; bj < 2; ++bj)
#pragma unroll
                    for (int n = 0; n < 2; ++n) *(u32x2*)(O + (size_t)(u.pm * 160 + ai * 80 + wr * 48 + m * 16 + fr) * ldc + u.pn * 256 + bj * 128 + wc * 32 + n * 16 + 4 * fq) = pk4(acc[ai][bj][m][n]);
    }
    __device__ __forceinline__ void operator()(const f32x4 (&acc)[2][2][5], const pg8::Unit& u, int wid, int fr, int fq) const {
#pragma unroll
        for (int ai = 0; ai < 2; ++ai)
#pragma unroll
            for (int m = 0; m < 5; ++m)
#pragma unroll
                for (int bj = 0; bj < 2; ++bj) *(u32x2*)(O + (size_t)(u.pm * 160 + ai * 80 + m * 16 + fr) * ldc + u.pn * 256 + bj * 128 + wid * 16 + 4 * fq) = pk4(acc[ai][bj][m]);
    }
};

template <bool FROM_INPUT, bool FINAL>
struct EpiResNorm {
    static constexpr bool AFTER_DRAIN = true;
    const float* xin_p; const float* xin_s; const bf16* xb_in;
    bf16* xb_out; float* xf_out; bf16* xn_out;
    const float* gA; const float* gB; const float* mod;
    int gate_off, layer_gate, shift_off, scale_off, layer_mod;
    unsigned* slots; unsigned* cnt;

    template <int MF> __device__ __forceinline__ void exchange(const f32x4 (&v)[2][2][MF][2], int e, int pm, int pn, int wr, int wc, int fr, int fq, LAS float* P, LAS float* R, int wid, int lane, int tid) const {
#pragma unroll
        for (int ai = 0; ai < 2; ++ai)
#pragma unroll
            for (int m = 0; m < MF; ++m) {
                float s = 0.f;
#pragma unroll
                for (int bj = 0; bj < 2; ++bj)
#pragma unroll
                    for (int n = 0; n < 2; ++n) { const f32x4 x = v[ai][bj][m][n]; s += (x[0] * x[0] + x[1] * x[1]) + (x[2] * x[2] + x[3] * x[3]); }
                s += __shfl_xor(s, 16); s += __shfl_xor(s, 32);
                if (fq == 0) P[(80 * ai + 48 * wr + 16 * m + fr) * 4 + wc] = s;
            }
        asm volatile("s_waitcnt lgkmcnt(0)" ::: "memory"); __builtin_amdgcn_s_barrier(); asm volatile("" ::: "memory");
        unsigned long long* sl = (unsigned long long*)(slots + ((size_t)(e * 64 + pm) * 160) * 4);
        if (tid < 160) { const float tot = (P[tid * 4 + 0] + P[tid * 4 + 1]) + (P[tid * 4 + 2] + P[tid * 4 + 3]);
            __hip_atomic_store((unsigned*)sl + tid * 4 + pn, __float_as_uint(tot) | 1u, __ATOMIC_RELAXED, __HIP_MEMORY_SCOPE_AGENT);
            unsigned long long a, b; unsigned spins = 0;
            for (;;) {
                a = __hip_atomic_load(sl + tid * 2 + 0, __ATOMIC_RELAXED, __HIP_MEMORY_SCOPE_AGENT); b = __hip_atomic_load(sl + tid * 2 + 1, __ATOMIC_RELAXED, __HIP_MEMORY_SCOPE_AGENT);
                if (((unsigned)a != 0u && (unsigned)(a >> 32) != 0u && (unsigned)b != 0u && (unsigned)(b >> 32) != 0u) || ++spins > (1u << 20)) break;
                __builtin_amdgcn_s_sleep(1);
            }
            const float q = (__uint_as_float((unsigned)a) + __uint_as_float((unsigned)(a >> 32))) + (__uint_as_float((unsigned)b) + __uint_as_float((unsigned)(b >> 32)));
            R[tid] = rsqrtf(q * (1.f / 1024.f) + 1e-6f); }
        asm volatile("s_waitcnt lgkmcnt(0)" ::: "memory"); __builtin_amdgcn_s_barrier(); asm volatile("" ::: "memory");
    }

    template <int MF> __device__ __forceinline__ void fused(f32x4 (&acc)[2][2][MF][2], const pg8::Unit& u, int wr, int wc, int fr, int fq, LAS unsigned char* lds, int wid, int lane, int tid) const {
        LAS float* P = (LAS float*)lds; LAS float* R = (LAS float*)(lds + 4096);
        const int pm = u.pm, pn = u.pn, row0 = 160 * pm;
        int cb = 256 * pn + 32 * wc + 4 * fq; asm volatile("" : "+v"(cb));
        const int c_lo = row_cond(row0), c_hi = row_cond(row0 + 159);
        f32x4 g[4], gtl[4], gth[4];
        {   const float* ml = mod + (size_t)(layer_gate * 3 + c_lo) * 6144 + gate_off; const float* mh = mod + (size_t)(layer_gate * 3 + c_hi) * 6144 + gate_off;
#pragma unroll
            for (int q = 0; q < 4; ++q) { const int col = cb + 128 * (q >> 1) + 16 * (q & 1); g[q] = *(const f32x4*)(gA + col); gtl[q] = *(const f32x4*)(ml + col); gth[q] = *(const f32x4*)(mh + col); } }
        using XT = typename std::conditional<FROM_INPUT, f32x4, u32x2>::type;
        XT x0[MF * 4], x1[MF * 4];
        auto ldx = [&](XT (&xr)[MF * 4], int ai) {
#pragma unroll
            for (int m = 0; m < MF; ++m) { const int row = row0 + 80 * ai + 48 * wr + 16 * m + fr;
#pragma unroll
                for (int q = 0; q < 4; ++q) { const int col = cb + 128 * (q >> 1) + 16 * (q & 1);
                    if constexpr (FROM_INPUT) xr[m * 4 + q] = *(const f32x4*)((row < NPR ? xin_p + (size_t)row * DM : xin_s + (size_t)(row - NPR) * DM) + col);
                    else xr[m * 4 + q] = *(const u32x2*)(xb_in + (size_t)row * DM + col); } } };
        auto upd = [&](const XT (&xr)[MF * 4], int ai) {
#pragma unroll
            for (int m = 0; m < MF; ++m) { const int rl = 80 * ai + 48 * wr + 16 * m + fr; const float rinv = R[rl]; const bool hi = row_cond(row0 + 80 * ai + 48 * wr + 16 * m) != c_lo;
#pragma unroll
                for (int q = 0; q < 4; ++q) { f32x4 x; if constexpr (FROM_INPUT) x = xr[m * 4 + q]; else x = unpk4(xr[m * 4 + q]);
                    const f32x4 gt = hi ? gth[q] : gtl[q];
                    acc[ai][q >> 1][m][q & 1] = x + gt * (acc[ai][q >> 1][m][q & 1] * rinv * g[q]); } } };
        ldx(x0, 0);
        if constexpr (!FROM_INPUT) ldx(x1, 1);
        asm volatile("" ::: "memory");
        exchange<MF>(acc, 0, pm, pn, wr, wc, fr, fq, P, R, wid, lane, tid);
        upd(x0, 0);
        if constexpr (FROM_INPUT) { asm volatile("" ::: "memory"); ldx(x1, 1); }
        upd(x1, 1);
#pragma unroll
        for (int ai = 0; ai < 2; ++ai)
#pragma unroll
            for (int m = 0; m < MF; ++m) { const int row = row0 + 80 * ai + 48 * wr + 16 * m + fr;
#pragma unroll
                for (int q = 0; q < 4; ++q) { const int col = cb + 128 * (q >> 1) + 16 * (q & 1); const f32x4 x = acc[ai][q >> 1][m][q & 1];
                    if constexpr (FINAL) *(f32x4*)(xf_out + (size_t)row * DM + col) = x; else *(u32x2*)(xb_out + (size_t)row * DM + col) = pk4(x); } }
        if constexpr (!FINAL) {
            f32x4 al[4], ah[4], sl[4], sh[4];
            {   const float* ml = mod + (size_t)(layer_mod * 3 + c_lo) * 6144; const float* mh = mod + (size_t)(layer_mod * 3 + c_hi) * 6144;
#pragma unroll
                for (int q = 0; q < 4; ++q) { const int col = cb + 128 * (q >> 1) + 16 * (q & 1); const f32x4 gb = *(const f32x4*)(gB + col);
                    al[q] = gb * (*(const f32x4*)(ml + scale_off + col) + 1.f); ah[q] = gb * (*(const f32x4*)(mh + scale_off + col) + 1.f);
                    sl[q] = *(const f32x4*)(ml + shift_off + col); sh[q] = *(const f32x4*)(mh + shift_off + col); } }
            asm volatile("" ::: "memory");
            exchange<MF>(acc, 1, pm, pn, wr, wc, fr, fq, P, R, wid, lane, tid);
#pragma unroll
            for (int ai = 0; ai < 2; ++ai)
#pragma unroll
                for (int m = 0; m < MF; ++m) { const int rl = 80 * ai + 48 * wr + 16 * m + fr, row = row0 + rl; const float rinv = R[rl]; const bool hi = row_cond(row0 + 80 * ai + 48 * wr + 16 * m) != c_lo;
#pragma unroll
                    for (int q = 0; q < 4; ++q) { const int col = cb + 128 * (q >> 1) + 16 * (q & 1);
                        const f32x4 h = (acc[ai][q >> 1][m][q & 1] * rinv) * (hi ? ah[q] : al[q]) + (hi ? sh[q] : sl[q]);
                        *(u32x2*)(xn_out + (size_t)row * DM + col) = pk4(h); } }
        }
    }
};

struct EpiProj {
    bf16 *Q, *KP, *KS, *VTP, *VTS, *FB; float *ock, *ocv; const float* rope;
    static constexpr bool ALIGN = false, AFTER_DRAIN = false;
    __device__ __forceinline__ f32x4 do_rope(f32x4 v, int t, int col) const {
        const int i0 = (col & 63) >> 1;
        const f32x2 c = *(const f32x2*)(rope + t * 32 + i0), s = *(const f32x2*)(rope + 1024 * 32 + t * 32 + i0);
        f32x4 o; o[0] = v[0] * c[0] - v[1] * s[0]; o[1] = v[0] * s[0] + v[1] * c[0]; o[2] = v[2] * c[1] - v[3] * s[1]; o[3] = v[2] * s[1] + v[3] * c[1]; return o;
    }
    __device__ __forceinline__ void operator()(const f32x4 (&acc)[2][2][4][2], const pg8::Unit& u, int wr, int wc, int fr, int fq) const {
        pg8::epi_each(acc, u.pm * 256 + wr * 64 + fr, u.pn * 256 + wc * 32 + 4 * fq, [&](int row, int col, const f32x4& v) { elem(row, col, v); });
    }
    __device__ __forceinline__ void operator()(const f32x4 (&acc)[2][2][5], const pg8::Unit& u, int wid, int fr, int fq) const {
        epi_each160(acc, u, wid, fr, fq, [&](int row, int col, const f32x4& v) { elem(row, col, v); });
    }
    template <int MF> __device__ __forceinline__ void tile(const f32x4 (&acc)[2][2][MF][2], const pg8::Unit& u, int wr, int wc, int fr, int fq) const {
#pragma unroll
        for (int ai = 0; ai < 2; ++ai)
#pragma unroll
            for (int m = 0; m < MF; ++m)
#pragma unroll
                for (int bj = 0; bj < 2; ++bj)
#pragma unroll
                    for (int n = 0; n < 2; ++n) elem(u.pm * 160 + ai * 80 + wr * 48 + m * 16 + fr, u.pn * 256 + bj * 128 + wc * 32 + n * 16 + 4 * fq, acc[ai][bj][m][n]);
    }
    __device__ __forceinline__ void elem(int row, int col, const f32x4& v) const {
        {
            const bool smp = row >= NPR; const int sr = row - NPR, sb = sr >> 10, st = sr & 1023;
            if (col < 512) {
                f32x4 o = v; if (smp) o = do_rope(v, st, col);
                *(u32x2*)(Q + (size_t)row * 512 + col) = pk4(o);
            } else if (col < 1024) {
                const int c = col - 512;
                if (!smp) { *(f32x4*)(ock + (size_t)row * 512 + c) = v; *(u32x2*)(KP + (size_t)row * 512 + c) = pk4(v); }
                else { const f32x4 o = do_rope(v, st, c); *(u32x2*)(KS + ((size_t)sb * LKS + PAST + st) * 512 + c) = pk4(o); }
            } else if (col < 1536) {
                const int c = col - 1024, h = c >> 7, d = c & 127;
                if (!smp) { *(f32x4*)(ocv + (size_t)row * 512 + c) = v; const int b = row >> 8, t = row & 255; bf16* p = VTP + ((size_t)(b * 4 + h) * 128 + d) * SEQ + keypos(t);
#pragma unroll
                    for (int e = 0; e < 4; ++e) p[(size_t)e * SEQ] = f2bf(v[e]); }
                else { bf16* p = VTS + ((size_t)(sb * 4 + h) * 128 + d) * LKS + keypos(PAST + st);
#pragma unroll
                    for (int e = 0; e < 4; ++e) p[(size_t)e * LKS] = f2bf(v[e]); }
            } else if (col < INE) {
                *(u32x2*)(FB + (size_t)row * INB + (col - 1536)) = pk4(v);
            }
        }
    }
};


template <int CTRL> __device__ __forceinline__ float dpp_mv(float old, float src) { return __int_as_float(__builtin_amdgcn_update_dpp(__float_as_int(old), __float_as_int(src), CTRL, 0xf, 0xf, false)); }
template <int CTRL> __device__ __forceinline__ float dpp_rot(float src) { return __int_as_float(__builtin_amdgcn_mov_dpp(__float_as_int(src), CTRL, 0xf, 0xf, true)); }
__device__ __forceinline__ float silu_mul(float x, float u) { return x * __builtin_amdgcn_rcpf(1.f + __expf(-x)) * u; }
struct EpiFfnConv {
    static constexpr bool ALIGN = true;
    bf16* ACT; const float* cw; const float* cb; float* SB; LAS float* xch;
    __device__ __forceinline__ void operator()(const f32x4 (&acc)[2][2][4][2], const pg8::Unit& u, int wr, int wc, int fr, int fq) const {
        const int pm = u.pm, pn = u.pn;
        const bool smp = pm >= 32; const int sidx = pm - 32, sq = sidx & 3;
        const bool has_prev = smp && sq > 0, has_next = smp && sq < 3;
#pragma unroll
        for (int ai = 0; ai < 2; ++ai)
#pragma unroll
            for (int n = 0; n < 2; ++n) { const int c = 32 * wc + 16 * n + 4 * fq, blk = 2 * ai + wr;
                if (fr == 0) *(LAS f32x4*)(xch + (blk * 2 + 0) * 128 + c) = acc[ai][1][0][n];
                if (fr == 15) *(LAS f32x4*)(xch + (blk * 2 + 1) * 128 + c) = acc[ai][1][3][n]; }
        asm volatile("s_waitcnt lgkmcnt(0)" ::: "memory"); __builtin_amdgcn_s_barrier(); asm volatile("" ::: "memory");
#pragma unroll
        for (int n = 0; n < 2; ++n) {
            const int c = 32 * wc + 16 * n + 4 * fq, f = 128 * pn + c;
            const f32x4 c0 = *(const f32x4*)(cw + f), c1 = *(const f32x4*)(cw + DFF + f), c2 = *(const f32x4*)(cw + 2 * DFF + f), cbv = *(const f32x4*)(cb + f);
#pragma unroll
            for (int ai = 0; ai < 2; ++ai) {
                const int blk = 2 * ai + wr;
                f32x4 gabove = {0.f, 0.f, 0.f, 0.f}, gbelow = gabove;
                if (blk > 0) gabove = *(const LAS f32x4*)(xch + ((blk - 1) * 2 + 1) * 128 + c);
                if (blk < 3) gbelow = *(const LAS f32x4*)(xch + ((blk + 1) * 2 + 0) * 128 + c);
#pragma unroll
                for (int m = 0; m < 4; ++m) {
                    const f32x4 g = acc[ai][1][m][n], uu = acc[ai][0][m][n];
                    f32x4 o, xs;
#pragma unroll
                    for (int e = 0; e < 4; ++e) {
                        const float pold = m > 0 ? dpp_rot<0x121>(acc[ai][1][m - 1][n][e]) : gabove[e];
                        const float prev = dpp_mv<0x111>(pold, g[e]);
                        const float nold = m < 3 ? dpp_rot<0x12F>(acc[ai][1][m + 1][n][e]) : gbelow[e];
                        const float next = dpp_mv<0x101>(nold, g[e]);
                        const float x = c0[e] * prev + (c1[e] * g[e] + (c2[e] * next + cbv[e]));
                        xs[e] = x; o[e] = silu_mul(x, uu[e]);
                    }
                    const int r = 128 * ai + 64 * wr + 16 * m + fr;
                    *(u32x2*)(ACT + (size_t)(256 * pm + r) * DFF + f) = pk4(o);
                    if (smp) {
                        if (r == 0) { *(f32x4*)(SB + (size_t)(0 * 8 + sidx) * DFF + f) = g; if (has_prev) { *(f32x4*)(SB + (size_t)(2 * 8 + sidx) * DFF + f) = xs; *(f32x4*)(SB + (size_t)(3 * 8 + sidx) * DFF + f) = uu; } }
                        if (r == 255) { *(f32x4*)(SB + (size_t)(1 * 8 + sidx) * DFF + f) = g; if (has_next) { *(f32x4*)(SB + (size_t)(4 * 8 + sidx) * DFF + f) = xs; *(f32x4*)(SB + (size_t)(5 * 8 + sidx) * DFF + f) = uu; } }
                    }
                }
            }
        }
    }
};
template <class Sched>
__device__ __forceinline__ void ffn_seam_fixup(const Sched& S, int rows_per_unit, bf16* ACT, const float* cw, const float* SB) {
    pg8::Unit u;
    for (int i = 0; S.next(i, u); ++i) {
        const int lo = u.pm * rows_per_unit, hi = lo + rows_per_unit;
        if (hi <= NPR) continue;
        int t0 = threadIdx.x; asm volatile("" : "+v"(t0));
        for (int sidx = 0; sidx < 8; ++sidx) {
            const int sq = sidx & 3, r0 = 256 * (32 + sidx), r1 = r0 + 255;
            const bool fix0 = sq > 0 && r0 >= lo && r0 < hi, fix1 = sq < 3 && r1 >= lo && r1 < hi;
            if (!fix0 && !fix1) continue;
            for (int f = t0; f < DFF; f += 512) {
                if (fix0) { const float x = SB[(size_t)(2 * 8 + sidx) * DFF + f] + cw[f] * SB[(size_t)(1 * 8 + sidx - 1) * DFF + f]; ACT[(size_t)r0 * DFF + f] = f2bf(silu_mul(x, SB[(size_t)(3 * 8 + sidx) * DFF + f])); }
                if (fix1) { const float x = SB[(size_t)(4 * 8 + sidx) * DFF + f] + cw[2 * DFF + f] * SB[(size_t)(0 * 8 + sidx + 1) * DFF + f]; ACT[(size_t)r1 * DFF + f] = f2bf(silu_mul(x, SB[(size_t)(5 * 8 + sidx) * DFF + f])); }
            }
        }
    }
    asm volatile("s_waitcnt vmcnt(0)" ::: "memory");
    __syncthreads();
}

struct DftOrder {
    int G, c; const char* A; const char* BtS; const char* BtP;
    __device__ bool next(int i, pg8::Unit& u) const {
        const int j = i * G + c; if (j >= 160) return false;
        u.pm = 0; u.a = A;
        if (j < 32) { const int b = j >> 4, p = (j >> 2) & 3, pn = j & 3; u.pn = pn; u.z = NPR + b * 1024 + p; u.b = BtS + ((size_t)(b * 4 + p) * 1024 + pn * 256) * 512 * 2; }
        else { const int q = j - 32, b = q >> 2, pn = q & 3; u.pn = pn; u.z = b * 256; u.b = BtP + ((size_t)b * 1024 + pn * 256) * 512 * 2; }
        return true;
    }
};
struct EpiDft {
    bf16* O;
    static constexpr bool ALIGN = false;
    __device__ __forceinline__ void operator()(const f32x4 (&acc)[2][2][4][2], const pg8::Unit& u, int wr, int wc, int fr, int fq) const {
        const int st = u.z >= NPR ? 4 : 1;
        pg8::epi_each(acc, wr * 64 + fr, u.pn * 256 + wc * 32 + 4 * fq, [&](int r, int col, const f32x4& v) { *(u32x2*)(O + (size_t)(u.z + st * r) * 1024 + col) = pk4(v); });
    }
};

__device__ __forceinline__ f32x16 mfma32(bf16x8 x, bf16x8 y, f32x16 c) { return __builtin_amdgcn_mfma_f32_32x32x16_bf16(x, y, c, 0, 0, 0); }
__device__ __forceinline__ void phase_attention(const Args& a, LAS unsigned char* lds, int bid, int G) {
    int tid = threadIdx.x; asm volatile("" : "+v"(tid));
    const int lane = tid & 63, wave = __builtin_amdgcn_readfirstlane(tid >> 6), tk = lane & 31, hh = lane >> 5;
    const float cs = 0.125f * 1.4426950408889634f;
    const bf16* Q = WSB(WS_Q);
    bf16* AB = WSB(WS_XN);
    const float* subln = FIN(I_SUBLN);
    constexpr int KST = 136, VST = 40;
    LAS bf16* Kl = (LAS bf16*)lds;
    LAS bf16* Vl = (LAS bf16*)(lds + 2 * 32 * KST * 2);
    LAS bf16* Ql = (LAS bf16*)(lds + 40960 + wave * 8192);
    const int lkey = tid >> 4, lkc = tid & 15, lvd = tid >> 2, lvc = tid & 3;
    for (int ai = 0; ai < 2; ++ai) {
        int item;
        if (G == 256) {
            if (bid >= 224) item = ai == 0 ? bid - 224 : -1;
            else if (bid >= 160) item = 32 + 2 * (bid - 160) + ai;
            else item = -1;
        } else item = bid + ai * G;
        if (item < 0 || item >= 160) continue;
        int b, h, nkeys, qrow0; const bf16 *Kb, *VT;
        if (item < 32) { b = item >> 4; h = (item >> 2) & 3; const int qb = item & 3; nkeys = LKS; qrow0 = NPR + b * 1024 + qb * 256 + wave * 32; Kb = WSB(WS_KS) + (size_t)b * LKS * 512; VT = WSB(WS_VTS) + (size_t)(b * 4 + h) * 128 * LKS; }
        else { const int j = item - 32; b = j >> 2; h = j & 3; nkeys = SEQ; qrow0 = b * 256 + wave * 32; Kb = WSB(WS_KP) + (size_t)b * 256 * 512; VT = WSB(WS_VTP) + (size_t)(b * 4 + h) * 128 * SEQ; }
        f32x16 O[2][4];
#pragma unroll
        for (int m = 0; m < 2; ++m)
#pragma unroll
            for (int mt = 0; mt < 4; ++mt)
#pragma unroll
                for (int r = 0; r < 16; ++r) O[m][mt][r] = 0.f;
        float mx[2] = {-1e30f, -1e30f}, ls[2] = {0.f, 0.f};
        const bf16* kg = Kb + (size_t)lkey * 512 + h * 128 + lkc * 8;
        const bf16* vg = VT + (size_t)lvd * nkeys + lvc * 8;
        __syncthreads();
#pragma unroll
        for (int m = 0; m < 2; ++m)
#pragma unroll
            for (int s = 0; s < 4; ++s) *(LAS bf16x8*)(Ql + ((m * 4 + s) * 64 + lane) * 8) = *(const bf16x8*)(Q + (size_t)(qrow0 + tk) * 512 + h * 128 + m * 64 + 16 * s + 8 * hh);
        { const u32x4 k0v = *(const u32x4*)kg, v0v = *(const u32x4*)vg;
          *(LAS u32x4*)(Kl + lkey * KST + lkc * 8) = k0v; *(LAS u32x4*)(Vl + lvd * VST + lvc * 8) = v0v; }
        const int nt = nkeys / 32;
        for (int t = 0; t < nt; ++t) {
            const int cur = t & 1;
            const bool more = t + 1 < nt;
            u32x4 kn = {0u, 0u, 0u, 0u}, vn = kn;
            if (more) { kn = *(const u32x4*)(kg + (size_t)(t + 1) * 32 * 512); vn = *(const u32x4*)(vg + (t + 1) * 32); }
            __syncthreads();
            const LAS bf16* Kc = Kl + cur * 32 * KST + tk * KST + 8 * hh;
            const LAS bf16* Vc = Vl + cur * 128 * VST + tk * VST + 8 * hh;
            bf16x8 pb[2][2];
#pragma unroll
            for (int m = 0; m < 2; ++m) {
                f32x16 S;
#pragma unroll
                for (int r = 0; r < 16; ++r) S[r] = 0.f;
#pragma unroll
                for (int s = 0; s < 4; ++s) { const bf16x8 kf = *(const LAS bf16x8*)(Kc + m * 64 + 16 * s); const bf16x8 qfr = *(const LAS bf16x8*)(Ql + ((m * 4 + s) * 64 + lane) * 8); S = mfma32(kf, qfr, S); }
                float tm = S[0];
#pragma unroll
                for (int r = 1; r < 16; ++r) tm = fmaxf(tm, S[r]);
                tm = fmaxf(tm, __shfl_xor(tm, 32));
                if (__any(tm > mx[m] + 44.0f)) {
                    const float mn = fmaxf(mx[m], tm), alpha = __builtin_amdgcn_exp2f((mx[m] - mn) * cs); mx[m] = mn;
                    ls[m] *= alpha;
#pragma unroll
                    for (int mt = 0; mt < 4; ++mt)
#pragma unroll
                        for (int r = 0; r < 16; ++r) O[m][mt][r] *= alpha;
                }
                const float mcur = mx[m];
                float ps = 0.f;
#pragma unroll
                for (int r = 0; r < 16; ++r) { S[r] = __builtin_amdgcn_exp2f((S[r] - mcur) * cs); ps += S[r]; }
                ls[m] += ps;
#pragma unroll
                for (int s2 = 0; s2 < 2; ++s2) { u32x4 w; w.x = pk2(S[8 * s2 + 0], S[8 * s2 + 1]); w.y = pk2(S[8 * s2 + 2], S[8 * s2 + 3]); w.z = pk2(S[8 * s2 + 4], S[8 * s2 + 5]); w.w = pk2(S[8 * s2 + 6], S[8 * s2 + 7]); pb[m][s2] = __builtin_bit_cast(bf16x8, w); }
            }
#pragma unroll
            for (int mt = 0; mt < 4; ++mt) {
#pragma unroll
                for (int s2 = 0; s2 < 2; ++s2) { const bf16x8 vf = *(const LAS bf16x8*)(Vc + 32 * mt * VST + 16 * s2);
                    O[0][mt] = mfma32(vf, pb[0][s2], O[0][mt]); O[1][mt] = mfma32(vf, pb[1][s2], O[1][mt]); }
            }
            if (more) { *(LAS u32x4*)(Kl + (cur ^ 1) * 32 * KST + lkey * KST + lkc * 8) = kn; *(LAS u32x4*)(Vl + (cur ^ 1) * 128 * VST + lvd * VST + lvc * 8) = vn; }
        }
        const float l0 = ls[0] + __shfl_xor(ls[0], 32), l1 = ls[1] + __shfl_xor(ls[1], 32);
        const float lam = WSF(WS_LAM)[0];
        const float i0 = 1.f / l0, i1 = lam / l1;
        float ss = 0.f;
#pragma unroll
        for (int mt = 0; mt < 4; ++mt)
#pragma unroll
            for (int r = 0; r < 16; ++r) { const float o = O[0][mt][r] * i0 - O[1][mt][r] * i1; O[0][mt][r] = o; ss += o * o; }
        ss += __shfl_xor(ss, 32);
        const float rinv = rsqrtf(ss * (1.f / 128.f) + 1e-6f) * 0.8f;
        bf16* dst = AB + (size_t)(qrow0 + tk) * 1024 + h * 128;
#pragma unroll
        for (int mt = 0; mt < 4; ++mt)
#pragma unroll
            for (int rq = 0; rq < 4; ++rq) { const int d = 32 * mt + 8 * rq + 4 * hh; const f32x4 g = *(const f32x4*)(subln + d);
                f32x4 o; o[0] = O[0][mt][4 * rq + 0] * rinv * g[0]; o[1] = O[0][mt][4 * rq + 1] * rinv * g[1]; o[2] = O[0][mt][4 * rq + 2] * rinv * g[2]; o[3] = O[0][mt][4 * rq + 3] * rinv * g[3];
                *(u32x2*)(dst + d) = pk4(o); }
    }
}

__device__ __forceinline__ float allred4(float x) {
    { auto r = __builtin_amdgcn_permlane16_swap(__float_as_uint(x), __float_as_uint(x), false, false); x = __uint_as_float(r[0]) + __uint_as_float(r[1]); }
    { auto r = __builtin_amdgcn_permlane32_swap(__float_as_uint(x), __float_as_uint(x), false, false); x = __uint_as_float(r[0]) + __uint_as_float(r[1]); }
    return x;
}

constexpr int OPS_KGRG = 0, OPS_KDBD = 4096, OPS_CINIT = 8192, OPS_VIMG = 12288, OPS_GAM = 14336, OPS_ITEM = 14592;
constexpr size_t WS_OPS = WS_MF;
static_assert(WS_OPS + (size_t)2 * 5120 * OPS_ITEM <= WS_Q, "ws ops");
__device__ __forceinline__ f32x4 mfma16(bf16x8 x, bf16x8 y, f32x4 c) { return __builtin_amdgcn_mfma_f32_16x16x32_bf16(x, y, c, 0, 0, 0); }
__device__ __forceinline__ bf16x8 frag_lo(f32x4 v) { u32x4 w; w.x = pk2(v[0], v[1]); w.y = pk2(v[2], v[3]); w.z = 0u; w.w = 0u; return __builtin_bit_cast(bf16x8, w); }
__device__ __forceinline__ void wave_lds_sync() { __syncthreads(); }


template <bool REV>
__device__ __forceinline__ void wkv_chunk_ops(unsigned char* ops, LAS unsigned char* wl, int lane, const float (&kkn)[16], const float (&wv)[16], const float (&kraw)[16], const float (&ad)[16], const float ka_, const float (&rr)[16], const unsigned (&vp)[8]) {
    int lane_ = lane; asm volatile("" : "+v"(lane_));
    const int lr = lane_ & 15, lg = lane_ >> 4, j = lane_;
    LAS bf16* KgR = (LAS bf16*)wl; LAS bf16* RgR = KgR + 16 * 72; LAS bf16* KiR = RgR + 16 * 72; LAS bf16* BiR = KiR + 16 * 72;
    LAS bf16* KgT = (LAS bf16*)(wl + 9216); LAS float* RgT = (LAS float*)(wl + 9216 + 2048); LAS bf16* VT = (LAS bf16*)(wl + 9216 + 2048 + 5120);
    LAS float* NL = (LAS float*)wl; LAS float* TL = (LAS float*)(wl + 2304);
    float gall = 1.f;
#pragma unroll
    for (int t = 0; t < 16; ++t) gall *= wv[t];
    *(float*)(ops + OPS_GAM + 4 * j) = gall;
    float grun = 1.f;
#pragma unroll
    for (int g = 0; g < 4; ++g) {
        float kdv[4], bdv[4]; unsigned vb4[4];
#pragma unroll
        for (int e = 0; e < 4; ++e) {
            const int tau = 4 * g + e, t = REV ? 15 - tau : tau;
            const float gprev = grun; grun *= wv[t];
            const float inv = __builtin_amdgcn_rcpf(grun);
            const float kg = kkn[t] * gprev, rg = rr[t] * grun, ki = kraw[t] * (1.f + (ad[t] - 1.f) * ka_) * inv, bi = kkn[t] * ad[t] * inv;
            kdv[e] = ki * gall; bdv[e] = -bi * gall; vb4[e] = (vp[t >> 1] >> (16 * (t & 1))) & 0xffffu;
            KgR[tau * 72 + j] = f2bf(kg); RgR[tau * 72 + j] = f2bf(rg); KiR[tau * 72 + j] = f2bf(ki); BiR[tau * 72 + j] = f2bf(bi);
            KgT[(g * 64 + j) * 4 + e] = f2bf(kg); RgT[j * 20 + tau] = rg; VT[(g * 64 + j) * 4 + e] = (bf16)vb4[e];
        }
        u32x4 w; w.x = pk2(kdv[0], kdv[1]); w.y = pk2(kdv[2], kdv[3]); w.z = pk2(bdv[0], bdv[1]); w.w = pk2(bdv[2], bdv[3]);
        *(u32x4*)(ops + OPS_KDBD + (((j >> 4) * 64 + (j & 15) + 16 * g) * 16)) = w;
        u32x2 vw; vw.x = vb4[0] | (vb4[1] << 16); vw.y = vb4[2] | (vb4[3] << 16);
        *(u32x2*)(ops + OPS_VIMG + (((j >> 4) * 64 + (j & 15) + 16 * g) * 8)) = vw;
    }
    wave_lds_sync();
    f32x4 akk = {0.f, 0.f, 0.f, 0.f}, akb = akk, ark = akk, arb = akk;
#pragma unroll
    for (int ks = 0; ks < 2; ++ks) {
        const bf16x8 fki = *(const LAS bf16x8*)(KiR + lr * 72 + 32 * ks + 8 * lg), fbi = *(const LAS bf16x8*)(BiR + lr * 72 + 32 * ks + 8 * lg);
        const bf16x8 fkg = *(const LAS bf16x8*)(KgR + lr * 72 + 32 * ks + 8 * lg), frg = *(const LAS bf16x8*)(RgR + lr * 72 + 32 * ks + 8 * lg);
        akk = mfma16(fki, fkg, akk); akb = mfma16(fbi, fkg, akb); ark = mfma16(fki, frg, ark); arb = mfma16(fbi, frg, arb);
    }
#pragma unroll
    for (int e = 0; e < 4; ++e) { const int s = 4 * lg + e; if (!(s < lr)) { akk[e] = 0.f; akb[e] = 0.f; } if (!(s <= lr)) { ark[e] = 0.f; arb[e] = 0.f; } }
    asm volatile("" : "+v"(akk), "+v"(akb), "+v"(ark), "+v"(arb));
    wave_lds_sync();
    *(LAS f32x4*)(NL + lr * 16 + 4 * lg) = akb;
    wave_lds_sync();
    {
        float Tc[16];
#pragma unroll
        for (int t = 0; t < 16; ++t) {
            float acc = (t == lr) ? 1.f : 0.f;
#pragma unroll
            for (int q4 = 0; q4 < (t + 3) / 4; ++q4) { const f32x4 nv = *(const LAS f32x4*)(NL + t * 16 + 4 * q4);
#pragma unroll
                for (int e = 0; e < 4; ++e) if (4 * q4 + e < t) acc -= nv[e] * Tc[4 * q4 + e]; }
            Tc[t] = acc;
        }
        if (lg == 0) {
#pragma unroll
            for (int t = 0; t < 16; ++t) TL[t * 16 + lr] = Tc[t];
        }
    }
    wave_lds_sync();
    const bf16x8 aT = frag_lo(*(const LAS f32x4*)(TL + lr * 16 + 4 * lg));
    const bf16x8 aKK = frag_lo(akk), aRK = frag_lo(ark), aRBn = frag_lo(-arb);
    const f32x4 z4 = {0.f, 0.f, 0.f, 0.f};
#pragma unroll
    for (int it = 0; it < 4; ++it) {
        const u32x2 vq = *(const LAS u32x2*)(VT + (lg * 64 + 16 * it + lr) * 4);
        const bf16x8 bV = __builtin_bit_cast(bf16x8, (u32x4){vq.x, vq.y, 0u, 0u});
        const f32x4 x1 = mfma16(aKK, bV, z4);
        const f32x4 vd = mfma16(aT, frag_lo(x1), z4);
        f32x4 yl = mfma16(aRK, bV, z4); yl = mfma16(aRBn, frag_lo(vd), yl);
        *(u32x2*)(ops + OPS_CINIT + ((0 * 4 + it) * 64 + lane) * 8) = pk4(vd);
        *(u32x2*)(ops + OPS_CINIT + ((1 * 4 + it) * 64 + lane) * 8) = pk4(yl);
    }
#pragma unroll
    for (int jt = 0; jt < 4; ++jt) {
        const u32x2 kq = *(const LAS u32x2*)(KgT + (lg * 64 + 16 * jt + lr) * 4);
        const bf16x8 bK = __builtin_bit_cast(bf16x8, (u32x4){kq.x, kq.y, 0u, 0u});
        const f32x4 kgp = mfma16(aT, bK, z4);
        const f32x4 rgp = mfma16(aRBn, frag_lo(kgp), *(const LAS f32x4*)(RgT + (16 * jt + lr) * 20 + 4 * lg));
        bf16* img = (bf16*)(ops + OPS_KGRG);
#pragma unroll
        for (int e = 0; e < 4; ++e) { const int t = 4 * lg + e; const int off = (((jt >> 1)) * 64 + t + 16 * (lr >> 2)) * 8 + 4 * (jt & 1) + (lr & 3);
            img[off] = f2bf(kgp[e]); img[2 * 64 * 8 + off] = f2bf(rgp[e]); }
    }
    wave_lds_sync();
}

__device__ __forceinline__ void phase_wkv_front(const Args& a, LAS unsigned char* lds, int bid, int G) {
    int tid = threadIdx.x; asm volatile("" : "+v"(tid));
    const int lane = tid & 63, wave = __builtin_amdgcn_readfirstlane(tid >> 6);
    constexpr int AST = 392;
    typedef const __attribute__((address_space(1))) bf16* gcb;
    const bf16* FB = (const bf16*)a.out;
    LAS bf16* act = (LAS bf16*)(lds + ACT_OFF);
    LAS unsigned char* wl = lds + wave * 18432;
    LAS float* TR = (LAS float*)wl;
    const float* mu = FIN(I_MU); const float* kvec = FIN(I_KVEC); const float* w0 = FIN(I_W0); const float* a0 = FIN(I_A0);
    bf16* AB = WSB(WS_XN); bf16* BON = WSB(WS_BONUS);
    int it_lo, it_n;
    if (G == 256) { if (bid < 160) { it_lo = 3 * bid; it_n = 3; } else if (bid < 224) { it_lo = 480 + 2 * (bid - 160); it_n = 2; } else { it_lo = 608 + (bid - 224); it_n = 1; } }
    else { it_lo = bid; it_n = (640 - bid + G - 1) / G; }
    for (int ii = 0; ii < it_n; ++ii) {
        const int item = (G == 256) ? it_lo + ii : it_lo + ii * G;
        int smp, sq, c, L, rowbase, nc;
        if (item < 128) { smp = 1; sq = item >> 6; c = item & 63; L = DSEQ; rowbase = NPR + sq * DSEQ; nc = 64; }
        else { const int p = item - 128; smp = 0; sq = p >> 4; c = p & 15; L = SEQ; rowbase = sq * SEQ; nc = 16; }
        const int row0 = rowbase + 16 * c, tp0 = 16 * c;
        __syncthreads();
        int tq = tid; asm volatile("" : "+v"(tq));
        for (int idx = tq; idx < 16 * 96; idx += 512) {
            const int tl = idx / 96, cg = idx - tl * 96, col = 1536 + 4 * cg, row = row0 + tl, tp = tp0 + tl;
            const f32x4 f = unpk4(*(const u32x2*)(FB + (size_t)row * INB + col));
            const f32x4 p = unpk4(*(const u32x2*)(FB + (size_t)(tp > 0 ? row - 1 : row) * INB + col)) * (tp > 0 ? 1.f : 0.f);
            const f32x4 n = unpk4(*(const u32x2*)(FB + (size_t)(tp < L - 1 ? row + 1 : row) * INB + col)) * (tp < L - 1 ? 1.f : 0.f);
            const f32x4 m0 = *(const f32x4*)(mu + col), m1 = *(const f32x4*)(mu + INB + col);
            f32x4 s = f + m0 * (p - f) + m1 * (n - f);
            const int kind = cg >> 5;
            if (kind == 0) { s[0] = tanhf(s[0]); s[1] = tanhf(s[1]); s[2] = tanhf(s[2]); s[3] = tanhf(s[3]); }
            else if (kind == 2) { s[0] = sigmoidf_(s[0]); s[1] = sigmoidf_(s[1]); s[2] = sigmoidf_(s[2]); s[3] = sigmoidf_(s[3]); }
            *(LAS u32x2*)(act + tl * AST + 4 * cg) = pk4(s);
        }
        __syncthreads();
        int j = lane; asm volatile("" : "+v"(j));
        const int lr = j & 15, lg = j >> 4;
        const int h = wave, col = h * 64 + j;
        auto lora_mma = [&](const bf16* WT, int ldk, int k0, int nks, f32x4 (&acc)[4]) {
            gcb wb = (gcb)(WT + (size_t)(h * 64 + lr) * ldk + 8 * lg);
            const LAS bf16* ab = act + lr * AST + k0 + 8 * lg;
            asm volatile("" : "+v"(wb), "+v"(ab));
#pragma unroll
            for (int jt = 0; jt < 4; ++jt) acc[jt] = (f32x4){0.f, 0.f, 0.f, 0.f};
            for (int ks = 0; ks < nks; ++ks) {
                const bf16x8 fa = *(const LAS bf16x8*)(ab + 32 * ks);
#pragma unroll
                for (int jt = 0; jt < 4; ++jt) { const bf16x8 fb = *(const __attribute__((address_space(1))) bf16x8*)(wb + (size_t)(16 * jt) * ldk + 32 * ks); acc[jt] = mfma16(fa, fb, acc[jt]); }
            }
        };
        auto tr_put = [&](int b, const f32x4 (&acc)[4]) {
#pragma unroll
            for (int jt = 0; jt < 4; ++jt) *(LAS f32x4*)(TR + b * 1280 + (16 * jt + lr) * 20 + 4 * lg) = acc[jt];
        };
        auto tr_get = [&](int b, float (&out)[16]) {
#pragma unroll
            for (int q = 0; q < 4; ++q) { const f32x4 x = *(const LAS f32x4*)(TR + b * 1280 + j * 20 + 4 * q); out[4 * q] = x[0]; out[4 * q + 1] = x[1]; out[4 * q + 2] = x[2]; out[4 * q + 3] = x[3]; }
        };
        f32x4 accG[4], accA0[4], accA1[4], accW0[4];
        lora_mma(WSB(WS_G2T), 128, 256, 4, accG);
        lora_mma(WSB(WS_A2T), 64, 128, 2, accA0);
        lora_mma(WSB(WS_A2T) + 512 * 64, 64, 192, 2, accA1);
        lora_mma(WSB(WS_W2T), 64, 0, 2, accW0);
        float r[16], k[16]; unsigned vp[8];
        {
            unsigned raw[3][18]; float v[16];
#pragma unroll
            for (int x = 0; x < 3; ++x)
#pragma unroll
                for (int q = 0; q < 18; ++q) { const int tp = tp0 - 1 + q; const int rw = row0 - 1 + q + (tp < 0 ? 1 : 0) - (tp > L - 1 ? 1 : 0); raw[x][q] = FB[(size_t)rw * INB + 512 * x + col]; }
            const float pm = tp0 > 0 ? 1.f : 0.f, nm = tp0 + 16 < L ? 1.f : 0.f;
            const float mr0 = mu[col], mr1 = mu[INB + col], mk0 = mu[512 + col], mk1 = mu[INB + 512 + col], mv0 = mu[1024 + col], mv1 = mu[INB + 1024 + col];
#pragma unroll
            for (int t = 0; t < 16; ++t) {
                const float pmask = t == 0 ? pm : 1.f, nmask = t == 15 ? nm : 1.f;
                { const float f = bf2f(raw[0][t + 1]), p = bf2f(raw[0][t]) * pmask, n = bf2f(raw[0][t + 2]) * nmask; r[t] = f + mr0 * (p - f) + mr1 * (n - f); }
                { const float f = bf2f(raw[1][t + 1]), p = bf2f(raw[1][t]) * pmask, n = bf2f(raw[1][t + 2]) * nmask; k[t] = f + mk0 * (p - f) + mk1 * (n - f); }
                { const float f = bf2f(raw[2][t + 1]), p = bf2f(raw[2][t]) * pmask, n = bf2f(raw[2][t + 2]) * nmask; v[t] = f + mv0 * (p - f) + mv1 * (n - f); }
            }
#pragma unroll
            for (int q = 0; q < 8; ++q) vp[q] = pk2(v[2 * q], v[2 * q + 1]);
        }
        float av0[16], av1[16];
        {
            float graw[16];
            tr_put(0, accG); tr_put(1, accA0); tr_put(2, accA1);
            wave_lds_sync();
            tr_get(0, graw); tr_get(1, av0); tr_get(2, av1);
            wave_lds_sync();
#pragma unroll
            for (int t = 0; t < 16; ++t) AB[(size_t)(row0 + t) * 1024 + 512 + col] = f2bf(graw[t]);
        }
        float wv0[16];
        {
            tr_put(0, accW0);
            wave_lds_sync();
            tr_get(0, wv0);
            wave_lds_sync();
            const float w00 = w0[col];
#pragma unroll
            for (int t = 0; t < 16; ++t) wv0[t] = __expf(-0.60653065971f * sigmoidf_(w00 + wv0[t]));
        }
        const float kk_ = kvec[col], ka_ = kvec[512 + col], rk_ = kvec[1024 + col], a00 = a0[col], a01 = a0[512 + col];
        float kkn[16];
        {
            LAS float* RED1 = (LAS float*)wl; LAS float* RED2 = RED1 + 64 * 17; LAS float* TOT = RED2 + 64 * 17;
#pragma unroll
            for (int t = 0; t < 16; ++t) {
                av0[t] = sigmoidf_(a00 + av0[t]); av1[t] = sigmoidf_(a01 + av1[t]);
                const float kr = k[t] * kk_; kkn[t] = kr;
                RED1[j * 17 + t] = kr * kr; RED2[j * 17 + t] = r[t] * rk_ * k[t] * (2.f + (av0[t] + av1[t] - 2.f) * ka_);
            }
            wave_lds_sync();
            float s1 = 0.f, s2 = 0.f;
#pragma unroll
            for (int jj = 0; jj < 16; ++jj) { s1 += RED1[(16 * lg + jj) * 17 + lr]; s2 += RED2[(16 * lg + jj) * 17 + lr]; }
            s1 = allred4(s1); s2 = allred4(s2);
            if (lg == 0) { TOT[lr] = rsqrtf(s1 + 1e-12f); TOT[16 + lr] = s2; }
            wave_lds_sync();
#pragma unroll
            for (int q = 0; q < 4; ++q) { const f32x4 ri = *(const LAS f32x4*)(TOT + 4 * q), rs = *(const LAS f32x4*)(TOT + 16 + 4 * q);
#pragma unroll
                for (int e = 0; e < 4; ++e) { const int t = 4 * q + e; kkn[t] *= ri[e]; BON[(size_t)(row0 + t) * 512 + col] = f2bf(rs[e] * __uint_as_float((t & 1) ? (vp[t >> 1] & 0xffff0000u) : (vp[t >> 1] << 16))); } }
            wave_lds_sync();
        }
        {
            const int oi = smp ? 4096 + (sq * 8 + h) * 64 + c : (sq * 8 + h) * 16 + c;
            wkv_chunk_ops<false>(a.ws + WS_OPS + (size_t)oi * OPS_ITEM, wl, lane, kkn, wv0, k, av0, ka_, r, vp);
        }
        {
            float wv1[16];
            { f32x4 accW1[4]; lora_mma(WSB(WS_W2T) + 512 * 64, 64, 64, 2, accW1); tr_put(0, accW1); wave_lds_sync(); tr_get(0, wv1); wave_lds_sync();
              const float w01 = w0[512 + col];
#pragma unroll
              for (int t = 0; t < 16; ++t) wv1[t] = __expf(-0.60653065971f * sigmoidf_(w01 + wv1[t])); }
            const int cc = nc - 1 - c;
            const int oi = 5120 + (smp ? 4096 + (sq * 8 + h) * 64 + cc : (sq * 8 + h) * 16 + cc);
            wkv_chunk_ops<true>(a.ws + WS_OPS + (size_t)oi * OPS_ITEM, wl, lane, kkn, wv1, k, av1, ka_, r, vp);
        }
    }
}

struct ChainOps { bf16x8 kgrg[2][2]; u32x2 cinit[2]; bf16x8 kdbd[4]; u32x2 vimg; f32x4 gam[4]; };
__device__ __forceinline__ void chain_load(ChainOps& o, const unsigned char* ops, int lane, int it) {
    const int lg = lane >> 4;
#pragma unroll
    for (int rt = 0; rt < 2; ++rt) {
#pragma unroll
        for (int ks = 0; ks < 2; ++ks) o.kgrg[rt][ks] = *(const bf16x8*)(ops + OPS_KGRG + ((rt * 2 + ks) * 64 + lane) * 16);
        o.cinit[rt] = *(const u32x2*)(ops + OPS_CINIT + ((rt * 4 + it) * 64 + lane) * 8);
    }
#pragma unroll
    for (int jt = 0; jt < 4; ++jt) { o.kdbd[jt] = *(const bf16x8*)(ops + OPS_KDBD + (jt * 64 + lane) * 16); o.gam[jt] = *(const f32x4*)(ops + OPS_GAM + (16 * jt + 4 * lg) * 4); }
    o.vimg = *(const u32x2*)(ops + OPS_VIMG + (it * 64 + lane) * 8);
}
__device__ __forceinline__ void wkv_sample_wave(const Args& a, LAS float* ybuf, int idx, int lane) {
    const int lr = lane & 15, lg = lane >> 4;
    const int dir = idx >> 6, ch = (idx >> 2) & 15, it = idx & 3;
    const int b = ch >> 3, h = ch & 7, nc = 64, L = DSEQ, rowbase = NPR + b * DSEQ, opsbase = 4096 + ch * 64;
    float* Y = a.out;
    f32x4 H[4];
    { const float* sp = FIN(I_ST) + (size_t)((b * 2 + dir) * 8 + h) * 4096;
#pragma unroll
      for (int jt = 0; jt < 4; ++jt) H[jt] = *(const f32x4*)(sp + (16 * it + lr) * 64 + 16 * jt + 4 * lg); }
    const unsigned char* opsp = a.ws + WS_OPS + (size_t)(dir * 5120 + opsbase) * OPS_ITEM;
    float* yg = Y + ((size_t)dir * NT + rowbase) * 512 + h * 64 + 16 * it + 4 * (lane & 3);
    ChainOps o0, o1;
    chain_load(o0, opsp, lane, it);
    chain_load(o1, opsp + OPS_ITEM, lane, it);
    auto step = [&](const ChainOps& cur, int c) {
        bf16x8 bh[2];
#pragma unroll
        for (int ks = 0; ks < 2; ++ks) { const u32x2 p0 = pk4(H[2 * ks]), p1 = pk4(H[2 * ks + 1]); bh[ks] = __builtin_bit_cast(bf16x8, (u32x4){p0.x, p0.y, p1.x, p1.y}); }
        f32x4 u = unpk4(cur.cinit[0]), y = unpk4(cur.cinit[1]);
#pragma unroll
        for (int ks = 0; ks < 2; ++ks) { u = mfma16(cur.kgrg[0][ks], bh[ks], u); y = mfma16(cur.kgrg[1][ks], bh[ks], y); }
#pragma unroll
        for (int e = 0; e < 4; ++e) ybuf[(16 * (c & 15) + 4 * lg + e) * 16 + lr] = y[e];
        const u32x2 up = pk4(u);
        const bf16x8 bvu = __builtin_bit_cast(bf16x8, (u32x4){cur.vimg.x, cur.vimg.y, up.x, up.y});
#pragma unroll
        for (int jt = 0; jt < 4; ++jt) H[jt] = mfma16(cur.kdbd[jt], bvu, H[jt] * cur.gam[jt]);
    };
    auto flush = [&](int c) {
        if ((c & 15) == 15) {
            asm volatile("s_waitcnt lgkmcnt(0)" ::: "memory");
            const int base = 256 * (c >> 4);
#pragma unroll 1
            for (int r0 = 0; r0 < 256; r0 += 16) { const int lt = base + r0 + (lane >> 2);
                *(f32x4*)(yg + (size_t)(dir ? L - 1 - lt : lt) * 512) = *(const LAS f32x4*)(ybuf + (r0 + (lane >> 2)) * 16 + 4 * (lane & 3)); }
            asm volatile("s_waitcnt lgkmcnt(0)" ::: "memory");
        }
    };
    ChainOps o2; chain_load(o2, opsp + 2 * OPS_ITEM, lane, it);
    int c = 0;
#pragma unroll 1
    for (; c + 2 < nc; c += 3) {
        step(o0, c); chain_load(o0, opsp + (size_t)(c + 3 < nc ? c + 3 : nc - 1) * OPS_ITEM, lane, it); flush(c);
        step(o1, c + 1); chain_load(o1, opsp + (size_t)(c + 4 < nc ? c + 4 : nc - 1) * OPS_ITEM, lane, it); flush(c + 1);
        step(o2, c + 2); chain_load(o2, opsp + (size_t)(c + 5 < nc ? c + 5 : nc - 1) * OPS_ITEM, lane, it); flush(c + 2);
    }
    for (; c < nc; ++c) { step(o0, c); flush(c); }
    asm volatile("s_waitcnt vmcnt(0) lgkmcnt(0)" ::: "memory");
}

struct ChainSh { bf16x8 kg, kd; float gm; };
struct ChainPr { u32x2 ci0, ci1, vi; };
__device__ __forceinline__ void chain_sh(ChainSh& o, const unsigned char* ops, int lane, int it) {
    o.kg = *(const bf16x8*)(ops + OPS_KGRG + (it * 64 + lane) * 16);
    o.kd = *(const bf16x8*)(ops + OPS_KDBD + (it * 64 + lane) * 16);
    o.gm = *(const float*)(ops + OPS_GAM + (16 * it + (lane & 15)) * 4);
}
__device__ __forceinline__ void chain_pr(ChainPr& o, const unsigned char* ops, int lane, int it) {
    o.ci0 = *(const u32x2*)(ops + OPS_CINIT + ((0 * 4 + it) * 64 + lane) * 8);
    o.ci1 = *(const u32x2*)(ops + OPS_CINIT + ((1 * 4 + it) * 64 + lane) * 8);
    o.vi = *(const u32x2*)(ops + OPS_VIMG + (it * 64 + lane) * 8);
}
template <bool DRY = false>
__device__ __forceinline__ void phase_wkv_chain(const Args& a, LAS unsigned char* lds, int bid, int G) {
    int tid = threadIdx.x; asm volatile("" : "+v"(tid));
    const int lane = tid & 63, wave = __builtin_amdgcn_readfirstlane(tid >> 6);
    const int lr = lane & 15, lg = lane >> 4;
    float* Y = a.out;
    LAS float* ybuf = (LAS float*)(lds + wave * 16384);
    const int dir = wave >> 2, it = wave & 3;
    LAS unsigned char* slot = lds + 131072 + dir * 8448;
    const bf16* BON = WSB(WS_BONUS); bf16* AB = WSB(WS_XN);
    const float* lnx = FIN(I_LNX);
    if (G == 256 && bid < 128) {
        if (wave == 0) wkv_sample_wave(a, (LAS float*)lds, bid, lane);
        return;
    }
#pragma unroll 1
    for (int jrep = 0; ; ++jrep) {
        int k;
        if (G == 256) { if (jrep < 2) k = 16 + 2 * (bid - 128) + jrep; else break; }
        else { k = bid + jrep * G; if (k >= 272) break; }
        int smp, b, h, nc, L, rowbase, opsbase;
        if (k < 16) { smp = 1; b = k >> 3; h = k & 7; nc = 64; L = DSEQ; rowbase = NPR + b * DSEQ; opsbase = 4096 + k * 64; }
        else { const int p = k - 16; smp = 0; b = p >> 3; h = p & 7; nc = 16; L = SEQ; rowbase = b * SEQ; opsbase = p * 16; }
        f32x4 H[4];
        if (smp) {
            const float* sp = FIN(I_ST) + (size_t)((b * 2 + dir) * 8 + h) * 4096;
#pragma unroll
            for (int jt = 0; jt < 4; ++jt) H[jt] = *(const f32x4*)(sp + (16 * it + lr) * 64 + 16 * jt + 4 * lg);
        } else {
#pragma unroll
            for (int jt = 0; jt < 4; ++jt) H[jt] = (f32x4){0.f, 0.f, 0.f, 0.f};
        }
        const unsigned char* opsp = a.ws + WS_OPS + (size_t)(dir * 5120 + opsbase) * OPS_ITEM;
        float* yg = Y + ((size_t)dir * NT + rowbase) * 512 + h * 64 + 16 * it + 4 * (lane & 3);
        constexpr int D = 8;
        ChainSh sh[D]; ChainPr pr[D];
#pragma unroll
        for (int i = 0; i < D; ++i) { chain_sh(sh[i], opsp + (size_t)i * OPS_ITEM, lane, it); chain_pr(pr[i], opsp + (size_t)i * OPS_ITEM, lane, it); }
        auto put = [&](const ChainSh& o) {
            *(LAS bf16x8*)(slot + it * 1024 + lane * 16) = o.kg; *(LAS bf16x8*)(slot + 4096 + it * 1024 + lane * 16) = o.kd;
            if (lane < 16) *(LAS float*)(slot + 8192 + (16 * it + lane) * 4) = o.gm; };
        put(sh[0]);
        chain_sh(sh[0], opsp + (size_t)(D < nc ? D : nc - 1) * OPS_ITEM, lane, it);
        asm volatile("s_waitcnt lgkmcnt(0)" ::: "memory"); __builtin_amdgcn_s_barrier(); asm volatile("" ::: "memory");
#pragma unroll 1
        for (int c = 0; c < nc; c += D) {
#pragma unroll
            for (int i = 0; i < D; ++i) {
                const int cc = c + i;
                bf16x8 kgrg[2][2], kdbd[4]; f32x4 gam[4];
#pragma unroll
                for (int q = 0; q < 4; ++q) { kgrg[q >> 1][q & 1] = *(const LAS bf16x8*)(slot + q * 1024 + lane * 16); kdbd[q] = *(const LAS bf16x8*)(slot + 4096 + q * 1024 + lane * 16); gam[q] = *(const LAS f32x4*)(slot + 8192 + (16 * q + 4 * lg) * 4); }
                asm volatile("s_waitcnt lgkmcnt(0)" ::: "memory"); __builtin_amdgcn_s_barrier(); asm volatile("" ::: "memory");
                put(sh[(i + 1) % D]);
                chain_sh(sh[(i + 1) % D], opsp + (size_t)(cc + 1 + D < nc ? cc + 1 + D : nc - 1) * OPS_ITEM, lane, it);
                const u32x2 c0 = pr[i].ci0, c1 = pr[i].ci1, cv = pr[i].vi;
                bf16x8 bh[2];
#pragma unroll
                for (int ks = 0; ks < 2; ++ks) { const u32x2 p0 = pk4(H[2 * ks]), p1 = pk4(H[2 * ks + 1]); bh[ks] = __builtin_bit_cast(bf16x8, (u32x4){p0.x, p0.y, p1.x, p1.y}); }
                f32x4 u = unpk4(c0), y = unpk4(c1);
#pragma unroll
                for (int ks = 0; ks < 2; ++ks) { u = mfma16(kgrg[0][ks], bh[ks], u); y = mfma16(kgrg[1][ks], bh[ks], y); }
#pragma unroll
                for (int e = 0; e < 4; ++e) ybuf[(16 * (cc & 15) + 4 * lg + e) * 16 + lr] = y[e];
                const u32x2 up = pk4(u);
                const bf16x8 bvu = __builtin_bit_cast(bf16x8, (u32x4){cv.x, cv.y, up.x, up.y});
#pragma unroll
                for (int jt = 0; jt < 4; ++jt) H[jt] = mfma16(kdbd[jt], bvu, H[jt] * gam[jt]);
                chain_pr(pr[i], opsp + (size_t)(cc + D < nc ? cc + D : nc - 1) * OPS_ITEM, lane, it);
                if (smp && (cc & 15) == 15) {
                    asm volatile("s_waitcnt lgkmcnt(0)" ::: "memory");
                    const int base = 256 * (cc >> 4);
#pragma unroll 1
                    for (int r0 = 0; r0 < 256; r0 += 16) { const int lt = base + r0 + (lane >> 2);
                        *(f32x4*)(yg + (size_t)(dir ? L - 1 - lt : lt) * 512) = *(const LAS f32x4*)(ybuf + (r0 + (lane >> 2)) * 16 + 4 * (lane & 3)); }
                }
                asm volatile("s_waitcnt lgkmcnt(0)" ::: "memory"); __builtin_amdgcn_s_barrier(); asm volatile("" ::: "memory");
            }
        }
        if (!smp) { float* op = a.out + OUT_ST + (size_t)((b * 2 + dir) * 8 + h) * 4096;
#pragma unroll
            for (int jt = 0; jt < 4; ++jt) *(f32x4*)(op + (16 * it + lr) * 64 + 16 * jt + 4 * lg) = H[jt]; }
        asm volatile("s_waitcnt vmcnt(0) lgkmcnt(0)" ::: "memory");
        __syncthreads();
        if (smp) continue;
        {
            const int hf = tid & 1;
            const float* l0p = lnx + h * 64 + 32 * hf; const float* l1p = lnx + 512 + h * 64 + 32 * hf;
            for (int t = tid >> 1; t < L; t += 256) {
                float x[32];
#pragma unroll
                for (int q = 0; q < 8; ++q) { const int itq = 2 * hf + (q >> 2);
                    const f32x4 f = *(const LAS f32x4*)(lds + itq * 16384 + (t * 16 + 4 * (q & 3)) * 4), g = *(const LAS f32x4*)(lds + (4 + itq) * 16384 + ((L - 1 - t) * 16 + 4 * (q & 3)) * 4);
                    x[4 * q] = f[0] + g[0]; x[4 * q + 1] = f[1] + g[1]; x[4 * q + 2] = f[2] + g[2]; x[4 * q + 3] = f[3] + g[3]; }
                float s = 0.f;
#pragma unroll
                for (int e = 0; e < 32; ++e) s += x[e];
                s += __shfl_xor(s, 1);
                const float mu = s * (1.f / 64.f);
                float v = 0.f;
#pragma unroll
                for (int e = 0; e < 32; ++e) { x[e] -= mu; v += x[e] * x[e]; }
                v += __shfl_xor(v, 1);
                const float rstd = rsqrtf(v * (1.f / 64.f) + 64e-5f);
                const size_t row = (size_t)rowbase + t;
                const bf16* bp = BON + row * 512 + h * 64 + 32 * hf; bf16* gp = AB + row * 1024 + 512 + h * 64 + 32 * hf;
#pragma unroll
                for (int q = 0; q < 4; ++q) {
                    const u32x4 bw = *(const u32x4*)(bp + 8 * q), gw4 = *(const u32x4*)(gp + 8 * q);
                    const f32x4 bo0 = unpk4((u32x2){bw.x, bw.y}), bo1 = unpk4((u32x2){bw.z, bw.w}), gg0 = unpk4((u32x2){gw4.x, gw4.y}), gg1 = unpk4((u32x2){gw4.z, gw4.w});
                    const f32x4 l00 = *(const f32x4*)(l0p + 8 * q), l01 = *(const f32x4*)(l0p + 8 * q + 4), l10 = *(const f32x4*)(l1p + 8 * q), l11 = *(const f32x4*)(l1p + 8 * q + 4);
                    f32x4 o0, o1;
#pragma unroll
                    for (int e = 0; e < 4; ++e) { o0[e] = (x[8 * q + e] * rstd * l00[e] + l10[e] + bo0[e]) * gg0[e]; o1[e] = (x[8 * q + 4 + e] * rstd * l01[e] + l11[e] + bo1[e]) * gg1[e]; }
                    const u32x2 p0 = pk4(o0), p1 = pk4(o1);
                    *(u32x4*)((DRY ? (bf16*)(a.ws + 248 * MiB) + row * 512 + h * 64 + 32 * hf : gp) + 8 * q) = (u32x4){p0.x, p0.y, p1.x, p1.y};
                }
            }
        }
        __syncthreads();
    }
}

template <bool WT = false>
__device__ __forceinline__ void phase_combine(const Args& a, int bid, int G) {
    int tid = threadIdx.x; asm volatile("" : "+v"(tid));
    const int lane = tid & 63, wave = tid >> 6;
    const int gw = bid * 8 + wave, NGW = G * 8;
    const float* Y = a.out; const bf16* BON = WSB(WS_BONUS); bf16* AB = WSB(WS_XN);
    const float* lnx = FIN(I_LNX);
    const int c = lane * 8;
    constexpr int R = 1;
    for (int row0 = NPR + gw; row0 < NT; row0 += R * NGW) {
        f32x4 f0[R], f1[R], g0[R], g1[R]; u32x4 bw[R], gw4[R];
#pragma unroll
        for (int q = 0; q < R; ++q) { const int row = row0 + q * NGW; if (row < NT) {
            f0[q] = *(const f32x4*)(Y + (size_t)row * 512 + c); f1[q] = *(const f32x4*)(Y + (size_t)row * 512 + c + 4);
            g0[q] = *(const f32x4*)(Y + (size_t)(NT + row) * 512 + c); g1[q] = *(const f32x4*)(Y + (size_t)(NT + row) * 512 + c + 4);
            bw[q] = *(const u32x4*)(BON + (size_t)row * 512 + c); gw4[q] = *(const u32x4*)(AB + (size_t)row * 1024 + 512 + c); } }
        const f32x4 l00 = *(const f32x4*)(lnx + c), l01 = *(const f32x4*)(lnx + c + 4), l10 = *(const f32x4*)(lnx + 512 + c), l11 = *(const f32x4*)(lnx + 512 + c + 4);
#pragma unroll
        for (int q = 0; q < R; ++q) { const int row = row0 + q * NGW; if (row < NT) {
            float x[8];
#pragma unroll
            for (int e = 0; e < 4; ++e) { x[e] = f0[q][e] + g0[q][e]; x[4 + e] = f1[q][e] + g1[q][e]; }
            float s = 0.f;
#pragma unroll
            for (int e = 0; e < 8; ++e) s += x[e];
            s += __shfl_xor(s, 1); s += __shfl_xor(s, 2); s += __shfl_xor(s, 4);
            const float mu = s * (1.f / 64.f);
            float v = 0.f;
#pragma unroll
            for (int e = 0; e < 8; ++e) { x[e] -= mu; v += x[e] * x[e]; }
            v += __shfl_xor(v, 1); v += __shfl_xor(v, 2); v += __shfl_xor(v, 4);
            const float rstd = rsqrtf(v * (1.f / 64.f) + 64e-5f);
            const f32x4 bo0 = unpk4((u32x2){bw[q].x, bw[q].y}), bo1 = unpk4((u32x2){bw[q].z, bw[q].w}), gg0 = unpk4((u32x2){gw4[q].x, gw4[q].y}), gg1 = unpk4((u32x2){gw4[q].z, gw4[q].w});
            f32x4 o0, o1;
#pragma unroll
            for (int e = 0; e < 4; ++e) { o0[e] = (x[e] * rstd * l00[e] + l10[e] + bo0[e]) * gg0[e]; o1[e] = (x[4 + e] * rstd * l01[e] + l11[e] + bo1[e]) * gg1[e]; }
            const u32x2 p0 = pk4(o0), p1 = pk4(o1);
            const u32x4 ov = {p0.x, p0.y, p1.x, p1.y};
            if (WT) {
                bf16* dst = AB + (size_t)row * 1024 + 512 + c;
                asm volatile("global_store_dwordx4 %0, %1, off sc0 sc1" :: "v"(dst), "v"(ov) : "memory");
                asm volatile("s_waitcnt vmcnt(0)" ::: "memory");
                if (lane == 0) __hip_atomic_fetch_add((unsigned*)(a.ws + WS_PCNT) + (row / 160) * 16, 1u, __ATOMIC_RELAXED, __HIP_MEMORY_SCOPE_AGENT);
            } else *(u32x4*)(AB + (size_t)row * 1024 + 512 + c) = ov;
        } }
    }
}

__device__ __forceinline__ void phase_chdft(const Args& a, LAS unsigned char* lds, int bid, int G) {
    int tid = threadIdx.x; asm volatile("" : "+v"(tid));
    const int lane = tid & 63, wave = tid >> 6, tk = lane & 31, hh = lane >> 5;
    const int gw = bid * 8 + wave, NGW = G * 8;
    constexpr int WST = 136;
    LAS bf16* Wd = (LAS bf16*)lds;
    const bf16* WDFT = WSB(WS_WDFT); const bf16* XN = WSB(WS_XN);
    __syncthreads();
    for (int i = tid; i < 256 * 16; i += 512) { const int r = i >> 4, c8 = i & 15; *(LAS u32x4*)(Wd + r * WST + 8 * c8) = *(const u32x4*)(WDFT + r * 128 + 8 * c8); }
    __syncthreads();
    for (int it8 = gw; it8 < 1024; it8 += NGW) {
        const int it = it8 >> 3, mtp2 = it8 & 7;
        const int b = it >> 6, g = (it >> 3) & 7, lt = it & 7, l2 = 32 * lt + tk;
        float twc[4], tws[4]; twc[0] = 1.f; tws[0] = 0.f;
#pragma unroll
        for (int p = 1; p < 4; ++p) { const float x = (float)(l2 * p) * (2.0f / 1024.0f); twc[p] = cospif(x); tws[p] = sinpif(x); }
        const bf16* xin = XN + (size_t)(NPR + b * 1024 + 32 * lt + tk) * 1024 + g * 128 + 8 * hh;
        bf16* zt = WSB(WS_YTS) + (size_t)b * 4 * 1024 * 512 + (size_t)(g * 128 + 4 * hh) * 512 + l2;
        {
            const int mtp = mtp2 >> 1, ph = mtp2 & 1;
            f32x16 Zr[2], Zi[2];
#pragma unroll
            for (int p = 0; p < 2; ++p)
#pragma unroll
                for (int r = 0; r < 16; ++r) { Zr[p][r] = 0.f; Zi[p][r] = 0.f; }
#pragma unroll
            for (int l1 = 0; l1 < 4; ++l1) {
                f32x16 yc, ys;
#pragma unroll
                for (int r = 0; r < 16; ++r) { yc[r] = 0.f; ys[r] = 0.f; }
#pragma unroll
                for (int s = 0; s < 8; ++s) {
                    const bf16x8 hbv = *(const bf16x8*)(xin + (size_t)(256 * l1) * 1024 + 16 * s);
                    const bf16x8 ac = *(const LAS bf16x8*)(Wd + (32 * mtp + tk) * WST + 16 * s + 8 * hh), as = *(const LAS bf16x8*)(Wd + (128 + 32 * mtp + tk) * WST + 16 * s + 8 * hh);
                    yc = mfma32(ac, hbv, yc); ys = mfma32(as, hbv, ys);
                }
                if (ph == 0) { Zr[0] += yc; Zi[0] -= ys; if (l1 & 1) { Zr[1] -= yc; Zi[1] += ys; } else { Zr[1] += yc; Zi[1] -= ys; } }
                else {
                    if (l1 == 0) { Zr[0] += yc; Zi[0] -= ys; Zr[1] += yc; Zi[1] -= ys; }
                    else if (l1 == 1) { Zr[0] -= ys; Zi[0] -= yc; Zr[1] += ys; Zi[1] += yc; }
                    else if (l1 == 2) { Zr[0] -= yc; Zi[0] += ys; Zr[1] -= yc; Zi[1] += ys; }
                    else { Zr[0] += ys; Zi[0] += yc; Zr[1] -= ys; Zi[1] -= yc; }
                }
                asm volatile("" : "+v"(Zr[0]), "+v"(Zi[0]), "+v"(Zr[1]), "+v"(Zi[1]));
            }
            typedef __attribute__((address_space(1))) bf16* gbp;
#pragma unroll
            for (int pi = 0; pi < 2; ++pi) {
                const int p = ph + 2 * pi;
                const float c = 0.5f * (p == 0 ? twc[0] : p == 1 ? twc[1] : p == 2 ? twc[2] : twc[3]), s = 0.5f * (p == 0 ? tws[0] : p == 1 ? tws[1] : p == 2 ? tws[2] : tws[3]);
#pragma unroll
                for (int rq = 0; rq < 4; ++rq) {
                    gbp pp = (gbp)(zt + (size_t)p * 1024 * 512 + (size_t)(32 * mtp + 8 * rq) * 512);
                    asm volatile("" : "+v"(pp));
#pragma unroll
                    for (int e = 0; e < 4; ++e) { const float zr = Zr[pi][4 * rq + e], zi = Zi[pi][4 * rq + e];
                        pp[(size_t)e * 512] = f2bf(zr * c + zi * s); pp[(size_t)e * 512 + 256] = f2bf(zr * s - zi * c); }
                }
            }
        }
    }
    for (int it2 = gw; it2 < (NPR / 32) * 16; it2 += NGW) {
        const int it = it2 >> 1, hsel = it2 & 1;
        const int r0 = (it >> 3) * 32, g = it & 7;
        bf16x8 hb[8];
#pragma unroll
        for (int s = 0; s < 8; ++s) hb[s] = *(const bf16x8*)(XN + (size_t)(r0 + tk) * 1024 + g * 128 + 16 * s + 8 * hh);
        bf16* dst; int ld, Lh, l;
        if (r0 < NPR) { const int b = r0 >> 8; l = (r0 & 255) + tk; dst = WSB(WS_YTP) + (size_t)b * 1024 * 512; ld = 512; Lh = 256; }
        else { const int sb = (r0 - NPR) >> 10; l = ((r0 - NPR) & 1023) + tk; dst = WSB(WS_YTS) + (size_t)sb * 1024 * 2048; ld = 2048; Lh = 1024; }
#pragma unroll 1
        for (int half = hsel; half <= hsel; ++half) {
            f32x16 acc[4];
#pragma unroll
            for (int mt = 0; mt < 4; ++mt)
#pragma unroll
                for (int r = 0; r < 16; ++r) acc[mt][r] = 0.f;
#pragma unroll
            for (int s = 0; s < 8; ++s)
#pragma unroll
                for (int mt = 0; mt < 4; ++mt) { const bf16x8 af = *(const LAS bf16x8*)(Wd + (32 * (4 * half + mt) + tk) * WST + 16 * s + 8 * hh); acc[mt] = mfma32(af, hb[s], acc[mt]);
                    if (mt == 3 && (s & 1)) asm volatile("" : "+v"(acc[0]), "+v"(acc[1]), "+v"(acc[2]), "+v"(acc[3]) :: "memory"); }
            typedef __attribute__((address_space(1))) bf16* gbp;
            gbp p0 = (gbp)(dst + (size_t)(g * 128 + 4 * hh) * ld + half * Lh + l);
#pragma unroll
            for (int mt = 0; mt < 4; ++mt) {
#pragma unroll
                for (int rq = 0; rq < 4; ++rq) {
                    gbp p = p0 + (size_t)(32 * mt + 8 * rq) * ld;
                    asm volatile("" : "+v"(p));
#pragma unroll
                    for (int e = 0; e < 4; ++e) p[(size_t)e * ld] = f2bf(acc[mt][4 * rq + e]);
                }
            }
        }
    }
}

constexpr int NPHASE = 20;
__global__ void __launch_bounds__(512, 2) mk_fwd(Args a0) {
    extern __shared__ __attribute__((aligned(16))) unsigned char lds_raw[];
    LAS unsigned char* lds = (LAS unsigned char*)lds_raw;
    const int tid = threadIdx.x, bid = blockIdx.x, G = gridDim.x;
    volatile LAS unsigned* MISC = (volatile LAS unsigned*)(lds + MISC_OFF);
    if (tid < 32) MISC[tid] = 0u;
    if (tid < 29) *(LAS unsigned long long*)(lds + PTAB_OFF + 8 * tid) = (unsigned long long)(tid < 27 ? a0.in[tid] : tid == 27 ? (const void*)a0.out : (const void*)a0.ws);
    __syncthreads();
    const int ph_lo = a0.ph_lo, ph_hi = a0.ph_hi;
    unsigned char* const ws_ctl = a0.ws;
    const bool one_launch = (ph_hi - ph_lo) > 1;
    XcdBarrier bar; bar.bar = (unsigned*)(ws_ctl + WS_CTL) + 4096; bar.x = 0; bar.st = nullptr;
    if (one_launch) bar = xcd_barrier_post((unsigned*)(ws_ctl + WS_CTL) + 4096, MISC + 8);
#ifndef DUP_PHASE
#define DUP_PHASE -1
#endif
#ifndef DUP_N
#define DUP_N 2
#endif
#ifndef ONLY_PHASE
#define ONLY_PHASE -1
#endif
#define XSL(i) ((unsigned*)(a.ws + WS_XSLOT) + (size_t)(i) * 2 * 64 * 160 * 4)
#define XCN(i) ((unsigned*)(a.ws + WS_CTL) + 8192 + (i) * 2 * 64 * 16)
#define IN(k) ((ONLY_PHASE < 0 || ONLY_PHASE == (k)) && ph_lo <= (k) && (k) < ph_hi)
#define SEAM(k) do { if (IN(k) && IN((k) + 1)) xcd_barrier(bar); } while (0)
    if (IN(1)) { const Args a = load_args(lds, ph_lo, ph_hi); const float* gains = FIN(I_GAINS); phase_prep<3>(a, lds, bid, G); phase_first_norm(a, lds, bid, G, gains + 0 * 1024); } SEAM(1);
    if (IN(2)) for (int rep_ = 0; rep_ < (DUP_PHASE == 2 ? DUP_N : 1); ++rep_) { if (rep_) xcd_barrier(bar); const Args a = load_args(lds, ph_lo, ph_hi); const float* gains = FIN(I_GAINS); (void)gains;
        pg8::Gemm g{1024, 1024, 1024}; pg8::PlainOrder160 S; S.init(WSB(WS_XN), WSB(WS_WIN), NT, INE_PAD, 1024, 1024, G, bid);
        EpiProj E{WSB(WS_Q), WSB(WS_KP), WSB(WS_KS), WSB(WS_VTP), WSB(WS_VTS), (bf16*)a.out, a.out + OUT_CK, a.out + OUT_CV, WSF(WS_ROPE)};
        pg8::gemm_phase160b(lds, g, S, E);
    } SEAM(2);
    if (IN(3)) for (int rep_ = 0; rep_ < (DUP_PHASE == 3 ? DUP_N : 1); ++rep_) { if (rep_) xcd_barrier(bar); const Args a = load_args(lds, ph_lo, ph_hi); const float* gains = FIN(I_GAINS); (void)gains;
#ifndef NO_FRONT
        phase_wkv_front(a, lds, bid, G);
#endif
#ifdef DUP_FRONT
        __syncthreads(); phase_wkv_front(a, lds, bid, G);
#endif
        __syncthreads();
#ifndef NO_ATT
        phase_attention(a, lds, bid, G);
#endif
#ifdef DUP_ATT
        __syncthreads(); phase_attention(a, lds, bid, G);
#endif
    } SEAM(3);
    if (IN(4)) for (int rep_ = 0; rep_ < (DUP_PHASE == 4 ? DUP_N : 1); ++rep_) { if (rep_) xcd_barrier(bar); const Args a = load_args(lds, ph_lo, ph_hi); const float* gains = FIN(I_GAINS); (void)gains;
#if defined(DUP_P4)
        phase_wkv_chain<true>(a, lds, bid, G); phase_prep<2>(a, lds, bid, G); xcd_barrier(bar);
#elif defined(DUP_CHAIN)
        phase_wkv_chain<true>(a, lds, bid, G); xcd_barrier(bar);
#elif defined(DUP_PREP2)
        phase_prep<2>(a, lds, bid, G); xcd_barrier(bar);
#endif
        phase_wkv_chain(a, lds, bid, G);
        if (G == 256) {
            const int wv_ = __builtin_amdgcn_readfirstlane(threadIdx.x >> 6);
            if (bid < 128) phase_prep<2>(a, lds, bid, G, wv_ == 0 ? -1 : (bid * 7 + wv_ - 1) * 3, 3, 2688);
        } else phase_prep<2>(a, lds, bid, G);
    } SEAM(4);
    if (IN(6)) for (int rep_ = 0; rep_ < (DUP_PHASE == 6 ? DUP_N : 1); ++rep_) { if (rep_) xcd_barrier(bar); const Args a = load_args(lds, ph_lo, ph_hi); const float* gains = FIN(I_GAINS); (void)gains;
        phase_combine<true>(a, bid, G);
        pg8::Gemm g{1024, 1024, 1024}; pg8::PlainOrder160 S; S.init(WSB(WS_XN), WSB(WS_WO), NT, 1024, 1024, 1024, G, bid);
        {
            pg8::Unit u0;
            if (S.next(0, u0) && u0.pm * 160 + 160 > NPR) {
                const unsigned want = (unsigned)(u0.pm * 160 + 160 - (u0.pm * 160 > NPR ? u0.pm * 160 : NPR));
                if (threadIdx.x == 0) { unsigned* pc = (unsigned*)(a.ws + WS_PCNT) + u0.pm * 16; unsigned spins = 0;
                    while (__hip_atomic_load(pc, __ATOMIC_RELAXED, __HIP_MEMORY_SCOPE_AGENT) < want) { __builtin_amdgcn_s_sleep(2); if (++spins > (1u << 20)) break; } }
            }
            __syncthreads();
        }
        EpiResNorm<true, false> E{FIN(I_XP), FIN(I_XS), nullptr, WSB(WS_XB), nullptr, WSB(WS_XN), gains + 1 * 1024, gains + 2 * 1024, WSF(WS_MOD), 2048, 0, 3072, 4096, 0, XSL(0), XCN(0)}; pg8::gemm_phase160b(lds, g, S, E);
    } SEAM(6);
    if (IN(8)) for (int rep_ = 0; rep_ < (DUP_PHASE == 8 ? DUP_N : 1); ++rep_) { if (rep_) xcd_barrier(bar); const Args a = load_args(lds, ph_lo, ph_hi); const float* gains = FIN(I_GAINS); (void)gains;
        pg8::Gemm g{1024, 1024, 1024}; pg8::PlainOrder S; S.init(WSB(WS_XN), WSB(WS_WFI), NT, DFF2, 1024, 1024, G, bid);
        EpiFfnConv E{WSB(WS_ACT), FIN(I_CONVW), FIN(I_CONVB), WSF(WS_SB), (LAS float*)(lds + 131072)}; pg8::gemm_phase(lds, g, S, E);
        { const int nun = (NT / 256) * (DFF2 / 256), nfull = nun % G;
          if (nfull == 0) phase_transpose_wfi1<0>(a, lds, bid, G); else if (bid >= nfull) phase_transpose_wfi1<0>(a, lds, bid - nfull, G - nfull); }
    }
    SEAM(8);
    if (IN(10)) for (int rep_ = 0; rep_ < (DUP_PHASE == 10 ? DUP_N : 1); ++rep_) { if (rep_) xcd_barrier(bar); const Args a = load_args(lds, ph_lo, ph_hi); const float* gains = FIN(I_GAINS); (void)gains;
        pg8::Gemm g{DFF, DFF, DFF}; pg8::PlainOrder160 S; S.init(WSB(WS_ACT), WSB(WS_WFO), NT, 1024, DFF, DFF, G, bid);
        ffn_seam_fixup(S, 160, WSB(WS_ACT), FIN(I_CONVW), WSF(WS_SB));
        EpiResNorm<false, false> E{nullptr, nullptr, WSB(WS_XB), WSB(WS_XB), nullptr, WSB(WS_XN), gains + 3 * 1024, gains + 4 * 1024, WSF(WS_MOD), 5120, 0, 0, 1024, 1, XSL(1), XCN(1)}; pg8::gemm_phase160b(lds, g, S, E);
    } SEAM(10);
    if (IN(12)) for (int rep_ = 0; rep_ < (DUP_PHASE == 12 ? DUP_N : 1); ++rep_) { if (rep_) xcd_barrier(bar); const Args a = load_args(lds, ph_lo, ph_hi); const float* gains = FIN(I_GAINS); (void)gains; phase_chdft(a, lds, bid, G); } SEAM(12);
    if (IN(13)) for (int rep_ = 0; rep_ < (DUP_PHASE == 13 ? DUP_N : 1); ++rep_) { if (rep_) xcd_barrier(bar); const Args a = load_args(lds, ph_lo, ph_hi); const float* gains = FIN(I_GAINS); (void)gains;
        { pg8::Gemm g{512, 512, 512}; DftOrder S{G, bid, (const char*)WSB(WS_A2P), (const char*)WSB(WS_YTS), (const char*)WSB(WS_YTP)}; EpiDft E{WSB(WS_XN)}; pg8::gemm_phase(lds, g, S, E); }
    } SEAM(13);
    if (IN(14)) for (int rep_ = 0; rep_ < (DUP_PHASE == 14 ? DUP_N : 1); ++rep_) { if (rep_) xcd_barrier(bar); const Args a = load_args(lds, ph_lo, ph_hi); const float* gains = FIN(I_GAINS); (void)gains;
        pg8::Gemm g{1024, 1024, 1024}; pg8::PlainOrder160 S; S.init(WSB(WS_XN), WSB(WS_WODD), NT, 1024, 1024, 1024, G, bid);
        EpiResNorm<false, false> E{nullptr, nullptr, WSB(WS_XB), WSB(WS_XB), nullptr, WSB(WS_XN), gains + 5 * 1024, gains + 6 * 1024, WSF(WS_MOD), 2048, 1, 3072, 4096, 1, XSL(2), XCN(2)}; pg8::gemm_phase160b(lds, g, S, E);
    } SEAM(14);
    if (IN(16)) for (int rep_ = 0; rep_ < (DUP_PHASE == 16 ? DUP_N : 1); ++rep_) { if (rep_) xcd_barrier(bar); const Args a = load_args(lds, ph_lo, ph_hi); const float* gains = FIN(I_GAINS); (void)gains;
        pg8::Gemm g{1024, 1024, 1024}; pg8::PlainOrder S; S.init(WSB(WS_XN), WSB(WS_WFI) + (size_t)DFF2 * 1024, NT, DFF2, 1024, 1024, G, bid);
        EpiFfnConv E{WSB(WS_ACT), FIN(I_CONVW) + 3 * DFF, FIN(I_CONVB) + DFF, WSF(WS_SB), (LAS float*)(lds + 131072)}; pg8::gemm_phase(lds, g, S, E);
        { const int nun = (NT / 256) * (DFF2 / 256), nfull = nun % G;
          if (nfull == 0) phase_transpose_wfi1<1>(a, lds, bid, G); else if (bid >= nfull) phase_transpose_wfi1<1>(a, lds, bid - nfull, G - nfull); }
    }
    SEAM(16);
    if (IN(18)) for (int rep_ = 0; rep_ < (DUP_PHASE == 18 ? DUP_N : 1); ++rep_) { if (rep_) xcd_barrier(bar); const Args a = load_args(lds, ph_lo, ph_hi); const float* gains = FIN(I_GAINS); (void)gains;
        pg8::Gemm g{DFF, DFF, DFF}; pg8::PlainOrder160 S; S.init(WSB(WS_ACT), WSB(WS_WFO) + (size_t)1024 * DFF, NT, 1024, DFF, DFF, G, bid);
        ffn_seam_fixup(S, 160, WSB(WS_ACT), FIN(I_CONVW) + 3 * DFF, WSF(WS_SB));
        EpiResNorm<false, true> E{nullptr, nullptr, WSB(WS_XB), nullptr, a.out, nullptr, gains + 7 * 1024, nullptr, WSF(WS_MOD), 5120, 1, 0, 0, 1, XSL(3), XCN(3)}; pg8::gemm_phase160b(lds, g, S, E);
    }
#undef IN
#undef SEAM
#undef XSL
#undef XCN
}

extern "C" void kernel_launch(void* const* d_in, const int* in_sizes, int n_in, void* d_out, int out_size, void* d_ws, size_t ws_size, hipStream_t stream) {
    static int grid = 0;
    if (grid == 0) {
        if (n_in != 27 || ws_size < WS_END) { fprintf(stderr, "kernel_launch: unexpected n_in %d / ws %zu\n", n_in, ws_size); grid = -1; return; }
        int dev = 0, cus = 0;
        if (hipGetDevice(&dev) != hipSuccess || hipDeviceGetAttribute(&cus, hipDeviceAttributeMultiprocessorCount, dev) != hipSuccess) { grid = -1; return; }
        if (hipFuncSetAttribute((const void*)mk_fwd, hipFuncAttributeMaxDynamicSharedMemorySize, LDS_BYTES) != hipSuccess) { fprintf(stderr, "kernel_launch: hipFuncSetAttribute failed\n"); grid = -1; return; }
        (void)hipGetLastError();
        if (cus < 256) { fprintf(stderr, "kernel_launch: needs 256 CUs (one workgroup per CU, 256 GEMM units per fused-norm phase), found %d\n", cus); grid = -1; return; }
        grid = 256;
    }
    if (grid < 0) return;
    (void)hipMemsetAsync((char*)d_ws + WS_CTL, 0, CTL_ZERO_BYTES, stream);
    Args a{};
    for (int i = 0; i < 27; ++i) a.in[i] = d_in[i];
    a.out = (float*)d_out; a.ws = (unsigned char*)d_ws;
#if MK_N_LAUNCHES == 1
    a.ph_lo = 0; a.ph_hi = NPHASE;
    hipLaunchKernelGGL(mk_fwd, dim3(grid), dim3(512), LDS_BYTES, stream, a);
#else
    for (int ph = 0; ph < NPHASE; ++ph) { a.ph_lo = ph; a.ph_hi = ph + 1; hipLaunchKernelGGL(mk_fwd, dim3(grid), dim3(512), LDS_BYTES, stream, a); }
#endif
}
```

```cpp
#include <hip/hip_runtime.h>
#include <type_traits>
#include <cstdio>
#include <cstdint>

#ifndef MK_N_LAUNCHES
#define MK_N_LAUNCHES 1
#endif

#define LAS __attribute__((address_space(3)))
typedef unsigned short bf16;
typedef short bf16x8 __attribute__((ext_vector_type(8)));
typedef float f32x4 __attribute__((ext_vector_type(4)));
typedef float f32x2 __attribute__((ext_vector_type(2)));
typedef float f32x16 __attribute__((ext_vector_type(16)));
typedef unsigned u32x4 __attribute__((ext_vector_type(4)));
typedef unsigned u32x2 __attribute__((ext_vector_type(2)));
typedef __bf16 bf16x2_t __attribute__((ext_vector_type(2)));

constexpr int DM = 1024;
constexpr int NPR = 8192, NSA = 2048, NT = 10240;
constexpr int SEQ = 256, DSEQ = 1024, PAST = 256, LKS = 1280;
constexpr int INE = 3456, INE_PAD = 3584, INB = 1920, DFF = 2816, DFF2 = 5632;
constexpr int OUT_YP = 0, OUT_CK = 10485760, OUT_CV = 14680064, OUT_ST = 18874368;

constexpr size_t MiB = 1u << 20;
constexpr size_t WS_CTL = 252 * MiB, CTL_ZERO_BYTES = 65536 + 1310720;
constexpr size_t WS_MOD = 1 * MiB;
constexpr size_t WS_ROPE = 1 * MiB + 256 * 1024;
constexpr size_t WS_LAM = 1 * MiB + 768 * 1024;
constexpr size_t WS_WIN = 2 * MiB;
constexpr size_t WS_WO = 9 * MiB;
constexpr size_t WS_WODD = 11 * MiB;
constexpr size_t WS_WFI = 13 * MiB;
constexpr size_t WS_WFO = 35 * MiB;
constexpr size_t WS_W2T = 46 * MiB;
constexpr size_t WS_A2T = 46 * MiB + 128 * 1024;
constexpr size_t WS_G2T = 46 * MiB + 256 * 1024;
constexpr size_t WS_WDFT = 46 * MiB + 512 * 1024;
constexpr size_t WS_A2P = 46 * MiB + 768 * 1024;
constexpr size_t WS_XN = 52 * MiB;
constexpr size_t WS_MF = 72 * MiB;
constexpr size_t WS_XB = 92 * MiB;
constexpr size_t WS_BIG = 112 * MiB;
constexpr size_t WS_Q = 216 * MiB;
constexpr size_t WS_KP = 226 * MiB;
constexpr size_t WS_KS = 234 * MiB;
constexpr size_t WS_VTP = 237 * MiB;
constexpr size_t WS_VTS = 245 * MiB;
constexpr size_t WS_BONUS = 24 * MiB;
constexpr size_t WS_ACT = WS_BIG;
constexpr size_t WS_SB = 51 * MiB;
constexpr size_t WS_F32B = WS_MF;
constexpr size_t WS_YTP = WS_BIG;
constexpr size_t WS_YTS = WS_BIG + 32 * MiB;
constexpr size_t WS_MOD1 = WS_CTL + 32768;
constexpr size_t WS_PCNT = WS_CTL + 57344;
constexpr size_t WS_XSLOT = WS_CTL + 65536;
constexpr size_t WS_END = 256 * MiB;
static_assert(WS_ACT + (size_t)NT * DFF * 2 <= WS_END, "ws");

constexpr int RING_BYTES = 131072;
constexpr int ACT_OFF = 147456;
constexpr int MISC_OFF = 160256;
constexpr int PTAB_OFF = 160512;
constexpr int LDS_BYTES = 160768;

__device__ __forceinline__ unsigned pk2(float lo, float hi) { f32x2 v = {lo, hi}; bf16x2_t b = __builtin_convertvector(v, bf16x2_t); return __builtin_bit_cast(unsigned, b); }
__device__ __forceinline__ bf16 f2bf(float f) { return (bf16)(pk2(f, 0.f) & 0xffffu); }
__device__ __forceinline__ float bf2f(unsigned b) { return __uint_as_float(b << 16); }
__device__ __forceinline__ u32x2 pk4(f32x4 v) { u32x2 o; o.x = pk2(v[0], v[1]); o.y = pk2(v[2], v[3]); return o; }
__device__ __forceinline__ f32x4 unpk4(u32x2 w) { f32x4 v; v[0] = __uint_as_float(w.x << 16); v[1] = __uint_as_float(w.x & 0xffff0000u); v[2] = __uint_as_float(w.y << 16); v[3] = __uint_as_float(w.y & 0xffff0000u); return v; }
__device__ __forceinline__ float sigmoidf_(float x) { return __builtin_amdgcn_rcpf(1.f + __expf(-x)); }
__device__ __forceinline__ float wave_sum(float v) {
#pragma unroll
    for (int o = 1; o < 64; o <<= 1) v += __shfl_xor(v, o);
    return v;
}
__device__ __forceinline__ int keypos(int key) { return (key & ~12) | ((key & 4) << 1) | ((key & 8) >> 1); }

#define XB_TMO      128
#define XB_XCNT(j)  (256  + 64 * (j))
#define XB_XSUB(j)  (1280 + 64 * (j))
#define XB_XGEN(j)  (2304 + 64 * (j))
#define XB_TOP      3328
#define XB_TOPGEN   3392
#define XCD_BAR_WORDS 3456
#define XB_SPIN_CAP (1u << 20)
__device__ __forceinline__ unsigned xb_ld(unsigned* p)              { return __hip_atomic_load(p, __ATOMIC_RELAXED, __HIP_MEMORY_SCOPE_AGENT); }
__device__ __forceinline__ unsigned xb_add(unsigned* p, unsigned v) { return __hip_atomic_fetch_add(p, v, __ATOMIC_RELAXED, __HIP_MEMORY_SCOPE_AGENT); }
__device__ __forceinline__ unsigned xb_xcc_id() { return (unsigned)__builtin_amdgcn_s_getreg((3 << 11) | 20) & 0xFu; }
#define XB_SPIN(cond, bar) do { unsigned _sp = 0; while (cond) { __builtin_amdgcn_s_sleep(1); \
    if ((++_sp & 255u) == 0u) { if (xb_ld(&(bar)[XB_TMO])) break; if (_sp > XB_SPIN_CAP) { atomicAdd(&(bar)[XB_TMO], 1u); break; } } } } while (0)
struct XcdBarrier { unsigned* bar; unsigned x; volatile LAS unsigned* st; };
__device__ __forceinline__ XcdBarrier xcd_barrier_post(unsigned* bar, volatile LAS unsigned* st) {
    XcdBarrier b; b.bar = bar; b.x = xb_xcc_id(); b.st = st;
    if (threadIdx.x == 0) (void)xb_add(&bar[XB_XCNT(b.x)], 1u);
    return b;
}
__device__ __forceinline__ void xcd_barrier_complete(unsigned* bar, unsigned x, unsigned& nloc, unsigned& nx) {
    const unsigned G = gridDim.x * gridDim.y * gridDim.z;
    unsigned sum, cnt, mine, sp = 0u;
    for (;;) {
        sum = 0u; cnt = 0u; mine = 0u;
#pragma unroll
        for (unsigned j = 0; j < 16; ++j) { const unsigned c = xb_ld(&bar[XB_XCNT(j)]); sum += c; cnt += (c > 0u) ? 1u : 0u; mine = (j == x) ? c : mine; }
        if (sum == G) break;
        __builtin_amdgcn_s_sleep(1);
        if ((++sp & 255u) == 0u) { if (xb_ld(&bar[XB_TMO])) break; if (sp > XB_SPIN_CAP) { atomicAdd(&bar[XB_TMO], 1u); break; } }
    }
    nloc = mine > 0u ? mine : 1u; nx = cnt > 0u ? cnt : 1u;
}
__device__ __forceinline__ void xcd_barrier(const XcdBarrier& b) {
    asm volatile("s_waitcnt vmcnt(0)" ::: "memory");
    __syncthreads();
    if (threadIdx.x == 0) {
        unsigned* bar = b.bar;
        __builtin_amdgcn_s_waitcnt(0);
        unsigned nloc = b.st[0], nx = b.st[1];
        if (nloc == 0u) { xcd_barrier_complete(bar, b.x, nloc, nx); b.st[0] = nloc; b.st[1] = nx; }
        const unsigned old = xb_add(&bar[XB_XSUB(b.x)], 1u);
        const unsigned gen = old / nloc;
        if (old + 1u == (gen + 1u) * nloc) {
            __builtin_amdgcn_fence(__ATOMIC_RELEASE, "agent");
            asm volatile("s_waitcnt vmcnt(0)" ::: "memory");
            const unsigned og = xb_add(&bar[XB_TOP], 1u);
            const unsigned tg = og / nx;
            if (og + 1u == (tg + 1u) * nx) xb_add(&bar[XB_TOPGEN], 1u);
            else XB_SPIN(xb_ld(&bar[XB_TOPGEN]) == tg, bar);
            xb_add(&bar[XB_XGEN(b.x)], 1u);
            __builtin_amdgcn_fence(__ATOMIC_ACQUIRE, "agent");
            asm volatile("s_waitcnt vmcnt(0)" ::: "memory");
        } else {
            XB_SPIN(xb_ld(&bar[XB_XGEN(b.x)]) == gen, bar);
            __builtin_amdgcn_fence(__ATOMIC_ACQUIRE, "agent");
            asm volatile("s_waitcnt vmcnt(0)" ::: "memory");
        }
    }
    __syncthreads();
}

namespace pg8 {
constexpr int BM = 256, BK = 64, HALF = 128, HTB = HALF * BK * 2, STAGE_BYTES = 8 * HTB, NXCD = 8, WGM = 8, WGM256 = 4;
__host__ __device__ __forceinline__ int lds_byte(int r, int c) { const int st = (r >> 4) * 2 + (c >> 5), rr = r & 15, cc = c & 31, ob = rr * 64 + cc * 2; return st * 1024 + (ob ^ (((ob >> 9) & 1) << 5)); }
__host__ __device__ __forceinline__ void stage_rc(int b, int& R, int& C) { const int st = b / 1024, sb = b % 1024, swz = sb ^ (((sb >> 9) & 1) << 5); R = (st >> 1) * 16 + swz / 64; C = (st & 1) * 32 + (swz % 64) / 2; }

struct Unit { int pm, pn, z; const char* a; const char* b; };
struct Gemm { int lda, ldb, K; };

struct PlainOrder {
    int nM, nN, nwg, G, c; const char* A; const char* Bt; size_t ta, tb;
    __device__ void init(const void* A_, const void* Bt_, int M, int N, int lda, int ldb, int G_, int c_) { A = (const char*)A_; Bt = (const char*)Bt_; nM = M / BM; nN = N / BM; nwg = nM * nN; G = G_; c = c_; ta = (size_t)BM * lda * 2; tb = (size_t)BM * ldb * 2; }
    __device__ __forceinline__ bool next(int i, Unit& u) const {
        const long L = (long)i * G + c; if (L >= nwg) return false;
        int wgid = (int)L; { const int q = nwg / NXCD, r = nwg % NXCD, xcd = wgid % NXCD, off = wgid / NXCD; wgid = (xcd < r ? xcd * (q + 1) : r * (q + 1) + (xcd - r) * q) + off; }
        const int nig = WGM256 * nN, gid = wgid / nig, fm = gid * WGM256, gsz = (nM - fm) < WGM256 ? (nM - fm) : WGM256;
        u.pm = fm + ((wgid % nig) % gsz); u.pn = (wgid % nig) / gsz; u.z = 0;
        u.a = A + (size_t)u.pm * ta; u.b = Bt + (size_t)u.pn * tb; return true;
    }
};

template <class F> __device__ __forceinline__ void epi_each(const f32x4 (&acc)[2][2][4][2], int row0, int col0, F&& f) {
#pragma unroll
    for (int ai = 0; ai < 2; ++ai)
#pragma unroll
        for (int m = 0; m < 4; ++m)
#pragma unroll
            for (int bj = 0; bj < 2; ++bj)
#pragma unroll
                for (int n = 0; n < 2; ++n) f(row0 + ai * HALF + m * 16, col0 + bj * HALF + n * 16, acc[ai][bj][m][n]);
}

template <class Epi, class Sched>
__device__ __forceinline__ void gemm_phase(LAS unsigned char* lds, const Gemm g, const Sched& S, const Epi& E) {
    int tid = threadIdx.x; asm volatile("" : "+v"(tid));
    const int wid = __builtin_amdgcn_readfirstlane(tid >> 6), lane = tid & 63, wr = wid >> 2, wc = wid & 3, fr = lane & 15, fq = lane >> 4;
    const int K = g.K, nt = K / BK;
    unsigned voffA[2], voffB[2];
#pragma unroll
    for (int i = 0; i < 2; ++i) { int R, C; stage_rc(tid * 16 + i * 8192, R, C); voffA[i] = (unsigned)(R * g.lda + C) * 2u; voffB[i] = (unsigned)(R * g.ldb + C) * 2u; }
    const size_t kstep = (size_t)(BK * 2);
    const size_t hstepA = (size_t)HALF * g.lda * 2, hstepB = (size_t)HALF * g.ldb * 2;
    const unsigned ldsw = (unsigned)wid * 1024u;
    const int aoff = lds_byte(wr * 64 + fr, fq * 8), boff = lds_byte(wc * 32 + fr, fq * 8);
#define PG8_SA(b, h) (((b) * 2 + (h)) * HTB)
#define PG8_SB(b, h) ((4 + (b) * 2 + (h)) * HTB)
#define PG8_STAGE(bufoff, gbase, voff) do { _Pragma("unroll") for (int _i = 0; _i < 2; ++_i) \
        __builtin_amdgcn_global_load_lds((const unsigned*)((const char*)(gbase) + (voff)[_i]), (LAS unsigned*)(lds + (bufoff) + ldsw + _i * 8192), 16, 0, 0); } while (0)
#define PG8_LDA(dst, b, h) do { _Pragma("unroll") for (int m = 0; m < 4; ++m) _Pragma("unroll") for (int k = 0; k < 2; ++k) dst[m][k] = *(const LAS bf16x8*)(lds + PG8_SA(b, h) + aoff + m * 2048 + k * 1024); } while (0)
#define PG8_LDB(dst, b, h) do { _Pragma("unroll") for (int n = 0; n < 2; ++n) _Pragma("unroll") for (int k = 0; k < 2; ++k) dst[n][k] = *(const LAS bf16x8*)(lds + PG8_SB(b, h) + boff + n * 2048 + k * 1024); } while (0)
#define PG8_MMA(ai, bj, At, Bt) do { __builtin_amdgcn_s_setprio(1); _Pragma("unroll") for (int m = 0; m < 4; ++m) _Pragma("unroll") for (int n = 0; n < 2; ++n) _Pragma("unroll") for (int k = 0; k < 2; ++k) \
        acc[ai][bj][m][n] = __builtin_amdgcn_mfma_f32_16x16x32_bf16(Bt[n][k], At[m][k], acc[ai][bj][m][n], 0, 0, 0); __builtin_amdgcn_s_setprio(0); } while (0)
#define PG8_WAIT_V(n) asm volatile("s_waitcnt vmcnt(" #n ")" ::: "memory")
#define PG8_WAIT_L(n) asm volatile("s_waitcnt lgkmcnt(" #n ")" ::: "memory")
#define PG8_BAR __builtin_amdgcn_s_barrier()
#define PG8_SCHED __builtin_amdgcn_sched_barrier(0)
    Unit cur, nxt; int ui = 0;
    if (!S.next(0, cur)) return;
    f32x4 acc[2][2][4][2];
#pragma unroll
    for (int a = 0; a < 2; ++a)
#pragma unroll
        for (int b = 0; b < 2; ++b)
#pragma unroll
            for (int m = 0; m < 4; ++m)
#pragma unroll
                for (int n = 0; n < 2; ++n) acc[a][b][m][n] = (f32x4){0.f, 0.f, 0.f, 0.f};
    bf16x8 At[4][2], B0[2][2], B1[2][2];
    const char* cA = cur.a; const char* cB = cur.b;
    PG8_STAGE(PG8_SB(0, 0), cB, voffB); PG8_STAGE(PG8_SA(0, 0), cA, voffA); PG8_STAGE(PG8_SB(0, 1), cB + hstepB, voffB); PG8_STAGE(PG8_SA(0, 1), cA + hstepA, voffA);
    if (wr == 1) PG8_BAR;
    PG8_WAIT_V(4); PG8_BAR;
    PG8_STAGE(PG8_SB(1, 0), cB + kstep, voffB); PG8_STAGE(PG8_SA(1, 0), cA + kstep, voffA); PG8_STAGE(PG8_SB(1, 1), cB + hstepB + kstep, voffB);
    PG8_WAIT_V(6); PG8_BAR;
    for (;;) {
        const bool has_next = S.next(ui + 1, nxt);
        const char* nA = has_next ? nxt.a : cA; const char* nB = has_next ? nxt.b : cB;
        for (int t = 0; t < nt; t += 2) {
            const bool last = (t == nt - 2);
            const char* a1 = cA + (size_t)(t + 1) * kstep;
            const char* a2 = last ? nA : cA + (size_t)(t + 2) * kstep; const char* b2 = last ? nB : cB + (size_t)(t + 2) * kstep;
            const char* a3 = a2 + kstep; const char* b3 = b2 + kstep;
            PG8_LDB(B0, 0, 0); PG8_SCHED; PG8_LDA(At, 0, 0); PG8_STAGE(PG8_SA(1, 1), a1 + hstepA, voffA);
            PG8_WAIT_L(8); PG8_BAR; PG8_WAIT_L(0); PG8_MMA(0, 0, At, B0); PG8_BAR; PG8_SCHED;
            PG8_LDB(B1, 0, 1); PG8_STAGE(PG8_SB(0, 0), b2, voffB);
            PG8_BAR; PG8_WAIT_L(0); PG8_MMA(0, 1, At, B1); PG8_BAR;
            PG8_LDA(At, 0, 1); PG8_STAGE(PG8_SA(0, 0), a2, voffA);
            PG8_BAR; PG8_WAIT_L(0); PG8_MMA(1, 0, At, B0); PG8_BAR; PG8_SCHED;
            PG8_STAGE(PG8_SB(0, 1), b2 + hstepB, voffB);
            PG8_WAIT_V(6); PG8_BAR; PG8_MMA(1, 1, At, B1); PG8_BAR;
            PG8_LDB(B0, 1, 0); PG8_SCHED; PG8_LDA(At, 1, 0); PG8_STAGE(PG8_SA(0, 1), a2 + hstepA, voffA);
            PG8_WAIT_L(8); PG8_BAR; PG8_WAIT_L(0); PG8_MMA(0, 0, At, B0); PG8_BAR; PG8_SCHED;
            PG8_LDB(B1, 1, 1); PG8_STAGE(PG8_SB(1, 0), b3, voffB);
            PG8_BAR; PG8_WAIT_L(0); PG8_MMA(0, 1, At, B1); PG8_BAR;
            PG8_LDA(At, 1, 1); PG8_STAGE(PG8_SA(1, 0), a3, voffA);
            PG8_BAR; PG8_WAIT_L(0); PG8_MMA(1, 0, At, B0); PG8_BAR; PG8_SCHED;
            PG8_STAGE(PG8_SB(1, 1), b3 + hstepB, voffB);
            PG8_WAIT_V(6); PG8_BAR; PG8_MMA(1, 1, At, B1); PG8_BAR;
        }
        if constexpr (Epi::ALIGN) { if (wr == 0) PG8_BAR; }
        E(acc, cur, wr, wc, fr, fq);
        if (!has_next) break;
#pragma unroll
        for (int a = 0; a < 2; ++a)
#pragma unroll
            for (int b = 0; b < 2; ++b)
#pragma unroll
                for (int m = 0; m < 4; ++m)
#pragma unroll
                    for (int n = 0; n < 2; ++n) acc[a][b][m][n] = (f32x4){0.f, 0.f, 0.f, 0.f};
        cur = nxt; cA = nA; cB = nB; ++ui;
        if constexpr (Epi::ALIGN) { if (wr == 1) PG8_BAR; }
    }
    PG8_WAIT_V(0);
    if constexpr (!Epi::ALIGN) { if (wr == 0) PG8_BAR; }
    PG8_BAR;
#undef PG8_SA
#undef PG8_SB
#undef PG8_STAGE
#undef PG8_LDA
#undef PG8_LDB
#undef PG8_MMA
#undef PG8_WAIT_V
#undef PG8_WAIT_L
#undef PG8_BAR
#undef PG8_SCHED
}

struct PlainOrder160 {
    int nM, nN, nwg, G, c; const char* A; const char* Bt; size_t ta, tb;
    __device__ void init(const void* A_, const void* Bt_, int M, int N, int lda, int ldb, int G_, int c_) { A = (const char*)A_; Bt = (const char*)Bt_; nM = M / 160; nN = N / BM; nwg = nM * nN; G = G_; c = c_; ta = (size_t)160 * lda * 2; tb = (size_t)BM * ldb * 2; }
    __device__ __forceinline__ bool next(int i, Unit& u) const {
        const long L = (long)i * G + c; if (L >= nwg) return false;
        int wgid = (int)L; { const int q = nwg / NXCD, r = nwg % NXCD, xcd = wgid % NXCD, off = wgid / NXCD; wgid = (xcd < r ? xcd * (q + 1) : r * (q + 1) + (xcd - r) * q) + off; }
        const int nig = WGM * nN, gid = wgid / nig, fm = gid * WGM, gsz = (nM - fm) < WGM ? (nM - fm) : WGM;
        u.pm = fm + ((wgid % nig) % gsz); u.pn = (wgid % nig) / gsz; u.z = 0;
        u.a = A + (size_t)u.pm * ta; u.b = Bt + (size_t)u.pn * tb; return true;
    }
};
template <class Epi, class Sched>
__device__ __forceinline__ void gemm_phase160(LAS unsigned char* lds, const Gemm g, const Sched& S, const Epi& E) {
    int tid = threadIdx.x; asm volatile("" : "+v"(tid));
    const int wid = __builtin_amdgcn_readfirstlane(tid >> 6), lane = tid & 63, half = wid >> 2, fr = lane & 15, fq = lane >> 4;
    const int K = g.K, nt = K / BK;
    constexpr int HTA = 80 * BK * 2;
    unsigned voffA[2], voffB[2];
    { int R, C; stage_rc(tid * 16, R, C); voffA[0] = (unsigned)(R * g.lda + C) * 2u; stage_rc((512 + (tid & 127)) * 16, R, C); voffA[1] = (unsigned)(R * g.lda + C) * 2u; }
#pragma unroll
    for (int i = 0; i < 2; ++i) { int R, C; stage_rc(tid * 16 + i * 8192, R, C); voffB[i] = (unsigned)(R * g.ldb + C) * 2u; }
    const size_t kstep = (size_t)(BK * 2);
    const size_t hstepA = (size_t)80 * g.lda * 2, hstepB = (size_t)HALF * g.ldb * 2;
    const unsigned ldswA0 = (unsigned)wid * 1024u, ldswA1 = 8192u + (unsigned)(wid & 1) * 1024u, ldswB = (unsigned)wid * 1024u;
    const int aoff = lds_byte(fr, fq * 8), boff = lds_byte(wid * 16 + fr, fq * 8);
#define PG8_SA(b, h) (((b) * 2 + (h)) * HTA)
#define PG8_SB(b, h) (4 * HTA + ((b) * 2 + (h)) * HTB)
#define PG8_STAGEA(bufoff, gbase) do { \
        __builtin_amdgcn_global_load_lds((const unsigned*)((const char*)(gbase) + voffA[0]), (LAS unsigned*)(lds + (bufoff) + ldswA0), 16, 0, 0); \
        __builtin_amdgcn_global_load_lds((const unsigned*)((const char*)(gbase) + voffA[1]), (LAS unsigned*)(lds + (bufoff) + ldswA1), 16, 0, 0); } while (0)
#define PG8_STAGEB(bufoff, gbase) do { _Pragma("unroll") for (int _i = 0; _i < 2; ++_i) \
        __builtin_amdgcn_global_load_lds((const unsigned*)((const char*)(gbase) + voffB[_i]), (LAS unsigned*)(lds + (bufoff) + ldswB + _i * 8192), 16, 0, 0); } while (0)
#define PG8_LDA(dst, b, h) do { _Pragma("unroll") for (int m = 0; m < 5; ++m) _Pragma("unroll") for (int k = 0; k < 2; ++k) dst[m][k] = *(const LAS bf16x8*)(lds + PG8_SA(b, h) + aoff + m * 2048 + k * 1024); } while (0)
#define PG8_LDB(dst, b, h) do { _Pragma("unroll") for (int k = 0; k < 2; ++k) dst[k] = *(const LAS bf16x8*)(lds + PG8_SB(b, h) + boff + k * 1024); } while (0)
#define PG8_MMA(ai, bj, At, Bt) do { __builtin_amdgcn_s_setprio(1); _Pragma("unroll") for (int m = 0; m < 5; ++m) _Pragma("unroll") for (int k = 0; k < 2; ++k) \
        acc[ai][bj][m] = __builtin_amdgcn_mfma_f32_16x16x32_bf16(Bt[k], At[m][k], acc[ai][bj][m], 0, 0, 0); __builtin_amdgcn_s_setprio(0); } while (0)
#define PG8_WAIT_V(n) asm volatile("s_waitcnt vmcnt(" #n ")" ::: "memory")
#define PG8_WAIT_L(n) asm volatile("s_waitcnt lgkmcnt(" #n ")" ::: "memory")
#define PG8_BAR __builtin_amdgcn_s_barrier()
#define PG8_SCHED __builtin_amdgcn_sched_barrier(0)
    Unit cur, nxt; int ui = 0;
    if (!S.next(0, cur)) return;
    f32x4 acc[2][2][5];
#pragma unroll
    for (int a = 0; a < 2; ++a)
#pragma unroll
        for (int b = 0; b < 2; ++b)
#pragma unroll
            for (int m = 0; m < 5; ++m) acc[a][b][m] = (f32x4){0.f, 0.f, 0.f, 0.f};
    bf16x8 At[5][2], B0[2], B1[2];
    const char* cA = cur.a; const char* cB = cur.b;
    PG8_STAGEB(PG8_SB(0, 0), cB); PG8_STAGEA(PG8_SA(0, 0), cA); PG8_STAGEB(PG8_SB(0, 1), cB + hstepB); PG8_STAGEA(PG8_SA(0, 1), cA + hstepA);
    if (half == 1) PG8_BAR;
    PG8_WAIT_V(4); PG8_BAR;
    PG8_STAGEB(PG8_SB(1, 0), cB + kstep); PG8_STAGEA(PG8_SA(1, 0), cA + kstep); PG8_STAGEB(PG8_SB(1, 1), cB + hstepB + kstep);
    PG8_WAIT_V(6); PG8_BAR;
    for (;;) {
        const bool has_next = S.next(ui + 1, nxt);
        const char* nA = has_next ? nxt.a : cA; const char* nB = has_next ? nxt.b : cB;
        for (int t = 0; t < nt; t += 2) {
            const bool last = (t == nt - 2);
            const char* a1 = cA + (size_t)(t + 1) * kstep;
            const char* a2 = last ? nA : cA + (size_t)(t + 2) * kstep; const char* b2 = last ? nB : cB + (size_t)(t + 2) * kstep;
            const char* a3 = a2 + kstep; const char* b3 = b2 + kstep;
            PG8_LDB(B0, 0, 0); PG8_SCHED; PG8_LDA(At, 0, 0); PG8_STAGEA(PG8_SA(1, 1), a1 + hstepA);
            PG8_WAIT_L(10); PG8_BAR; PG8_WAIT_L(0); PG8_MMA(0, 0, At, B0); PG8_BAR; PG8_SCHED;
            PG8_LDB(B1, 0, 1); PG8_STAGEB(PG8_SB(0, 0), b2);
            PG8_BAR; PG8_WAIT_L(0); PG8_MMA(0, 1, At, B1); PG8_BAR;
            PG8_LDA(At, 0, 1); PG8_STAGEA(PG8_SA(0, 0), a2);
            PG8_BAR; PG8_WAIT_L(0); PG8_MMA(1, 0, At, B0); PG8_BAR; PG8_SCHED;
            PG8_STAGEB(PG8_SB(0, 1), b2 + hstepB);
            PG8_WAIT_V(6); PG8_BAR; PG8_MMA(1, 1, At, B1); PG8_BAR;
            PG8_LDB(B0, 1, 0); PG8_SCHED; PG8_LDA(At, 1, 0); PG8_STAGEA(PG8_SA(0, 1), a2 + hstepA);
            PG8_WAIT_L(10); PG8_BAR; PG8_WAIT_L(0); PG8_MMA(0, 0, At, B0); PG8_BAR; PG8_SCHED;
            PG8_LDB(B1, 1, 1); PG8_STAGEB(PG8_SB(1, 0), b3);
            PG8_BAR; PG8_WAIT_L(0); PG8_MMA(0, 1, At, B1); PG8_BAR;
            PG8_LDA(At, 1, 1); PG8_STAGEA(PG8_SA(1, 0), a3);
            PG8_BAR; PG8_WAIT_L(0); PG8_MMA(1, 0, At, B0); PG8_BAR; PG8_SCHED;
            PG8_STAGEB(PG8_SB(1, 1), b3 + hstepB);
            PG8_WAIT_V(6); PG8_BAR; PG8_MMA(1, 1, At, B1); PG8_BAR;
        }
        E(acc, cur, wid, fr, fq);
        if (!has_next) break;
#pragma unroll
        for (int a = 0; a < 2; ++a)
#pragma unroll
            for (int b = 0; b < 2; ++b)
#pragma unroll
                for (int m = 0; m < 5; ++m) acc[a][b][m] = (f32x4){0.f, 0.f, 0.f, 0.f};
        cur = nxt; cA = nA; cB = nB; ++ui;
    }
    PG8_WAIT_V(0);
    if (half == 0) PG8_BAR;
    PG8_BAR;
#undef PG8_SA
#undef PG8_SB
#undef PG8_STAGEA
#undef PG8_STAGEB
#undef PG8_LDA
#undef PG8_LDB
#undef PG8_MMA
#undef PG8_WAIT_V
#undef PG8_WAIT_L
#undef PG8_BAR
#undef PG8_SCHED
}

template <int MF, class Epi, class Sched>
__device__ __forceinline__ void gemm_phase160b_run(LAS unsigned char* lds, const Gemm g, const Sched& S, const Epi& E, int tid, int wid, int lane, int wr, int wc) {
    const int fr = lane & 15, fq = lane >> 4;
    const int K = g.K, nt = K / BK;
    constexpr int HTA = 80 * BK * 2;
    unsigned voffA[2], voffB[2];
    { int R, C; stage_rc(tid * 16, R, C); voffA[0] = (unsigned)(R * g.lda + C) * 2u; stage_rc((512 + (tid & 127)) * 16, R, C); voffA[1] = (unsigned)(R * g.lda + C) * 2u; }
#pragma unroll
    for (int i = 0; i < 2; ++i) { int R, C; stage_rc(tid * 16 + i * 8192, R, C); voffB[i] = (unsigned)(R * g.ldb + C) * 2u; }
    const size_t kstep = (size_t)(BK * 2);
    const size_t hstepA = (size_t)80 * g.lda * 2, hstepB = (size_t)HALF * g.ldb * 2;
    const unsigned ldswA0 = (unsigned)wid * 1024u, ldswA1 = 8192u + (unsigned)(wid & 1) * 1024u, ldswB = (unsigned)wid * 1024u;
    const int aoff = lds_byte(wr * 48 + fr, fq * 8), boff = lds_byte(wc * 32 + fr, fq * 8);
#define PG8_SA(b, h) (((b) * 2 + (h)) * HTA)
#define PG8_SB(b, h) (4 * HTA + ((b) * 2 + (h)) * HTB)
#define PG8_STAGEA(bufoff, gbase) do { \
        __builtin_amdgcn_global_load_lds((const unsigned*)((const char*)(gbase) + voffA[0]), (LAS unsigned*)(lds + (bufoff) + ldswA0), 16, 0, 0); \
        __builtin_amdgcn_global_load_lds((const unsigned*)((const char*)(gbase) + voffA[1]), (LAS unsigned*)(lds + (bufoff) + ldswA1), 16, 0, 0); } while (0)
#define PG8_STAGEB(bufoff, gbase) do { _Pragma("unroll") for (int _i = 0; _i < 2; ++_i) \
        __builtin_amdgcn_global_load_lds((const unsigned*)((const char*)(gbase) + voffB[_i]), (LAS unsigned*)(lds + (bufoff) + ldswB + _i * 8192), 16, 0, 0); } while (0)
#define PG8_LDA(dst, b, h) do { _Pragma("unroll") for (int m = 0; m < MF; ++m) _Pragma("unroll") for (int k = 0; k < 2; ++k) dst[m][k] = *(const LAS bf16x8*)(lds + PG8_SA(b, h) + aoff + m * 2048 + k * 1024); } while (0)
#define PG8_LDB(dst, b, h) do { _Pragma("unroll") for (int n = 0; n < 2; ++n) _Pragma("unroll") for (int k = 0; k < 2; ++k) dst[n][k] = *(const LAS bf16x8*)(lds + PG8_SB(b, h) + boff + n * 2048 + k * 1024); } while (0)
#define PG8_MMA(ai, bj, At, Bt) do { __builtin_amdgcn_s_setprio(1); _Pragma("unroll") for (int m = 0; m < MF; ++m) _Pragma("unroll") for (int n = 0; n < 2; ++n) _Pragma("unroll") for (int k = 0; k < 2; ++k) \
        acc[ai][bj][m][n] = __builtin_amdgcn_mfma_f32_16x16x32_bf16(Bt[n][k], At[m][k], acc[ai][bj][m][n], 0, 0, 0); __builtin_amdgcn_s_setprio(0); } while (0)
#define PG8_WAIT_V(n) asm volatile("s_waitcnt vmcnt(" #n ")" ::: "memory")
#define PG8_WAIT_L(n) asm volatile("s_waitcnt lgkmcnt(" #n ")" ::: "memory")
#define PG8_WAIT_LA() do { if (MF == 3) PG8_WAIT_L(6); else PG8_WAIT_L(4); } while (0)
#define PG8_BAR __builtin_amdgcn_s_barrier()
#define PG8_SCHED __builtin_amdgcn_sched_barrier(0)
    Unit cur, nxt; int ui = 0;
    if (!S.next(0, cur)) return;
    f32x4 acc[2][2][MF][2];
#pragma unroll
    for (int a = 0; a < 2; ++a)
#pragma unroll
        for (int b = 0; b < 2; ++b)
#pragma unroll
            for (int m = 0; m < MF; ++m)
#pragma unroll
                for (int n = 0; n < 2; ++n) acc[a][b][m][n] = (f32x4){0.f, 0.f, 0.f, 0.f};
    bf16x8 At[MF][2], B0[2][2], B1[2][2];
    const char* cA = cur.a; const char* cB = cur.b;
    PG8_STAGEB(PG8_SB(0, 0), cB); PG8_STAGEA(PG8_SA(0, 0), cA); PG8_STAGEB(PG8_SB(0, 1), cB + hstepB); PG8_STAGEA(PG8_SA(0, 1), cA + hstepA);
    if (wr == 1) PG8_BAR;
    PG8_WAIT_V(4); PG8_BAR;
    PG8_STAGEB(PG8_SB(1, 0), cB + kstep); PG8_STAGEA(PG8_SA(1, 0), cA + kstep); PG8_STAGEB(PG8_SB(1, 1), cB + hstepB + kstep);
    PG8_WAIT_V(6); PG8_BAR;
    for (;;) {
        const bool has_next = S.next(ui + 1, nxt);
        const char* nA = has_next ? nxt.a : cA; const char* nB = has_next ? nxt.b : cB;
        for (int t = 0; t < nt; t += 2) {
            const bool last = (t == nt - 2);
            const char* a1 = cA + (size_t)(t + 1) * kstep;
            const char* a2 = last ? nA : cA + (size_t)(t + 2) * kstep; const char* b2 = last ? nB : cB + (size_t)(t + 2) * kstep;
            const char* a3 = a2 + kstep; const char* b3 = b2 + kstep;
            PG8_LDB(B0, 0, 0); PG8_SCHED; PG8_LDA(At, 0, 0); PG8_STAGEA(PG8_SA(1, 1), a1 + hstepA);
            PG8_WAIT_LA(); PG8_BAR; PG8_WAIT_L(0); PG8_MMA(0, 0, At, B0); PG8_BAR; PG8_SCHED;
            PG8_LDB(B1, 0, 1); PG8_STAGEB(PG8_SB(0, 0), b2);
            PG8_BAR; PG8_WAIT_L(0); PG8_MMA(0, 1, At, B1); PG8_BAR;
            PG8_LDA(At, 0, 1); PG8_STAGEA(PG8_SA(0, 0), a2);
            PG8_BAR; PG8_WAIT_L(0); PG8_MMA(1, 0, At, B0); PG8_BAR; PG8_SCHED;
            PG8_STAGEB(PG8_SB(0, 1), b2 + hstepB);
            PG8_WAIT_V(6); PG8_BAR; PG8_MMA(1, 1, At, B1); PG8_BAR;
            PG8_LDB(B0, 1, 0); PG8_SCHED; PG8_LDA(At, 1, 0); PG8_STAGEA(PG8_SA(0, 1), a2 + hstepA);
            PG8_WAIT_LA(); PG8_BAR; PG8_WAIT_L(0); PG8_MMA(0, 0, At, B0); PG8_BAR; PG8_SCHED;
            PG8_LDB(B1, 1, 1); PG8_STAGEB(PG8_SB(1, 0), b3);
            PG8_BAR; PG8_WAIT_L(0); PG8_MMA(0, 1, At, B1); PG8_BAR;
            PG8_LDA(At, 1, 1); PG8_STAGEA(PG8_SA(1, 0), a3);
            PG8_BAR; PG8_WAIT_L(0); PG8_MMA(1, 0, At, B0); PG8_BAR; PG8_SCHED;
            PG8_STAGEB(PG8_SB(1, 1), b3 + hstepB);
            PG8_WAIT_V(6); PG8_BAR; PG8_MMA(1, 1, At, B1); PG8_BAR;
        }
        if constexpr (!Epi::AFTER_DRAIN) E.template tile<MF>(acc, cur, wr, wc, fr, fq);
        if (!has_next) break;
#pragma unroll
        for (int a = 0; a < 2; ++a)
#pragma unroll
            for (int b = 0; b < 2; ++b)
#pragma unroll
                for (int m = 0; m < MF; ++m)
#pragma unroll
                    for (int n = 0; n < 2; ++n) acc[a][b][m][n] = (f32x4){0.f, 0.f, 0.f, 0.f};
        cur = nxt; cA = nA; cB = nB; ++ui;
    }
    PG8_WAIT_V(0);
    if (wr == 0) PG8_BAR;
    PG8_BAR;
    if constexpr (Epi::AFTER_DRAIN) E.template fused<MF>(acc, cur, wr, wc, fr, fq, lds, wid, lane, tid);
#undef PG8_SA
#undef PG8_SB
#undef PG8_STAGEA
#undef PG8_STAGEB
#undef PG8_LDA
#undef PG8_LDB
#undef PG8_MMA
#undef PG8_WAIT_V
#undef PG8_WAIT_L
#undef PG8_WAIT_LA
#undef PG8_BAR
#undef PG8_SCHED
}
template <class Epi, class Sched>
__device__ __forceinline__ void gemm_phase160b(LAS unsigned char* lds, const Gemm g, const Sched& S, const Epi& E) {
    int tid = threadIdx.x; asm volatile("" : "+v"(tid));
    const int wid = __builtin_amdgcn_readfirstlane(tid >> 6), lane = tid & 63, wr = wid >> 2, wc = wid & 3;
    if (wr == 0) gemm_phase160b_run<3>(lds, g, S, E, tid, wid, lane, wr, wc);
    else gemm_phase160b_run<2>(lds, g, S, E, tid, wid, lane, wr, wc);
}
}

struct Args { const void* in[27]; float* out; unsigned char* ws; int ph_lo, ph_hi; };
enum { I_XP = 0, I_XS, I_CK, I_CV, I_ST, I_C, I_CCTX, I_WADA, I_BADA, I_GAINS, I_WIN, I_WOUT, I_LAMBDA, I_SUBLN, I_MU, I_W0, I_W2, I_A0, I_A2, I_G2, I_KVEC, I_LNX, I_WODD, I_WFI, I_CONVW, I_CONVB, I_WFO };
#define FIN(k) ((const float*)a.in[k])
#define WSB(off) ((bf16*)(a.ws + (off)))
#define WSF(off) ((float*)(a.ws + (off)))


__device__ __forceinline__ const void* ptab_ld(LAS unsigned char* lds, int k) {
    const u32x2 w = *(const LAS u32x2*)(lds + PTAB_OFF + 8 * k);
    const unsigned long long v = ((unsigned long long)(unsigned)__builtin_amdgcn_readfirstlane((int)w.y) << 32) | (unsigned)__builtin_amdgcn_readfirstlane((int)w.x);
    return (const void*)(const __attribute__((address_space(1))) void*)v;
}
__device__ __forceinline__ Args load_args(LAS unsigned char* lds, int ph_lo, int ph_hi) {
    Args r;
#pragma unroll
    for (int i = 0; i < 27; ++i) r.in[i] = ptab_ld(lds, i);
    r.out = (float*)ptab_ld(lds, 27); r.ws = (unsigned char*)ptab_ld(lds, 28); r.ph_lo = ph_lo; r.ph_hi = ph_hi;
    return r;
}
__device__ __forceinline__ int row_cond(int row) { return row < NPR ? 0 : 1 + ((row - NPR) >> 10); }

template <bool FFN_PERM = false>
__device__ __forceinline__ void p0_transpose_item(const float* W, int K, int N, bf16* WT, LAS float* scr, int item, int lane) {
    const int nblk = N / 64, kb = item / nblk, nb = item % nblk, k0 = 64 * kb, n0 = 64 * nb;
    const int d0 = FFN_PERM ? (n0 < DFF ? (n0 / 128) * 256 + (n0 % 128) : ((n0 - DFF) / 128) * 256 + 128 + ((n0 - DFF) % 128)) : n0;
    const int c2 = 2 * (lane & 31);
#pragma unroll 8
    for (int i = 0; i < 32; ++i) { const int kk = 2 * i + (lane >> 5); const f32x2 v = *(const f32x2*)(W + (size_t)(k0 + kk) * N + n0 + c2); scr[kk * 65 + c2] = v[0]; scr[kk * 65 + c2 + 1] = v[1]; }
    asm volatile("s_waitcnt lgkmcnt(0)" ::: "memory");
    const int c = lane & 7;
#pragma unroll
    for (int j = 0; j < 8; ++j) { const int n = (lane >> 3) + 8 * j; const LAS float* s = scr + (8 * c) * 65 + n;
        u32x4 o; o.x = pk2(s[0 * 65], s[1 * 65]); o.y = pk2(s[2 * 65], s[3 * 65]); o.z = pk2(s[4 * 65], s[5 * 65]); o.w = pk2(s[6 * 65], s[7 * 65]);
        *(u32x4*)(WT + (size_t)(d0 + n) * K + k0 + 8 * c) = o; }
    asm volatile("s_waitcnt lgkmcnt(0)" ::: "memory");
}

template <int STAGE>
__device__ __forceinline__ void phase_prep(const Args& a, LAS unsigned char* lds, int bid, int G, int vgw = -2, int nmine = 1, int nvw = 0) {
    int tid = threadIdx.x; asm volatile("" : "+v"(tid));
    const int lane = tid & 63, wave = tid >> 6;
    const int gw = bid * 8 + wave, NGW = G * 8;
    const int gt = bid * 512 + tid, NGT = G * 512;
    constexpr int I_IN = (1024 / 64) * (INE / 64), I_SQ = (1024 / 64) * (1024 / 64), I_FI = (1024 / 64) * (DFF2 / 64), I_FO = (DFF / 64) * (1024 / 64), I_L64 = 1 * (512 / 64), I_L128 = 2 * (512 / 64);
    if (STAGE == 1 || STAGE == 3) {
        LAS float* scr = (LAS float*)(lds + wave * 18432);
        constexpr int NITEMS = I_IN + 4 * I_L64 + I_L128;
        for (int it = gw; it < NITEMS; it += NGW) {
            int r = it;
            if (r < I_IN) { p0_transpose_item(FIN(I_WIN), 1024, INE, WSB(WS_WIN), scr, r, lane); continue; } r -= I_IN;
            if (r < 2 * I_L64) { const int d = r / I_L64; p0_transpose_item(FIN(I_W2) + (size_t)d * 64 * 512, 64, 512, WSB(WS_W2T) + (size_t)d * 512 * 64, scr, r % I_L64, lane); continue; } r -= 2 * I_L64;
            if (r < 2 * I_L64) { const int d = r / I_L64; p0_transpose_item(FIN(I_A2) + (size_t)d * 64 * 512, 64, 512, WSB(WS_A2T) + (size_t)d * 512 * 64, scr, r % I_L64, lane); continue; } r -= 2 * I_L64;
            p0_transpose_item(FIN(I_G2), 128, 512, WSB(WS_G2T), scr, r, lane);
        }
        for (int i = gt; i < (INE_PAD - INE) * 1024 / 8; i += NGT) ((u32x4*)(WSB(WS_WIN) + (size_t)INE * 1024))[i] = (u32x4){0u, 0u, 0u, 0u};
    }
    if (STAGE == 2) {
        LAS float* scr = (LAS float*)(lds + wave * 18432);
        constexpr int NITEMS = I_SQ + I_FI + I_FO;
        const int s0 = vgw == -2 ? gw : vgw, ns = vgw == -2 ? NGW : nvw;
        for (int sl = 0; sl < nmine; ++sl)
        for (int it = s0 < 0 ? NITEMS : s0 + sl; it < NITEMS; it += ns) {
            int r = it;
            if (r < I_SQ) { p0_transpose_item(FIN(I_WOUT), 1024, 1024, WSB(WS_WO), scr, r, lane); continue; } r -= I_SQ;
            if (r < I_FI) { p0_transpose_item<true>(FIN(I_WFI), 1024, DFF2, WSB(WS_WFI), scr, r, lane); continue; } r -= I_FI;
            p0_transpose_item(FIN(I_WFO), DFF, 1024, WSB(WS_WFO), scr, r, lane);
        }
    }
    if (STAGE == 0 || STAGE == 3) {
        for (int i = gt; i < 256 * 128; i += NGT) {
            const int n = i >> 7, c = i & 127, m = (c * (n & 127)) & 127; const float x = (float)m * (2.0f / 128.0f);
            WSB(WS_WDFT)[i] = f2bf(n < 128 ? cospif(x) : sinpif(x));
        }
        for (int i = gt; i < 256 * 512; i += NGT) {
            const int lp = i >> 9, k = i & 511, l = k & 255, m = (lp * l) & 255; const float x = (float)m * (2.0f / 256.0f), s = 0.00552427172801990f;
            WSB(WS_A2P)[i] = f2bf(k < 256 ? s * cospif(x) : -s * sinpif(x));
        }
        for (int i = gt; i < 1024 * 32; i += NGT) {
            const int t = i >> 5, f = i & 31; const float inv = powf(10000.0f, -(float)(f & 15) / 16.0f), pos = (float)(f < 16 ? (t >> 6) : (t & 63)), ang = pos * inv;
            WSF(WS_ROPE)[i] = cosf(ang); WSF(WS_ROPE)[1024 * 32 + i] = sinf(ang);
        }
        if (gt == 0) {
            const float* lp = FIN(I_LAMBDA); float s1 = 0.f, s2 = 0.f;
            for (int i = 0; i < 64; ++i) { s1 += lp[i] * lp[64 + i]; s2 += lp[128 + i] * lp[192 + i]; }
            WSF(WS_LAM)[0] = expf(s1) - expf(s2) + 0.2f;
        }
        for (int i = gt; i < 2 * 256 * 512; i += NGT) {
            const int b = i >> 17, t = (i >> 9) & 255, c = i & 511;
            WSB(WS_KS)[((size_t)b * LKS + t) * 512 + c] = f2bf(FIN(I_CK)[i]);
            const int h = c >> 7, d = c & 127;
            WSB(WS_VTS)[((size_t)(b * 4 + h) * 128 + d) * LKS + keypos(t)] = f2bf(FIN(I_CV)[i]);
        }
    }
    if (STAGE == 0 || STAGE == 1 || STAGE == 3) {
        LAS float* sc = (LAS float*)lds;
        LAS float* red = (LAS float*)(lds + 16384);
        __syncthreads();
        for (int i = tid; i < 3 * 1024; i += 512) { const int cd = i >> 10, k = i & 1023; const float x = cd == 0 ? FIN(I_CCTX)[k] : FIN(I_C)[(cd - 1) * 1024 + k]; sc[i] = x / (1.f + __expf(-x)); }
        __syncthreads();
        const int kq = tid >> 3, nl = tid & 7;
        const int it_lo = STAGE == 0 ? 0 : 64, it_hi = STAGE == 0 ? 64 : 2 * 192;
        for (int q = 0; ; ++q) {
            int it;
            if (STAGE == 3) {
                if (G == 256) { if (q == 0) { if (bid >= 64) continue; it = bid; } else if (q == 1) { if (bid < 64) continue; it = bid; } else if (q == 2) { if (bid >= 128) continue; it = 256 + bid; } else break; }
                else { it = bid + q * G; if (it >= 2 * 192) break; }
            } else { it = it_lo + bid + q * G; if (it >= it_hi) break; }
            const int l = it / 192, n0 = (it % 192) * 32;
            const float* W = FIN(I_WADA) + (size_t)l * 1024 * 6144 + n0 + 4 * nl;
            f32x4 s0 = {0.f, 0.f, 0.f, 0.f}, s1 = s0, s2 = s0;
#pragma unroll 4
            for (int kk = 0; kk < 16; ++kk) { const int k = kq * 16 + kk; const f32x4 w = *(const f32x4*)(W + (size_t)k * 6144); s0 += w * sc[k]; s1 += w * sc[1024 + k]; s2 += w * sc[2048 + k]; }
            *(LAS f32x4*)(red + (kq * 3 + 0) * 32 + 4 * nl) = s0; *(LAS f32x4*)(red + (kq * 3 + 1) * 32 + 4 * nl) = s1; *(LAS f32x4*)(red + (kq * 3 + 2) * 32 + 4 * nl) = s2;
            __syncthreads();
            if (tid < 96) { const int cd = tid >> 5, n = tid & 31; float s = FIN(I_BADA)[l * 6144 + n0 + n];
                for (int qq = 0; qq < 64; ++qq) s += red[(qq * 3 + cd) * 32 + n];
                if (STAGE == 3 && it < 64)
                    __hip_atomic_store((unsigned*)(a.ws + WS_MOD1) + cd * 2048 + n0 + n, __float_as_uint(s) | 1u, __ATOMIC_RELAXED, __HIP_MEMORY_SCOPE_AGENT);
                else WSF(WS_MOD)[(size_t)(l * 3 + cd) * 6144 + n0 + n] = s; }
            __syncthreads();
        }
    }
}

__device__ __forceinline__ void phase_first_norm(const Args& a, LAS unsigned char* lds, int bid, int G, const float* gB) {
    int tid = threadIdx.x; asm volatile("" : "+v"(tid));
    const int lane = tid & 63, wave = tid >> 6;
    const int gw = bid * 8 + wave, NGW = G * 8;
    LAS float* modl = (LAS float*)lds;
    __syncthreads();
    {   const unsigned* side = (const unsigned*)(a.ws + WS_MOD1);
        unsigned v[12]; unsigned spins = 0;
        for (;;) { bool ok = true;
#pragma unroll
            for (int i = 0; i < 12; ++i) { v[i] = __hip_atomic_load(side + tid + 512 * i, __ATOMIC_RELAXED, __HIP_MEMORY_SCOPE_AGENT); ok = ok && (v[i] != 0u); }
            if (ok || ++spins > (1u << 20)) break;
            __builtin_amdgcn_s_sleep(2); }
#pragma unroll
        for (int i = 0; i < 12; ++i) modl[tid + 512 * i] = __uint_as_float(v[i]);
    }
    __syncthreads();
    bf16* XN = WSB(WS_XN);
    constexpr int R = 5;
    for (int row0 = gw; row0 < NT; row0 += R * NGW) {
        f32x4 x[R][4];
#pragma unroll
        for (int q = 0; q < R; ++q) { const int row = row0 + q * NGW; if (row < NT) {
            const float* xin = row < NPR ? FIN(I_XP) + (size_t)row * DM : FIN(I_XS) + (size_t)(row - NPR) * DM;
#pragma unroll
            for (int j = 0; j < 4; ++j) x[q][j] = *(const f32x4*)(xin + 4 * lane + 256 * j); } }
#pragma unroll
        for (int q = 0; q < R; ++q) { const int row = row0 + q * NGW; if (row < NT) {
            const LAS float* ml = modl + row_cond(row) * 2048;
            float ss = 0.f;
#pragma unroll
            for (int j = 0; j < 4; ++j) ss += (x[q][j][0] * x[q][j][0] + x[q][j][1] * x[q][j][1]) + (x[q][j][2] * x[q][j][2] + x[q][j][3] * x[q][j][3]);
            const float rinv = rsqrtf(wave_sum(ss) * (1.f / DM) + 1e-6f);
#pragma unroll
            for (int j = 0; j < 4; ++j) { const f32x4 g = *(const f32x4*)(gB + 4 * lane + 256 * j), sc = *(const LAS f32x4*)(ml + 1024 + 4 * lane + 256 * j), sh = *(const LAS f32x4*)(ml + 4 * lane + 256 * j);
                const f32x4 h = (x[q][j] * rinv * g) * (sc + 1.f) + sh; *(u32x2*)(XN + (size_t)row * DM + 4 * lane + 256 * j) = pk4(h); }
        } }
    }
}

template <int SEL>
__device__ __forceinline__ void phase_transpose_wfi1(const Args& a, LAS unsigned char* lds, int bid, int G) {
    int tid = threadIdx.x; asm volatile("" : "+v"(tid));
    const int lane = tid & 63, wave = tid >> 6;
    LAS float* scr = (LAS float*)(lds + wave * 18432);
    constexpr int I_FI = (1024 / 64) * (DFF2 / 64), I_SQ = (1024 / 64) * (1024 / 64), I_FO = (DFF / 64) * (1024 / 64);
    if (SEL == 0) {
        for (int it = bid * 8 + wave; it < I_FI + I_SQ; it += G * 8) {
            if (it < I_FI) p0_transpose_item<true>(FIN(I_WFI) + (size_t)1024 * DFF2, 1024, DFF2, WSB(WS_WFI) + (size_t)DFF2 * 1024, scr, it, lane);
            else p0_transpose_item(FIN(I_WODD), 1024, 1024, WSB(WS_WODD), scr, it - I_FI, lane); }
    } else {
        for (int it = bid * 8 + wave; it < I_FO; it += G * 8) p0_transpose_item(FIN(I_WFO) + (size_t)DFF * 1024, DFF, 1024, WSB(WS_WFO) + (size_t)1024 * DFF, scr, it, lane);
    }
    __syncthreads();
}
template <bool HAS_RES, bool HAS_H, bool X_FROM_INPUT, bool X_TO_OUTPUT = false>
__device__ __forceinline__ void phase_resnorm(const Args& a, int bid, int G, const bf16* mf, const float* gA, int gate_off, int layer_gate, const float* gB, int shift_off, int scale_off, int layer_mod) {
    int tid = threadIdx.x; asm volatile("" : "+v"(tid));
    const int lane = tid & 63, wave = tid >> 6;
    const int gw = bid * 8 + wave, NGW = G * 8;
    float* X = a.out; bf16* XB = WSB(WS_XB);
    bf16* XN = WSB(WS_XN);
    constexpr int R = 5;
    for (int row0 = gw; row0 < NT; row0 += R * NGW) {
        f32x4 x[R][4], m[R][4];
#pragma unroll
        for (int q = 0; q < R; ++q) { const int row = row0 + q * NGW; if (row < NT) {
            const float* xin = row < NPR ? FIN(I_XP) + (size_t)row * DM : FIN(I_XS) + (size_t)(row - NPR) * DM;
#pragma unroll
            for (int j = 0; j < 4; ++j) { x[q][j] = X_FROM_INPUT ? *(const f32x4*)(xin + 4 * lane + 256 * j) : unpk4(*(const u32x2*)(XB + (size_t)row * DM + 4 * lane + 256 * j)); if (HAS_RES) m[q][j] = unpk4(*(const u32x2*)(mf + (size_t)row * DM + 4 * lane + 256 * j)); } } }
#pragma unroll
        for (int q = 0; q < R; ++q) { const int row = row0 + q * NGW; if (row < NT) {
            const float* mod = WSF(WS_MOD) + (size_t)(layer_mod * 3 + row_cond(row)) * 6144;
            const float* modg = WSF(WS_MOD) + (size_t)(layer_gate * 3 + row_cond(row)) * 6144;
            if (HAS_RES) {
                float ss = 0.f;
#pragma unroll
                for (int j = 0; j < 4; ++j) ss += (m[q][j][0] * m[q][j][0] + m[q][j][1] * m[q][j][1]) + (m[q][j][2] * m[q][j][2] + m[q][j][3] * m[q][j][3]);
                const float rinv = rsqrtf(wave_sum(ss) * (1.f / DM) + 1e-6f);
#pragma unroll
                for (int j = 0; j < 4; ++j) { const f32x4 g = *(const f32x4*)(gA + 4 * lane + 256 * j), gt = *(const f32x4*)(modg + gate_off + 4 * lane + 256 * j);
                    x[q][j] = x[q][j] + gt * (m[q][j] * rinv * g);
                    if (X_TO_OUTPUT) *(f32x4*)(X + (size_t)row * DM + 4 * lane + 256 * j) = x[q][j]; else *(u32x2*)(XB + (size_t)row * DM + 4 * lane + 256 * j) = pk4(x[q][j]); }
            }
            if (HAS_H) {
                float ss = 0.f;
#pragma unroll
                for (int j = 0; j < 4; ++j) ss += (x[q][j][0] * x[q][j][0] + x[q][j][1] * x[q][j][1]) + (x[q][j][2] * x[q][j][2] + x[q][j][3] * x[q][j][3]);
                const float rinv = rsqrtf(wave_sum(ss) * (1.f / DM) + 1e-6f);
#pragma unroll
                for (int j = 0; j < 4; ++j) { const f32x4 g = *(const f32x4*)(gB + 4 * lane + 256 * j), sc = *(const f32x4*)(mod + scale_off + 4 * lane + 256 * j), sh = *(const f32x4*)(mod + shift_off + 4 * lane + 256 * j);
                    const f32x4 h = (x[q][j] * rinv * g) * (sc + 1.f) + sh; *(u32x2*)(XN + (size_t)row * DM + 4 * lane + 256 * j) = pk4(h); }
            }
        } }
    }
}

struct EpiF32 {
    float* C; int ldc;
    static constexpr bool ALIGN = false;
    __device__ __forceinline__ void operator()(const f32x4 (&acc)[2][2][4][2], const pg8::Unit& u, int wr, int wc, int fr, int fq) const {
        pg8::epi_each(acc, u.pm * 256 + wr * 64 + fr, u.pn * 256 + wc * 32 + 4 * fq, [&](int row, int col, const f32x4& v) { *(f32x4*)(C + (size_t)row * ldc + col) = v; });
    }
};
struct EpiBf16 {
    bf16* O; int ldc;
    static constexpr bool ALIGN = false;
    __device__ __forceinline__ void operator()(const f32x4 (&acc)[2][2][4][2], const pg8::Unit& u, int wr, int wc, int fr, int fq) const {
        pg8::epi_each(acc, u.z + u.pm * 256 + wr * 64 + fr, u.pn * 256 + wc * 32 + 4 * fq, [&](int row, int col, const f32x4& v) { *(u32x2*)(O + (size_t)row * ldc + col) = pk4(v); });
    }
};

template <class F> __device__ __forceinline__ void epi_each160(const f32x4 (&acc)[2][2][5], const pg8::Unit& u, int wid, int fr, int fq, F&& f) {
#pragma unroll
    for (int ai = 0; ai < 2; ++ai)
#pragma unroll
        for (int m = 0; m < 5; ++m)
#pragma unroll
            for (int bj = 0; bj < 2; ++bj) f(u.pm * 160 + ai * 80 + m * 16 + fr, u.pn * 256 + bj * 128 + wid * 16 + 4 * fq, acc[ai][bj][m]);
}
struct EpiBf16_160 {
    bf16* O; int ldc;
    static constexpr bool AFTER_DRAIN = false;
    template <int MF> __device__ __forceinline__ void tile(const f32x4 (&acc)[2][2][MF][2], const pg8::Unit& u, int wr, int wc, int fr, int fq) const {
#pragma unroll
        for (int ai = 0; ai < 2; ++ai)
#pragma unroll
            for (int m = 0; m < MF; ++m)
#pragma unroll
                for (int bj = 0; bj < 2; ++bj)
#pragma unroll
                    for (int n = 0; n < 2; ++n) *(u32x2*)(O + (size_t)(u.pm * 160 + ai * 80 + wr * 48 + m * 16 + fr) * ldc + u.pn * 256 + bj * 128 + wc * 32 + n * 16 + 4 * fq) = pk4(acc[ai][bj][m][n]);
    }
    __device__ __forceinline__ void operator()(const f32x4 (&acc)[2][2][5], const pg8::Unit& u, int wid, int fr, int fq) const {
#pragma unroll
        for (int ai = 0; ai < 2; ++ai)
#pragma unroll
            for (int m = 0; m < 5; ++m)
#pragma unroll
                for (int bj = 0; bj < 2; ++bj) *(u32x2*)(O + (size_t)(u.pm * 160 + ai * 80 + m * 16 + fr) * ldc + u.pn * 256 + bj * 128 + wid * 16 + 4 * fq) = pk4(acc[ai][bj][m]);
    }
};

template <bool FROM_INPUT, bool FINAL>
struct EpiResNorm {
    static constexpr bool AFTER_DRAIN = true;
    const float* xin_p; const float* xin_s; const bf16* xb_in;
    bf16* xb_out; float* xf_out; bf16* xn_out;
    const float* gA; const float* gB; const float* mod;
    int gate_off, layer_gate, shift_off, scale_off, layer_mod;
    unsigned* slots; unsigned* cnt;

    template <int MF> __device__ __forceinline__ void exchange(const f32x4 (&v)[2][2][MF][2], int e, int pm, int pn, int wr, int wc, int fr, int fq, LAS float* P, LAS float* R, int wid, int lane, int tid) const {
#pragma unroll
        for (int ai = 0; ai < 2; ++ai)
#pragma unroll
            for (int m = 0; m < MF; ++m) {
                float s = 0.f;
#pragma unroll
                for (int bj = 0; bj < 2; ++bj)
#pragma unroll
                    for (int n = 0; n < 2; ++n) { const f32x4 x = v[ai][bj][m][n]; s += (x[0] * x[0] + x[1] * x[1]) + (x[2] * x[2] + x[3] * x[3]); }
                s += __shfl_xor(s, 16); s += __shfl_xor(s, 32);
                if (fq == 0) P[(80 * ai + 48 * wr + 16 * m + fr) * 4 + wc] = s;
            }
        asm volatile("s_waitcnt lgkmcnt(0)" ::: "memory"); __builtin_amdgcn_s_barrier(); asm volatile("" ::: "memory");
        unsigned long long* sl = (unsigned long long*)(slots + ((size_t)(e * 64 + pm) * 160) * 4);
        if (tid < 160) { const float tot = (P[tid * 4 + 0] + P[tid * 4 + 1]) + (P[tid * 4 + 2] + P[tid * 4 + 3]);
            __hip_atomic_store((unsigned*)sl + tid * 4 + pn, __float_as_uint(tot) | 1u, __ATOMIC_RELAXED, __HIP_MEMORY_SCOPE_AGENT);
            unsigned long long a, b; unsigned spins = 0;
            for (;;) {
                a = __hip_atomic_load(sl + tid * 2 + 0, __ATOMIC_RELAXED, __HIP_MEMORY_SCOPE_AGENT); b = __hip_atomic_load(sl + tid * 2 + 1, __ATOMIC_RELAXED, __HIP_MEMORY_SCOPE_AGENT);
                if (((unsigned)a != 0u && (unsigned)(a >> 32) != 0u && (unsigned)b != 0u && (unsigned)(b >> 32) != 0u) || ++spins > (1u << 20)) break;
                __builtin_amdgcn_s_sleep(1);
            }
            const float q = (__uint_as_float((unsigned)a) + __uint_as_float((unsigned)(a >> 32))) + (__uint_as_float((unsigned)b) + __uint_as_float((unsigned)(b >> 32)));
            R[tid] = rsqrtf(q * (1.f / 1024.f) + 1e-6f); }
        asm volatile("s_waitcnt lgkmcnt(0)" ::: "memory"); __builtin_amdgcn_s_barrier(); asm volatile("" ::: "memory");
    }

    template <int MF> __device__ __forceinline__ void fused(f32x4 (&acc)[2][2][MF][2], const pg8::Unit& u, int wr, int wc, int fr, int fq, LAS unsigned char* lds, int wid, int lane, int tid) const {
        LAS float* P = (LAS float*)lds; LAS float* R = (LAS float*)(lds + 4096);
        const int pm = u.pm, pn = u.pn, row0 = 160 * pm;
        int cb = 256 * pn + 32 * wc + 4 * fq; asm volatile("" : "+v"(cb));
        const int c_lo = row_cond(row0), c_hi = row_cond(row0 + 159);
        f32x4 g[4], gtl[4], gth[4];
        {   const float* ml = mod + (size_t)(layer_gate * 3 + c_lo) * 6144 + gate_off; const float* mh = mod + (size_t)(layer_gate * 3 + c_hi) * 6144 + gate_off;
#pragma unroll
            for (int q = 0; q < 4; ++q) { const int col = cb + 128 * (q >> 1) + 16 * (q & 1); g[q] = *(const f32x4*)(gA + col); gtl[q] = *(const f32x4*)(ml + col); gth[q] = *(const f32x4*)(mh + col); } }
        using XT = typename std::conditional<FROM_INPUT, f32x4, u32x2>::type;
        XT x0[MF * 4], x1[MF * 4];
        auto ldx = [&](XT (&xr)[MF * 4], int ai) {
#pragma unroll
            for (int m = 0; m < MF; ++m) { const int row = row0 + 80 * ai + 48 * wr + 16 * m + fr;
#pragma unroll
                for (int q = 0; q < 4; ++q) { const int col = cb + 128 * (q >> 1) + 16 * (q & 1);
                    if constexpr (FROM_INPUT) xr[m * 4 + q] = *(const f32x4*)((row < NPR ? xin_p + (size_t)row * DM : xin_s + (size_t)(row - NPR) * DM) + col);
                    else xr[m * 4 + q] = *(const u32x2*)(xb_in + (size_t)row * DM + col); } } };
        auto upd = [&](const XT (&xr)[MF * 4], int ai) {
#pragma unroll
            for (int m = 0; m < MF; ++m) { const int rl = 80 * ai + 48 * wr + 16 * m + fr; const float rinv = R[rl]; const bool hi = row_cond(row0 + 80 * ai + 48 * wr + 16 * m) != c_lo;
#pragma unroll
                for (int q = 0; q < 4; ++q) { f32x4 x; if constexpr (FROM_INPUT) x = xr[m * 4 + q]; else x = unpk4(xr[m * 4 + q]);
                    const f32x4 gt = hi ? gth[q] : gtl[q];
                    acc[ai][q >> 1][m][q & 1] = x + gt * (acc[ai][q >> 1][m][q & 1] * rinv * g[q]); } } };
        ldx(x0, 0);
        if constexpr (!FROM_INPUT) ldx(x1, 1);
        asm volatile("" ::: "memory");
        exchange<MF>(acc, 0, pm, pn, wr, wc, fr, fq, P, R, wid, lane, tid);
        upd(x0, 0);
        if constexpr (FROM_INPUT) { asm volatile("" ::: "memory"); ldx(x1, 1); }
        upd(x1, 1);
#pragma unroll
        for (int ai = 0; ai < 2; ++ai)
#pragma unroll
            for (int m = 0; m < MF; ++m) { const int row = row0 + 80 * ai + 48 * wr + 16 * m + fr;
#pragma unroll
                for (int q = 0; q < 4; ++q) { const int col = cb + 128 * (q >> 1) + 16 * (q & 1); const f32x4 x = acc[ai][q >> 1][m][q & 1];
                    if constexpr (FINAL) *(f32x4*)(xf_out + (size_t)row * DM + col) = x; else *(u32x2*)(xb_out + (size_t)row * DM + col) = pk4(x); } }
        if constexpr (!FINAL) {
            f32x4 al[4], ah[4], sl[4], sh[4];
            {   const float* ml = mod + (size_t)(layer_mod * 3 + c_lo) * 6144; const float* mh = mod + (size_t)(layer_mod * 3 + c_hi) * 6144;
#pragma unroll
                for (int q = 0; q < 4; ++q) { const int col = cb + 128 * (q >> 1) + 16 * (q & 1); const f32x4 gb = *(const f32x4*)(gB + col);
                    al[q] = gb * (*(const f32x4*)(ml + scale_off + col) + 1.f); ah[q] = gb * (*(const f32x4*)(mh + scale_off + col) + 1.f);
                    sl[q] = *(const f32x4*)(ml + shift_off + col); sh[q] = *(const f32x4*)(mh + shift_off + col); } }
            asm volatile("" ::: "memory");
            exchange<MF>(acc, 1, pm, pn, wr, wc, fr, fq, P, R, wid, lane, tid);
#pragma unroll
            for (int ai = 0; ai < 2; ++ai)
#pragma unroll
                for (int m = 0; m < MF; ++m) { const int rl = 80 * ai + 48 * wr + 16 * m + fr, row = row0 + rl; const float rinv = R[rl]; const bool hi = row_cond(row0 + 80 * ai + 48 * wr + 16 * m) != c_lo;
#pragma unroll
                    for (int q = 0; q < 4; ++q) { const int col = cb + 128 * (q >> 1) + 16 * (q & 1);
                        const f32x4 h = (acc[ai][q >> 1][m][q & 1] * rinv) * (hi ? ah[q] : al[q]) + (hi ? sh[q] : sl[q]);
                        *(u32x2*)(xn_out + (size_t)row * DM + col) = pk4(h); } }
        }
    }
};

struct EpiProj {
    bf16 *Q, *KP, *KS, *VTP, *VTS, *FB; float *ock, *ocv; const float* rope;
    static constexpr bool ALIGN = false, AFTER_DRAIN = false;
    __device__ __forceinline__ f32x4 do_rope(f32x4 v, int t, int col) const {
        const int i0 = (col & 63) >> 1;
        const f32x2 c = *(const f32x2*)(rope + t * 32 + i0), s = *(const f32x2*)(rope + 1024 * 32 + t * 32 + i0);
        f32x4 o; o[0] = v[0] * c[0] - v[1] * s[0]; o[1] = v[0] * s[0] + v[1] * c[0]; o[2] = v[2] * c[1] - v[3] * s[1]; o[3] = v[2] * s[1] + v[3] * c[1]; return o;
    }
    __device__ __forceinline__ void operator()(const f32x4 (&acc)[2][2][4][2], const pg8::Unit& u, int wr, int wc, int fr, int fq) const {
        pg8::epi_each(acc, u.pm * 256 + wr * 64 + fr, u.pn * 256 + wc * 32 + 4 * fq, [&](int row, int col, const f32x4& v) { elem(row, col, v); });
    }
    __device__ __forceinline__ void operator()(const f32x4 (&acc)[2][2][5], const pg8::Unit& u, int wid, int fr, int fq) const {
        epi_each160(acc, u, wid, fr, fq, [&](int row, int col, const f32x4& v) { elem(row, col, v); });
    }
    template <int MF> __device__ __forceinline__ void tile(const f32x4 (&acc)[2][2][MF][2], const pg8::Unit& u, int wr, int wc, int fr, int fq) const {
#pragma unroll
        for (int ai = 0; ai < 2; ++ai)
#pragma unroll
            for (int m = 0; m < MF; ++m)
#pragma unroll
                for (int bj = 0; bj < 2; ++bj)
#pragma unroll
                    for (int n = 0; n < 2; ++n) elem(u.pm * 160 + ai * 80 + wr * 48 + m * 16 + fr, u.pn * 256 + bj * 128 + wc * 32 + n * 16 + 4 * fq, acc[ai][bj][m][n]);
    }
    __device__ __forceinline__ void elem(int row, int col, const f32x4& v) const {
        {
            const bool smp = row >= NPR; const int sr = row - NPR, sb = sr >> 10, st = sr & 1023;
            if (col < 512) {
                f32x4 o = v; if (smp) o = do_rope(v, st, col);
                *(u32x2*)(Q + (size_t)row * 512 + col) = pk4(o);
            } else if (col < 1024) {
                const int c = col - 512;
                if (!smp) { *(f32x4*)(ock + (size_t)row * 512 + c) = v; *(u32x2*)(KP + (size_t)row * 512 + c) = pk4(v); }
                else { const f32x4 o = do_rope(v, st, c); *(u32x2*)(KS + ((size_t)sb * LKS + PAST + st) * 512 + c) = pk4(o); }
            } else if (col < 1536) {
                const int c = col - 1024, h = c >> 7, d = c & 127;
                if (!smp) { *(f32x4*)(ocv + (size_t)row * 512 + c) = v; const int b = row >> 8, t = row & 255; bf16* p = VTP + ((size_t)(b * 4 + h) * 128 + d) * SEQ + keypos(t);
#pragma unroll
                    for (int e = 0; e < 4; ++e) p[(size_t)e * SEQ] = f2bf(v[e]); }
                else { bf16* p = VTS + ((size_t)(sb * 4 + h) * 128 + d) * LKS + keypos(PAST + st);
#pragma unroll
                    for (int e = 0; e < 4; ++e) p[(size_t)e * LKS] = f2bf(v[e]); }
            } else if (col < INE) {
                *(u32x2*)(FB + (size_t)row * INB + (col - 1536)) = pk4(v);
            }
        }
    }
};


template <int CTRL> __device__ __forceinline__ float dpp_mv(float old, float src) { return __int_as_float(__builtin_amdgcn_update_dpp(__float_as_int(old), __float_as_int(src), CTRL, 0xf, 0xf, false)); }
template <int CTRL> __device__ __forceinline__ float dpp_rot(float src) { return __int_as_float(__builtin_amdgcn_mov_dpp(__float_as_int(src), CTRL, 0xf, 0xf, true)); }
__device__ __forceinline__ float silu_mul(float x, float u) { return x * __builtin_amdgcn_rcpf(1.f + __expf(-x)) * u; }
struct EpiFfnConv {
    static constexpr bool ALIGN = true;
    bf16* ACT; const float* cw; const float* cb; float* SB; LAS float* xch;
    __device__ __forceinline__ void operator()(const f32x4 (&acc)[2][2][4][2], const pg8::Unit& u, int wr, int wc, int fr, int fq) const {
        const int pm = u.pm, pn = u.pn;
        const bool smp = pm >= 32; const int sidx = pm - 32, sq = sidx & 3;
        const bool has_prev = smp && sq > 0, has_next = smp && sq < 3;
#pragma unroll
        for (int ai = 0; ai < 2; ++ai)
#pragma unroll
            for (int n = 0; n < 2; ++n) { const int c = 32 * wc + 16 * n + 4 * fq, blk = 2 * ai + wr;
                if (fr == 0) *(LAS f32x4*)(xch + (blk * 2 + 0) * 128 + c) = acc[ai][1][0][n];
                if (fr == 15) *(LAS f32x4*)(xch + (blk * 2 + 1) * 128 + c) = acc[ai][1][3][n]; }
        asm volatile("s_waitcnt lgkmcnt(0)" ::: "memory"); __builtin_amdgcn_s_barrier(); asm volatile("" ::: "memory");
#pragma unroll
        for (int n = 0; n < 2; ++n) {
            const int c = 32 * wc + 16 * n + 4 * fq, f = 128 * pn + c;
            const f32x4 c0 = *(const f32x4*)(cw + f), c1 = *(const f32x4*)(cw + DFF + f), c2 = *(const f32x4*)(cw + 2 * DFF + f), cbv = *(const f32x4*)(cb + f);
#pragma unroll
            for (int ai = 0; ai < 2; ++ai) {
                const int blk = 2 * ai + wr;
                f32x4 gabove = {0.f, 0.f, 0.f, 0.f}, gbelow = gabove;
                if (blk > 0) gabove = *(const LAS f32x4*)(xch + ((blk - 1) * 2 + 1) * 128 + c);
                if (blk < 3) gbelow = *(const LAS f32x4*)(xch + ((blk + 1) * 2 + 0) * 128 + c);
#pragma unroll
                for (int m = 0; m < 4; ++m) {
                    const f32x4 g = acc[ai][1][m][n], uu = acc[ai][0][m][n];
                    f32x4 o, xs;
#pragma unroll
                    for (int e = 0; e < 4; ++e) {
                        const float pold = m > 0 ? dpp_rot<0x121>(acc[ai][1][m - 1][n][e]) : gabove[e];
                        const float prev = dpp_mv<0x111>(pold, g[e]);
                        const float nold = m < 3 ? dpp_rot<0x12F>(acc[ai][1][m + 1][n][e]) : gbelow[e];
                        const float next = dpp_mv<0x101>(nold, g[e]);
                        const float x = c0[e] * prev + (c1[e] * g[e] + (c2[e] * next + cbv[e]));
                        xs[e] = x; o[e] = silu_mul(x, uu[e]);
                    }
                    const int r = 128 * ai + 64 * wr + 16 * m + fr;
                    *(u32x2*)(ACT + (size_t)(256 * pm + r) * DFF + f) = pk4(o);
                    if (smp) {
                        if (r == 0) { *(f32x4*)(SB + (size_t)(0 * 8 + sidx) * DFF + f) = g; if (has_prev) { *(f32x4*)(SB + (size_t)(2 * 8 + sidx) * DFF + f) = xs; *(f32x4*)(SB + (size_t)(3 * 8 + sidx) * DFF + f) = uu; } }
                        if (r == 255) { *(f32x4*)(SB + (size_t)(1 * 8 + sidx) * DFF + f) = g; if (has_next) { *(f32x4*)(SB + (size_t)(4 * 8 + sidx) * DFF + f) = xs; *(f32x4*)(SB + (size_t)(5 * 8 + sidx) * DFF + f) = uu; } }
                    }
                }
            }
        }
    }
};
template <class Sched>
__device__ __forceinline__ void ffn_seam_fixup(const Sched& S, int rows_per_unit, bf16* ACT, const float* cw, const float* SB) {
    pg8::Unit u;
    for (int i = 0; S.next(i, u); ++i) {
        const int lo = u.pm * rows_per_unit, hi = lo + rows_per_unit;
        if (hi <= NPR) continue;
        int t0 = threadIdx.x; asm volatile("" : "+v"(t0));
        for (int sidx = 0; sidx < 8; ++sidx) {
            const int sq = sidx & 3, r0 = 256 * (32 + sidx), r1 = r0 + 255;
            const bool fix0 = sq > 0 && r0 >= lo && r0 < hi, fix1 = sq < 3 && r1 >= lo && r1 < hi;
            if (!fix0 && !fix1) continue;
            for (int f = t0; f < DFF; f += 512) {
                if (fix0) { const float x = SB[(size_t)(2 * 8 + sidx) * DFF + f] + cw[f] * SB[(size_t)(1 * 8 + sidx - 1) * DFF + f]; ACT[(size_t)r0 * DFF + f] = f2bf(silu_mul(x, SB[(size_t)(3 * 8 + sidx) * DFF + f])); }
                if (fix1) { const float x = SB[(size_t)(4 * 8 + sidx) * DFF + f] + cw[2 * DFF + f] * SB[(size_t)(0 * 8 + sidx + 1) * DFF + f]; ACT[(size_t)r1 * DFF + f] = f2bf(silu_mul(x, SB[(size_t)(5 * 8 + sidx) * DFF + f])); }
            }
        }
    }
    asm volatile("s_waitcnt vmcnt(0)" ::: "memory");
    __syncthreads();
}

struct DftOrder {
    int G, c; const char* A; const char* BtS; const char* BtP;
    __device__ bool next(int i, pg8::Unit& u) const {
        const int j = i * G + c; if (j >= 160) return false;
        u.pm = 0; u.a = A;
        if (j < 32) { const int b = j >> 4, p = (j >> 2) & 3, pn = j & 3; u.pn = pn; u.z = NPR + b * 1024 + p; u.b = BtS + ((size_t)(b * 4 + p) * 1024 + pn * 256) * 512 * 2; }
        else { const int q = j - 32, b = q >> 2, pn = q & 3; u.pn = pn; u.z = b * 256; u.b = BtP + ((size_t)b * 1024 + pn * 256) * 512 * 2; }
        return true;
    }
};
struct EpiDft {
    bf16* O;
    static constexpr bool ALIGN = false;
    __device__ __forceinline__ void operator()(const f32x4 (&acc)[2][2][4][2], const pg8::Unit& u, int wr, int wc, int fr, int fq) const {
        const int st = u.z >= NPR ? 4 : 1;
        pg8::epi_each(acc, wr * 64 + fr, u.pn * 256 + wc * 32 + 4 * fq, [&](int r, int col, const f32x4& v) { *(u32x2*)(O + (size_t)(u.z + st * r) * 1024 + col) = pk4(v); });
    }
};

__device__ __forceinline__ f32x16 mfma32(bf16x8 x, bf16x8 y, f32x16 c) { return __builtin_amdgcn_mfma_f32_32x32x16_bf16(x, y, c, 0, 0, 0); }
__device__ __forceinline__ void phase_attention(const Args& a, LAS unsigned char* lds, int bid, int G) {
    int tid = threadIdx.x; asm volatile("" : "+v"(tid));
    const int lane = tid & 63, wave = __builtin_amdgcn_readfirstlane(tid >> 6), tk = lane & 31, hh = lane >> 5;
    const float cs = 0.125f * 1.4426950408889634f;
    const bf16* Q = WSB(WS_Q);
    bf16* AB = WSB(WS_XN);
    const float* subln = FIN(I_SUBLN);
    constexpr int KST = 136, VST = 40;
    LAS bf16* Kl = (LAS bf16*)lds;
    LAS bf16* Vl = (LAS bf16*)(lds + 2 * 32 * KST * 2);
    LAS bf16* Ql = (LAS bf16*)(lds + 40960 + wave * 8192);
    const int lkey = tid >> 4, lkc = tid & 15, lvd = tid >> 2, lvc = tid & 3;
    for (int ai = 0; ai < 2; ++ai) {
        int item;
        if (G == 256) {
            if (bid >= 224) item = ai == 0 ? bid - 224 : -1;
            else if (bid >= 160) item = 32 + 2 * (bid - 160) + ai;
            else item = -1;
        } else item = bid + ai * G;
        if (item < 0 || item >= 160) continue;
        int b, h, nkeys, qrow0; const bf16 *Kb, *VT;
        if (item < 32) { b = item >> 4; h = (item >> 2) & 3; const int qb = item & 3; nkeys = LKS; qrow0 = NPR + b * 1024 + qb * 256 + wave * 32; Kb = WSB(WS_KS) + (size_t)b * LKS * 512; VT = WSB(WS_VTS) + (size_t)(b * 4 + h) * 128 * LKS; }
        else { const int j = item - 32; b = j >> 2; h = j & 3; nkeys = SEQ; qrow0 = b * 256 + wave * 32; Kb = WSB(WS_KP) + (size_t)b * 256 * 512; VT = WSB(WS_VTP) + (size_t)(b * 4 + h) * 128 * SEQ; }
        f32x16 O[2][4];
#pragma unroll
        for (int m = 0; m < 2; ++m)
#pragma unroll
            for (int mt = 0; mt < 4; ++mt)
#pragma unroll
                for (int r = 0; r < 16; ++r) O[m][mt][r] = 0.f;
        float mx[2] = {-1e30f, -1e30f}, ls[2] = {0.f, 0.f};
        const bf16* kg = Kb + (size_t)lkey * 512 + h * 128 + lkc * 8;
        const bf16* vg = VT + (size_t)lvd * nkeys + lvc * 8;
        __syncthreads();
#pragma unroll
        for (int m = 0; m < 2; ++m)
#pragma unroll
            for (int s = 0; s < 4; ++s) *(LAS bf16x8*)(Ql + ((m * 4 + s) * 64 + lane) * 8) = *(const bf16x8*)(Q + (size_t)(qrow0 + tk) * 512 + h * 128 + m * 64 + 16 * s + 8 * hh);
        { const u32x4 k0v = *(const u32x4*)kg, v0v = *(const u32x4*)vg;
          *(LAS u32x4*)(Kl + lkey * KST + lkc * 8) = k0v; *(LAS u32x4*)(Vl + lvd * VST + lvc * 8) = v0v; }
        const int nt = nkeys / 32;
        for (int t = 0; t < nt; ++t) {
            const int cur = t & 1;
            const bool more = t + 1 < nt;
            u32x4 kn = {0u, 0u, 0u, 0u}, vn = kn;
            if (more) { kn = *(const u32x4*)(kg + (size_t)(t + 1) * 32 * 512); vn = *(const u32x4*)(vg + (t + 1) * 32); }
            __syncthreads();
            const LAS bf16* Kc = Kl + cur * 32 * KST + tk * KST + 8 * hh;
            const LAS bf16* Vc = Vl + cur * 128 * VST + tk * VST + 8 * hh;
            bf16x8 pb[2][2];
#pragma unroll
            for (int m = 0; m < 2; ++m) {
                f32x16 S;
#pragma unroll
                for (int r = 0; r < 16; ++r) S[r] = 0.f;
#pragma unroll
                for (int s = 0; s < 4; ++s) { const bf16x8 kf = *(const LAS bf16x8*)(Kc + m * 64 + 16 * s); const bf16x8 qfr = *(const LAS bf16x8*)(Ql + ((m * 4 + s) * 64 + lane) * 8); S = mfma32(kf, qfr, S); }
                float tm = S[0];
#pragma unroll
                for (int r = 1; r < 16; ++r) tm = fmaxf(tm, S[r]);
                tm = fmaxf(tm, __shfl_xor(tm, 32));
                if (__any(tm > mx[m] + 44.0f)) {
                    const float mn = fmaxf(mx[m], tm), alpha = __builtin_amdgcn_exp2f((mx[m] - mn) * cs); mx[m] = mn;
                    ls[m] *= alpha;
#pragma unroll
                    for (int mt = 0; mt < 4; ++mt)
#pragma unroll
                        for (int r = 0; r < 16; ++r) O[m][mt][r] *= alpha;
                }
                const float mcur = mx[m];
                float ps = 0.f;
#pragma unroll
                for (int r = 0; r < 16; ++r) { S[r] = __builtin_amdgcn_exp2f((S[r] - mcur) * cs); ps += S[r]; }
                ls[m] += ps;
#pragma unroll
                for (int s2 = 0; s2 < 2; ++s2) { u32x4 w; w.x = pk2(S[8 * s2 + 0], S[8 * s2 + 1]); w.y = pk2(S[8 * s2 + 2], S[8 * s2 + 3]); w.z = pk2(S[8 * s2 + 4], S[8 * s2 + 5]); w.w = pk2(S[8 * s2 + 6], S[8 * s2 + 7]); pb[m][s2] = __builtin_bit_cast(bf16x8, w); }
            }
#pragma unroll
            for (int mt = 0; mt < 4; ++mt) {
#pragma unroll
                for (int s2 = 0; s2 < 2; ++s2) { const bf16x8 vf = *(const LAS bf16x8*)(Vc + 32 * mt * VST + 16 * s2);
                    O[0][mt] = mfma32(vf, pb[0][s2], O[0][mt]); O[1][mt] = mfma32(vf, pb[1][s2], O[1][mt]); }
            }
            if (more) { *(LAS u32x4*)(Kl + (cur ^ 1) * 32 * KST + lkey * KST + lkc * 8) = kn; *(LAS u32x4*)(Vl + (cur ^ 1) * 128 * VST + lvd * VST + lvc * 8) = vn; }
        }
        const float l0 = ls[0] + __shfl_xor(ls[0], 32), l1 = ls[1] + __shfl_xor(ls[1], 32);
        const float lam = WSF(WS_LAM)[0];
        const float i0 = 1.f / l0, i1 = lam / l1;
        float ss = 0.f;
#pragma unroll
        for (int mt = 0; mt < 4; ++mt)
#pragma unroll
            for (int r = 0; r < 16; ++r) { const float o = O[0][mt][r] * i0 - O[1][mt][r] * i1; O[0][mt][r] = o; ss += o * o; }
        ss += __shfl_xor(ss, 32);
        const float rinv = rsqrtf(ss * (1.f / 128.f) + 1e-6f) * 0.8f;
        bf16* dst = AB + (size_t)(qrow0 + tk) * 1024 + h * 128;
#pragma unroll
        for (int mt = 0; mt < 4; ++mt)
#pragma unroll
            for (int rq = 0; rq < 4; ++rq) { const int d = 32 * mt + 8 * rq + 4 * hh; const f32x4 g = *(const f32x4*)(subln + d);
                f32x4 o; o[0] = O[0][mt][4 * rq + 0] * rinv * g[0]; o[1] = O[0][mt][4 * rq + 1] * rinv * g[1]; o[2] = O[0][mt][4 * rq + 2] * rinv * g[2]; o[3] = O[0][mt][4 * rq + 3] * rinv * g[3];
                *(u32x2*)(dst + d) = pk4(o); }
    }
}

__device__ __forceinline__ float allred4(float x) {
    { auto r = __builtin_amdgcn_permlane16_swap(__float_as_uint(x), __float_as_uint(x), false, false); x = __uint_as_float(r[0]) + __uint_as_float(r[1]); }
    { auto r = __builtin_amdgcn_permlane32_swap(__float_as_uint(x), __float_as_uint(x), false, false); x = __uint_as_float(r[0]) + __uint_as_float(r[1]); }
    return x;
}

constexpr int OPS_KGRG = 0, OPS_KDBD = 4096, OPS_CINIT = 8192, OPS_VIMG = 12288, OPS_GAM = 14336, OPS_ITEM = 14592;
constexpr size_t WS_OPS = WS_MF;
static_assert(WS_OPS + (size_t)2 * 5120 * OPS_ITEM <= WS_Q, "ws ops");
__device__ __forceinline__ f32x4 mfma16(bf16x8 x, bf16x8 y, f32x4 c) { return __builtin_amdgcn_mfma_f32_16x16x32_bf16(x, y, c, 0, 0, 0); }
__device__ __forceinline__ bf16x8 frag_lo(f32x4 v) { u32x4 w; w.x = pk2(v[0], v[1]); w.y = pk2(v[2], v[3]); w.z = 0u; w.w = 0u; return __builtin_bit_cast(bf16x8, w); }
__device__ __forceinline__ void wave_lds_sync() { __syncthreads(); }


template <bool REV>
__device__ __forceinline__ void wkv_chunk_ops(unsigned char* ops, LAS unsigned char* wl, int lane, const float (&kkn)[16], const float (&wv)[16], const float (&kraw)[16], const float (&ad)[16], const float ka_, const float (&rr)[16], const unsigned (&vp)[8]) {
    int lane_ = lane; asm volatile("" : "+v"(lane_));
    const int lr = lane_ & 15, lg = lane_ >> 4, j = lane_;
    LAS bf16* KgR = (LAS bf16*)wl; LAS bf16* RgR = KgR + 16 * 72; LAS bf16* KiR = RgR + 16 * 72; LAS bf16* BiR = KiR + 16 * 72;
    LAS bf16* KgT = (LAS bf16*)(wl + 9216); LAS float* RgT = (LAS float*)(wl + 9216 + 2048); LAS bf16* VT = (LAS bf16*)(wl + 9216 + 2048 + 5120);
    LAS float* NL = (LAS float*)wl; LAS float* TL = (LAS float*)(wl + 2304);
    float gall = 1.f;
#pragma unroll
    for (int t = 0; t < 16; ++t) gall *= wv[t];
    *(float*)(ops + OPS_GAM + 4 * j) = gall;
    float grun = 1.f;
#pragma unroll
    for (int g = 0; g < 4; ++g) {
        float kdv[4], bdv[4]; unsigned vb4[4];
#pragma unroll
        for (int e = 0; e < 4; ++e) {
            const int tau = 4 * g + e, t = REV ? 15 - tau : tau;
            const float gprev = grun; grun *= wv[t];
            const float inv = __builtin_amdgcn_rcpf(grun);
            const float kg = kkn[t] * gprev, rg = rr[t] * grun, ki = kraw[t] * (1.f + (ad[t] - 1.f) * ka_) * inv, bi = kkn[t] * ad[t] * inv;
            kdv[e] = ki * gall; bdv[e] = -bi * gall; vb4[e] = (vp[t >> 1] >> (16 * (t & 1))) & 0xffffu;
            KgR[tau * 72 + j] = f2bf(kg); RgR[tau * 72 + j] = f2bf(rg); KiR[tau * 72 + j] = f2bf(ki); BiR[tau * 72 + j] = f2bf(bi);
            KgT[(g * 64 + j) * 4 + e] = f2bf(kg); RgT[j * 20 + tau] = rg; VT[(g * 64 + j) * 4 + e] = (bf16)vb4[e];
        }
        u32x4 w; w.x = pk2(kdv[0], kdv[1]); w.y = pk2(kdv[2], kdv[3]); w.z = pk2(bdv[0], bdv[1]); w.w = pk2(bdv[2], bdv[3]);
        *(u32x4*)(ops + OPS_KDBD + (((j >> 4) * 64 + (j & 15) + 16 * g) * 16)) = w;
        u32x2 vw; vw.x = vb4[0] | (vb4[1] << 16); vw.y = vb4[2] | (vb4[3] << 16);
        *(u32x2*)(ops + OPS_VIMG + (((j >> 4) * 64 + (j & 15) + 16 * g) * 8)) = vw;
    }
    wave_lds_sync();
    f32x4 akk = {0.f, 0.f, 0.f, 0.f}, akb = akk, ark = akk, arb = akk;
#pragma unroll
    for (int ks = 0; ks < 2; ++ks) {
        const bf16x8 fki = *(const LAS bf16x8*)(KiR + lr * 72 + 32 * ks + 8 * lg), fbi = *(const LAS bf16x8*)(BiR + lr * 72 + 32 * ks + 8 * lg);
        const bf16x8 fkg = *(const LAS bf16x8*)(KgR + lr * 72 + 32 * ks + 8 * lg), frg = *(const LAS bf16x8*)(RgR + lr * 72 + 32 * ks + 8 * lg);
        akk = mfma16(fki, fkg, akk); akb = mfma16(fbi, fkg, akb); ark = mfma16(fki, frg, ark); arb = mfma16(fbi, frg, arb);
    }
#pragma unroll
    for (int e = 0; e < 4; ++e) { const int s = 4 * lg + e; if (!(s < lr)) { akk[e] = 0.f; akb[e] = 0.f; } if (!(s <= lr)) { ark[e] = 0.f; arb[e] = 0.f; } }
    asm volatile("" : "+v"(akk), "+v"(akb), "+v"(ark), "+v"(arb));
    wave_lds_sync();
    *(LAS f32x4*)(NL + lr * 16 + 4 * lg) = akb;
    wave_lds_sync();
    {
        float Tc[16];
#pragma unroll
        for (int t = 0; t < 16; ++t) {
            float acc = (t == lr) ? 1.f : 0.f;
#pragma unroll
            for (int q4 = 0; q4 < (t + 3) / 4; ++q4) { const f32x4 nv = *(const LAS f32x4*)(NL + t * 16 + 4 * q4);
#pragma unroll
                for (int e = 0; e < 4; ++e) if (4 * q4 + e < t) acc -= nv[e] * Tc[4 * q4 + e]; }
            Tc[t] = acc;
        }
        if (lg == 0) {
#pragma unroll
            for (int t = 0; t < 16; ++t) TL[t * 16 + lr] = Tc[t];
        }
    }
    wave_lds_sync();
    const bf16x8 aT = frag_lo(*(const LAS f32x4*)(TL + lr * 16 + 4 * lg));
    const bf16x8 aKK = frag_lo(akk), aRK = frag_lo(ark), aRBn = frag_lo(-arb);
    const f32x4 z4 = {0.f, 0.f, 0.f, 0.f};
#pragma unroll
    for (int it = 0; it < 4; ++it) {
        const u32x2 vq = *(const LAS u32x2*)(VT + (lg * 64 + 16 * it + lr) * 4);
        const bf16x8 bV = __builtin_bit_cast(bf16x8, (u32x4){vq.x, vq.y, 0u, 0u});
        const f32x4 x1 = mfma16(aKK, bV, z4);
        const f32x4 vd = mfma16(aT, frag_lo(x1), z4);
        f32x4 yl = mfma16(aRK, bV, z4); yl = mfma16(aRBn, frag_lo(vd), yl);
        *(u32x2*)(ops + OPS_CINIT + ((0 * 4 + it) * 64 + lane) * 8) = pk4(vd);
        *(u32x2*)(ops + OPS_CINIT + ((1 * 4 + it) * 64 + lane) * 8) = pk4(yl);
    }
#pragma unroll
    for (int jt = 0; jt < 4; ++jt) {
        const u32x2 kq = *(const LAS u32x2*)(KgT + (lg * 64 + 16 * jt + lr) * 4);
        const bf16x8 bK = __builtin_bit_cast(bf16x8, (u32x4){kq.x, kq.y, 0u, 0u});
        const f32x4 kgp = mfma16(aT, bK, z4);
        const f32x4 rgp = mfma16(aRBn, frag_lo(kgp), *(const LAS f32x4*)(RgT + (16 * jt + lr) * 20 + 4 * lg));
        bf16* img = (bf16*)(ops + OPS_KGRG);
#pragma unroll
        for (int e = 0; e < 4; ++e) { const int t = 4 * lg + e; const int off = (((jt >> 1)) * 64 + t + 16 * (lr >> 2)) * 8 + 4 * (jt & 1) + (lr & 3);
            img[off] = f2bf(kgp[e]); img[2 * 64 * 8 + off] = f2bf(rgp[e]); }
    }
    wave_lds_sync();
}

__device__ __forceinline__ void phase_wkv_front(const Args& a, LAS unsigned char* lds, int bid, int G) {
    int tid = threadIdx.x; asm volatile("" : "+v"(tid));
    const int lane = tid & 63, wave = __builtin_amdgcn_readfirstlane(tid >> 6);
    constexpr int AST = 392;
    typedef const __attribute__((address_space(1))) bf16* gcb;
    const bf16* FB = (const bf16*)a.out;
    LAS bf16* act = (LAS bf16*)(lds + ACT_OFF);
    LAS unsigned char* wl = lds + wave * 18432;
    LAS float* TR = (LAS float*)wl;
    const float* mu = FIN(I_MU); const float* kvec = FIN(I_KVEC); const float* w0 = FIN(I_W0); const float* a0 = FIN(I_A0);
    bf16* AB = WSB(WS_XN); bf16* BON = WSB(WS_BONUS);
    int it_lo, it_n;
    if (G == 256) { if (bid < 160) { it_lo = 3 * bid; it_n = 3; } else if (bid < 224) { it_lo = 480 + 2 * (bid - 160); it_n = 2; } else { it_lo = 608 + (bid - 224); it_n = 1; } }
    else { it_lo = bid; it_n = (640 - bid + G - 1) / G; }
    for (int ii = 0; ii < it_n; ++ii) {
        const int item = (G == 256) ? it_lo + ii : it_lo + ii * G;
        int smp, sq, c, L, rowbase, nc;
        if (item < 128) { smp = 1; sq = item >> 6; c = item & 63; L = DSEQ; rowbase = NPR + sq * DSEQ; nc = 64; }
        else { const int p = item - 128; smp = 0; sq = p >> 4; c = p & 15; L = SEQ; rowbase = sq * SEQ; nc = 16; }
        const int row0 = rowbase + 16 * c, tp0 = 16 * c;
        __syncthreads();
        int tq = tid; asm volatile("" : "+v"(tq));
        for (int idx = tq; idx < 16 * 96; idx += 512) {
            const int tl = idx / 96, cg = idx - tl * 96, col = 1536 + 4 * cg, row = row0 + tl, tp = tp0 + tl;
            const f32x4 f = unpk4(*(const u32x2*)(FB + (size_t)row * INB + col));
            const f32x4 p = unpk4(*(const u32x2*)(FB + (size_t)(tp > 0 ? row - 1 : row) * INB + col)) * (tp > 0 ? 1.f : 0.f);
            const f32x4 n = unpk4(*(const u32x2*)(FB + (size_t)(tp < L - 1 ? row + 1 : row) * INB + col)) * (tp < L - 1 ? 1.f : 0.f);
            const f32x4 m0 = *(const f32x4*)(mu + col), m1 = *(const f32x4*)(mu + INB + col);
            f32x4 s = f + m0 * (p - f) + m1 * (n - f);
            const int kind = cg >> 5;
            if (kind == 0) { s[0] = tanhf(s[0]); s[1] = tanhf(s[1]); s[2] = tanhf(s[2]); s[3] = tanhf(s[3]); }
            else if (kind == 2) { s[0] = sigmoidf_(s[0]); s[1] = sigmoidf_(s[1]); s[2] = sigmoidf_(s[2]); s[3] = sigmoidf_(s[3]); }
            *(LAS u32x2*)(act + tl * AST + 4 * cg) = pk4(s);
        }
        __syncthreads();
        int j = lane; asm volatile("" : "+v"(j));
        const int lr = j & 15, lg = j >> 4;
        const int h = wave, col = h * 64 + j;
        auto lora_mma = [&](const bf16* WT, int ldk, int k0, int nks, f32x4 (&acc)[4]) {
            gcb wb = (gcb)(WT + (size_t)(h * 64 + lr) * ldk + 8 * lg);
            const LAS bf16* ab = act + lr * AST + k0 + 8 * lg;
            asm volatile("" : "+v"(wb), "+v"(ab));
#pragma unroll
            for (int jt = 0; jt < 4; ++jt) acc[jt] = (f32x4){0.f, 0.f, 0.f, 0.f};
            for (int ks = 0; ks < nks; ++ks) {
                const bf16x8 fa = *(const LAS bf16x8*)(ab + 32 * ks);
#pragma unroll
                for (int jt = 0; jt < 4; ++jt) { const bf16x8 fb = *(const __attribute__((address_space(1))) bf16x8*)(wb + (size_t)(16 * jt) * ldk + 32 * ks); acc[jt] = mfma16(fa, fb, acc[jt]); }
            }
        };
        auto tr_put = [&](int b, const f32x4 (&acc)[4]) {
#pragma unroll
            for (int jt = 0; jt < 4; ++jt) *(LAS f32x4*)(TR + b * 1280 + (16 * jt + lr) * 20 + 4 * lg) = acc[jt];
        };
        auto tr_get = [&](int b, float (&out)[16]) {
#pragma unroll
            for (int q = 0; q < 4; ++q) { const f32x4 x = *(const LAS f32x4*)(TR + b * 1280 + j * 20 + 4 * q); out[4 * q] = x[0]; out[4 * q + 1] = x[1]; out[4 * q + 2] = x[2]; out[4 * q + 3] = x[3]; }
        };
        f32x4 accG[4], accA0[4], accA1[4], accW0[4];
        lora_mma(WSB(WS_G2T), 128, 256, 4, accG);
        lora_mma(WSB(WS_A2T), 64, 128, 2, accA0);
        lora_mma(WSB(WS_A2T) + 512 * 64, 64, 192, 2, accA1);
        lora_mma(WSB(WS_W2T), 64, 0, 2, accW0);
        float r[16], k[16]; unsigned vp[8];
        {
            unsigned raw[3][18]; float v[16];
#pragma unroll
            for (int x = 0; x < 3; ++x)
#pragma unroll
                for (int q = 0; q < 18; ++q) { const int tp = tp0 - 1 + q; const int rw = row0 - 1 + q + (tp < 0 ? 1 : 0) - (tp > L - 1 ? 1 : 0); raw[x][q] = FB[(size_t)rw * INB + 512 * x + col]; }
            const float pm = tp0 > 0 ? 1.f : 0.f, nm = tp0 + 16 < L ? 1.f : 0.f;
            const float mr0 = mu[col], mr1 = mu[INB + col], mk0 = mu[512 + col], mk1 = mu[INB + 512 + col], mv0 = mu[1024 + col], mv1 = mu[INB + 1024 + col];
#pragma unroll
            for (int t = 0; t < 16; ++t) {
                const float pmask = t == 0 ? pm : 1.f, nmask = t == 15 ? nm : 1.f;
                { const float f = bf2f(raw[0][t + 1]), p = bf2f(raw[0][t]) * pmask, n = bf2f(raw[0][t + 2]) * nmask; r[t] = f + mr0 * (p - f) + mr1 * (n - f); }
                { const float f = bf2f(raw[1][t + 1]), p = bf2f(raw[1][t]) * pmask, n = bf2f(raw[1][t + 2]) * nmask; k[t] = f + mk0 * (p - f) + mk1 * (n - f); }
                { const float f = bf2f(raw[2][t + 1]), p = bf2f(raw[2][t]) * pmask, n = bf2f(raw[2][t + 2]) * nmask; v[t] = f + mv0 * (p - f) + mv1 * (n - f); }
            }
#pragma unroll
            for (int q = 0; q < 8; ++q) vp[q] = pk2(v[2 * q], v[2 * q + 1]);
        }
        float av0[16], av1[16];
        {
            float graw[16];
            tr_put(0, accG); tr_put(1, accA0); tr_put(2, accA1);
            wave_lds_sync();
            tr_get(0, graw); tr_get(1, av0); tr_get(2, av1);
            wave_lds_sync();
#pragma unroll
            for (int t = 0; t < 16; ++t) AB[(size_t)(row0 + t) * 1024 + 512 + col] = f2bf(graw[t]);
        }
        float wv0[16];
        {
            tr_put(0, accW0);
            wave_lds_sync();
            tr_get(0, wv0);
            wave_lds_sync();
            const float w00 = w0[col];
#pragma unroll
            for (int t = 0; t < 16; ++t) wv0[t] = __expf(-0.60653065971f * sigmoidf_(w00 + wv0[t]));
        }
        const float kk_ = kvec[col], ka_ = kvec[512 + col], rk_ = kvec[1024 + col], a00 = a0[col], a01 = a0[512 + col];
        float kkn[16];
        {
            LAS float* RED1 = (LAS float*)wl; LAS float* RED2 = RED1 + 64 * 17; LAS float* TOT = RED2 + 64 * 17;
#pragma unroll
            for (int t = 0; t < 16; ++t) {
                av0[t] = sigmoidf_(a00 + av0[t]); av1[t] = sigmoidf_(a01 + av1[t]);
                const float kr = k[t] * kk_; kkn[t] = kr;
                RED1[j * 17 + t] = kr * kr; RED2[j * 17 + t] = r[t] * rk_ * k[t] * (2.f + (av0[t] + av1[t] - 2.f) * ka_);
            }
            wave_lds_sync();
            float s1 = 0.f, s2 = 0.f;
#pragma unroll
            for (int jj = 0; jj < 16; ++jj) { s1 += RED1[(16 * lg + jj) * 17 + lr]; s2 += RED2[(16 * lg + jj) * 17 + lr]; }
            s1 = allred4(s1); s2 = allred4(s2);
            if (lg == 0) { TOT[lr] = rsqrtf(s1 + 1e-12f); TOT[16 + lr] = s2; }
            wave_lds_sync();
#pragma unroll
            for (int q = 0; q < 4; ++q) { const f32x4 ri = *(const LAS f32x4*)(TOT + 4 * q), rs = *(const LAS f32x4*)(TOT + 16 + 4 * q);
#pragma unroll
                for (int e = 0; e < 4; ++e) { const int t = 4 * q + e; kkn[t] *= ri[e]; BON[(size_t)(row0 + t) * 512 + col] = f2bf(rs[e] * __uint_as_float((t & 1) ? (vp[t >> 1] & 0xffff0000u) : (vp[t >> 1] << 16))); } }
            wave_lds_sync();
        }
        {
            const int oi = smp ? 4096 + (sq * 8 + h) * 64 + c : (sq * 8 + h) * 16 + c;
            wkv_chunk_ops<false>(a.ws + WS_OPS + (size_t)oi * OPS_ITEM, wl, lane, kkn, wv0, k, av0, ka_, r, vp);
        }
        {
            float wv1[16];
            { f32x4 accW1[4]; lora_mma(WSB(WS_W2T) + 512 * 64, 64, 64, 2, accW1); tr_put(0, accW1); wave_lds_sync(); tr_get(0, wv1); wave_lds_sync();
              const float w01 = w0[512 + col];
#pragma unroll
              for (int t = 0; t < 16; ++t) wv1[t] = __expf(-0.60653065971f * sigmoidf_(w01 + wv1[t])); }
            const int cc = nc - 1 - c;
            const int oi = 5120 + (smp ? 4096 + (sq * 8 + h) * 64 + cc : (sq * 8 + h) * 16 + cc);
            wkv_chunk_ops<true>(a.ws + WS_OPS + (size_t)oi * OPS_ITEM, wl, lane, kkn, wv1, k, av1, ka_, r, vp);
        }
    }
}

struct ChainOps { bf16x8 kgrg[2][2]; u32x2 cinit[2]; bf16x8 kdbd[4]; u32x2 vimg; f32x4 gam[4]; };
__device__ __forceinline__ void chain_load(ChainOps& o, const unsigned char* ops, int lane, int it) {
    const int lg = lane >> 4;
#pragma unroll
    for (int rt = 0; rt < 2; ++rt) {
#pragma unroll
        for (int ks = 0; ks < 2; ++ks) o.kgrg[rt][ks] = *(const bf16x8*)(ops + OPS_KGRG + ((rt * 2 + ks) * 64 + lane) * 16);
        o.cinit[rt] = *(const u32x2*)(ops + OPS_CINIT + ((rt * 4 + it) * 64 + lane) * 8);
    }
#pragma unroll
    for (int jt = 0; jt < 4; ++jt) { o.kdbd[jt] = *(const bf16x8*)(ops + OPS_KDBD + (jt * 64 + lane) * 16); o.gam[jt] = *(const f32x4*)(ops + OPS_GAM + (16 * jt + 4 * lg) * 4); }
    o.vimg = *(const u32x2*)(ops + OPS_VIMG + (it * 64 + lane) * 8);
}
__device__ __forceinline__ void wkv_sample_wave(const Args& a, LAS float* ybuf, int idx, int lane) {
    const int lr = lane & 15, lg = lane >> 4;
    const int dir = idx >> 6, ch = (idx >> 2) & 15, it = idx & 3;
    const int b = ch >> 3, h = ch & 7, nc = 64, L = DSEQ, rowbase = NPR + b * DSEQ, opsbase = 4096 + ch * 64;
    float* Y = a.out;
    f32x4 H[4];
    { const float* sp = FIN(I_ST) + (size_t)((b * 2 + dir) * 8 + h) * 4096;
#pragma unroll
      for (int jt = 0; jt < 4; ++jt) H[jt] = *(const f32x4*)(sp + (16 * it + lr) * 64 + 16 * jt + 4 * lg); }
    const unsigned char* opsp = a.ws + WS_OPS + (size_t)(dir * 5120 + opsbase) * OPS_ITEM;
    float* yg = Y + ((size_t)dir * NT + rowbase) * 512 + h * 64 + 16 * it + 4 * (lane & 3);
    ChainOps o0, o1;
    chain_load(o0, opsp, lane, it);
    chain_load(o1, opsp + OPS_ITEM, lane, it);
    auto step = [&](const ChainOps& cur, int c) {
        bf16x8 bh[2];
#pragma unroll
        for (int ks = 0; ks < 2; ++ks) { const u32x2 p0 = pk4(H[2 * ks]), p1 = pk4(H[2 * ks + 1]); bh[ks] = __builtin_bit_cast(bf16x8, (u32x4){p0.x, p0.y, p1.x, p1.y}); }
        f32x4 u = unpk4(cur.cinit[0]), y = unpk4(cur.cinit[1]);
#pragma unroll
        for (int ks = 0; ks < 2; ++ks) { u = mfma16(cur.kgrg[0][ks], bh[ks], u); y = mfma16(cur.kgrg[1][ks], bh[ks], y); }
#pragma unroll
        for (int e = 0; e < 4; ++e) ybuf[(16 * (c & 15) + 4 * lg + e) * 16 + lr] = y[e];
        const u32x2 up = pk4(u);
        const bf16x8 bvu = __builtin_bit_cast(bf16x8, (u32x4){cur.vimg.x, cur.vimg.y, up.x, up.y});
#pragma unroll
        for (int jt = 0; jt < 4; ++jt) H[jt] = mfma16(cur.kdbd[jt], bvu, H[jt] * cur.gam[jt]);
    };
    auto flush = [&](int c) {
        if ((c & 15) == 15) {
            asm volatile("s_waitcnt lgkmcnt(0)" ::: "memory");
            const int base = 256 * (c >> 4);
#pragma unroll 1
            for (int r0 = 0; r0 < 256; r0 += 16) { const int lt = base + r0 + (lane >> 2);
                *(f32x4*)(yg + (size_t)(dir ? L - 1 - lt : lt) * 512) = *(const LAS f32x4*)(ybuf + (r0 + (lane >> 2)) * 16 + 4 * (lane & 3)); }
            asm volatile("s_waitcnt lgkmcnt(0)" ::: "memory");
        }
    };
    ChainOps o2; chain_load(o2, opsp + 2 * OPS_ITEM, lane, it);
    int c = 0;
#pragma unroll 1
    for (; c + 2 < nc; c += 3) {
        step(o0, c); chain_load(o0, opsp + (size_t)(c + 3 < nc ? c + 3 : nc - 1) * OPS_ITEM, lane, it); flush(c);
        step(o1, c + 1); chain_load(o1, opsp + (size_t)(c + 4 < nc ? c + 4 : nc - 1) * OPS_ITEM, lane, it); flush(c + 1);
        step(o2, c + 2); chain_load(o2, opsp + (size_t)(c + 5 < nc ? c + 5 : nc - 1) * OPS_ITEM, lane, it); flush(c + 2);
    }
    for (; c < nc; ++c) { step(o0, c); flush(c); }
    asm volatile("s_waitcnt vmcnt(0) lgkmcnt(0)" ::: "memory");
}

struct ChainSh { bf16x8 kg, kd; float gm; };
struct ChainPr { u32x2 ci0, ci1, vi; };
__device__ __forceinline__ void chain_sh(ChainSh& o, const unsigned char* ops, int lane, int it) {
    o.kg = *(const bf16x8*)(ops + OPS_KGRG + (it * 64 + lane) * 16);
    o.kd = *(const bf16x8*)(ops + OPS_KDBD + (it * 64 + lane) * 16);
    o.gm = *(const float*)(ops + OPS_GAM + (16 * it + (lane & 15)) * 4);
}
__device__ __forceinline__ void chain_pr(ChainPr& o, const unsigned char* ops, int lane, int it) {
    o.ci0 = *(const u32x2*)(ops + OPS_CINIT + ((0 * 4 + it) * 64 + lane) * 8);
    o.ci1 = *(const u32x2*)(ops + OPS_CINIT + ((1 * 4 + it) * 64 + lane) * 8);
    o.vi = *(const u32x2*)(ops + OPS_VIMG + (it * 64 + lane) * 8);
}
template <bool DRY = false>
__device__ __forceinline__ void phase_wkv_chain(const Args& a, LAS unsigned char* lds, int bid, int G) {
    int tid = threadIdx.x; asm volatile("" : "+v"(tid));
    const int lane = tid & 63, wave = __builtin_amdgcn_readfirstlane(tid >> 6);
    const int lr = lane & 15, lg = lane >> 4;
    float* Y = a.out;
    LAS float* ybuf = (LAS float*)(lds + wave * 16384);
    const int dir = wave >> 2, it = wave & 3;
    LAS unsigned char* slot = lds + 131072 + dir * 8448;
    const bf16* BON = WSB(WS_BONUS); bf16* AB = WSB(WS_XN);
    const float* lnx = FIN(I_LNX);
    if (G == 256 && bid < 128) {
        if (wave == 0) wkv_sample_wave(a, (LAS float*)lds, bid, lane);
        return;
    }
#pragma unroll 1
    for (int jrep = 0; ; ++jrep) {
        int k;
        if (G == 256) { if (jrep < 2) k = 16 + 2 * (bid - 128) + jrep; else break; }
        else { k = bid + jrep * G; if (k >= 272) break; }
        int smp, b, h, nc, L, rowbase, opsbase;
        if (k < 16) { smp = 1; b = k >> 3; h = k & 7; nc = 64; L = DSEQ; rowbase = NPR + b * DSEQ; opsbase = 4096 + k * 64; }
        else { const int p = k - 16; smp = 0; b = p >> 3; h = p & 7; nc = 16; L = SEQ; rowbase = b * SEQ; opsbase = p * 16; }
        f32x4 H[4];
        if (smp) {
            const float* sp = FIN(I_ST) + (size_t)((b * 2 + dir) * 8 + h) * 4096;
#pragma unroll
            for (int jt = 0; jt < 4; ++jt) H[jt] = *(const f32x4*)(sp + (16 * it + lr) * 64 + 16 * jt + 4 * lg);
        } else {
#pragma unroll
            for (int jt = 0; jt < 4; ++jt) H[jt] = (f32x4){0.f, 0.f, 0.f, 0.f};
        }
        const unsigned char* opsp = a.ws + WS_OPS + (size_t)(dir * 5120 + opsbase) * OPS_ITEM;
        float* yg = Y + ((size_t)dir * NT + rowbase) * 512 + h * 64 + 16 * it + 4 * (lane & 3);
        constexpr int D = 8;
        ChainSh sh[D]; ChainPr pr[D];
#pragma unroll
        for (int i = 0; i < D; ++i) { chain_sh(sh[i], opsp + (size_t)i * OPS_ITEM, lane, it); chain_pr(pr[i], opsp + (size_t)i * OPS_ITEM, lane, it); }
        auto put = [&](const ChainSh& o) {
            *(LAS bf16x8*)(slot + it * 1024 + lane * 16) = o.kg; *(LAS bf16x8*)(slot + 4096 + it * 1024 + lane * 16) = o.kd;
            if (lane < 16) *(LAS float*)(slot + 8192 + (16 * it + lane) * 4) = o.gm; };
        put(sh[0]);
        chain_sh(sh[0], opsp + (size_t)(D < nc ? D : nc - 1) * OPS_ITEM, lane, it);
        asm volatile("s_waitcnt lgkmcnt(0)" ::: "memory"); __builtin_amdgcn_s_barrier(); asm volatile("" ::: "memory");
#pragma unroll 1
        for (int c = 0; c < nc; c += D) {
#pragma unroll
            for (int i = 0; i < D; ++i) {
                const int cc = c + i;
                bf16x8 kgrg[2][2], kdbd[4]; f32x4 gam[4];
#pragma unroll
                for (int q = 0; q < 4; ++q) { kgrg[q >> 1][q & 1] = *(const LAS bf16x8*)(slot + q * 1024 + lane * 16); kdbd[q] = *(const LAS bf16x8*)(slot + 4096 + q * 1024 + lane * 16); gam[q] = *(const LAS f32x4*)(slot + 8192 + (16 * q + 4 * lg) * 4); }
                asm volatile("s_waitcnt lgkmcnt(0)" ::: "memory"); __builtin_amdgcn_s_barrier(); asm volatile("" ::: "memory");
                put(sh[(i + 1) % D]);
                chain_sh(sh[(i + 1) % D], opsp + (size_t)(cc + 1 + D < nc ? cc + 1 + D : nc - 1) * OPS_ITEM, lane, it);
                const u32x2 c0 = pr[i].ci0, c1 = pr[i].ci1, cv = pr[i].vi;
                bf16x8 bh[2];
#pragma unroll
                for (int ks = 0; ks < 2; ++ks) { const u32x2 p0 = pk4(H[2 * ks]), p1 = pk4(H[2 * ks + 1]); bh[ks] = __builtin_bit_cast(bf16x8, (u32x4){p0.x, p0.y, p1.x, p1.y}); }
                f32x4 u = unpk4(c0), y = unpk4(c1);
#pragma unroll
                for (int ks = 0; ks < 2; ++ks) { u = mfma16(kgrg[0][ks], bh[ks], u); y = mfma16(kgrg[1][ks], bh[ks], y); }
#pragma unroll
                for (int e = 0; e < 4; ++e) ybuf[(16 * (cc & 15) + 4 * lg + e) * 16 + lr] = y[e];
                const u32x2 up = pk4(u);
                const bf16x8 bvu = __builtin_bit_cast(bf16x8, (u32x4){cv.x, cv.y, up.x, up.y});
#pragma unroll
                for (int jt = 0; jt < 4; ++jt) H[jt] = mfma16(kdbd[jt], bvu, H[jt] * gam[jt]);
                chain_pr(pr[i], opsp + (size_t)(cc + D < nc ? cc + D : nc - 1) * OPS_ITEM, lane, it);
                if (smp && (cc & 15) == 15) {
                    asm volatile("s_waitcnt lgkmcnt(0)" ::: "memory");
                    const int base = 256 * (cc >> 4);
#pragma unroll 1
                    for (int r0 = 0; r0 < 256; r0 += 16) { const int lt = base + r0 + (lane >> 2);
                        *(f32x4*)(yg + (size_t)(dir ? L - 1 - lt : lt) * 512) = *(const LAS f32x4*)(ybuf + (r0 + (lane >> 2)) * 16 + 4 * (lane & 3)); }
                }
                asm volatile("s_waitcnt lgkmcnt(0)" ::: "memory"); __builtin_amdgcn_s_barrier(); asm volatile("" ::: "memory");
            }
        }
        if (!smp) { float* op = a.out + OUT_ST + (size_t)((b * 2 + dir) * 8 + h) * 4096;
#pragma unroll
            for (int jt = 0; jt < 4; ++jt) *(f32x4*)(op + (16 * it + lr) * 64 + 16 * jt + 4 * lg) = H[jt]; }
        asm volatile("s_waitcnt vmcnt(0) lgkmcnt(0)" ::: "memory");
        __syncthreads();
        if (smp) continue;
        {
            const int hf = tid & 1;
            const float* l0p = lnx + h * 64 + 32 * hf; const float* l1p = lnx + 512 + h * 64 + 32 * hf;
            for (int t = tid >> 1; t < L; t += 256) {
                float x[32];
#pragma unroll
                for (int q = 0; q < 8; ++q) { const int itq = 2 * hf + (q >> 2);
                    const f32x4 f = *(const LAS f32x4*)(lds + itq * 16384 + (t * 16 + 4 * (q & 3)) * 4), g = *(const LAS f32x4*)(lds + (4 + itq) * 16384 + ((L - 1 - t) * 16 + 4 * (q & 3)) * 4);
                    x[4 * q] = f[0] + g[0]; x[4 * q + 1] = f[1] + g[1]; x[4 * q + 2] = f[2] + g[2]; x[4 * q + 3] = f[3] + g[3]; }
                float s = 0.f;
#pragma unroll
                for (int e = 0; e < 32; ++e) s += x[e];
                s += __shfl_xor(s, 1);
                const float mu = s * (1.f / 64.f);
                float v = 0.f;
#pragma unroll
                for (int e = 0; e < 32; ++e) { x[e] -= mu; v += x[e] * x[e]; }
                v += __shfl_xor(v, 1);
                const float rstd = rsqrtf(v * (1.f / 64.f) + 64e-5f);
                const size_t row = (size_t)rowbase + t;
                const bf16* bp = BON + row * 512 + h * 64 + 32 * hf; bf16* gp = AB + row * 1024 + 512 + h * 64 + 32 * hf;
#pragma unroll
                for (int q = 0; q < 4; ++q) {
                    const u32x4 bw = *(const u32x4*)(bp + 8 * q), gw4 = *(const u32x4*)(gp + 8 * q);
                    const f32x4 bo0 = unpk4((u32x2){bw.x, bw.y}), bo1 = unpk4((u32x2){bw.z, bw.w}), gg0 = unpk4((u32x2){gw4.x, gw4.y}), gg1 = unpk4((u32x2){gw4.z, gw4.w});
                    const f32x4 l00 = *(const f32x4*)(l0p + 8 * q), l01 = *(const f32x4*)(l0p + 8 * q + 4), l10 = *(const f32x4*)(l1p + 8 * q), l11 = *(const f32x4*)(l1p + 8 * q + 4);
                    f32x4 o0, o1;
#pragma unroll
                    for (int e = 0; e < 4; ++e) { o0[e] = (x[8 * q + e] * rstd * l00[e] + l10[e] + bo0[e]) * gg0[e]; o1[e] = (x[8 * q + 4 + e] * rstd * l01[e] + l11[e] + bo1[e]) * gg1[e]; }
                    const u32x2 p0 = pk4(o0), p1 = pk4(o1);
                    *(u32x4*)((DRY ? (bf16*)(a.ws + 248 * MiB) + row * 512 + h * 64 + 32 * hf : gp) + 8 * q) = (u32x4){p0.x, p0.y, p1.x, p1.y};
                }
            }
        }
        __syncthreads();
    }
}

template <bool WT = false>
__device__ __forceinline__ void phase_combine(const Args& a, int bid, int G) {
    int tid = threadIdx.x; asm volatile("" : "+v"(tid));
    const int lane = tid & 63, wave = tid >> 6;
    const int gw = bid * 8 + wave, NGW = G * 8;
    const float* Y = a.out; const bf16* BON = WSB(WS_BONUS); bf16* AB = WSB(WS_XN);
    const float* lnx = FIN(I_LNX);
    const int c = lane * 8;
    constexpr int R = 1;
    for (int row0 = NPR + gw; row0 < NT; row0 += R * NGW) {
        f32x4 f0[R], f1[R], g0[R], g1[R]; u32x4 bw[R], gw4[R];
#pragma unroll
        for (int q = 0; q < R; ++q) { const int row = row0 + q * NGW; if (row < NT) {
            f0[q] = *(const f32x4*)(Y + (size_t)row * 512 + c); f1[q] = *(const f32x4*)(Y + (size_t)row * 512 + c + 4);
            g0[q] = *(const f32x4*)(Y + (size_t)(NT + row) * 512 + c); g1[q] = *(const f32x4*)(Y + (size_t)(NT + row) * 512 + c + 4);
            bw[q] = *(const u32x4*)(BON + (size_t)row * 512 + c); gw4[q] = *(const u32x4*)(AB + (size_t)row * 1024 + 512 + c); } }
        const f32x4 l00 = *(const f32x4*)(lnx + c), l01 = *(const f32x4*)(lnx + c + 4), l10 = *(const f32x4*)(lnx + 512 + c), l11 = *(const f32x4*)(lnx + 512 + c + 4);
#pragma unroll
        for (int q = 0; q < R; ++q) { const int row = row0 + q * NGW; if (row < NT) {
            float x[8];
#pragma unroll
            for (int e = 0; e < 4; ++e) { x[e] = f0[q][e] + g0[q][e]; x[4 + e] = f1[q][e] + g1[q][e]; }
            float s = 0.f;
#pragma unroll
            for (int e = 0; e < 8; ++e) s += x[e];
            s += __shfl_xor(s, 1); s += __shfl_xor(s, 2); s += __shfl_xor(s, 4);
            const float mu = s * (1.f / 64.f);
            float v = 0.f;
#pragma unroll
            for (int e = 0; e < 8; ++e) { x[e] -= mu; v += x[e] * x[e]; }
            v += __shfl_xor(v, 1); v += __shfl_xor(v, 2); v += __shfl_xor(v, 4);
            const float rstd = rsqrtf(v * (1.f / 64.f) + 64e-5f);
            const f32x4 bo0 = unpk4((u32x2){bw[q].x, bw[q].y}), bo1 = unpk4((u32x2){bw[q].z, bw[q].w}), gg0 = unpk4((u32x2){gw4[q].x, gw4[q].y}), gg1 = unpk4((u32x2){gw4[q].z, gw4[q].w});
            f32x4 o0, o1;
#pragma unroll
            for (int e = 0; e < 4; ++e) { o0[e] = (x[e] * rstd * l00[e] + l10[e] + bo0[e]) * gg0[e]; o1[e] = (x[4 + e] * rstd * l01[e] + l11[e] + bo1[e]) * gg1[e]; }
            const u32x2 p0 = pk4(o0), p1 = pk4(o1);
            const u32x4 ov = {p0.x, p0.y, p1.x, p1.y};
            if (WT) {
                bf16* dst = AB + (size_t)row * 1024 + 512 + c;
                asm volatile("global_store_dwordx4 %0, %1, off sc0 sc1" :: "v"(dst), "v"(ov) : "memory");
                asm volatile("s_waitcnt vmcnt(0)" ::: "memory");
                if (lane == 0) __hip_atomic_fetch_add((unsigned*)(a.ws + WS_PCNT) + (row / 160) * 16, 1u, __ATOMIC_RELAXED, __HIP_MEMORY_SCOPE_AGENT);
            } else *(u32x4*)(AB + (size_t)row * 1024 + 512 + c) = ov;
        } }
    }
}

__device__ __forceinline__ void phase_chdft(const Args& a, LAS unsigned char* lds, int bid, int G) {
    int tid = threadIdx.x; asm volatile("" : "+v"(tid));
    const int lane = tid & 63, wave = tid >> 6, tk = lane & 31, hh = lane >> 5;
    const int gw = bid * 8 + wave, NGW = G * 8;
    constexpr int WST = 136;
    LAS bf16* Wd = (LAS bf16*)lds;
    const bf16* WDFT = WSB(WS_WDFT); const bf16* XN = WSB(WS_XN);
    __syncthreads();
    for (int i = tid; i < 256 * 16; i += 512) { const int r = i >> 4, c8 = i & 15; *(LAS u32x4*)(Wd + r * WST + 8 * c8) = *(const u32x4*)(WDFT + r * 128 + 8 * c8); }
    __syncthreads();
    for (int it8 = gw; it8 < 1024; it8 += NGW) {
        const int it = it8 >> 3, mtp2 = it8 & 7;
        const int b = it >> 6, g = (it >> 3) & 7, lt = it & 7, l2 = 32 * lt + tk;
        float twc[4], tws[4]; twc[0] = 1.f; tws[0] = 0.f;
#pragma unroll
        for (int p = 1; p < 4; ++p) { const float x = (float)(l2 * p) * (2.0f / 1024.0f); twc[p] = cospif(x); tws[p] = sinpif(x); }
        const bf16* xin = XN + (size_t)(NPR + b * 1024 + 32 * lt + tk) * 1024 + g * 128 + 8 * hh;
        bf16* zt = WSB(WS_YTS) + (size_t)b * 4 * 1024 * 512 + (size_t)(g * 128 + 4 * hh) * 512 + l2;
        {
            const int mtp = mtp2 >> 1, ph = mtp2 & 1;
            f32x16 Zr[2], Zi[2];
#pragma unroll
            for (int p = 0; p < 2; ++p)
#pragma unroll
                for (int r = 0; r < 16; ++r) { Zr[p][r] = 0.f; Zi[p][r] = 0.f; }
#pragma unroll
            for (int l1 = 0; l1 < 4; ++l1) {
                f32x16 yc, ys;
#pragma unroll
                for (int r = 0; r < 16; ++r) { yc[r] = 0.f; ys[r] = 0.f; }
#pragma unroll
                for (int s = 0; s < 8; ++s) {
                    const bf16x8 hbv = *(const bf16x8*)(xin + (size_t)(256 * l1) * 1024 + 16 * s);
                    const bf16x8 ac = *(const LAS bf16x8*)(Wd + (32 * mtp + tk) * WST + 16 * s + 8 * hh), as = *(const LAS bf16x8*)(Wd + (128 + 32 * mtp + tk) * WST + 16 * s + 8 * hh);
                    yc = mfma32(ac, hbv, yc); ys = mfma32(as, hbv, ys);
                }
                if (ph == 0) { Zr[0] += yc; Zi[0] -= ys; if (l1 & 1) { Zr[1] -= yc; Zi[1] += ys; } else { Zr[1] += yc; Zi[1] -= ys; } }
                else {
                    if (l1 == 0) { Zr[0] += yc; Zi[0] -= ys; Zr[1] += yc; Zi[1] -= ys; }
                    else if (l1 == 1) { Zr[0] -= ys; Zi[0] -= yc; Zr[1] += ys; Zi[1] += yc; }
                    else if (l1 == 2) { Zr[0] -= yc; Zi[0] += ys; Zr[1] -= yc; Zi[1] += ys; }
                    else { Zr[0] += ys; Zi[0] += yc; Zr[1] -= ys; Zi[1] -= yc; }
                }
                asm volatile("" : "+v"(Zr[0]), "+v"(Zi[0]), "+v"(Zr[1]), "+v"(Zi[1]));
            }
            typedef __attribute__((address_space(1))) bf16* gbp;
#pragma unroll
            for (int pi = 0; pi < 2; ++pi) {
                const int p = ph + 2 * pi;
                const float c = 0.5f * (p == 0 ? twc[0] : p == 1 ? twc[1] : p == 2 ? twc[2] : twc[3]), s = 0.5f * (p == 0 ? tws[0] : p == 1 ? tws[1] : p == 2 ? tws[2] : tws[3]);
#pragma unroll
                for (int rq = 0; rq < 4; ++rq) {
                    gbp pp = (gbp)(zt + (size_t)p * 1024 * 512 + (size_t)(32 * mtp + 8 * rq) * 512);
                    asm volatile("" : "+v"(pp));
#pragma unroll
                    for (int e = 0; e < 4; ++e) { const float zr = Zr[pi][4 * rq + e], zi = Zi[pi][4 * rq + e];
                        pp[(size_t)e * 512] = f2bf(zr * c + zi * s); pp[(size_t)e * 512 + 256] = f2bf(zr * s - zi * c); }
                }
            }
        }
    }
    for (int it2 = gw; it2 < (NPR / 32) * 16; it2 += NGW) {
        const int it = it2 >> 1, hsel = it2 & 1;
        const int r0 = (it >> 3) * 32, g = it & 7;
        bf16x8 hb[8];
#pragma unroll
        for (int s = 0; s < 8; ++s) hb[s] = *(const bf16x8*)(XN + (size_t)(r0 + tk) * 1024 + g * 128 + 16 * s + 8 * hh);
        bf16* dst; int ld, Lh, l;
        if (r0 < NPR) { const int b = r0 >> 8; l = (r0 & 255) + tk; dst = WSB(WS_YTP) + (size_t)b * 1024 * 512; ld = 512; Lh = 256; }
        else { const int sb = (r0 - NPR) >> 10; l = ((r0 - NPR) & 1023) + tk; dst = WSB(WS_YTS) + (size_t)sb * 1024 * 2048; ld = 2048; Lh = 1024; }
#pragma unroll 1
        for (int half = hsel; half <= hsel; ++half) {
            f32x16 acc[4];
#pragma unroll
            for (int mt = 0; mt < 4; ++mt)
#pragma unroll
                for (int r = 0; r < 16; ++r) acc[mt][r] = 0.f;
#pragma unroll
            for (int s = 0; s < 8; ++s)
#pragma unroll
                for (int mt = 0; mt < 4; ++mt) { const bf16x8 af = *(const LAS bf16x8*)(Wd + (32 * (4 * half + mt) + tk) * WST + 16 * s + 8 * hh); acc[mt] = mfma32(af, hb[s], acc[mt]);
                    if (mt == 3 && (s & 1)) asm volatile("" : "+v"(acc[0]), "+v"(acc[1]), "+v"(acc[2]), "+v"(acc[3]) :: "memory"); }
            typedef __attribute__((address_space(1))) bf16* gbp;
            gbp p0 = (gbp)(dst + (size_t)(g * 128 + 4 * hh) * ld + half * Lh + l);
#pragma unroll
            for (int mt = 0; mt < 4; ++mt) {
#pragma unroll
                for (int rq = 0; rq < 4; ++rq) {
                    gbp p = p0 + (size_t)(32 * mt + 8 * rq) * ld;
                    asm volatile("" : "+v"(p));
#pragma unroll
                    for (int e = 0; e < 4; ++e) p[(size_t)e * ld] = f2bf(acc[mt][4 * rq + e]);
                }
            }
        }
    }
}

constexpr int NPHASE = 20;
__global__ void __launch_bounds__(512, 2) mk_fwd(Args a0) {
    extern __shared__ __attribute__((aligned(16))) unsigned char lds_raw[];
    LAS unsigned char* lds = (LAS unsigned char*)lds_raw;
    const int tid = threadIdx.x, bid = blockIdx.x, G = gridDim.x;
    volatile LAS unsigned* MISC = (volatile LAS unsigned*)(lds + MISC_OFF);
    if (tid < 32) MISC[tid] = 0u;
    if (tid < 29) *(LAS unsigned long long*)(lds + PTAB_OFF + 8 * tid) = (unsigned long long)(tid < 27 ? a0.in[tid] : tid == 27 ? (const void*)a0.out : (const void*)a0.ws);
    __syncthreads();
    const int ph_lo = a0.ph_lo, ph_hi = a0.ph_hi;
    unsigned char* const ws_ctl = a0.ws;
    const bool one_launch = (ph_hi - ph_lo) > 1;
    XcdBarrier bar; bar.bar = (unsigned*)(ws_ctl + WS_CTL) + 4096; bar.x = 0; bar.st = nullptr;
    if (one_launch) bar = xcd_barrier_post((unsigned*)(ws_ctl + WS_CTL) + 4096, MISC + 8);
#ifndef DUP_PHASE
#define DUP_PHASE -1
#endif
#ifndef DUP_N
#define DUP_N 2
#endif
#ifndef ONLY_PHASE
#define ONLY_PHASE -1
#endif
#define XSL(i) ((unsigned*)(a.ws + WS_XSLOT) + (size_t)(i) * 2 * 64 * 160 * 4)
#define XCN(i) ((unsigned*)(a.ws + WS_CTL) + 8192 + (i) * 2 * 64 * 16)
#define IN(k) ((ONLY_PHASE < 0 || ONLY_PHASE == (k)) && ph_lo <= (k) && (k) < ph_hi)
#define SEAM(k) do { if (IN(k) && IN((k) + 1)) xcd_barrier(bar); } while (0)
    if (IN(1)) { const Args a = load_args(lds, ph_lo, ph_hi); const float* gains = FIN(I_GAINS); phase_prep<3>(a, lds, bid, G); phase_first_norm(a, lds, bid, G, gains + 0 * 1024); } SEAM(1);
    if (IN(2)) for (int rep_ = 0; rep_ < (DUP_PHASE == 2 ? DUP_N : 1); ++rep_) { if (rep_) xcd_barrier(bar); const Args a = load_args(lds, ph_lo, ph_hi); const float* gains = FIN(I_GAINS); (void)gains;
        pg8::Gemm g{1024, 1024, 1024}; pg8::PlainOrder160 S; S.init(WSB(WS_XN), WSB(WS_WIN), NT, INE_PAD, 1024, 1024, G, bid);
        EpiProj E{WSB(WS_Q), WSB(WS_KP), WSB(WS_KS), WSB(WS_VTP), WSB(WS_VTS), (bf16*)a.out, a.out + OUT_CK, a.out + OUT_CV, WSF(WS_ROPE)};
        pg8::gemm_phase160b(lds, g, S, E);
    } SEAM(2);
    if (IN(3)) for (int rep_ = 0; rep_ < (DUP_PHASE == 3 ? DUP_N : 1); ++rep_) { if (rep_) xcd_barrier(bar); const Args a = load_args(lds, ph_lo, ph_hi); const float* gains = FIN(I_GAINS); (void)gains;
#ifndef NO_FRONT
        phase_wkv_front(a, lds, bid, G);
#endif
#ifdef DUP_FRONT
        __syncthreads(); phase_wkv_front(a, lds, bid, G);
#endif
        __syncthreads();
#ifndef NO_ATT
        phase_attention(a, lds, bid, G);
#endif
#ifdef DUP_ATT
        __syncthreads(); phase_attention(a, lds, bid, G);
#endif
    } SEAM(3);
    if (IN(4)) for (int rep_ = 0; rep_ < (DUP_PHASE == 4 ? DUP_N : 1); ++rep_) { if (rep_) xcd_barrier(bar); const Args a = load_args(lds, ph_lo, ph_hi); const float* gains = FIN(I_GAINS); (void)gains;
#if defined(DUP_P4)
        phase_wkv_chain<true>(a, lds, bid, G); phase_prep<2>(a, lds, bid, G); xcd_barrier(bar);
#elif defined(DUP_CHAIN)
        phase_wkv_chain<true>(a, lds, bid, G); xcd_barrier(bar);
#elif defined(DUP_PREP2)
        phase_prep<2>(a, lds, bid, G); xcd_barrier(bar);
#endif
        phase_wkv_chain(a, lds, bid, G);
        if (G == 256) {
            const int wv_ = __builtin_amdgcn_readfirstlane(threadIdx.x >> 6);
            if (bid < 128) phase_prep<2>(a, lds, bid, G, wv_ == 0 ? -1 : (bid * 7 + wv_ - 1) * 3, 3, 2688);
        } else phase_prep<2>(a, lds, bid, G);
    } SEAM(4);
    if (IN(6)) for (int rep_ = 0; rep_ < (DUP_PHASE == 6 ? DUP_N : 1); ++rep_) { if (rep_) xcd_barrier(bar); const Args a = load_args(lds, ph_lo, ph_hi); const float* gains = FIN(I_GAINS); (void)gains;
        phase_combine<true>(a, bid, G);
        pg8::Gemm g{1024, 1024, 1024}; pg8::PlainOrder160 S; S.init(WSB(WS_XN), WSB(WS_WO), NT, 1024, 1024, 1024, G, bid);
        {
            pg8::Unit u0;
            if (S.next(0, u0) && u0.pm * 160 + 160 > NPR) {
                const unsigned want = (unsigned)(u0.pm * 160 + 160 - (u0.pm * 160 > NPR ? u0.pm * 160 : NPR));
                if (threadIdx.x == 0) { unsigned* pc = (unsigned*)(a.ws + WS_PCNT) + u0.pm * 16; unsigned spins = 0;
                    while (__hip_atomic_load(pc, __ATOMIC_RELAXED, __HIP_MEMORY_SCOPE_AGENT) < want) { __builtin_amdgcn_s_sleep(2); if (++spins > (1u << 20)) break; } }
            }
            __syncthreads();
        }
        EpiResNorm<true, false> E{FIN(I_XP), FIN(I_XS), nullptr, WSB(WS_XB), nullptr, WSB(WS_XN), gains + 1 * 1024, gains + 2 * 1024, WSF(WS_MOD), 2048, 0, 3072, 4096, 0, XSL(0), XCN(0)}; pg8::gemm_phase160b(lds, g, S, E);
    } SEAM(6);
    if (IN(8)) for (int rep_ = 0; rep_ < (DUP_PHASE == 8 ? DUP_N : 1); ++rep_) { if (rep_) xcd_barrier(bar); const Args a = load_args(lds, ph_lo, ph_hi); const float* gains = FIN(I_GAINS); (void)gains;
        pg8::Gemm g{1024, 1024, 1024}; pg8::PlainOrder S; S.init(WSB(WS_XN), WSB(WS_WFI), NT, DFF2, 1024, 1024, G, bid);
        EpiFfnConv E{WSB(WS_ACT), FIN(I_CONVW), FIN(I_CONVB), WSF(WS_SB), (LAS float*)(lds + 131072)}; pg8::gemm_phase(lds, g, S, E);
        { const int nun = (NT / 256) * (DFF2 / 256), nfull = nun % G;
          if (nfull == 0) phase_transpose_wfi1<0>(a, lds, bid, G); else if (bid >= nfull) phase_transpose_wfi1<0>(a, lds, bid - nfull, G - nfull); }
    }
    SEAM(8);
    if (IN(10)) for (int rep_ = 0; rep_ < (DUP_PHASE == 10 ? DUP_N : 1); ++rep_) { if (rep_) xcd_barrier(bar); const Args a = load_args(lds, ph_lo, ph_hi); const float* gains = FIN(I_GAINS); (void)gains;
        pg8::Gemm g{DFF, DFF, DFF}; pg8::PlainOrder160 S; S.init(WSB(WS_ACT), WSB(WS_WFO), NT, 1024, DFF, DFF, G, bid);
        ffn_seam_fixup(S, 160, WSB(WS_ACT), FIN(I_CONVW), WSF(WS_SB));
        EpiResNorm<false, false> E{nullptr, nullptr, WSB(WS_XB), WSB(WS_XB), nullptr, WSB(WS_XN), gains + 3 * 1024, gains + 4 * 1024, WSF(WS_MOD), 5120, 0, 0, 1024, 1, XSL(1), XCN(1)}; pg8::gemm_phase160b(lds, g, S, E);
    } SEAM(10);
    if (IN(12)) for (int rep_ = 0; rep_ < (DUP_PHASE == 12 ? DUP_N : 1); ++rep_) { if (rep_) xcd_barrier(bar); const Args a = load_args(lds, ph_lo, ph_hi); const float* gains = FIN(I_GAINS); (void)gains; phase_chdft(a, lds, bid, G); } SEAM(12);
    if (IN(13)) for (int rep_ = 0; rep_ < (DUP_PHASE == 13 ? DUP_N : 1); ++rep_) { if (rep_) xcd_barrier(bar); const Args a = load_args(lds, ph_lo, ph_hi); const float* gains = FIN(I_GAINS); (void)gains;
        { pg8::Gemm g{512, 512, 512}; DftOrder S{G, bid, (const char*)WSB(WS_A2P), (const char*)WSB(WS_YTS), (const char*)WSB(WS_YTP)}; EpiDft E{WSB(WS_XN)}; pg8::gemm_phase(lds, g, S, E); }
    } SEAM(13);
    if (IN(14)) for (int rep_ = 0; rep_ < (DUP_PHASE == 14 ? DUP_N : 1); ++rep_) { if (rep_) xcd_barrier(bar); const Args a = load_args(lds, ph_lo, ph_hi); const float* gains = FIN(I_GAINS); (void)gains;
        pg8::Gemm g{1024, 1024, 1024}; pg8::PlainOrder160 S; S.init(WSB(WS_XN), WSB(WS_WODD), NT, 1024, 1024, 1024, G, bid);
        EpiResNorm<false, false> E{nullptr, nullptr, WSB(WS_XB), WSB(WS_XB), nullptr, WSB(WS_XN), gains + 5 * 1024, gains + 6 * 1024, WSF(WS_MOD), 2048, 1, 3072, 4096, 1, XSL(2), XCN(2)}; pg8::gemm_phase160b(lds, g, S, E);
    } SEAM(14);
    if (IN(16)) for (int rep_ = 0; rep_ < (DUP_PHASE == 16 ? DUP_N : 1); ++rep_) { if (rep_) xcd_barrier(bar); const Args a = load_args(lds, ph_lo, ph_hi); const float* gains = FIN(I_GAINS); (void)gains;
        pg8::Gemm g{1024, 1024, 1024}; pg8::PlainOrder S; S.init(WSB(WS_XN), WSB(WS_WFI) + (size_t)DFF2 * 1024, NT, DFF2, 1024, 1024, G, bid);
        EpiFfnConv E{WSB(WS_ACT), FIN(I_CONVW) + 3 * DFF, FIN(I_CONVB) + DFF, WSF(WS_SB), (LAS float*)(lds + 131072)}; pg8::gemm_phase(lds, g, S, E);
        { const int nun = (NT / 256) * (DFF2 / 256), nfull = nun % G;
          if (nfull == 0) phase_transpose_wfi1<1>(a, lds, bid, G); else if (bid >= nfull) phase_transpose_wfi1<1>(a, lds, bid - nfull, G - nfull); }
    }
    SEAM(16);
    if (IN(18)) for (int rep_ = 0; rep_ < (DUP_PHASE == 18 ? DUP_N : 1); ++rep_) { if (rep_) xcd_barrier(bar); const Args a = load_args(lds, ph_lo, ph_hi); const float* gains = FIN(I_GAINS); (void)gains;
        pg8::Gemm g{DFF, DFF, DFF}; pg8::PlainOrder160 S; S.init(WSB(WS_ACT), WSB(WS_WFO) + (size_t)1024 * DFF, NT, 1024, DFF, DFF, G, bid);
        ffn_seam_fixup(S, 160, WSB(WS_ACT), FIN(I_CONVW) + 3 * DFF, WSF(WS_SB));
        EpiResNorm<false, true> E{nullptr, nullptr, WSB(WS_XB), nullptr, a.out, nullptr, gains + 7 * 1024, nullptr, WSF(WS_MOD), 5120, 1, 0, 0, 1, XSL(3), XCN(3)}; pg8::gemm_phase160b(lds, g, S, E);
    }
#undef IN
#undef SEAM
#undef XSL
#undef XCN
}

extern "C" void kernel_launch(void* const* d_in, const int* in_sizes, int n_in, void* d_out, int out_size, void* d_ws, size_t ws_size, hipStream_t stream) {
    static int grid = 0;
    if (grid == 0) {
        if (n_in != 27 || ws_size < WS_END) { fprintf(stderr, "kernel_launch: unexpected n_in %d / ws %zu\n", n_in, ws_size); grid = -1; return; }
        int dev = 0, cus = 0;
        if (hipGetDevice(&dev) != hipSuccess || hipDeviceGetAttribute(&cus, hipDeviceAttributeMultiprocessorCount, dev) != hipSuccess) { grid = -1; return; }
        if (hipFuncSetAttribute((const void*)mk_fwd, hipFuncAttributeMaxDynamicSharedMemorySize, LDS_BYTES) != hipSuccess) { fprintf(stderr, "kernel_launch: hipFuncSetAttribute failed\n"); grid = -1; return; }
        (void)hipGetLastError();
        if (cus < 256) { fprintf(stderr, "kernel_launch: needs 256 CUs (one workgroup per CU, 256 GEMM units per fused-norm phase), found %d\n", cus); grid = -1; return; }
        grid = 256;
    }
    if (grid < 0) return;
    (void)hipMemsetAsync((char*)d_ws + WS_CTL, 0, CTL_ZERO_BYTES, stream);
    Args a{};
    for (int i = 0; i < 27; ++i) a.in[i] = d_in[i];
    a.out = (float*)d_out; a.ws = (unsigned char*)d_ws;
#if MK_N_LAUNCHES == 1
    a.ph_lo = 0; a.ph_hi = NPHASE;
    hipLaunchKernelGGL(mk_fwd, dim3(grid), dim3(512), LDS_BYTES, stream, a);
#else
    for (int ph = 0; ph < NPHASE; ++ph) { a.ph_lo = ph; a.ph_hi = ph + 1; hipLaunchKernelGGL(mk_fwd, dim3(grid), dim3(512), LDS_BYTES, stream, a); }
#endif
}
```

```cpp
#include <hip/hip_runtime.h>
#include <type_traits>
#include <cstdio>
#include <cstdint>

#ifndef MK_N_LAUNCHES
#define MK_N_LAUNCHES 1
#endif

#define LAS __attribute__((address_space(3)))
typedef unsigned short bf16;
typedef short bf16x8 __attribute__((ext_vector_type(8)));
typedef float f32x4 __attribute__((ext_vector_type(4)));
typedef float f32x2 __attribute__((ext_vector_type(2)));
typedef float f32x16 __attribute__((ext_vector_type(16)));
typedef unsigned u32x4 __attribute__((ext_vector_type(4)));
typedef unsigned u32x2 __attribute__((ext_vector_type(2)));
typedef __bf16 bf16x2_t __attribute__((ext_vector_type(2)));

constexpr int DM = 1024;
constexpr int NPR = 8192, NSA = 2048, NT = 10240;
constexpr int SEQ = 256, DSEQ = 1024, PAST = 256, LKS = 1280;
constexpr int INE = 3456, INE_PAD = 3584, INB = 1920, DFF = 2816, DFF2 = 5632;
constexpr int OUT_YP = 0, OUT_CK = 10485760, OUT_CV = 14680064, OUT_ST = 18874368;

constexpr size_t MiB = 1u << 20;
constexpr size_t WS_CTL = 252 * MiB, CTL_ZERO_BYTES = 65536 + 1310720;
constexpr size_t WS_MOD = 1 * MiB;
constexpr size_t WS_ROPE = 1 * MiB + 256 * 1024;
constexpr size_t WS_LAM = 1 * MiB + 768 * 1024;
constexpr size_t WS_WIN = 2 * MiB;
constexpr size_t WS_WO = 9 * MiB;
constexpr size_t WS_WODD = 11 * MiB;
constexpr size_t WS_WFI = 13 * MiB;
constexpr size_t WS_WFO = 35 * MiB;
constexpr size_t WS_W2T = 46 * MiB;
constexpr size_t WS_A2T = 46 * MiB + 128 * 1024;
constexpr size_t WS_G2T = 46 * MiB + 256 * 1024;
constexpr size_t WS_WDFT = 46 * MiB + 512 * 1024;
constexpr size_t WS_A2P = 46 * MiB + 768 * 1024;
constexpr size_t WS_XN = 52 * MiB;
constexpr size_t WS_MF = 72 * MiB;
constexpr size_t WS_XB = 92 * MiB;
constexpr size_t WS_BIG = 112 * MiB;
constexpr size_t WS_Q = 216 * MiB;
constexpr size_t WS_KP = 226 * MiB;
constexpr size_t WS_KS = 234 * MiB;
constexpr size_t WS_VTP = 237 * MiB;
constexpr size_t WS_VTS = 245 * MiB;
constexpr size_t WS_BONUS = 24 * MiB;
constexpr size_t WS_ACT = WS_BIG;
constexpr size_t WS_SB = 51 * MiB;
constexpr size_t WS_F32B = WS_MF;
constexpr size_t WS_YTP = WS_BIG;
constexpr size_t WS_YTS = WS_BIG + 32 * MiB;
constexpr size_t WS_MOD1 = WS_CTL + 32768;
constexpr size_t WS_PCNT = WS_CTL + 57344;
constexpr size_t WS_XSLOT = WS_CTL + 65536;
constexpr size_t WS_END = 256 * MiB;
static_assert(WS_ACT + (size_t)NT * DFF * 2 <= WS_END, "ws");

constexpr int RING_BYTES = 131072;
constexpr int ACT_OFF = 147456;
constexpr int MISC_OFF = 160256;
constexpr int PTAB_OFF = 160512;
constexpr int LDS_BYTES = 160768;

__device__ __forceinline__ unsigned pk2(float lo, float hi) { f32x2 v = {lo, hi}; bf16x2_t b = __builtin_convertvector(v, bf16x2_t); return __builtin_bit_cast(unsigned, b); }
__device__ __forceinline__ bf16 f2bf(float f) { return (bf16)(pk2(f, 0.f) & 0xffffu); }
__device__ __forceinline__ float bf2f(unsigned b) { return __uint_as_float(b << 16); }
__device__ __forceinline__ u32x2 pk4(f32x4 v) { u32x2 o; o.x = pk2(v[0], v[1]); o.y = pk2(v[2], v[3]); return o; }
__device__ __forceinline__ f32x4 unpk4(u32x2 w) { f32x4 v; v[0] = __uint_as_float(w.x << 16); v[1] = __uint_as_float(w.x & 0xffff0000u); v[2] = __uint_as_float(w.y << 16); v[3] = __uint_as_float(w.y & 0xffff0000u); return v; }
__device__ __forceinline__ float sigmoidf_(float x) { return __builtin_amdgcn_rcpf(1.f + __expf(-x)); }
__device__ __forceinline__ float wave_sum(float v) {
#pragma unroll
    for (int o = 1; o < 64; o <<= 1) v += __shfl_xor(v, o);
    return v;
}
__device__ __forceinline__ int keypos(int key) { return (key & ~12) | ((key & 4) << 1) | ((key & 8) >> 1); }

#define XB_TMO      128
#define XB_XCNT(j)  (256  + 64 * (j))
#define XB_XSUB(j)  (1280 + 64 * (j))
#define XB_XGEN(j)  (2304 + 64 * (j))
#define XB_TOP      3328
#define XB_TOPGEN   3392
#define XCD_BAR_WORDS 3456
#define XB_SPIN_CAP (1u << 20)
__device__ __forceinline__ unsigned xb_ld(unsigned* p)              { return __hip_atomic_load(p, __ATOMIC_RELAXED, __HIP_MEMORY_SCOPE_AGENT); }
__device__ __forceinline__ unsigned xb_add(unsigned* p, unsigned v) { return __hip_atomic_fetch_add(p, v, __ATOMIC_RELAXED, __HIP_MEMORY_SCOPE_AGENT); }
__device__ __forceinline__ unsigned xb_xcc_id() { return (unsigned)__builtin_amdgcn_s_getreg((3 << 11) | 20) & 0xFu; }
#define XB_SPIN(cond, bar) do { unsigned _sp = 0; while (cond) { __builtin_amdgcn_s_sleep(1); \
    if ((++_sp & 255u) == 0u) { if (xb_ld(&(bar)[XB_TMO])) break; if (_sp > XB_SPIN_CAP) { atomicAdd(&(bar)[XB_TMO], 1u); break; } } } } while (0)
struct XcdBarrier { unsigned* bar; unsigned x; volatile LAS unsigned* st; };
__device__ __forceinline__ XcdBarrier xcd_barrier_post(unsigned* bar, volatile LAS unsigned* st) {
    XcdBarrier b; b.bar = bar; b.x = xb_xcc_id(); b.st = st;
    if (threadIdx.x == 0) (void)xb_add(&bar[XB_XCNT(b.x)], 1u);
    return b;
}
__device__ __forceinline__ void xcd_barrier_complete(unsigned* bar, unsigned x, unsigned& nloc, unsigned& nx) {
    const unsigned G = gridDim.x * gridDim.y * gridDim.z;
    unsigned sum, cnt, mine, sp = 0u;
    for (;;) {
        sum = 0u; cnt = 0u; mine = 0u;
#pragma unroll
        for (unsigned j = 0; j < 16; ++j) { const unsigned c = xb_ld(&bar[XB_XCNT(j)]); sum += c; cnt += (c > 0u) ? 1u : 0u; mine = (j == x) ? c : mine; }
        if (sum == G) break;
        __builtin_amdgcn_s_sleep(1);
        if ((++sp & 255u) == 0u) { if (xb_ld(&bar[XB_TMO])) break; if (sp > XB_SPIN_CAP) { atomicAdd(&bar[XB_TMO], 1u); break; } }
    }
    nloc = mine > 0u ? mine : 1u; nx = cnt > 0u ? cnt : 1u;
}
__device__ __forceinline__ void xcd_barrier(const XcdBarrier& b) {
    asm volatile("s_waitcnt vmcnt(0)" ::: "memory");
    __syncthreads();
    if (threadIdx.x == 0) {
        unsigned* bar = b.bar;
        __builtin_amdgcn_s_waitcnt(0);
        unsigned nloc = b.st[0], nx = b.st[1];
        if (nloc == 0u) { xcd_barrier_complete(bar, b.x, nloc, nx); b.st[0] = nloc; b.st[1] = nx; }
        const unsigned old = xb_add(&bar[XB_XSUB(b.x)], 1u);
        const unsigned gen = old / nloc;
        asm volatile("buffer_inv sc1" ::: "memory");
        if (old + 1u == (gen + 1u) * nloc) {
            __builtin_amdgcn_fence(__ATOMIC_RELEASE, "agent");
            asm volatile("s_waitcnt vmcnt(0)" ::: "memory");
            const unsigned og = xb_add(&bar[XB_TOP], 1u);
            const unsigned tg = og / nx;
            if (og + 1u != (tg + 1u) * nx) XB_SPIN(xb_ld(&bar[XB_TOP]) < (tg + 1u) * nx, bar);
            xb_add(&bar[XB_XGEN(b.x)], 1u);
        } else {
            XB_SPIN(xb_ld(&bar[XB_XGEN(b.x)]) == gen, bar);
            asm volatile("s_waitcnt vmcnt(0)" ::: "memory");
        }
    }
    __syncthreads();
}

namespace pg8 {
constexpr int BM = 256, BK = 64, HALF = 128, HTB = HALF * BK * 2, STAGE_BYTES = 8 * HTB, NXCD = 8, WGM = 8, WGM256 = 4;
__host__ __device__ __forceinline__ int lds_byte(int r, int c) { const int st = (r >> 4) * 2 + (c >> 5), rr = r & 15, cc = c & 31, ob = rr * 64 + cc * 2; return st * 1024 + (ob ^ (((ob >> 9) & 1) << 5)); }
__host__ __device__ __forceinline__ void stage_rc(int b, int& R, int& C) { const int st = b / 1024, sb = b % 1024, swz = sb ^ (((sb >> 9) & 1) << 5); R = (st >> 1) * 16 + swz / 64; C = (st & 1) * 32 + (swz % 64) / 2; }

struct Unit { int pm, pn, z; const char* a; const char* b; };
struct Gemm { int lda, ldb, K; };

struct PlainOrder {
    int nM, nN, nwg, G, c; const char* A; const char* Bt; size_t ta, tb;
    __device__ void init(const void* A_, const void* Bt_, int M, int N, int lda, int ldb, int G_, int c_) { A = (const char*)A_; Bt = (const char*)Bt_; nM = M / BM; nN = N / BM; nwg = nM * nN; G = G_; c = c_; ta = (size_t)BM * lda * 2; tb = (size_t)BM * ldb * 2; }
    __device__ __forceinline__ bool next(int i, Unit& u) const {
        const long L = (long)i * G + c; if (L >= nwg) return false;
        int wgid = (int)L; { const int q = nwg / NXCD, r = nwg % NXCD, xcd = wgid % NXCD, off = wgid / NXCD; wgid = (xcd < r ? xcd * (q + 1) : r * (q + 1) + (xcd - r) * q) + off; }
        const int nig = WGM256 * nN, gid = wgid / nig, fm = gid * WGM256, gsz = (nM - fm) < WGM256 ? (nM - fm) : WGM256;
        u.pm = fm + ((wgid % nig) % gsz); u.pn = (wgid % nig) / gsz; u.z = 0;
        u.a = A + (size_t)u.pm * ta; u.b = Bt + (size_t)u.pn * tb; return true;
    }
};

template <class F> __device__ __forceinline__ void epi_each(const f32x4 (&acc)[2][2][4][2], int row0, int col0, F&& f) {
#pragma unroll
    for (int ai = 0; ai < 2; ++ai)
#pragma unroll
        for (int m = 0; m < 4; ++m)
#pragma unroll
            for (int bj = 0; bj < 2; ++bj)
#pragma unroll
                for (int n = 0; n < 2; ++n) f(row0 + ai * HALF + m * 16, col0 + bj * HALF + n * 16, acc[ai][bj][m][n]);
}

template <class Epi, class Sched>
__device__ __forceinline__ void gemm_phase(LAS unsigned char* lds, const Gemm g, const Sched& S, const Epi& E) {
    int tid = threadIdx.x; asm volatile("" : "+v"(tid));
    const int wid = __builtin_amdgcn_readfirstlane(tid >> 6), lane = tid & 63, wr = wid >> 2, wc = wid & 3, fr = lane & 15, fq = lane >> 4;
    const int K = g.K, nt = K / BK;
    unsigned voffA[2], voffB[2];
#pragma unroll
    for (int i = 0; i < 2; ++i) { int R, C; stage_rc(tid * 16 + i * 8192, R, C); voffA[i] = (unsigned)(R * g.lda + C) * 2u; voffB[i] = (unsigned)(R * g.ldb + C) * 2u; }
    const size_t kstep = (size_t)(BK * 2);
    const size_t hstepA = (size_t)HALF * g.lda * 2, hstepB = (size_t)HALF * g.ldb * 2;
    const unsigned ldsw = (unsigned)wid * 1024u;
    const int aoff = lds_byte(wr * 64 + fr, fq * 8), boff = lds_byte(wc * 32 + fr, fq * 8);
#define PG8_SA(b, h) (((b) * 2 + (h)) * HTB)
#define PG8_SB(b, h) ((4 + (b) * 2 + (h)) * HTB)
#define PG8_STAGE(bufoff, gbase, voff) do { _Pragma("unroll") for (int _i = 0; _i < 2; ++_i) \
        __builtin_amdgcn_global_load_lds((const unsigned*)((const char*)(gbase) + (voff)[_i]), (LAS unsigned*)(lds + (bufoff) + ldsw + _i * 8192), 16, 0, 0); } while (0)
#define PG8_LDA(dst, b, h) do { _Pragma("unroll") for (int m = 0; m < 4; ++m) _Pragma("unroll") for (int k = 0; k < 2; ++k) dst[m][k] = *(const LAS bf16x8*)(lds + PG8_SA(b, h) + aoff + m * 2048 + k * 1024); } while (0)
#define PG8_LDB(dst, b, h) do { _Pragma("unroll") for (int n = 0; n < 2; ++n) _Pragma("unroll") for (int k = 0; k < 2; ++k) dst[n][k] = *(const LAS bf16x8*)(lds + PG8_SB(b, h) + boff + n * 2048 + k * 1024); } while (0)
#define PG8_MMA(ai, bj, At, Bt) do { __builtin_amdgcn_s_setprio(1); _Pragma("unroll") for (int m = 0; m < 4; ++m) _Pragma("unroll") for (int n = 0; n < 2; ++n) _Pragma("unroll") for (int k = 0; k < 2; ++k) \
        acc[ai][bj][m][n] = __builtin_amdgcn_mfma_f32_16x16x32_bf16(Bt[n][k], At[m][k], acc[ai][bj][m][n], 0, 0, 0); __builtin_amdgcn_s_setprio(0); } while (0)
#define PG8_WAIT_V(n) asm volatile("s_waitcnt vmcnt(" #n ")" ::: "memory")
#define PG8_WAIT_L(n) asm volatile("s_waitcnt lgkmcnt(" #n ")" ::: "memory")
#define PG8_BAR __builtin_amdgcn_s_barrier()
#define PG8_SCHED __builtin_amdgcn_sched_barrier(0)
    Unit cur, nxt; int ui = 0;
    if (!S.next(0, cur)) return;
    f32x4 acc[2][2][4][2];
#pragma unroll
    for (int a = 0; a < 2; ++a)
#pragma unroll
        for (int b = 0; b < 2; ++b)
#pragma unroll
            for (int m = 0; m < 4; ++m)
#pragma unroll
                for (int n = 0; n < 2; ++n) acc[a][b][m][n] = (f32x4){0.f, 0.f, 0.f, 0.f};
    bf16x8 At[4][2], B0[2][2], B1[2][2];
    const char* cA = cur.a; const char* cB = cur.b;
    PG8_STAGE(PG8_SB(0, 0), cB, voffB); PG8_STAGE(PG8_SA(0, 0), cA, voffA); PG8_STAGE(PG8_SB(0, 1), cB + hstepB, voffB); PG8_STAGE(PG8_SA(0, 1), cA + hstepA, voffA);
    if (wr == 1) PG8_BAR;
    PG8_WAIT_V(4); PG8_BAR;
    PG8_STAGE(PG8_SB(1, 0), cB + kstep, voffB); PG8_STAGE(PG8_SA(1, 0), cA + kstep, voffA); PG8_STAGE(PG8_SB(1, 1), cB + hstepB + kstep, voffB);
    PG8_WAIT_V(6); PG8_BAR;
    for (;;) {
        const bool has_next = S.next(ui + 1, nxt);
        const char* nA = has_next ? nxt.a : cA; const char* nB = has_next ? nxt.b : cB;
        for (int t = 0; t < nt; t += 2) {
            const bool last = (t == nt - 2);
            const char* a1 = cA + (size_t)(t + 1) * kstep;
            const char* a2 = last ? nA : cA + (size_t)(t + 2) * kstep; const char* b2 = last ? nB : cB + (size_t)(t + 2) * kstep;
            const char* a3 = a2 + kstep; const char* b3 = b2 + kstep;
            PG8_LDB(B0, 0, 0); PG8_SCHED; PG8_LDA(At, 0, 0); PG8_STAGE(PG8_SA(1, 1), a1 + hstepA, voffA);
            PG8_WAIT_L(8); PG8_BAR; PG8_WAIT_L(0); PG8_MMA(0, 0, At, B0); PG8_BAR; PG8_SCHED;
            PG8_LDB(B1, 0, 1); PG8_STAGE(PG8_SB(0, 0), b2, voffB);
            PG8_BAR; PG8_WAIT_L(0); PG8_MMA(0, 1, At, B1); PG8_BAR;
            PG8_LDA(At, 0, 1); PG8_STAGE(PG8_SA(0, 0), a2, voffA);
            PG8_BAR; PG8_WAIT_L(0); PG8_MMA(1, 0, At, B0); PG8_BAR; PG8_SCHED;
            PG8_STAGE(PG8_SB(0, 1), b2 + hstepB, voffB);
            PG8_WAIT_V(6); PG8_BAR; PG8_MMA(1, 1, At, B1); PG8_BAR;
            PG8_LDB(B0, 1, 0); PG8_SCHED; PG8_LDA(At, 1, 0); PG8_STAGE(PG8_SA(0, 1), a2 + hstepA, voffA);
            PG8_WAIT_L(8); PG8_BAR; PG8_WAIT_L(0); PG8_MMA(0, 0, At, B0); PG8_BAR; PG8_SCHED;
            PG8_LDB(B1, 1, 1); PG8_STAGE(PG8_SB(1, 0), b3, voffB);
            PG8_BAR; PG8_WAIT_L(0); PG8_MMA(0, 1, At, B1); PG8_BAR;
            PG8_LDA(At, 1, 1); PG8_STAGE(PG8_SA(1, 0), a3, voffA);
            PG8_BAR; PG8_WAIT_L(0); PG8_MMA(1, 0, At, B0); PG8_BAR; PG8_SCHED;
            PG8_STAGE(PG8_SB(1, 1), b3 + hstepB, voffB);
            PG8_WAIT_V(6); PG8_BAR; PG8_MMA(1, 1, At, B1); PG8_BAR;
        }
        if constexpr (Epi::ALIGN) { if (wr == 0) PG8_BAR; }
        E(acc, cur, wr, wc, fr, fq);
        if (!has_next) break;
#pragma unroll
        for (int a = 0; a < 2; ++a)
#pragma unroll
            for (int b = 0; b < 2; ++b)
#pragma unroll
                for (int m = 0; m < 4; ++m)
#pragma unroll
                    for (int n = 0; n < 2; ++n) acc[a][b][m][n] = (f32x4){0.f, 0.f, 0.f, 0.f};
        cur = nxt; cA = nA; cB = nB; ++ui;
        if constexpr (Epi::ALIGN) { if (wr == 1) PG8_BAR; }
    }
    PG8_WAIT_V(0);
    if constexpr (!Epi::ALIGN) { if (wr == 0) PG8_BAR; }
    PG8_BAR;
#undef PG8_SA
#undef PG8_SB
#undef PG8_STAGE
#undef PG8_LDA
#undef PG8_LDB
#undef PG8_MMA
#undef PG8_WAIT_V
#undef PG8_WAIT_L
#undef PG8_BAR
#undef PG8_SCHED
}

struct PlainOrder160 {
    int nM, nN, nwg, G, c; const char* A; const char* Bt; size_t ta, tb;
    __device__ void init(const void* A_, const void* Bt_, int M, int N, int lda, int ldb, int G_, int c_) { A = (const char*)A_; Bt = (const char*)Bt_; nM = M / 160; nN = N / BM; nwg = nM * nN; G = G_; c = c_; ta = (size_t)160 * lda * 2; tb = (size_t)BM * ldb * 2; }
    __device__ __forceinline__ bool next(int i, Unit& u) const {
        const long L = (long)i * G + c; if (L >= nwg) return false;
        int wgid = (int)L; { const int q = nwg / NXCD, r = nwg % NXCD, xcd = wgid % NXCD, off = wgid / NXCD; wgid = (xcd < r ? xcd * (q + 1) : r * (q + 1) + (xcd - r) * q) + off; }
        const int nig = WGM * nN, gid = wgid / nig, fm = gid * WGM, gsz = (nM - fm) < WGM ? (nM - fm) : WGM;
        u.pm = fm + ((wgid % nig) % gsz); u.pn = (wgid % nig) / gsz; u.z = 0;
        u.a = A + (size_t)u.pm * ta; u.b = Bt + (size_t)u.pn * tb; return true;
    }
};
template <class Epi, class Sched>
__device__ __forceinline__ void gemm_phase160(LAS unsigned char* lds, const Gemm g, const Sched& S, const Epi& E) {
    int tid = threadIdx.x; asm volatile("" : "+v"(tid));
    const int wid = __builtin_amdgcn_readfirstlane(tid >> 6), lane = tid & 63, half = wid >> 2, fr = lane & 15, fq = lane >> 4;
    const int K = g.K, nt = K / BK;
    constexpr int HTA = 80 * BK * 2;
    unsigned voffA[2], voffB[2];
    { int R, C; stage_rc(tid * 16, R, C); voffA[0] = (unsigned)(R * g.lda + C) * 2u; stage_rc((512 + (tid & 127)) * 16, R, C); voffA[1] = (unsigned)(R * g.lda + C) * 2u; }
#pragma unroll
    for (int i = 0; i < 2; ++i) { int R, C; stage_rc(tid * 16 + i * 8192, R, C); voffB[i] = (unsigned)(R * g.ldb + C) * 2u; }
    const size_t kstep = (size_t)(BK * 2);
    const size_t hstepA = (size_t)80 * g.lda * 2, hstepB = (size_t)HALF * g.ldb * 2;
    const unsigned ldswA0 = (unsigned)wid * 1024u, ldswA1 = 8192u + (unsigned)(wid & 1) * 1024u, ldswB = (unsigned)wid * 1024u;
    const int aoff = lds_byte(fr, fq * 8), boff = lds_byte(wid * 16 + fr, fq * 8);
#define PG8_SA(b, h) (((b) * 2 + (h)) * HTA)
#define PG8_SB(b, h) (4 * HTA + ((b) * 2 + (h)) * HTB)
#define PG8_STAGEA(bufoff, gbase) do { \
        __builtin_amdgcn_global_load_lds((const unsigned*)((const char*)(gbase) + voffA[0]), (LAS unsigned*)(lds + (bufoff) + ldswA0), 16, 0, 0); \
        __builtin_amdgcn_global_load_lds((const unsigned*)((const char*)(gbase) + voffA[1]), (LAS unsigned*)(lds + (bufoff) + ldswA1), 16, 0, 0); } while (0)
#define PG8_STAGEB(bufoff, gbase) do { _Pragma("unroll") for (int _i = 0; _i < 2; ++_i) \
        __builtin_amdgcn_global_load_lds((const unsigned*)((const char*)(gbase) + voffB[_i]), (LAS unsigned*)(lds + (bufoff) + ldswB + _i * 8192), 16, 0, 0); } while (0)
#define PG8_LDA(dst, b, h) do { _Pragma("unroll") for (int m = 0; m < 5; ++m) _Pragma("unroll") for (int k = 0; k < 2; ++k) dst[m][k] = *(const LAS bf16x8*)(lds + PG8_SA(b, h) + aoff + m * 2048 + k * 1024); } while (0)
#define PG8_LDB(dst, b, h) do { _Pragma("unroll") for (int k = 0; k < 2; ++k) dst[k] = *(const LAS bf16x8*)(lds + PG8_SB(b, h) + boff + k * 1024); } while (0)
#define PG8_MMA(ai, bj, At, Bt) do { __builtin_amdgcn_s_setprio(1); _Pragma("unroll") for (int m = 0; m < 5; ++m) _Pragma("unroll") for (int k = 0; k < 2; ++k) \
        acc[ai][bj][m] = __builtin_amdgcn_mfma_f32_16x16x32_bf16(Bt[k], At[m][k], acc[ai][bj][m], 0, 0, 0); __builtin_amdgcn_s_setprio(0); } while (0)
#define PG8_WAIT_V(n) asm volatile("s_waitcnt vmcnt(" #n ")" ::: "memory")
#define PG8_WAIT_L(n) asm volatile("s_waitcnt lgkmcnt(" #n ")" ::: "memory")
#define PG8_BAR __builtin_amdgcn_s_barrier()
#define PG8_SCHED __builtin_amdgcn_sched_barrier(0)
    Unit cur, nxt; int ui = 0;
    if (!S.next(0, cur)) return;
    f32x4 acc[2][2][5];
#pragma unroll
    for (int a = 0; a < 2; ++a)
#pragma unroll
        for (int b = 0; b < 2; ++b)
#pragma unroll
            for (int m = 0; m < 5; ++m) acc[a][b][m] = (f32x4){0.f, 0.f, 0.f, 0.f};
    bf16x8 At[5][2], B0[2], B1[2];
    const char* cA = cur.a; const char* cB = cur.b;
    PG8_STAGEB(PG8_SB(0, 0), cB); PG8_STAGEA(PG8_SA(0, 0), cA); PG8_STAGEB(PG8_SB(0, 1), cB + hstepB); PG8_STAGEA(PG8_SA(0, 1), cA + hstepA);
    if (half == 1) PG8_BAR;
    PG8_WAIT_V(4); PG8_BAR;
    PG8_STAGEB(PG8_SB(1, 0), cB + kstep); PG8_STAGEA(PG8_SA(1, 0), cA + kstep); PG8_STAGEB(PG8_SB(1, 1), cB + hstepB + kstep);
    PG8_WAIT_V(6); PG8_BAR;
    for (;;) {
        const bool has_next = S.next(ui + 1, nxt);
        const char* nA = has_next ? nxt.a : cA; const char* nB = has_next ? nxt.b : cB;
        for (int t = 0; t < nt; t += 2) {
            const bool last = (t == nt - 2);
            const char* a1 = cA + (size_t)(t + 1) * kstep;
            const char* a2 = last ? nA : cA + (size_t)(t + 2) * kstep; const char* b2 = last ? nB : cB + (size_t)(t + 2) * kstep;
            const char* a3 = a2 + kstep; const char* b3 = b2 + kstep;
            PG8_LDB(B0, 0, 0); PG8_SCHED; PG8_LDA(At, 0, 0); PG8_STAGEA(PG8_SA(1, 1), a1 + hstepA);
            PG8_WAIT_L(10); PG8_BAR; PG8_WAIT_L(0); PG8_MMA(0, 0, At, B0); PG8_BAR; PG8_SCHED;
            PG8_LDB(B1, 0, 1); PG8_STAGEB(PG8_SB(0, 0), b2);
            PG8_BAR; PG8_WAIT_L(0); PG8_MMA(0, 1, At, B1); PG8_BAR;
            PG8_LDA(At, 0, 1); PG8_STAGEA(PG8_SA(0, 0), a2);
            PG8_BAR; PG8_WAIT_L(0); PG8_MMA(1, 0, At, B0); PG8_BAR; PG8_SCHED;
            PG8_STAGEB(PG8_SB(0, 1), b2 + hstepB);
            PG8_WAIT_V(6); PG8_BAR; PG8_MMA(1, 1, At, B1); PG8_BAR;
            PG8_LDB(B0, 1, 0); PG8_SCHED; PG8_LDA(At, 1, 0); PG8_STAGEA(PG8_SA(0, 1), a2 + hstepA);
            PG8_WAIT_L(10); PG8_BAR; PG8_WAIT_L(0); PG8_MMA(0, 0, At, B0); PG8_BAR; PG8_SCHED;
            PG8_LDB(B1, 1, 1); PG8_STAGEB(PG8_SB(1, 0), b3);
            PG8_BAR; PG8_WAIT_L(0); PG8_MMA(0, 1, At, B1); PG8_BAR;
            PG8_LDA(At, 1, 1); PG8_STAGEA(PG8_SA(1, 0), a3);
            PG8_BAR; PG8_WAIT_L(0); PG8_MMA(1, 0, At, B0); PG8_BAR; PG8_SCHED;
            PG8_STAGEB(PG8_SB(1, 1), b3 + hstepB);
            PG8_WAIT_V(6); PG8_BAR; PG8_MMA(1, 1, At, B1); PG8_BAR;
        }
        E(acc, cur, wid, fr, fq);
        if (!has_next) break;
#pragma unroll
        for (int a = 0; a < 2; ++a)
#pragma unroll
            for (int b = 0; b < 2; ++b)
#pragma unroll
                for (int m = 0; m < 5; ++m) acc[a][b][m] = (f32x4){0.f, 0.f, 0.f, 0.f};
        cur = nxt; cA = nA; cB = nB; ++ui;
    }
    PG8_WAIT_V(0);
    if (half == 0) PG8_BAR;
    PG8_BAR;
#undef PG8_SA
#undef PG8_SB
#undef PG8_STAGEA
#undef PG8_STAGEB
#undef PG8_LDA
#undef PG8_LDB
#undef PG8_MMA
#undef PG8_WAIT_V
#undef PG8_WAIT_L
#undef PG8_BAR
#undef PG8_SCHED
}

template <int MF, class Epi, class Sched>
__device__ __forceinline__ void gemm_phase160b_run(LAS unsigned char* lds, const Gemm g, const Sched& S, const Epi& E, int tid, int wid, int lane, int wr, int wc) {
    const int fr = lane & 15, fq = lane >> 4;
    const int K = g.K, nt = K / BK;
    constexpr int HTA = 80 * BK * 2;
    unsigned voffA[2], voffB[2];
    { int R, C; stage_rc(tid * 16, R, C); voffA[0] = (unsigned)(R * g.lda + C) * 2u; stage_rc((512 + (tid & 127)) * 16, R, C); voffA[1] = (unsigned)(R * g.lda + C) * 2u; }
#pragma unroll
    for (int i = 0; i < 2; ++i) { int R, C; stage_rc(tid * 16 + i * 8192, R, C); voffB[i] = (unsigned)(R * g.ldb + C) * 2u; }
    const size_t kstep = (size_t)(BK * 2);
    const size_t hstepA = (size_t)80 * g.lda * 2, hstepB = (size_t)HALF * g.ldb * 2;
    const unsigned ldswA0 = (unsigned)wid * 1024u, ldswA1 = 8192u + (unsigned)(wid & 1) * 1024u, ldswB = (unsigned)wid * 1024u;
    const int aoff = lds_byte(wr * 48 + fr, fq * 8), boff = lds_byte(wc * 32 + fr, fq * 8);
#define PG8_SA(b, h) (((b) * 2 + (h)) * HTA)
#define PG8_SB(b, h) (4 * HTA + ((b) * 2 + (h)) * HTB)
#define PG8_STAGEA(bufoff, gbase) do { \
        __builtin_amdgcn_global_load_lds((const unsigned*)((const char*)(gbase) + voffA[0]), (LAS unsigned*)(lds + (bufoff) + ldswA0), 16, 0, 0); \
        __builtin_amdgcn_global_load_lds((const unsigned*)((const char*)(gbase) + voffA[1]), (LAS unsigned*)(lds + (bufoff) + ldswA1), 16, 0, 0); } while (0)
#define PG8_STAGEB(bufoff, gbase) do { _Pragma("unroll") for (int _i = 0; _i < 2; ++_i) \
        __builtin_amdgcn_global_load_lds((const unsigned*)((const char*)(gbase) + voffB[_i]), (LAS unsigned*)(lds + (bufoff) + ldswB + _i * 8192), 16, 0, 0); } while (0)
#define PG8_LDA(dst, b, h) do { _Pragma("unroll") for (int m = 0; m < MF; ++m) _Pragma("unroll") for (int k = 0; k < 2; ++k) dst[m][k] = *(const LAS bf16x8*)(lds + PG8_SA(b, h) + aoff + m * 2048 + k * 1024); } while (0)
#define PG8_LDB(dst, b, h) do { _Pragma("unroll") for (int n = 0; n < 2; ++n) _Pragma("unroll") for (int k = 0; k < 2; ++k) dst[n][k] = *(const LAS bf16x8*)(lds + PG8_SB(b, h) + boff + n * 2048 + k * 1024); } while (0)
#define PG8_MMA(ai, bj, At, Bt) do { __builtin_amdgcn_s_setprio(1); _Pragma("unroll") for (int m = 0; m < MF; ++m) _Pragma("unroll") for (int n = 0; n < 2; ++n) _Pragma("unroll") for (int k = 0; k < 2; ++k) \
        acc[ai][bj][m][n] = __builtin_amdgcn_mfma_f32_16x16x32_bf16(Bt[n][k], At[m][k], acc[ai][bj][m][n], 0, 0, 0); __builtin_amdgcn_s_setprio(0); } while (0)
#define PG8_WAIT_V(n) asm volatile("s_waitcnt vmcnt(" #n ")" ::: "memory")
#define PG8_WAIT_L(n) asm volatile("s_waitcnt lgkmcnt(" #n ")" ::: "memory")
#define PG8_WAIT_LA() do { if (MF == 3) PG8_WAIT_L(6); else PG8_WAIT_L(4); } while (0)
#define PG8_BAR __builtin_amdgcn_s_barrier()
#define PG8_SCHED __builtin_amdgcn_sched_barrier(0)
    Unit cur, nxt; int ui = 0;
    if (!S.next(0, cur)) return;
    f32x4 acc[2][2][MF][2];
#pragma unroll
    for (int a = 0; a < 2; ++a)
#pragma unroll
        for (int b = 0; b < 2; ++b)
#pragma unroll
            for (int m = 0; m < MF; ++m)
#pragma unroll
                for (int n = 0; n < 2; ++n) acc[a][b][m][n] = (f32x4){0.f, 0.f, 0.f, 0.f};
    bf16x8 At[MF][2], B0[2][2], B1[2][2];
    const char* cA = cur.a; const char* cB = cur.b;
    PG8_STAGEB(PG8_SB(0, 0), cB); PG8_STAGEA(PG8_SA(0, 0), cA); PG8_STAGEB(PG8_SB(0, 1), cB + hstepB); PG8_STAGEA(PG8_SA(0, 1), cA + hstepA);
    if (wr == 1) PG8_BAR;
    PG8_WAIT_V(4); PG8_BAR;
    PG8_STAGEB(PG8_SB(1, 0), cB + kstep); PG8_STAGEA(PG8_SA(1, 0), cA + kstep); PG8_STAGEB(PG8_SB(1, 1), cB + hstepB + kstep);
    PG8_WAIT_V(6); PG8_BAR;
    for (;;) {
        const bool has_next = S.next(ui + 1, nxt);
        const char* nA = has_next ? nxt.a : cA; const char* nB = has_next ? nxt.b : cB;
        for (int t = 0; t < nt; t += 2) {
            const bool last = (t == nt - 2);
            const char* a1 = cA + (size_t)(t + 1) * kstep;
            const char* a2 = last ? nA : cA + (size_t)(t + 2) * kstep; const char* b2 = last ? nB : cB + (size_t)(t + 2) * kstep;
            const char* a3 = a2 + kstep; const char* b3 = b2 + kstep;
            PG8_LDB(B0, 0, 0); PG8_SCHED; PG8_LDA(At, 0, 0); PG8_STAGEA(PG8_SA(1, 1), a1 + hstepA);
            PG8_WAIT_LA(); PG8_BAR; PG8_WAIT_L(0); PG8_MMA(0, 0, At, B0); PG8_BAR; PG8_SCHED;
            PG8_LDB(B1, 0, 1); PG8_STAGEB(PG8_SB(0, 0), b2);
            PG8_BAR; PG8_WAIT_L(0); PG8_MMA(0, 1, At, B1); PG8_BAR;
            PG8_LDA(At, 0, 1); PG8_STAGEA(PG8_SA(0, 0), a2);
            PG8_BAR; PG8_WAIT_L(0); PG8_MMA(1, 0, At, B0); PG8_BAR; PG8_SCHED;
            PG8_STAGEB(PG8_SB(0, 1), b2 + hstepB);
            PG8_WAIT_V(6); PG8_BAR; PG8_MMA(1, 1, At, B1); PG8_BAR;
            PG8_LDB(B0, 1, 0); PG8_SCHED; PG8_LDA(At, 1, 0); PG8_STAGEA(PG8_SA(0, 1), a2 + hstepA);
            PG8_WAIT_LA(); PG8_BAR; PG8_WAIT_L(0); PG8_MMA(0, 0, At, B0); PG8_BAR; PG8_SCHED;
            PG8_LDB(B1, 1, 1); PG8_STAGEB(PG8_SB(1, 0), b3);
            PG8_BAR; PG8_WAIT_L(0); PG8_MMA(0, 1, At, B1); PG8_BAR;
            PG8_LDA(At, 1, 1); PG8_STAGEA(PG8_SA(1, 0), a3);
            PG8_BAR; PG8_WAIT_L(0); PG8_MMA(1, 0, At, B0); PG8_BAR; PG8_SCHED;
            PG8_STAGEB(PG8_SB(1, 1), b3 + hstepB);
            PG8_WAIT_V(6); PG8_BAR; PG8_MMA(1, 1, At, B1); PG8_BAR;
        }
        if constexpr (!Epi::AFTER_DRAIN) E.template tile<MF>(acc, cur, wr, wc, fr, fq);
        if (!has_next) break;
#pragma unroll
        for (int a = 0; a < 2; ++a)
#pragma unroll
            for (int b = 0; b < 2; ++b)
#pragma unroll
                for (int m = 0; m < MF; ++m)
#pragma unroll
                    for (int n = 0; n < 2; ++n) acc[a][b][m][n] = (f32x4){0.f, 0.f, 0.f, 0.f};
        cur = nxt; cA = nA; cB = nB; ++ui;
    }
    PG8_WAIT_V(0);
    if (wr == 0) PG8_BAR;
    PG8_BAR;
    if constexpr (Epi::AFTER_DRAIN) E.template fused<MF>(acc, cur, wr, wc, fr, fq, lds, wid, lane, tid);
#undef PG8_SA
#undef PG8_SB
#undef PG8_STAGEA
#undef PG8_STAGEB
#undef PG8_LDA
#undef PG8_LDB
#undef PG8_MMA
#undef PG8_WAIT_V
#undef PG8_WAIT_L
#undef PG8_WAIT_LA
#undef PG8_BAR
#undef PG8_SCHED
}
template <class Epi, class Sched>
__device__ __forceinline__ void gemm_phase160b(LAS unsigned char* lds, const Gemm g, const Sched& S, const Epi& E) {
    int tid = threadIdx.x; asm volatile("" : "+v"(tid));
    const int wid = __builtin_amdgcn_readfirstlane(tid >> 6), lane = tid & 63, wr = wid >> 2, wc = wid & 3;
    if (wr == 0) gemm_phase160b_run<3>(lds, g, S, E, tid, wid, lane, wr, wc);
    else gemm_phase160b_run<2>(lds, g, S, E, tid, wid, lane, wr, wc);
}
}

struct Args { const void* in[27]; float* out; unsigned char* ws; int ph_lo, ph_hi; };
enum { I_XP = 0, I_XS, I_CK, I_CV, I_ST, I_C, I_CCTX, I_WADA, I_BADA, I_GAINS, I_WIN, I_WOUT, I_LAMBDA, I_SUBLN, I_MU, I_W0, I_W2, I_A0, I_A2, I_G2, I_KVEC, I_LNX, I_WODD, I_WFI, I_CONVW, I_CONVB, I_WFO };
#define FIN(k) ((const float*)a.in[k])
#define WSB(off) ((bf16*)(a.ws + (off)))
#define WSF(off) ((float*)(a.ws + (off)))


__device__ __forceinline__ const void* ptab_ld(LAS unsigned char* lds, int k) {
    const u32x2 w = *(const LAS u32x2*)(lds + PTAB_OFF + 8 * k);
    const unsigned long long v = ((unsigned long long)(unsigned)__builtin_amdgcn_readfirstlane((int)w.y) << 32) | (unsigned)__builtin_amdgcn_readfirstlane((int)w.x);
    return (const void*)(const __attribute__((address_space(1))) void*)v;
}
__device__ __forceinline__ Args load_args(LAS unsigned char* lds, int ph_lo, int ph_hi) {
    Args r;
#pragma unroll
    for (int i = 0; i < 27; ++i) r.in[i] = ptab_ld(lds, i);
    r.out = (float*)ptab_ld(lds, 27); r.ws = (unsigned char*)ptab_ld(lds, 28); r.ph_lo = ph_lo; r.ph_hi = ph_hi;
    return r;
}
__device__ __forceinline__ int row_cond(int row) { return row < NPR ? 0 : 1 + ((row - NPR) >> 10); }

template <bool FFN_PERM = false, bool P32 = false>
__device__ __forceinline__ void p0_transpose_item(const float* W, int K, int N, bf16* WT, LAS float* scr, int item, int lane) {
    const int nblk = N / 64, kb = item / nblk, nb = item % nblk, k0 = 64 * kb, n0 = 64 * nb;
    const int d0 = FFN_PERM ? (n0 < DFF ? (n0 / 128) * 256 + (n0 % 128) : ((n0 - DFF) / 128) * 256 + 128 + ((n0 - DFF) % 128)) : n0;
    const int c2 = 2 * (lane & 31);
#pragma unroll 8
    for (int i = 0; i < 32; ++i) { const int kk = 2 * i + (lane >> 5); const f32x2 v = *(const f32x2*)(W + (size_t)(k0 + kk) * N + n0 + c2); scr[kk * 65 + c2] = v[0]; scr[kk * 65 + c2 + 1] = v[1]; }
    asm volatile("s_waitcnt lgkmcnt(0)" ::: "memory");
    const int c = lane & 7;
#pragma unroll
    for (int j = 0; j < 8; ++j) { const int n = (lane >> 3) + 8 * j; const LAS float* s = scr + (8 * c) * 65 + n;
        u32x4 o; o.x = pk2(s[0 * 65], s[1 * 65]); o.y = pk2(s[2 * 65], s[3 * 65]); o.z = pk2(s[4 * 65], s[5 * 65]); o.w = pk2(s[6 * 65], s[7 * 65]);
        const int nr = (FFN_PERM || P32) ? (n & 32) + 16 * ((n >> 2) & 1) + 4 * ((n & 31) >> 3) + (n & 3) : n;
        *(u32x4*)(WT + (size_t)(d0 + nr) * K + k0 + 8 * c) = o; }
    asm volatile("s_waitcnt lgkmcnt(0)" ::: "memory");
}

template <int STAGE>
__device__ __forceinline__ void phase_prep(const Args& a, LAS unsigned char* lds, int bid, int G, int vgw = -2, int nmine = 1, int nvw = 0) {
    int tid = threadIdx.x; asm volatile("" : "+v"(tid));
    const int lane = tid & 63, wave = tid >> 6;
    const int gw = bid * 8 + wave, NGW = G * 8;
    const int gt = bid * 512 + tid, NGT = G * 512;
    constexpr int I_IN = (1024 / 64) * (INE / 64), I_SQ = (1024 / 64) * (1024 / 64), I_FI = (1024 / 64) * (DFF2 / 64), I_FO = (DFF / 64) * (1024 / 64), I_L64 = 1 * (512 / 64), I_L128 = 2 * (512 / 64);
    if (STAGE == 1 || STAGE == 3) {
        LAS float* scr = (LAS float*)(lds + wave * 18432);
        constexpr int NITEMS = I_IN + 4 * I_L64 + I_L128;
        for (int it = gw; it < NITEMS; it += NGW) {
            int r = it;
            if (r < I_IN) { p0_transpose_item<false, true>(FIN(I_WIN), 1024, INE, WSB(WS_WIN), scr, r, lane); continue; } r -= I_IN;
            if (r < 2 * I_L64) { const int d = r / I_L64; p0_transpose_item(FIN(I_W2) + (size_t)d * 64 * 512, 64, 512, WSB(WS_W2T) + (size_t)d * 512 * 64, scr, r % I_L64, lane); continue; } r -= 2 * I_L64;
            if (r < 2 * I_L64) { const int d = r / I_L64; p0_transpose_item(FIN(I_A2) + (size_t)d * 64 * 512, 64, 512, WSB(WS_A2T) + (size_t)d * 512 * 64, scr, r % I_L64, lane); continue; } r -= 2 * I_L64;
            p0_transpose_item(FIN(I_G2), 128, 512, WSB(WS_G2T), scr, r, lane);
        }
        for (int i = gt; i < (INE_PAD - INE) * 1024 / 8; i += NGT) ((u32x4*)(WSB(WS_WIN) + (size_t)INE * 1024))[i] = (u32x4){0u, 0u, 0u, 0u};
    }
    if (STAGE == 2) {
        LAS float* scr = (LAS float*)(lds + wave * 18432);
        constexpr int NITEMS = I_SQ + I_FI + I_FO;
        const int s0 = vgw == -2 ? gw : vgw, ns = vgw == -2 ? NGW : nvw;
        for (int sl = 0; sl < nmine; ++sl)
        for (int it = s0 < 0 ? NITEMS : s0 + sl; it < NITEMS; it += ns) {
            int r = it;
            if (r < I_SQ) { p0_transpose_item<false, true>(FIN(I_WOUT), 1024, 1024, WSB(WS_WO), scr, r, lane); continue; } r -= I_SQ;
            if (r < I_FI) { p0_transpose_item<true>(FIN(I_WFI), 1024, DFF2, WSB(WS_WFI), scr, r, lane); continue; } r -= I_FI;
            p0_transpose_item<false, true>(FIN(I_WFO), DFF, 1024, WSB(WS_WFO), scr, r, lane);
        }
    }
    if (STAGE == 0 || STAGE == 3) {
        for (int i = gt; i < 256 * 128; i += NGT) {
            const int n = i >> 7, c = i & 127, m = (c * (n & 127)) & 127; const float x = (float)m * (2.0f / 128.0f);
            WSB(WS_WDFT)[i] = f2bf(n < 128 ? cospif(x) : sinpif(x));
        }
        for (int i = gt; i < 256 * 512; i += NGT) {
            const int lp = i >> 9, k = i & 511, l = k & 255, m = (lp * l) & 255; const float x = (float)m * (2.0f / 256.0f), s = 0.00552427172801990f;
            WSB(WS_A2P)[i] = f2bf(k < 256 ? s * cospif(x) : -s * sinpif(x));
        }
        for (int i = gt; i < 1024 * 32; i += NGT) {
            const int t = i >> 5, f = i & 31; const float inv = powf(10000.0f, -(float)(f & 15) / 16.0f), pos = (float)(f < 16 ? (t >> 6) : (t & 63)), ang = pos * inv;
            WSF(WS_ROPE)[i] = cosf(ang); WSF(WS_ROPE)[1024 * 32 + i] = sinf(ang);
        }
        if (gt == 0) {
            const float* lp = FIN(I_LAMBDA); float s1 = 0.f, s2 = 0.f;
            for (int i = 0; i < 64; ++i) { s1 += lp[i] * lp[64 + i]; s2 += lp[128 + i] * lp[192 + i]; }
            WSF(WS_LAM)[0] = expf(s1) - expf(s2) + 0.2f;
        }
        for (int i = gt; i < 2 * 256 * 512; i += NGT) {
            const int b = i >> 17, t = (i >> 9) & 255, c = i & 511;
            WSB(WS_KS)[((size_t)b * LKS + t) * 512 + c] = f2bf(FIN(I_CK)[i]);
            const int h = c >> 7, d = c & 127;
            WSB(WS_VTS)[((size_t)(b * 4 + h) * 128 + d) * LKS + keypos(t)] = f2bf(FIN(I_CV)[i]);
        }
    }
    if (STAGE == 0 || STAGE == 1 || STAGE == 3) {
        LAS float* sc = (LAS float*)lds;
        LAS float* red = (LAS float*)(lds + 16384);
        __syncthreads();
        for (int i = tid; i < 3 * 1024; i += 512) { const int cd = i >> 10, k = i & 1023; const float x = cd == 0 ? FIN(I_CCTX)[k] : FIN(I_C)[(cd - 1) * 1024 + k]; sc[i] = x / (1.f + __expf(-x)); }
        __syncthreads();
        const int kq = tid >> 3, nl = tid & 7;
        const int it_lo = STAGE == 0 ? 0 : 64, it_hi = STAGE == 0 ? 64 : 2 * 192;
        for (int q = 0; ; ++q) {
            int it;
            if (STAGE == 3) {
                if (G == 256) { if (q == 0) { if (bid >= 64) continue; it = bid; } else if (q == 1) { if (bid < 64) continue; it = bid; } else if (q == 2) { if (bid >= 128) continue; it = 256 + bid; } else break; }
                else { it = bid + q * G; if (it >= 2 * 192) break; }
            } else { it = it_lo + bid + q * G; if (it >= it_hi) break; }
            const int l = it / 192, n0 = (it % 192) * 32;
            const float* W = FIN(I_WADA) + (size_t)l * 1024 * 6144 + n0 + 4 * nl;
            f32x4 s0 = {0.f, 0.f, 0.f, 0.f}, s1 = s0, s2 = s0;
#pragma unroll 4
            for (int kk = 0; kk < 16; ++kk) { const int k = kq * 16 + kk; const f32x4 w = *(const f32x4*)(W + (size_t)k * 6144); s0 += w * sc[k]; s1 += w * sc[1024 + k]; s2 += w * sc[2048 + k]; }
            *(LAS f32x4*)(red + (kq * 3 + 0) * 32 + 4 * nl) = s0; *(LAS f32x4*)(red + (kq * 3 + 1) * 32 + 4 * nl) = s1; *(LAS f32x4*)(red + (kq * 3 + 2) * 32 + 4 * nl) = s2;
            __syncthreads();
            if (tid < 96) { const int cd = tid >> 5, n = tid & 31; float s = FIN(I_BADA)[l * 6144 + n0 + n];
                for (int qq = 0; qq < 64; ++qq) s += red[(qq * 3 + cd) * 32 + n];
                if (STAGE == 3 && it < 64)
                    __hip_atomic_store((unsigned*)(a.ws + WS_MOD1) + cd * 2048 + n0 + n, __float_as_uint(s) | 1u, __ATOMIC_RELAXED, __HIP_MEMORY_SCOPE_AGENT);
                else WSF(WS_MOD)[(size_t)(l * 3 + cd) * 6144 + n0 + n] = s; }
            __syncthreads();
        }
    }
}

__device__ __forceinline__ void phase_first_norm(const Args& a, LAS unsigned char* lds, int bid, int G, const float* gB) {
    int tid = threadIdx.x; asm volatile("" : "+v"(tid));
    const int lane = tid & 63, wave = tid >> 6;
    const int gw = bid * 8 + wave, NGW = G * 8;
    LAS float* modl = (LAS float*)lds;
    __syncthreads();
    {   const unsigned* side = (const unsigned*)(a.ws + WS_MOD1);
        unsigned v[12]; unsigned spins = 0;
        for (;;) { bool ok = true;
#pragma unroll
            for (int i = 0; i < 12; ++i) { v[i] = __hip_atomic_load(side + tid + 512 * i, __ATOMIC_RELAXED, __HIP_MEMORY_SCOPE_AGENT); ok = ok && (v[i] != 0u); }
            if (ok || ++spins > (1u << 20)) break;
            __builtin_amdgcn_s_sleep(2); }
#pragma unroll
        for (int i = 0; i < 12; ++i) modl[tid + 512 * i] = __uint_as_float(v[i]);
    }
    __syncthreads();
    bf16* XN = WSB(WS_XN);
    constexpr int R = 5;
    for (int row0 = gw; row0 < NT; row0 += R * NGW) {
        f32x4 x[R][4];
#pragma unroll
        for (int q = 0; q < R; ++q) { const int row = row0 + q * NGW; if (row < NT) {
            const float* xin = row < NPR ? FIN(I_XP) + (size_t)row * DM : FIN(I_XS) + (size_t)(row - NPR) * DM;
#pragma unroll
            for (int j = 0; j < 4; ++j) x[q][j] = *(const f32x4*)(xin + 8 * lane + 512 * (j >> 1) + 4 * (j & 1)); } }
#pragma unroll
        for (int q = 0; q < R; ++q) { const int row = row0 + q * NGW; if (row < NT) {
            const LAS float* ml = modl + row_cond(row) * 2048;
            float ss = 0.f;
#pragma unroll
            for (int j = 0; j < 4; ++j) ss += (x[q][j][0] * x[q][j][0] + x[q][j][1] * x[q][j][1]) + (x[q][j][2] * x[q][j][2] + x[q][j][3] * x[q][j][3]);
            const float rinv = rsqrtf(wave_sum(ss) * (1.f / DM) + 1e-6f);
#pragma unroll
            for (int jj = 0; jj < 2; ++jj) { u32x2 pw[2];
#pragma unroll
                for (int k = 0; k < 2; ++k) { const int c = 8 * lane + 512 * jj + 4 * k; const f32x4 g = *(const f32x4*)(gB + c), sc = *(const LAS f32x4*)(ml + 1024 + c), sh = *(const LAS f32x4*)(ml + c);
                    pw[k] = pk4((x[q][2 * jj + k] * rinv * g) * (sc + 1.f) + sh); }
                *(u32x4*)(XN + (size_t)row * DM + 8 * lane + 512 * jj) = (u32x4){pw[0].x, pw[0].y, pw[1].x, pw[1].y}; }
        } }
    }
}

template <int SEL>
__device__ __forceinline__ void phase_transpose_wfi1(const Args& a, LAS unsigned char* lds, int bid, int G) {
    int tid = threadIdx.x; asm volatile("" : "+v"(tid));
    const int lane = tid & 63, wave = tid >> 6;
    LAS float* scr = (LAS float*)(lds + wave * 18432);
    constexpr int I_FI = (1024 / 64) * (DFF2 / 64), I_SQ = (1024 / 64) * (1024 / 64), I_FO = (DFF / 64) * (1024 / 64);
    if (SEL == 0) {
        for (int it = bid * 8 + wave; it < I_FI + I_SQ; it += G * 8) {
            if (it < I_FI) p0_transpose_item<true>(FIN(I_WFI) + (size_t)1024 * DFF2, 1024, DFF2, WSB(WS_WFI) + (size_t)DFF2 * 1024, scr, it, lane);
            else p0_transpose_item<false, true>(FIN(I_WODD), 1024, 1024, WSB(WS_WODD), scr, it - I_FI, lane); }
    } else {
        for (int it = bid * 8 + wave; it < I_FO; it += G * 8) p0_transpose_item<false, true>(FIN(I_WFO) + (size_t)DFF * 1024, DFF, 1024, WSB(WS_WFO) + (size_t)1024 * DFF, scr, it, lane);
    }
    __syncthreads();
}
template <bool HAS_RES, bool HAS_H, bool X_FROM_INPUT, bool X_TO_OUTPUT = false>
__device__ __forceinline__ void phase_resnorm(const Args& a, int bid, int G, const bf16* mf, const float* gA, int gate_off, int layer_gate, const float* gB, int shift_off, int scale_off, int layer_mod) {
    int tid = threadIdx.x; asm volatile("" : "+v"(tid));
    const int lane = tid & 63, wave = tid >> 6;
    const int gw = bid * 8 + wave, NGW = G * 8;
    float* X = a.out; bf16* XB = WSB(WS_XB);
    bf16* XN = WSB(WS_XN);
    constexpr int R = 5;
    for (int row0 = gw; row0 < NT; row0 += R * NGW) {
        f32x4 x[R][4], m[R][4];
#pragma unroll
        for (int q = 0; q < R; ++q) { const int row = row0 + q * NGW; if (row < NT) {
            const float* xin = row < NPR ? FIN(I_XP) + (size_t)row * DM : FIN(I_XS) + (size_t)(row - NPR) * DM;
#pragma unroll
            for (int j = 0; j < 4; ++j) { x[q][j] = X_FROM_INPUT ? *(const f32x4*)(xin + 4 * lane + 256 * j) : unpk4(*(const u32x2*)(XB + (size_t)row * DM + 4 * lane + 256 * j)); if (HAS_RES) m[q][j] = unpk4(*(const u32x2*)(mf + (size_t)row * DM + 4 * lane + 256 * j)); } } }
#pragma unroll
        for (int q = 0; q < R; ++q) { const int row = row0 + q * NGW; if (row < NT) {
            const float* mod = WSF(WS_MOD) + (size_t)(layer_mod * 3 + row_cond(row)) * 6144;
            const float* modg = WSF(WS_MOD) + (size_t)(layer_gate * 3 + row_cond(row)) * 6144;
            if (HAS_RES) {
                float ss = 0.f;
#pragma unroll
                for (int j = 0; j < 4; ++j) ss += (m[q][j][0] * m[q][j][0] + m[q][j][1] * m[q][j][1]) + (m[q][j][2] * m[q][j][2] + m[q][j][3] * m[q][j][3]);
                const float rinv = rsqrtf(wave_sum(ss) * (1.f / DM) + 1e-6f);
#pragma unroll
                for (int j = 0; j < 4; ++j) { const f32x4 g = *(const f32x4*)(gA + 4 * lane + 256 * j), gt = *(const f32x4*)(modg + gate_off + 4 * lane + 256 * j);
                    x[q][j] = x[q][j] + gt * (m[q][j] * rinv * g);
                    if (X_TO_OUTPUT) *(f32x4*)(X + (size_t)row * DM + 4 * lane + 256 * j) = x[q][j]; else *(u32x2*)(XB + (size_t)row * DM + 4 * lane + 256 * j) = pk4(x[q][j]); }
            }
            if (HAS_H) {
                float ss = 0.f;
#pragma unroll
                for (int j = 0; j < 4; ++j) ss += (x[q][j][0] * x[q][j][0] + x[q][j][1] * x[q][j][1]) + (x[q][j][2] * x[q][j][2] + x[q][j][3] * x[q][j][3]);
                const float rinv = rsqrtf(wave_sum(ss) * (1.f / DM) + 1e-6f);
#pragma unroll
                for (int j = 0; j < 4; ++j) { const f32x4 g = *(const f32x4*)(gB + 4 * lane + 256 * j), sc = *(const f32x4*)(mod + scale_off + 4 * lane + 256 * j), sh = *(const f32x4*)(mod + shift_off + 4 * lane + 256 * j);
                    const f32x4 h = (x[q][j] * rinv * g) * (sc + 1.f) + sh; *(u32x2*)(XN + (size_t)row * DM + 4 * lane + 256 * j) = pk4(h); }
            }
        } }
    }
}

struct EpiF32 {
    float* C; int ldc;
    static constexpr bool ALIGN = false;
    __device__ __forceinline__ void operator()(const f32x4 (&acc)[2][2][4][2], const pg8::Unit& u, int wr, int wc, int fr, int fq) const {
        pg8::epi_each(acc, u.pm * 256 + wr * 64 + fr, u.pn * 256 + wc * 32 + 4 * fq, [&](int row, int col, const f32x4& v) { *(f32x4*)(C + (size_t)row * ldc + col) = v; });
    }
};
struct EpiBf16 {
    bf16* O; int ldc;
    static constexpr bool ALIGN = false;
    __device__ __forceinline__ void operator()(const f32x4 (&acc)[2][2][4][2], const pg8::Unit& u, int wr, int wc, int fr, int fq) const {
        pg8::epi_each(acc, u.z + u.pm * 256 + wr * 64 + fr, u.pn * 256 + wc * 32 + 4 * fq, [&](int row, int col, const f32x4& v) { *(u32x2*)(O + (size_t)row * ldc + col) = pk4(v); });
    }
};

template <class F> __device__ __forceinline__ void epi_each160(const f32x4 (&acc)[2][2][5], const pg8::Unit& u, int wid, int fr, int fq, F&& f) {
#pragma unroll
    for (int ai = 0; ai < 2; ++ai)
#pragma unroll
        for (int m = 0; m < 5; ++m)
#pragma unroll
            for (int bj = 0; bj < 2; ++bj) f(u.pm * 160 + ai * 80 + m * 16 + fr, u.pn * 256 + bj * 128 + wid * 16 + 4 * fq, acc[ai][bj][m]);
}
struct EpiBf16_160 {
    bf16* O; int ldc;
    static constexpr bool AFTER_DRAIN = false;
    template <int MF> __device__ __forceinline__ void tile(const f32x4 (&acc)[2][2][MF][2], const pg8::Unit& u, int wr, int wc, int fr, int fq) const {
#pragma unroll
        for (int ai = 0; ai < 2; ++ai)
#pragma unroll
            for (int m = 0; m < MF; ++m)
#pragma unroll
                for (int bj = 0; bj < 2; ++bj)
#pragma unroll
                    for (int n = 0; n < 2; ++n) *(u32x2*)(O + (size_t)(u.pm * 160 + ai * 80 + wr * 48 + m * 16 + fr) * ldc + u.pn * 256 + bj * 128 + wc * 32 + n * 16 + 4 * fq) = pk4(acc[ai][bj][m][n]);
    }
    __device__ __forceinline__ void operator()(const f32x4 (&acc)[2][2][5], const pg8::Unit& u, int wid, int fr, int fq) const {
#pragma unroll
        for (int ai = 0; ai < 2; ++ai)
#pragma unroll
            for (int m = 0; m < 5; ++m)
#pragma unroll
                for (int bj = 0; bj < 2; ++bj) *(u32x2*)(O + (size_t)(u.pm * 160 + ai * 80 + m * 16 + fr) * ldc + u.pn * 256 + bj * 128 + wid * 16 + 4 * fq) = pk4(acc[ai][bj][m]);
    }
};

template <bool FROM_INPUT, bool FINAL>
struct EpiResNorm {
    static constexpr bool AFTER_DRAIN = true;
    const float* xin_p; const float* xin_s; const bf16* xb_in;
    bf16* xb_out; float* xf_out; bf16* xn_out;
    const float* gA; const float* gB; const float* mod;
    int gate_off, layer_gate, shift_off, scale_off, layer_mod;
    unsigned* slots; unsigned* cnt;

    template <int MF> __device__ __forceinline__ void exchange(const f32x4 (&v)[2][2][MF][2], int e, int pm, int pn, int wr, int wc, int fr, int fq, LAS float* P, LAS float* R, int wid, int lane, int tid) const {
#pragma unroll
        for (int ai = 0; ai < 2; ++ai)
#pragma unroll
            for (int m = 0; m < MF; ++m) {
                float s = 0.f;
#pragma unroll
                for (int bj = 0; bj < 2; ++bj)
#pragma unroll
                    for (int n = 0; n < 2; ++n) { const f32x4 x = v[ai][bj][m][n]; s += (x[0] * x[0] + x[1] * x[1]) + (x[2] * x[2] + x[3] * x[3]); }
                s += __shfl_xor(s, 16); s += __shfl_xor(s, 32);
                if (fq == 0) P[(80 * ai + 48 * wr + 16 * m + fr) * 4 + wc] = s;
            }
        asm volatile("s_waitcnt lgkmcnt(0)" ::: "memory"); __builtin_amdgcn_s_barrier(); asm volatile("" ::: "memory");
        unsigned long long* sl = (unsigned long long*)(slots + ((size_t)(e * 64 + pm) * 160) * 4);
        if (tid < 160) { const float tot = (P[tid * 4 + 0] + P[tid * 4 + 1]) + (P[tid * 4 + 2] + P[tid * 4 + 3]);
            __hip_atomic_store((unsigned*)sl + tid * 4 + pn, __float_as_uint(tot) | 1u, __ATOMIC_RELAXED, __HIP_MEMORY_SCOPE_AGENT);
            unsigned long long a, b; unsigned spins = 0;
            for (;;) {
                a = __hip_atomic_load(sl + tid * 2 + 0, __ATOMIC_RELAXED, __HIP_MEMORY_SCOPE_AGENT); b = __hip_atomic_load(sl + tid * 2 + 1, __ATOMIC_RELAXED, __HIP_MEMORY_SCOPE_AGENT);
                if (((unsigned)a != 0u && (unsigned)(a >> 32) != 0u && (unsigned)b != 0u && (unsigned)(b >> 32) != 0u) || ++spins > (1u << 20)) break;
                __builtin_amdgcn_s_sleep(1);
            }
            const float q = (__uint_as_float((unsigned)a) + __uint_as_float((unsigned)(a >> 32))) + (__uint_as_float((unsigned)b) + __uint_as_float((unsigned)(b >> 32)));
            R[tid] = rsqrtf(q * (1.f / 1024.f) + 1e-6f); }
        asm volatile("s_waitcnt lgkmcnt(0)" ::: "memory"); __builtin_amdgcn_s_barrier(); asm volatile("" ::: "memory");
    }

    template <int MF> __device__ __forceinline__ void fused(f32x4 (&acc)[2][2][MF][2], const pg8::Unit& u, int wr, int wc, int fr, int fq, LAS unsigned char* lds, int wid, int lane, int tid) const {
        LAS float* P = (LAS float*)lds; LAS float* R = (LAS float*)(lds + 4096);
        const int pm = u.pm, pn = u.pn, row0 = 160 * pm;
        int cb = 256 * pn + 32 * wc + 8 * fq;
        const int c_lo = row_cond(row0), c_hi = row_cond(row0 + 159);
        f32x4 g[4], gtl[4], gth[4];
        {   const float* ml = mod + (size_t)(layer_gate * 3 + c_lo) * 6144 + gate_off; const float* mh = mod + (size_t)(layer_gate * 3 + c_hi) * 6144 + gate_off;
#pragma unroll
            for (int q = 0; q < 4; ++q) { const int col = cb + 128 * (q >> 1) + 4 * (q & 1); g[q] = *(const f32x4*)(gA + col); gtl[q] = *(const f32x4*)(ml + col); gth[q] = *(const f32x4*)(mh + col); } }
        using XT = typename std::conditional<FROM_INPUT, f32x4, u32x2>::type;
        XT x0[MF * 4], x1[MF * 4];
        auto ldx = [&](XT (&xr)[MF * 4], int ai) {
#pragma unroll
            for (int m = 0; m < MF; ++m) { const int row = row0 + 80 * ai + 48 * wr + 16 * m + fr;
#pragma unroll
                for (int q = 0; q < 4; ++q) { const int col = cb + 128 * (q >> 1) + 4 * (q & 1);
                    if constexpr (FROM_INPUT) xr[m * 4 + q] = *(const f32x4*)((row < NPR ? xin_p + (size_t)row * DM : xin_s + (size_t)(row - NPR) * DM) + col);
                    else xr[m * 4 + q] = *(const u32x2*)(xb_in + (size_t)row * DM + col); } } };
        auto upd = [&](const XT (&xr)[MF * 4], int ai) {
#pragma unroll
            for (int m = 0; m < MF; ++m) { const int rl = 80 * ai + 48 * wr + 16 * m + fr; const float rinv = R[rl]; const bool hi = row_cond(row0 + 80 * ai + 48 * wr + 16 * m) != c_lo;
#pragma unroll
                for (int q = 0; q < 4; ++q) { f32x4 x; if constexpr (FROM_INPUT) x = xr[m * 4 + q]; else x = unpk4(xr[m * 4 + q]);
                    const f32x4 gt = hi ? gth[q] : gtl[q];
                    acc[ai][q >> 1][m][q & 1] = x + gt * (acc[ai][q >> 1][m][q & 1] * rinv * g[q]); } } };
        ldx(x0, 0);
        if constexpr (!FROM_INPUT) ldx(x1, 1);
        asm volatile("" ::: "memory");
        exchange<MF>(acc, 0, pm, pn, wr, wc, fr, fq, P, R, wid, lane, tid);
        upd(x0, 0);
        if constexpr (FROM_INPUT) { asm volatile("" ::: "memory"); ldx(x1, 1); }
        upd(x1, 1);
#pragma unroll
        for (int ai = 0; ai < 2; ++ai)
#pragma unroll
            for (int m = 0; m < MF; ++m) { const int row = row0 + 80 * ai + 48 * wr + 16 * m + fr;
#pragma unroll
                for (int q = 0; q < 4; ++q) { const int col = cb + 128 * (q >> 1) + 4 * (q & 1); const f32x4 x = acc[ai][q >> 1][m][q & 1];
                    if constexpr (FINAL) *(f32x4*)(xf_out + (size_t)row * DM + col) = x; else *(u32x2*)(xb_out + (size_t)row * DM + col) = pk4(x); } }
        if constexpr (!FINAL) {
            f32x4 al[4], ah[4], sl[4], sh[4];
            {   const float* ml = mod + (size_t)(layer_mod * 3 + c_lo) * 6144; const float* mh = mod + (size_t)(layer_mod * 3 + c_hi) * 6144;
#pragma unroll
                for (int q = 0; q < 4; ++q) { const int col = cb + 128 * (q >> 1) + 4 * (q & 1); const f32x4 gb = *(const f32x4*)(gB + col);
                    al[q] = gb * (*(const f32x4*)(ml + scale_off + col) + 1.f); ah[q] = gb * (*(const f32x4*)(mh + scale_off + col) + 1.f);
                    sl[q] = *(const f32x4*)(ml + shift_off + col); sh[q] = *(const f32x4*)(mh + shift_off + col); } }
            asm volatile("" ::: "memory");
            exchange<MF>(acc, 1, pm, pn, wr, wc, fr, fq, P, R, wid, lane, tid);
#pragma unroll
            for (int ai = 0; ai < 2; ++ai)
#pragma unroll
                for (int m = 0; m < MF; ++m) { const int rl = 80 * ai + 48 * wr + 16 * m + fr, row = row0 + rl; const float rinv = R[rl]; const bool hi = row_cond(row0 + 80 * ai + 48 * wr + 16 * m) != c_lo;
#pragma unroll
                    for (int q = 0; q < 4; ++q) { const int col = cb + 128 * (q >> 1) + 4 * (q & 1);
                        const f32x4 h = (acc[ai][q >> 1][m][q & 1] * rinv) * (hi ? ah[q] : al[q]) + (hi ? sh[q] : sl[q]);
                        *(u32x2*)(xn_out + (size_t)row * DM + col) = pk4(h); } }
        }
    }
};

struct EpiProj {
    bf16 *Q, *KP, *KS, *VTP, *VTS, *FB; float *ock, *ocv; const float* rope;
    static constexpr bool ALIGN = false, AFTER_DRAIN = false;
    __device__ __forceinline__ f32x4 do_rope(f32x4 v, int t, int col) const {
        const int i0 = (col & 63) >> 1;
        const f32x2 c = *(const f32x2*)(rope + t * 32 + i0), s = *(const f32x2*)(rope + 1024 * 32 + t * 32 + i0);
        f32x4 o; o[0] = v[0] * c[0] - v[1] * s[0]; o[1] = v[0] * s[0] + v[1] * c[0]; o[2] = v[2] * c[1] - v[3] * s[1]; o[3] = v[2] * s[1] + v[3] * c[1]; return o;
    }
    __device__ __forceinline__ void operator()(const f32x4 (&acc)[2][2][4][2], const pg8::Unit& u, int wr, int wc, int fr, int fq) const {
        pg8::epi_each(acc, u.pm * 256 + wr * 64 + fr, u.pn * 256 + wc * 32 + 4 * fq, [&](int row, int col, const f32x4& v) { elem(row, col, v); });
    }
    __device__ __forceinline__ void operator()(const f32x4 (&acc)[2][2][5], const pg8::Unit& u, int wid, int fr, int fq) const {
        epi_each160(acc, u, wid, fr, fq, [&](int row, int col, const f32x4& v) { elem(row, col, v); });
    }
    template <int MF> __device__ __forceinline__ void tile(const f32x4 (&acc)[2][2][MF][2], const pg8::Unit& u, int wr, int wc, int fr, int fq) const {
#pragma unroll
        for (int ai = 0; ai < 2; ++ai)
#pragma unroll
            for (int m = 0; m < MF; ++m)
#pragma unroll
                for (int bj = 0; bj < 2; ++bj) elem8(u.pm * 160 + ai * 80 + wr * 48 + m * 16 + fr, u.pn * 256 + bj * 128 + wc * 32 + 8 * fq, acc[ai][bj][m][0], acc[ai][bj][m][1]);
    }
    __device__ __forceinline__ void elem8(int row, int col, const f32x4& v0, const f32x4& v1) const {
        const bool smp = row >= NPR; const int sr = row - NPR, sb = sr >> 10, st = sr & 1023;
        if (col < 512) {
            f32x4 o0 = v0, o1 = v1; if (smp) { o0 = do_rope(v0, st, col); o1 = do_rope(v1, st, col + 4); }
            const u32x2 a = pk4(o0), b = pk4(o1); *(u32x4*)(Q + (size_t)row * 512 + col) = (u32x4){a.x, a.y, b.x, b.y};
        } else if (col < 1024) {
            const int c = col - 512;
            if (!smp) { *(f32x4*)(ock + (size_t)row * 512 + c) = v0; *(f32x4*)(ock + (size_t)row * 512 + c + 4) = v1; const u32x2 a = pk4(v0), b = pk4(v1); *(u32x4*)(KP + (size_t)row * 512 + c) = (u32x4){a.x, a.y, b.x, b.y}; }
            else { const f32x4 o0 = do_rope(v0, st, c), o1 = do_rope(v1, st, c + 4); const u32x2 a = pk4(o0), b = pk4(o1); *(u32x4*)(KS + ((size_t)sb * LKS + PAST + st) * 512 + c) = (u32x4){a.x, a.y, b.x, b.y}; }
        } else if (col < 1536) { elem(row, col, v0); elem(row, col + 4, v1);
        } else if (col < INE) {
            const u32x2 a = pk4(v0), b = pk4(v1); *(u32x4*)(FB + (size_t)row * INB + (col - 1536)) = (u32x4){a.x, a.y, b.x, b.y};
        }
    }
    __device__ __forceinline__ void elem(int row, int col, const f32x4& v) const {
        {
            const bool smp = row >= NPR; const int sr = row - NPR, sb = sr >> 10, st = sr & 1023;
            if (col < 512) {
                f32x4 o = v; if (smp) o = do_rope(v, st, col);
                *(u32x2*)(Q + (size_t)row * 512 + col) = pk4(o);
            } else if (col < 1024) {
                const int c = col - 512;
                if (!smp) { *(f32x4*)(ock + (size_t)row * 512 + c) = v; *(u32x2*)(KP + (size_t)row * 512 + c) = pk4(v); }
                else { const f32x4 o = do_rope(v, st, c); *(u32x2*)(KS + ((size_t)sb * LKS + PAST + st) * 512 + c) = pk4(o); }
            } else if (col < 1536) {
                const int c = col - 1024, h = c >> 7, d = c & 127;
                if (!smp) { *(f32x4*)(ocv + (size_t)row * 512 + c) = v; const int b = row >> 8, t = row & 255; bf16* p = VTP + ((size_t)(b * 4 + h) * 128 + d) * SEQ + keypos(t);
#pragma unroll
                    for (int e = 0; e < 4; ++e) p[(size_t)e * SEQ] = f2bf(v[e]); }
                else { bf16* p = VTS + ((size_t)(sb * 4 + h) * 128 + d) * LKS + keypos(PAST + st);
#pragma unroll
                    for (int e = 0; e < 4; ++e) p[(size_t)e * LKS] = f2bf(v[e]); }
            } else if (col < INE) {
                *(u32x2*)(FB + (size_t)row * INB + (col - 1536)) = pk4(v);
            }
        }
    }
};


template <int CTRL> __device__ __forceinline__ float dpp_mv(float old, float src) { return __int_as_float(__builtin_amdgcn_update_dpp(__float_as_int(old), __float_as_int(src), CTRL, 0xf, 0xf, false)); }
template <int CTRL> __device__ __forceinline__ float dpp_rot(float src) { return __int_as_float(__builtin_amdgcn_mov_dpp(__float_as_int(src), CTRL, 0xf, 0xf, true)); }
__device__ __forceinline__ float silu_mul(float x, float u) { return x * __builtin_amdgcn_rcpf(1.f + __expf(-x)) * u; }
struct EpiFfnConv {
    static constexpr bool ALIGN = true;
    bf16* ACT; const float* cw; const float* cb; float* SB; LAS float* xch;
    __device__ __forceinline__ void operator()(const f32x4 (&acc)[2][2][4][2], const pg8::Unit& u, int wr, int wc, int fr, int fq) const {
        const int pm = u.pm, pn = u.pn;
        const bool smp = pm >= 32; const int sidx = pm - 32, sq = sidx & 3;
        const bool has_prev = smp && sq > 0, has_next = smp && sq < 3;
#pragma unroll
        for (int ai = 0; ai < 2; ++ai)
#pragma unroll
            for (int n = 0; n < 2; ++n) { const int c = 32 * wc + 16 * n + 4 * fq, blk = 2 * ai + wr;
                if (fr == 0) *(LAS f32x4*)(xch + (blk * 2 + 0) * 128 + c) = acc[ai][1][0][n];
                if (fr == 15) *(LAS f32x4*)(xch + (blk * 2 + 1) * 128 + c) = acc[ai][1][3][n]; }
        asm volatile("s_waitcnt lgkmcnt(0)" ::: "memory"); __builtin_amdgcn_s_barrier(); asm volatile("" ::: "memory");
        u32x2 hold[2][4];
#pragma unroll
        for (int n = 0; n < 2; ++n) {
            const int c = 32 * wc + 16 * n + 4 * fq, f = 128 * pn + 32 * wc + 8 * fq + 4 * n;
            const f32x4 c0 = *(const f32x4*)(cw + f), c1 = *(const f32x4*)(cw + DFF + f), c2 = *(const f32x4*)(cw + 2 * DFF + f), cbv = *(const f32x4*)(cb + f);
#pragma unroll
            for (int ai = 0; ai < 2; ++ai) {
                const int blk = 2 * ai + wr;
                f32x4 gabove = {0.f, 0.f, 0.f, 0.f}, gbelow = gabove;
                if (blk > 0) gabove = *(const LAS f32x4*)(xch + ((blk - 1) * 2 + 1) * 128 + c);
                if (blk < 3) gbelow = *(const LAS f32x4*)(xch + ((blk + 1) * 2 + 0) * 128 + c);
#pragma unroll
                for (int m = 0; m < 4; ++m) {
                    const f32x4 g = acc[ai][1][m][n], uu = acc[ai][0][m][n];
                    f32x4 o, xs;
#pragma unroll
                    for (int e = 0; e < 4; ++e) {
                        const float pold = m > 0 ? dpp_rot<0x121>(acc[ai][1][m - 1][n][e]) : gabove[e];
                        const float prev = dpp_mv<0x111>(pold, g[e]);
                        const float nold = m < 3 ? dpp_rot<0x12F>(acc[ai][1][m + 1][n][e]) : gbelow[e];
                        const float next = dpp_mv<0x101>(nold, g[e]);
                        const float x = c0[e] * prev + (c1[e] * g[e] + (c2[e] * next + cbv[e]));
                        xs[e] = x; o[e] = silu_mul(x, uu[e]);
                    }
                    const int r = 128 * ai + 64 * wr + 16 * m + fr;
                    if (n == 0) hold[ai][m] = pk4(o);
                    else { const u32x2 hi = pk4(o); *(u32x4*)(ACT + (size_t)(256 * pm + r) * DFF + f - 4) = (u32x4){hold[ai][m].x, hold[ai][m].y, hi.x, hi.y}; }
                    if (smp) {
                        if (r == 0) { *(f32x4*)(SB + (size_t)(0 * 8 + sidx) * DFF + f) = g; if (has_prev) { *(f32x4*)(SB + (size_t)(2 * 8 + sidx) * DFF + f) = xs; *(f32x4*)(SB + (size_t)(3 * 8 + sidx) * DFF + f) = uu; } }
                        if (r == 255) { *(f32x4*)(SB + (size_t)(1 * 8 + sidx) * DFF + f) = g; if (has_next) { *(f32x4*)(SB + (size_t)(4 * 8 + sidx) * DFF + f) = xs; *(f32x4*)(SB + (size_t)(5 * 8 + sidx) * DFF + f) = uu; } }
                    }
                }
            }
        }
    }
};
template <class Sched>
__device__ __forceinline__ void ffn_seam_fixup(const Sched& S, int rows_per_unit, bf16* ACT, const float* cw, const float* SB) {
    pg8::Unit u;
    for (int i = 0; S.next(i, u); ++i) {
        const int lo = u.pm * rows_per_unit, hi = lo + rows_per_unit;
        if (hi <= NPR) continue;
        int t0 = threadIdx.x; asm volatile("" : "+v"(t0));
        for (int sidx = 0; sidx < 8; ++sidx) {
            const int sq = sidx & 3, r0 = 256 * (32 + sidx), r1 = r0 + 255;
            const bool fix0 = sq > 0 && r0 >= lo && r0 < hi, fix1 = sq < 3 && r1 >= lo && r1 < hi;
            if (!fix0 && !fix1) continue;
            for (int f = t0; f < DFF; f += 512) {
                if (fix0) { const float x = SB[(size_t)(2 * 8 + sidx) * DFF + f] + cw[f] * SB[(size_t)(1 * 8 + sidx - 1) * DFF + f]; ACT[(size_t)r0 * DFF + f] = f2bf(silu_mul(x, SB[(size_t)(3 * 8 + sidx) * DFF + f])); }
                if (fix1) { const float x = SB[(size_t)(4 * 8 + sidx) * DFF + f] + cw[2 * DFF + f] * SB[(size_t)(0 * 8 + sidx + 1) * DFF + f]; ACT[(size_t)r1 * DFF + f] = f2bf(silu_mul(x, SB[(size_t)(5 * 8 + sidx) * DFF + f])); }
            }
        }
    }
    asm volatile("s_waitcnt vmcnt(0)" ::: "memory");
    __syncthreads();
}

struct DftOrder {
    int G, c; const char* A; const char* BtS; const char* BtP;
    __device__ bool next(int i, pg8::Unit& u) const {
        const int j = i * G + c; if (j >= 160) return false;
        u.pm = 0; u.a = A;
        if (j < 32) { const int b = j >> 4, p = (j >> 2) & 3, pn = j & 3; u.pn = pn; u.z = NPR + b * 1024 + p; u.b = BtS + ((size_t)(b * 4 + p) * 1024 + pn * 256) * 512 * 2; }
        else { const int q = j - 32, b = q >> 2, pn = q & 3; u.pn = pn; u.z = b * 256; u.b = BtP + ((size_t)b * 1024 + pn * 256) * 512 * 2; }
        return true;
    }
};
struct EpiDft {
    bf16* O;
    static constexpr bool ALIGN = false;
    __device__ __forceinline__ void operator()(const f32x4 (&acc)[2][2][4][2], const pg8::Unit& u, int wr, int wc, int fr, int fq) const {
        const int st = u.z >= NPR ? 4 : 1;
#pragma unroll
        for (int ai = 0; ai < 2; ++ai)
#pragma unroll
            for (int m = 0; m < 4; ++m)
#pragma unroll
                for (int bj = 0; bj < 2; ++bj) { const int r = wr * 64 + fr + ai * 128 + m * 16, col = u.pn * 256 + bj * 128 + wc * 32 + 8 * fq;
                    const u32x2 a = pk4(acc[ai][bj][m][0]), b = pk4(acc[ai][bj][m][1]); *(u32x4*)(O + (size_t)(u.z + st * r) * 1024 + col) = (u32x4){a.x, a.y, b.x, b.y}; }
    }
};

__device__ __forceinline__ f32x16 mfma32(bf16x8 x, bf16x8 y, f32x16 c) { return __builtin_amdgcn_mfma_f32_32x32x16_bf16(x, y, c, 0, 0, 0); }
__device__ __forceinline__ void phase_attention(const Args& a, LAS unsigned char* lds, int bid, int G) {
    int tid = threadIdx.x; asm volatile("" : "+v"(tid));
    const int lane = tid & 63, wave = __builtin_amdgcn_readfirstlane(tid >> 6), tk = lane & 31, hh = lane >> 5;
    const float cs = 0.125f * 1.4426950408889634f;
    const bf16* Q = WSB(WS_Q);
    bf16* AB = WSB(WS_XN);
    const float* subln = FIN(I_SUBLN);
    constexpr int KST = 136, VST = 40;
    LAS bf16* Kl = (LAS bf16*)lds;
    LAS bf16* Vl = (LAS bf16*)(lds + 2 * 32 * KST * 2);
    LAS bf16* Ql = (LAS bf16*)(lds + 40960 + wave * 8192);
    const int lkey = tid >> 4, lkc = tid & 15, lvd = tid >> 2, lvc = tid & 3;
    const int tkp = (tk & 19) | ((tk & 4) << 1) | ((tk & 8) >> 1);
    for (int ai = 0; ai < 2; ++ai) {
        int item;
        if (G == 256) {
            if (bid >= 224) item = ai == 0 ? bid - 224 : -1;
            else if (bid >= 160) item = 32 + 2 * (bid - 160) + ai;
            else item = -1;
        } else item = bid + ai * G;
        if (item < 0 || item >= 160) continue;
        int b, h, nkeys, qrow0; const bf16 *Kb, *VT;
        if (item < 32) { b = item >> 4; h = (item >> 2) & 3; const int qb = item & 3; nkeys = LKS; qrow0 = NPR + b * 1024 + qb * 256 + wave * 32; Kb = WSB(WS_KS) + (size_t)b * LKS * 512; VT = WSB(WS_VTS) + (size_t)(b * 4 + h) * 128 * LKS; }
        else { const int j = item - 32; b = j >> 2; h = j & 3; nkeys = SEQ; qrow0 = b * 256 + wave * 32; Kb = WSB(WS_KP) + (size_t)b * 256 * 512; VT = WSB(WS_VTP) + (size_t)(b * 4 + h) * 128 * SEQ; }
        f32x16 O[2][4];
#pragma unroll
        for (int m = 0; m < 2; ++m)
#pragma unroll
            for (int mt = 0; mt < 4; ++mt)
#pragma unroll
                for (int r = 0; r < 16; ++r) O[m][mt][r] = 0.f;
        float mx[2] = {-1e30f, -1e30f}, ls[2] = {0.f, 0.f};
        const bf16* kg = Kb + (size_t)lkey * 512 + h * 128 + lkc * 8;
        const bf16* vg = VT + (size_t)lvd * nkeys + lvc * 8;
        __syncthreads();
#pragma unroll
        for (int m = 0; m < 2; ++m)
#pragma unroll
            for (int s = 0; s < 4; ++s) *(LAS bf16x8*)(Ql + ((m * 4 + s) * 64 + lane) * 8) = *(const bf16x8*)(Q + (size_t)(qrow0 + tk) * 512 + h * 128 + m * 64 + 16 * s + 8 * hh);
        { const u32x4 k0v = *(const u32x4*)kg, v0v = *(const u32x4*)vg;
          *(LAS u32x4*)(Kl + lkey * KST + lkc * 8) = k0v; *(LAS u32x4*)(Vl + lvd * VST + lvc * 8) = v0v; }
        const int nt = nkeys / 32;
        for (int t = 0; t < nt; ++t) {
            const int cur = t & 1;
            const bool more = t + 1 < nt;
            u32x4 kn = {0u, 0u, 0u, 0u}, vn = kn;
            if (more) { kn = *(const u32x4*)(kg + (size_t)(t + 1) * 32 * 512); vn = *(const u32x4*)(vg + (t + 1) * 32); }
            __syncthreads();
            const LAS bf16* Kc = Kl + cur * 32 * KST + tk * KST + 8 * hh;
            const LAS bf16* Vc = Vl + cur * 128 * VST + tkp * VST + 8 * hh;
            bf16x8 pb[2][2];
#pragma unroll
            for (int m = 0; m < 2; ++m) {
                f32x16 S;
#pragma unroll
                for (int r = 0; r < 16; ++r) S[r] = 0.f;
#pragma unroll
                for (int s = 0; s < 4; ++s) { const bf16x8 kf = *(const LAS bf16x8*)(Kc + m * 64 + 16 * s); const bf16x8 qfr = *(const LAS bf16x8*)(Ql + ((m * 4 + s) * 64 + lane) * 8); S = mfma32(kf, qfr, S); }
                float tm = S[0];
#pragma unroll
                for (int r = 1; r < 16; ++r) tm = fmaxf(tm, S[r]);
                tm = fmaxf(tm, __shfl_xor(tm, 32));
                if (__any(tm > mx[m] + 44.0f)) {
                    const float mn = fmaxf(mx[m], tm), alpha = __builtin_amdgcn_exp2f((mx[m] - mn) * cs); mx[m] = mn;
                    ls[m] *= alpha;
#pragma unroll
                    for (int mt = 0; mt < 4; ++mt)
#pragma unroll
                        for (int r = 0; r < 16; ++r) O[m][mt][r] *= alpha;
                }
                const float mcur = mx[m];
                float ps = 0.f;
#pragma unroll
                for (int r = 0; r < 16; ++r) { S[r] = __builtin_amdgcn_exp2f((S[r] - mcur) * cs); ps += S[r]; }
                ls[m] += ps;
#pragma unroll
                for (int s2 = 0; s2 < 2; ++s2) { u32x4 w; w.x = pk2(S[8 * s2 + 0], S[8 * s2 + 1]); w.y = pk2(S[8 * s2 + 2], S[8 * s2 + 3]); w.z = pk2(S[8 * s2 + 4], S[8 * s2 + 5]); w.w = pk2(S[8 * s2 + 6], S[8 * s2 + 7]); pb[m][s2] = __builtin_bit_cast(bf16x8, w); }
            }
#pragma unroll
            for (int mt = 0; mt < 4; ++mt) {
#pragma unroll
                for (int s2 = 0; s2 < 2; ++s2) { const bf16x8 vf = *(const LAS bf16x8*)(Vc + 32 * mt * VST + 16 * s2);
                    O[0][mt] = mfma32(vf, pb[0][s2], O[0][mt]); O[1][mt] = mfma32(vf, pb[1][s2], O[1][mt]); }
            }
            if (more) { *(LAS u32x4*)(Kl + (cur ^ 1) * 32 * KST + lkey * KST + lkc * 8) = kn; *(LAS u32x4*)(Vl + (cur ^ 1) * 128 * VST + lvd * VST + lvc * 8) = vn; }
        }
        const float l0 = ls[0] + __shfl_xor(ls[0], 32), l1 = ls[1] + __shfl_xor(ls[1], 32);
        const float lam = WSF(WS_LAM)[0];
        const float i0 = 1.f / l0, i1 = lam / l1;
        float ss = 0.f;
#pragma unroll
        for (int mt = 0; mt < 4; ++mt)
#pragma unroll
            for (int r = 0; r < 16; ++r) { const float o = O[0][mt][r] * i0 - O[1][mt][r] * i1; O[0][mt][r] = o; ss += o * o; }
        ss += __shfl_xor(ss, 32);
        const float rinv = rsqrtf(ss * (1.f / 128.f) + 1e-6f) * 0.8f;
        bf16* dst = AB + (size_t)(qrow0 + tk) * 1024 + h * 128;
#pragma unroll
        for (int mt = 0; mt < 4; ++mt)
#pragma unroll
            for (int j = 0; j < 2; ++j) { const int d = 32 * mt + 16 * j + 8 * hh; const f32x4 g0 = *(const f32x4*)(subln + d), g1 = *(const f32x4*)(subln + d + 4);
                f32x4 o0, o1; o0[0] = O[0][mt][8 * j + 0] * rinv * g0[0]; o0[1] = O[0][mt][8 * j + 1] * rinv * g0[1]; o0[2] = O[0][mt][8 * j + 2] * rinv * g0[2]; o0[3] = O[0][mt][8 * j + 3] * rinv * g0[3];
                o1[0] = O[0][mt][8 * j + 4] * rinv * g1[0]; o1[1] = O[0][mt][8 * j + 5] * rinv * g1[1]; o1[2] = O[0][mt][8 * j + 6] * rinv * g1[2]; o1[3] = O[0][mt][8 * j + 7] * rinv * g1[3];
                const u32x2 p0 = pk4(o0), p1 = pk4(o1); u32x4 w; w.x = p0.x; w.y = p0.y; w.z = p1.x; w.w = p1.y;
                *(u32x4*)(dst + d) = w; }
    }
}

__device__ __forceinline__ float allred4(float x) {
    { auto r = __builtin_amdgcn_permlane16_swap(__float_as_uint(x), __float_as_uint(x), false, false); x = __uint_as_float(r[0]) + __uint_as_float(r[1]); }
    { auto r = __builtin_amdgcn_permlane32_swap(__float_as_uint(x), __float_as_uint(x), false, false); x = __uint_as_float(r[0]) + __uint_as_float(r[1]); }
    return x;
}

constexpr int OPS_KGRG = 0, OPS_KDBD = 4096, OPS_CINIT = 8192, OPS_VIMG = 12288, OPS_GAM = 14336, OPS_ITEM = 14592;
constexpr size_t WS_OPS = WS_MF;
static_assert(WS_OPS + (size_t)2 * 5120 * OPS_ITEM <= WS_Q, "ws ops");
__device__ __forceinline__ f32x4 mfma16(bf16x8 x, bf16x8 y, f32x4 c) { return __builtin_amdgcn_mfma_f32_16x16x32_bf16(x, y, c, 0, 0, 0); }
__device__ __forceinline__ bf16x8 frag_lo(f32x4 v) { u32x4 w; w.x = pk2(v[0], v[1]); w.y = pk2(v[2], v[3]); w.z = 0u; w.w = 0u; return __builtin_bit_cast(bf16x8, w); }
__device__ __forceinline__ void wave_lds_sync() { __syncthreads(); }


template <bool REV>
__device__ __forceinline__ void wkv_chunk_ops(unsigned char* ops, LAS unsigned char* wl, int lane, const float (&kkn)[16], const float (&wv)[16], const float (&kraw)[16], const float (&ad)[16], const float ka_, const float (&rr)[16], const unsigned (&vp)[8]) {
    int lane_ = lane; asm volatile("" : "+v"(lane_));
    const int lr = lane_ & 15, lg = lane_ >> 4, j = lane_;
    LAS bf16* KgR = (LAS bf16*)wl; LAS bf16* RgR = KgR + 16 * 72; LAS bf16* KiR = RgR + 16 * 72; LAS bf16* BiR = KiR + 16 * 72;
    LAS bf16* KgT = (LAS bf16*)(wl + 9216); LAS float* RgT = (LAS float*)(wl + 9216 + 2048); LAS bf16* VT = (LAS bf16*)(wl + 9216 + 2048 + 5120);
    LAS float* NL = (LAS float*)wl; LAS float* TL = (LAS float*)(wl + 2304);
    float gall = 1.f;
#pragma unroll
    for (int t = 0; t < 16; ++t) gall *= wv[t];
    *(float*)(ops + OPS_GAM + 4 * j) = gall;
    float grun = 1.f;
#pragma unroll
    for (int g = 0; g < 4; ++g) {
        float kdv[4], bdv[4]; unsigned vb4[4];
#pragma unroll
        for (int e = 0; e < 4; ++e) {
            const int tau = 4 * g + e, t = REV ? 15 - tau : tau;
            const float gprev = grun; grun *= wv[t];
            const float inv = __builtin_amdgcn_rcpf(grun);
            const float kg = kkn[t] * gprev, rg = rr[t] * grun, ki = kraw[t] * (1.f + (ad[t] - 1.f) * ka_) * inv, bi = kkn[t] * ad[t] * inv;
            kdv[e] = ki * gall; bdv[e] = -bi * gall; vb4[e] = (vp[t >> 1] >> (16 * (t & 1))) & 0xffffu;
            KgR[tau * 72 + j] = f2bf(kg); RgR[tau * 72 + j] = f2bf(rg); KiR[tau * 72 + j] = f2bf(ki); BiR[tau * 72 + j] = f2bf(bi);
            KgT[(g * 64 + j) * 4 + e] = f2bf(kg); RgT[j * 20 + tau] = rg; VT[(g * 64 + j) * 4 + e] = (bf16)vb4[e];
        }
        u32x4 w; w.x = pk2(kdv[0], kdv[1]); w.y = pk2(kdv[2], kdv[3]); w.z = pk2(bdv[0], bdv[1]); w.w = pk2(bdv[2], bdv[3]);
        *(u32x4*)(ops + OPS_KDBD + (((j >> 4) * 64 + (j & 15) + 16 * g) * 16)) = w;
        u32x2 vw; vw.x = vb4[0] | (vb4[1] << 16); vw.y = vb4[2] | (vb4[3] << 16);
        *(u32x2*)(ops + OPS_VIMG + (((j >> 4) * 64 + (j & 15) + 16 * g) * 8)) = vw;
    }
    wave_lds_sync();
    f32x4 akk = {0.f, 0.f, 0.f, 0.f}, akb = akk, ark = akk, arb = akk;
#pragma unroll
    for (int ks = 0; ks < 2; ++ks) {
        const bf16x8 fki = *(const LAS bf16x8*)(KiR + lr * 72 + 32 * ks + 8 * lg), fbi = *(const LAS bf16x8*)(BiR + lr * 72 + 32 * ks + 8 * lg);
        const bf16x8 fkg = *(const LAS bf16x8*)(KgR + lr * 72 + 32 * ks + 8 * lg), frg = *(const LAS bf16x8*)(RgR + lr * 72 + 32 * ks + 8 * lg);
        akk = mfma16(fki, fkg, akk); akb = mfma16(fbi, fkg, akb); ark = mfma16(fki, frg, ark); arb = mfma16(fbi, frg, arb);
    }
#pragma unroll
    for (int e = 0; e < 4; ++e) { const int s = 4 * lg + e; if (!(s < lr)) { akk[e] = 0.f; akb[e] = 0.f; } if (!(s <= lr)) { ark[e] = 0.f; arb[e] = 0.f; } }
    asm volatile("" : "+v"(akk), "+v"(akb), "+v"(ark), "+v"(arb));
    wave_lds_sync();
    *(LAS f32x4*)(NL + lr * 16 + 4 * lg) = akb;
    wave_lds_sync();
    {
        float Tc[16];
#pragma unroll
        for (int t = 0; t < 16; ++t) {
            float acc = (t == lr) ? 1.f : 0.f;
#pragma unroll
            for (int q4 = 0; q4 < (t + 3) / 4; ++q4) { const f32x4 nv = *(const LAS f32x4*)(NL + t * 16 + 4 * q4);
#pragma unroll
                for (int e = 0; e < 4; ++e) if (4 * q4 + e < t) acc -= nv[e] * Tc[4 * q4 + e]; }
            Tc[t] = acc;
        }
        if (lg == 0) {
#pragma unroll
            for (int t = 0; t < 16; ++t) TL[t * 16 + lr] = Tc[t];
        }
    }
    wave_lds_sync();
    const bf16x8 aT = frag_lo(*(const LAS f32x4*)(TL + lr * 16 + 4 * lg));
    const bf16x8 aKK = frag_lo(akk), aRK = frag_lo(ark), aRBn = frag_lo(-arb);
    const f32x4 z4 = {0.f, 0.f, 0.f, 0.f};
#pragma unroll
    for (int it = 0; it < 4; ++it) {
        const u32x2 vq = *(const LAS u32x2*)(VT + (lg * 64 + 16 * it + lr) * 4);
        const bf16x8 bV = __builtin_bit_cast(bf16x8, (u32x4){vq.x, vq.y, 0u, 0u});
        const f32x4 x1 = mfma16(aKK, bV, z4);
        const f32x4 vd = mfma16(aT, frag_lo(x1), z4);
        f32x4 yl = mfma16(aRK, bV, z4); yl = mfma16(aRBn, frag_lo(vd), yl);
        { const u32x2 pv = pk4(vd), py = pk4(yl); *(u32x4*)(ops + OPS_CINIT + (it * 64 + lane) * 16) = (u32x4){pv.x, pv.y, py.x, py.y}; }
    }
#pragma unroll
    for (int jt = 0; jt < 4; ++jt) {
        const u32x2 kq = *(const LAS u32x2*)(KgT + (lg * 64 + 16 * jt + lr) * 4);
        const bf16x8 bK = __builtin_bit_cast(bf16x8, (u32x4){kq.x, kq.y, 0u, 0u});
        const f32x4 kgp = mfma16(aT, bK, z4);
        const f32x4 rgp = mfma16(aRBn, frag_lo(kgp), *(const LAS f32x4*)(RgT + (16 * jt + lr) * 20 + 4 * lg));
#pragma unroll
        for (int e = 0; e < 4; ++e) { KiR[(4 * lg + e) * 72 + 16 * jt + lr] = f2bf(kgp[e]); BiR[(4 * lg + e) * 72 + 16 * jt + lr] = f2bf(rgp[e]); }
    }
    wave_lds_sync();
#pragma unroll
    for (int rt = 0; rt < 2; ++rt)
#pragma unroll
        for (int ks = 0; ks < 2; ++ks) {
            const LAS bf16* I = (rt ? BiR : KiR) + lr * 72 + 32 * ks + 4 * lg;
            const u32x2 lo = *(const LAS u32x2*)I, hi = *(const LAS u32x2*)(I + 16);
            *(u32x4*)(ops + OPS_KGRG + ((rt * 2 + ks) * 64 + lane_) * 16) = (u32x4){lo.x, lo.y, hi.x, hi.y};
        }
    wave_lds_sync();
}

__device__ __forceinline__ void phase_wkv_front(const Args& a, LAS unsigned char* lds, int bid, int G) {
    int tid = threadIdx.x; asm volatile("" : "+v"(tid));
    const int lane = tid & 63, wave = __builtin_amdgcn_readfirstlane(tid >> 6);
    constexpr int AST = 392;
    typedef const __attribute__((address_space(1))) bf16* gcb;
    const bf16* FB = (const bf16*)a.out;
    LAS bf16* act = (LAS bf16*)(lds + ACT_OFF);
    LAS unsigned char* wl = lds + wave * 18432;
    LAS float* TR = (LAS float*)wl;
    const float* mu = FIN(I_MU); const float* kvec = FIN(I_KVEC); const float* w0 = FIN(I_W0); const float* a0 = FIN(I_A0);
    bf16* AB = WSB(WS_XN); bf16* BON = WSB(WS_BONUS);
    int it_lo, it_n;
    if (G == 256) { if (bid < 160) { it_lo = 3 * bid; it_n = 3; } else if (bid < 224) { it_lo = 480 + 2 * (bid - 160); it_n = 2; } else { it_lo = 608 + (bid - 224); it_n = 1; } }
    else { it_lo = bid; it_n = (640 - bid + G - 1) / G; }
    for (int ii = 0; ii < it_n; ++ii) {
        const int item = (G == 256) ? it_lo + ii : it_lo + ii * G;
        int smp, sq, c, L, rowbase, nc;
        if (item < 128) { smp = 1; sq = item >> 6; c = item & 63; L = DSEQ; rowbase = NPR + sq * DSEQ; nc = 64; }
        else { const int p = item - 128; smp = 0; sq = p >> 4; c = p & 15; L = SEQ; rowbase = sq * SEQ; nc = 16; }
        const int row0 = rowbase + 16 * c, tp0 = 16 * c;
        __syncthreads();
        int tq = tid; asm volatile("" : "+v"(tq));
        for (int idx = tq; idx < 16 * 96; idx += 512) {
            const int tl = idx / 96, cg = idx - tl * 96, col = 1536 + 4 * cg, row = row0 + tl, tp = tp0 + tl;
            const f32x4 f = unpk4(*(const u32x2*)(FB + (size_t)row * INB + col));
            const f32x4 p = unpk4(*(const u32x2*)(FB + (size_t)(tp > 0 ? row - 1 : row) * INB + col)) * (tp > 0 ? 1.f : 0.f);
            const f32x4 n = unpk4(*(const u32x2*)(FB + (size_t)(tp < L - 1 ? row + 1 : row) * INB + col)) * (tp < L - 1 ? 1.f : 0.f);
            const f32x4 m0 = *(const f32x4*)(mu + col), m1 = *(const f32x4*)(mu + INB + col);
            f32x4 s = f + m0 * (p - f) + m1 * (n - f);
            const int kind = cg >> 5;
            if (kind == 0) { s[0] = tanhf(s[0]); s[1] = tanhf(s[1]); s[2] = tanhf(s[2]); s[3] = tanhf(s[3]); }
            else if (kind == 2) { s[0] = sigmoidf_(s[0]); s[1] = sigmoidf_(s[1]); s[2] = sigmoidf_(s[2]); s[3] = sigmoidf_(s[3]); }
            *(LAS u32x2*)(act + tl * AST + 4 * cg) = pk4(s);
        }
        __syncthreads();
        int j = lane; asm volatile("" : "+v"(j));
        const int lr = j & 15, lg = j >> 4;
        const int h = wave, col = h * 64 + j;
        auto lora_mma = [&](const bf16* WT, int ldk, int k0, int nks, f32x4 (&acc)[4]) {
            gcb wb = (gcb)(WT + (size_t)(h * 64 + lr) * ldk + 8 * lg);
            const LAS bf16* ab = act + lr * AST + k0 + 8 * lg;
            asm volatile("" : "+v"(wb), "+v"(ab));
#pragma unroll
            for (int jt = 0; jt < 4; ++jt) acc[jt] = (f32x4){0.f, 0.f, 0.f, 0.f};
            for (int ks = 0; ks < nks; ++ks) {
                const bf16x8 fa = *(const LAS bf16x8*)(ab + 32 * ks);
#pragma unroll
                for (int jt = 0; jt < 4; ++jt) { const bf16x8 fb = *(const __attribute__((address_space(1))) bf16x8*)(wb + (size_t)(16 * jt) * ldk + 32 * ks); acc[jt] = mfma16(fa, fb, acc[jt]); }
            }
        };
        auto tr_put = [&](int b, const f32x4 (&acc)[4]) {
#pragma unroll
            for (int jt = 0; jt < 4; ++jt) *(LAS f32x4*)(TR + b * 1280 + (16 * jt + lr) * 20 + 4 * lg) = acc[jt];
        };
        auto tr_get = [&](int b, float (&out)[16]) {
#pragma unroll
            for (int q = 0; q < 4; ++q) { const f32x4 x = *(const LAS f32x4*)(TR + b * 1280 + j * 20 + 4 * q); out[4 * q] = x[0]; out[4 * q + 1] = x[1]; out[4 * q + 2] = x[2]; out[4 * q + 3] = x[3]; }
        };
        f32x4 accG[4], accA0[4], accA1[4], accW0[4];
        lora_mma(WSB(WS_G2T), 128, 256, 4, accG);
        lora_mma(WSB(WS_A2T), 64, 128, 2, accA0);
        lora_mma(WSB(WS_A2T) + 512 * 64, 64, 192, 2, accA1);
        lora_mma(WSB(WS_W2T), 64, 0, 2, accW0);
        float r[16], k[16]; unsigned vp[8];
        {
            unsigned raw[3][18]; float v[16];
#pragma unroll
            for (int x = 0; x < 3; ++x)
#pragma unroll
                for (int q = 0; q < 18; ++q) { const int tp = tp0 - 1 + q; const int rw = row0 - 1 + q + (tp < 0 ? 1 : 0) - (tp > L - 1 ? 1 : 0); raw[x][q] = FB[(size_t)rw * INB + 512 * x + col]; }
            const float pm = tp0 > 0 ? 1.f : 0.f, nm = tp0 + 16 < L ? 1.f : 0.f;
            const float mr0 = mu[col], mr1 = mu[INB + col], mk0 = mu[512 + col], mk1 = mu[INB + 512 + col], mv0 = mu[1024 + col], mv1 = mu[INB + 1024 + col];
#pragma unroll
            for (int t = 0; t < 16; ++t) {
                const float pmask = t == 0 ? pm : 1.f, nmask = t == 15 ? nm : 1.f;
                { const float f = bf2f(raw[0][t + 1]), p = bf2f(raw[0][t]) * pmask, n = bf2f(raw[0][t + 2]) * nmask; r[t] = f + mr0 * (p - f) + mr1 * (n - f); }
                { const float f = bf2f(raw[1][t + 1]), p = bf2f(raw[1][t]) * pmask, n = bf2f(raw[1][t + 2]) * nmask; k[t] = f + mk0 * (p - f) + mk1 * (n - f); }
                { const float f = bf2f(raw[2][t + 1]), p = bf2f(raw[2][t]) * pmask, n = bf2f(raw[2][t + 2]) * nmask; v[t] = f + mv0 * (p - f) + mv1 * (n - f); }
            }
#pragma unroll
            for (int q = 0; q < 8; ++q) vp[q] = pk2(v[2 * q], v[2 * q + 1]);
        }
        float av0[16], av1[16];
        {
            float graw[16];
            tr_put(0, accG); tr_put(1, accA0); tr_put(2, accA1);
            wave_lds_sync();
            tr_get(0, graw); tr_get(1, av0); tr_get(2, av1);
            wave_lds_sync();
#pragma unroll
            for (int t = 0; t < 16; ++t) AB[(size_t)(row0 + t) * 1024 + 512 + col] = f2bf(graw[t]);
        }
        float wv0[16];
        {
            tr_put(0, accW0);
            wave_lds_sync();
            tr_get(0, wv0);
            wave_lds_sync();
            const float w00 = w0[col];
#pragma unroll
            for (int t = 0; t < 16; ++t) wv0[t] = __expf(-0.60653065971f * sigmoidf_(w00 + wv0[t]));
        }
        const float kk_ = kvec[col], ka_ = kvec[512 + col], rk_ = kvec[1024 + col], a00 = a0[col], a01 = a0[512 + col];
        float kkn[16];
        {
            LAS float* RED1 = (LAS float*)wl; LAS float* RED2 = RED1 + 64 * 17; LAS float* TOT = RED2 + 64 * 17;
#pragma unroll
            for (int t = 0; t < 16; ++t) {
                av0[t] = sigmoidf_(a00 + av0[t]); av1[t] = sigmoidf_(a01 + av1[t]);
                const float kr = k[t] * kk_; kkn[t] = kr;
                RED1[j * 17 + t] = kr * kr; RED2[j * 17 + t] = r[t] * rk_ * k[t] * (2.f + (av0[t] + av1[t] - 2.f) * ka_);
            }
            wave_lds_sync();
            float s1 = 0.f, s2 = 0.f;
#pragma unroll
            for (int jj = 0; jj < 16; ++jj) { s1 += RED1[(16 * lg + jj) * 17 + lr]; s2 += RED2[(16 * lg + jj) * 17 + lr]; }
            s1 = allred4(s1); s2 = allred4(s2);
            if (lg == 0) { TOT[lr] = rsqrtf(s1 + 1e-12f); TOT[16 + lr] = s2; }
            wave_lds_sync();
#pragma unroll
            for (int q = 0; q < 4; ++q) { const f32x4 ri = *(const LAS f32x4*)(TOT + 4 * q), rs = *(const LAS f32x4*)(TOT + 16 + 4 * q);
#pragma unroll
                for (int e = 0; e < 4; ++e) { const int t = 4 * q + e; kkn[t] *= ri[e]; BON[(size_t)(row0 + t) * 512 + col] = f2bf(rs[e] * __uint_as_float((t & 1) ? (vp[t >> 1] & 0xffff0000u) : (vp[t >> 1] << 16))); } }
            wave_lds_sync();
        }
        {
            const int oi = smp ? 4096 + (sq * 8 + h) * 64 + c : (sq * 8 + h) * 16 + c;
            wkv_chunk_ops<false>(a.ws + WS_OPS + (size_t)oi * OPS_ITEM, wl, lane, kkn, wv0, k, av0, ka_, r, vp);
        }
        {
            float wv1[16];
            { f32x4 accW1[4]; lora_mma(WSB(WS_W2T) + 512 * 64, 64, 64, 2, accW1); tr_put(0, accW1); wave_lds_sync(); tr_get(0, wv1); wave_lds_sync();
              const float w01 = w0[512 + col];
#pragma unroll
              for (int t = 0; t < 16; ++t) wv1[t] = __expf(-0.60653065971f * sigmoidf_(w01 + wv1[t])); }
            const int cc = nc - 1 - c;
            const int oi = 5120 + (smp ? 4096 + (sq * 8 + h) * 64 + cc : (sq * 8 + h) * 16 + cc);
            wkv_chunk_ops<true>(a.ws + WS_OPS + (size_t)oi * OPS_ITEM, wl, lane, kkn, wv1, k, av1, ka_, r, vp);
        }
    }
}

struct ChainOps { bf16x8 kgrg[2][2]; u32x4 cinit; bf16x8 kdbd[4]; u32x2 vimg; f32x4 gam[4]; };
__device__ __forceinline__ void chain_load(ChainOps& o, const unsigned char* ops, int lane, int it) {
    const int lg = lane >> 4;
#pragma unroll
    for (int rt = 0; rt < 2; ++rt) {
#pragma unroll
        for (int ks = 0; ks < 2; ++ks) o.kgrg[rt][ks] = *(const bf16x8*)(ops + OPS_KGRG + ((rt * 2 + ks) * 64 + lane) * 16);
    }
    o.cinit = *(const u32x4*)(ops + OPS_CINIT + (it * 64 + lane) * 16);
#pragma unroll
    for (int jt = 0; jt < 4; ++jt) { o.kdbd[jt] = *(const bf16x8*)(ops + OPS_KDBD + (jt * 64 + lane) * 16); o.gam[jt] = *(const f32x4*)(ops + OPS_GAM + (16 * jt + 4 * lg) * 4); }
    o.vimg = *(const u32x2*)(ops + OPS_VIMG + (it * 64 + lane) * 8);
}
__device__ __forceinline__ void wkv_sample_wave(const Args& a, LAS float* ybuf, int idx, int lane) {
    const int lr = lane & 15, lg = lane >> 4;
    const int dir = idx >> 6, ch = (idx >> 2) & 15, it = idx & 3;
    const int b = ch >> 3, h = ch & 7, nc = 64, L = DSEQ, rowbase = NPR + b * DSEQ, opsbase = 4096 + ch * 64;
    float* Y = a.out;
    f32x4 H[4];
    { const float* sp = FIN(I_ST) + (size_t)((b * 2 + dir) * 8 + h) * 4096;
#pragma unroll
      for (int jt = 0; jt < 4; ++jt) H[jt] = *(const f32x4*)(sp + (16 * it + lr) * 64 + 16 * jt + 4 * lg); }
    const unsigned char* opsp = a.ws + WS_OPS + (size_t)(dir * 5120 + opsbase) * OPS_ITEM;
    float* yg = Y + ((size_t)dir * NT + rowbase) * 512 + h * 64 + 16 * it + 4 * (lane & 3);
    ChainOps o0, o1;
    chain_load(o0, opsp, lane, it);
    chain_load(o1, opsp + OPS_ITEM, lane, it);
    auto step = [&](const ChainOps& cur, int c) {
        bf16x8 bh[2];
#pragma unroll
        for (int ks = 0; ks < 2; ++ks) { const u32x2 p0 = pk4(H[2 * ks]), p1 = pk4(H[2 * ks + 1]); bh[ks] = __builtin_bit_cast(bf16x8, (u32x4){p0.x, p0.y, p1.x, p1.y}); }
        f32x4 u = unpk4((u32x2){cur.cinit.x, cur.cinit.y}), y = unpk4((u32x2){cur.cinit.z, cur.cinit.w});
#pragma unroll
        for (int ks = 0; ks < 2; ++ks) { u = mfma16(cur.kgrg[0][ks], bh[ks], u); y = mfma16(cur.kgrg[1][ks], bh[ks], y); }
#pragma unroll
        for (int e = 0; e < 4; ++e) ybuf[(16 * (c & 15) + 4 * lg + e) * 16 + lr] = y[e];
        const u32x2 up = pk4(u);
        const bf16x8 bvu = __builtin_bit_cast(bf16x8, (u32x4){cur.vimg.x, cur.vimg.y, up.x, up.y});
#pragma unroll
        for (int jt = 0; jt < 4; ++jt) H[jt] = mfma16(cur.kdbd[jt], bvu, H[jt] * cur.gam[jt]);
    };
    auto flush = [&](int c) {
        if ((c & 15) == 15) {
            asm volatile("s_waitcnt lgkmcnt(0)" ::: "memory");
            const int base = 256 * (c >> 4);
#pragma unroll 1
            for (int r0 = 0; r0 < 256; r0 += 16) { const int lt = base + r0 + (lane >> 2);
                *(f32x4*)(yg + (size_t)(dir ? L - 1 - lt : lt) * 512) = *(const LAS f32x4*)(ybuf + (r0 + (lane >> 2)) * 16 + 4 * (lane & 3)); }
            asm volatile("s_waitcnt lgkmcnt(0)" ::: "memory");
        }
    };
    ChainOps o2; chain_load(o2, opsp + 2 * OPS_ITEM, lane, it);
    int c = 0;
#pragma unroll 1
    for (; c + 2 < nc; c += 3) {
        step(o0, c); chain_load(o0, opsp + (size_t)(c + 3 < nc ? c + 3 : nc - 1) * OPS_ITEM, lane, it); flush(c);
        step(o1, c + 1); chain_load(o1, opsp + (size_t)(c + 4 < nc ? c + 4 : nc - 1) * OPS_ITEM, lane, it); flush(c + 1);
        step(o2, c + 2); chain_load(o2, opsp + (size_t)(c + 5 < nc ? c + 5 : nc - 1) * OPS_ITEM, lane, it); flush(c + 2);
    }
    for (; c < nc; ++c) { step(o0, c); flush(c); }
    asm volatile("s_waitcnt vmcnt(0) lgkmcnt(0)" ::: "memory");
}

struct ChainSh { bf16x8 kg, kd; float gm; };
struct ChainPr { u32x4 ci; u32x2 vi; };
__device__ __forceinline__ void chain_sh(ChainSh& o, const unsigned char* ops, int lane, int it) {
    o.kg = *(const bf16x8*)(ops + OPS_KGRG + (it * 64 + lane) * 16);
    o.kd = *(const bf16x8*)(ops + OPS_KDBD + (it * 64 + lane) * 16);
    o.gm = *(const float*)(ops + OPS_GAM + (16 * it + (lane & 15)) * 4);
}
__device__ __forceinline__ void chain_pr(ChainPr& o, const unsigned char* ops, int lane, int it) {
    { int o8 = 8; asm volatile("" : "+s"(o8));
      const u32x2 lo = *(const u32x2*)(ops + OPS_CINIT + (it * 64 + lane) * 16), hi = *(const u32x2*)(ops + OPS_CINIT + (it * 64 + lane) * 16 + o8); o.ci = (u32x4){lo.x, lo.y, hi.x, hi.y}; }
    o.vi = *(const u32x2*)(ops + OPS_VIMG + (it * 64 + lane) * 8);
}
template <bool DRY = false>
__device__ __forceinline__ void phase_wkv_chain(const Args& a, LAS unsigned char* lds, int bid, int G) {
    int tid = threadIdx.x; asm volatile("" : "+v"(tid));
    const int lane = tid & 63, wave = __builtin_amdgcn_readfirstlane(tid >> 6);
    const int lr = lane & 15, lg = lane >> 4;
    float* Y = a.out;
    LAS float* ybuf = (LAS float*)(lds + wave * 16384);
    const int dir = wave >> 2, it = wave & 3;
    LAS unsigned char* slot = lds + 131072 + dir * 8448;
    const bf16* BON = WSB(WS_BONUS); bf16* AB = WSB(WS_XN);
    const float* lnx = FIN(I_LNX);
    if (G == 256 && bid < 128) {
        if (wave == 0) wkv_sample_wave(a, (LAS float*)lds, bid, lane);
        return;
    }
#pragma unroll 1
    for (int jrep = 0; ; ++jrep) {
        int k;
        if (G == 256) { if (jrep < 2) k = 16 + 2 * (bid - 128) + jrep; else break; }
        else { k = bid + jrep * G; if (k >= 272) break; }
        int smp, b, h, nc, L, rowbase, opsbase;
        if (k < 16) { smp = 1; b = k >> 3; h = k & 7; nc = 64; L = DSEQ; rowbase = NPR + b * DSEQ; opsbase = 4096 + k * 64; }
        else { const int p = k - 16; smp = 0; b = p >> 3; h = p & 7; nc = 16; L = SEQ; rowbase = b * SEQ; opsbase = p * 16; }
        f32x4 H[4];
        if (smp) {
            const float* sp = FIN(I_ST) + (size_t)((b * 2 + dir) * 8 + h) * 4096;
#pragma unroll
            for (int jt = 0; jt < 4; ++jt) H[jt] = *(const f32x4*)(sp + (16 * it + lr) * 64 + 16 * jt + 4 * lg);
        } else {
#pragma unroll
            for (int jt = 0; jt < 4; ++jt) H[jt] = (f32x4){0.f, 0.f, 0.f, 0.f};
        }
        const unsigned char* opsp = a.ws + WS_OPS + (size_t)(dir * 5120 + opsbase) * OPS_ITEM;
        float* yg = Y + ((size_t)dir * NT + rowbase) * 512 + h * 64 + 16 * it + 4 * (lane & 3);
        constexpr int D = 8;
        ChainSh sh[D]; ChainPr pr[D];
#pragma unroll
        for (int i = 0; i < D; ++i) { chain_sh(sh[i], opsp + (size_t)i * OPS_ITEM, lane, it); chain_pr(pr[i], opsp + (size_t)i * OPS_ITEM, lane, it); }
        auto put = [&](const ChainSh& o) {
            *(LAS bf16x8*)(slot + it * 1024 + lane * 16) = o.kg; *(LAS bf16x8*)(slot + 4096 + it * 1024 + lane * 16) = o.kd;
            if (lane < 16) *(LAS float*)(slot + 8192 + (16 * it + lane) * 4) = o.gm; };
        put(sh[0]);
        chain_sh(sh[0], opsp + (size_t)(D < nc ? D : nc - 1) * OPS_ITEM, lane, it);
        asm volatile("s_waitcnt lgkmcnt(0)" ::: "memory"); __builtin_amdgcn_s_barrier(); asm volatile("" ::: "memory");
#pragma unroll 1
        for (int c = 0; c < nc; c += D) {
#pragma unroll
            for (int i = 0; i < D; ++i) {
                const int cc = c + i;
                bf16x8 kgrg[2][2], kdbd[4]; f32x4 gam[4];
#pragma unroll
                for (int q = 0; q < 4; ++q) { kgrg[q >> 1][q & 1] = *(const LAS bf16x8*)(slot + q * 1024 + lane * 16); kdbd[q] = *(const LAS bf16x8*)(slot + 4096 + q * 1024 + lane * 16); gam[q] = *(const LAS f32x4*)(slot + 8192 + (16 * q + 4 * lg) * 4); }
                asm volatile("s_waitcnt lgkmcnt(0)" ::: "memory"); __builtin_amdgcn_s_barrier(); asm volatile("" ::: "memory");
                put(sh[(i + 1) % D]);
                chain_sh(sh[(i + 1) % D], opsp + (size_t)(cc + 1 + D < nc ? cc + 1 + D : nc - 1) * OPS_ITEM, lane, it);
                const u32x2 c0 = (u32x2){pr[i].ci.x, pr[i].ci.y}, c1 = (u32x2){pr[i].ci.z, pr[i].ci.w}, cv = pr[i].vi;
                bf16x8 bh[2];
#pragma unroll
                for (int ks = 0; ks < 2; ++ks) { const u32x2 p0 = pk4(H[2 * ks]), p1 = pk4(H[2 * ks + 1]); bh[ks] = __builtin_bit_cast(bf16x8, (u32x4){p0.x, p0.y, p1.x, p1.y}); }
                f32x4 u = unpk4(c0), y = unpk4(c1);
#pragma unroll
                for (int ks = 0; ks < 2; ++ks) { u = mfma16(kgrg[0][ks], bh[ks], u); y = mfma16(kgrg[1][ks], bh[ks], y); }
#pragma unroll
                for (int e = 0; e < 4; ++e) ybuf[(16 * (cc & 15) + 4 * lg + e) * 16 + lr] = y[e];
                const u32x2 up = pk4(u);
                const bf16x8 bvu = __builtin_bit_cast(bf16x8, (u32x4){cv.x, cv.y, up.x, up.y});
#pragma unroll
                for (int jt = 0; jt < 4; ++jt) H[jt] = mfma16(kdbd[jt], bvu, H[jt] * gam[jt]);
                chain_pr(pr[i], opsp + (size_t)(cc + D < nc ? cc + D : nc - 1) * OPS_ITEM, lane, it);
                if (smp && (cc & 15) == 15) {
                    asm volatile("s_waitcnt lgkmcnt(0)" ::: "memory");
                    const int base = 256 * (cc >> 4);
#pragma unroll 1
                    for (int r0 = 0; r0 < 256; r0 += 16) { const int lt = base + r0 + (lane >> 2);
                        *(f32x4*)(yg + (size_t)(dir ? L - 1 - lt : lt) * 512) = *(const LAS f32x4*)(ybuf + (r0 + (lane >> 2)) * 16 + 4 * (lane & 3)); }
                }
                asm volatile("s_waitcnt lgkmcnt(0)" ::: "memory"); __builtin_amdgcn_s_barrier(); asm volatile("" ::: "memory");
            }
        }
        if (!smp) { float* op = a.out + OUT_ST + (size_t)((b * 2 + dir) * 8 + h) * 4096;
#pragma unroll
            for (int jt = 0; jt < 4; ++jt) *(f32x4*)(op + (16 * it + lr) * 64 + 16 * jt + 4 * lg) = H[jt]; }
        asm volatile("s_waitcnt vmcnt(0) lgkmcnt(0)" ::: "memory");
        __syncthreads();
        if (smp) continue;
        {
            const int c8 = tid & 7, itq = c8 >> 1, co = 8 * (c8 & 1), cc = h * 64 + 8 * c8;
            const f32x4 l00 = *(const f32x4*)(lnx + cc), l01 = *(const f32x4*)(lnx + cc + 4), l10 = *(const f32x4*)(lnx + 512 + cc), l11 = *(const f32x4*)(lnx + 512 + cc + 4);
            constexpr int RP = 4;
            u32x4 bw[RP], gw4[RP];
#pragma unroll
            for (int p = 0; p < RP; ++p) { const size_t row = (size_t)rowbase + (tid >> 3) + 64 * p; bw[p] = *(const u32x4*)(BON + row * 512 + cc); gw4[p] = *(const u32x4*)(AB + row * 1024 + 512 + cc); }
#pragma unroll
            for (int p = 0; p < RP; ++p) {
                const int t = (tid >> 3) + 64 * p; const size_t row = (size_t)rowbase + t;
                const LAS unsigned char* yf = lds + itq * 16384 + (t * 16 + co) * 4; const LAS unsigned char* yb = lds + (4 + itq) * 16384 + ((L - 1 - t) * 16 + co) * 4;
                const f32x4 f0 = *(const LAS f32x4*)yf, f1 = *(const LAS f32x4*)(yf + 16), g0 = *(const LAS f32x4*)yb, g1 = *(const LAS f32x4*)(yb + 16);
                float x[8];
#pragma unroll
                for (int e2 = 0; e2 < 4; ++e2) { x[e2] = f0[e2] + g0[e2]; x[4 + e2] = f1[e2] + g1[e2]; }
                float s = 0.f;
#pragma unroll
                for (int e2 = 0; e2 < 8; ++e2) s += x[e2];
                s += __shfl_xor(s, 1); s += __shfl_xor(s, 2); s += __shfl_xor(s, 4);
                const float mu = s * (1.f / 64.f);
                float v = 0.f;
#pragma unroll
                for (int e2 = 0; e2 < 8; ++e2) { x[e2] -= mu; v += x[e2] * x[e2]; }
                v += __shfl_xor(v, 1); v += __shfl_xor(v, 2); v += __shfl_xor(v, 4);
                const float rstd = rsqrtf(v * (1.f / 64.f) + 64e-5f);
                const f32x4 bo0 = unpk4((u32x2){bw[p].x, bw[p].y}), bo1 = unpk4((u32x2){bw[p].z, bw[p].w}), gg0 = unpk4((u32x2){gw4[p].x, gw4[p].y}), gg1 = unpk4((u32x2){gw4[p].z, gw4[p].w});
                f32x4 o0, o1;
#pragma unroll
                for (int e2 = 0; e2 < 4; ++e2) { o0[e2] = (x[e2] * rstd * l00[e2] + l10[e2] + bo0[e2]) * gg0[e2]; o1[e2] = (x[4 + e2] * rstd * l01[e2] + l11[e2] + bo1[e2]) * gg1[e2]; }
                const u32x2 p0 = pk4(o0), p1 = pk4(o1);
                *(u32x4*)((DRY ? (bf16*)(a.ws + 248 * MiB) + row * 512 : AB + row * 1024 + 512) + cc) = (u32x4){p0.x, p0.y, p1.x, p1.y};
            }
        }
        __syncthreads();
    }
}

template <bool WT = false>
__device__ __forceinline__ void phase_combine(const Args& a, int bid, int G) {
    int tid = threadIdx.x; asm volatile("" : "+v"(tid));
    const int lane = tid & 63, wave = tid >> 6;
    const int gw = bid * 8 + wave, NGW = G * 8;
    const float* Y = a.out; const bf16* BON = WSB(WS_BONUS); bf16* AB = WSB(WS_XN);
    const float* lnx = FIN(I_LNX);
    const int c = lane * 8;
    constexpr int R = 1;
    for (int row0 = NPR + gw; row0 < NT; row0 += R * NGW) {
        f32x4 f0[R], f1[R], g0[R], g1[R]; u32x4 bw[R], gw4[R];
#pragma unroll
        for (int q = 0; q < R; ++q) { const int row = row0 + q * NGW; if (row < NT) {
            f0[q] = *(const f32x4*)(Y + (size_t)row * 512 + c); f1[q] = *(const f32x4*)(Y + (size_t)row * 512 + c + 4);
            g0[q] = *(const f32x4*)(Y + (size_t)(NT + row) * 512 + c); g1[q] = *(const f32x4*)(Y + (size_t)(NT + row) * 512 + c + 4);
            bw[q] = *(const u32x4*)(BON + (size_t)row * 512 + c); gw4[q] = *(const u32x4*)(AB + (size_t)row * 1024 + 512 + c); } }
        const f32x4 l00 = *(const f32x4*)(lnx + c), l01 = *(const f32x4*)(lnx + c + 4), l10 = *(const f32x4*)(lnx + 512 + c), l11 = *(const f32x4*)(lnx + 512 + c + 4);
#pragma unroll
        for (int q = 0; q < R; ++q) { const int row = row0 + q * NGW; if (row < NT) {
            float x[8];
#pragma unroll
            for (int e = 0; e < 4; ++e) { x[e] = f0[q][e] + g0[q][e]; x[4 + e] = f1[q][e] + g1[q][e]; }
            float s = 0.f;
#pragma unroll
            for (int e = 0; e < 8; ++e) s += x[e];
            s += __shfl_xor(s, 1); s += __shfl_xor(s, 2); s += __shfl_xor(s, 4);
            const float mu = s * (1.f / 64.f);
            float v = 0.f;
#pragma unroll
            for (int e = 0; e < 8; ++e) { x[e] -= mu; v += x[e] * x[e]; }
            v += __shfl_xor(v, 1); v += __shfl_xor(v, 2); v += __shfl_xor(v, 4);
            const float rstd = rsqrtf(v * (1.f / 64.f) + 64e-5f);
            const f32x4 bo0 = unpk4((u32x2){bw[q].x, bw[q].y}), bo1 = unpk4((u32x2){bw[q].z, bw[q].w}), gg0 = unpk4((u32x2){gw4[q].x, gw4[q].y}), gg1 = unpk4((u32x2){gw4[q].z, gw4[q].w});
            f32x4 o0, o1;
#pragma unroll
            for (int e = 0; e < 4; ++e) { o0[e] = (x[e] * rstd * l00[e] + l10[e] + bo0[e]) * gg0[e]; o1[e] = (x[4 + e] * rstd * l01[e] + l11[e] + bo1[e]) * gg1[e]; }
            const u32x2 p0 = pk4(o0), p1 = pk4(o1);
            const u32x4 ov = {p0.x, p0.y, p1.x, p1.y};
            if (WT) {
                bf16* dst = AB + (size_t)row * 1024 + 512 + c;
                asm volatile("global_store_dwordx4 %0, %1, off sc0 sc1" :: "v"(dst), "v"(ov) : "memory");
                asm volatile("s_waitcnt vmcnt(0)" ::: "memory");
                if (lane == 0) __hip_atomic_fetch_add((unsigned*)(a.ws + WS_PCNT) + (row / 160) * 16, 1u, __ATOMIC_RELAXED, __HIP_MEMORY_SCOPE_AGENT);
            } else *(u32x4*)(AB + (size_t)row * 1024 + 512 + c) = ov;
        } }
    }
}

__device__ __forceinline__ void phase_chdft(const Args& a, LAS unsigned char* lds, int bid, int G) {
    int tid = threadIdx.x; asm volatile("" : "+v"(tid));
    const int lane = tid & 63, wave = tid >> 6, tk = lane & 31, hh = lane >> 5;
    const int gw = bid * 8 + wave, NGW = G * 8;
    constexpr int WST = 136;
    LAS bf16* Wd = (LAS bf16*)lds;
    const bf16* WDFT = WSB(WS_WDFT); const bf16* XN = WSB(WS_XN);
    __syncthreads();
    for (int i = tid; i < 256 * 16; i += 512) { const int r = i >> 4, c8 = i & 15; *(LAS u32x4*)(Wd + r * WST + 8 * c8) = *(const u32x4*)(WDFT + r * 128 + 8 * c8); }
    __syncthreads();
    for (int it8 = gw; it8 < 1024; it8 += NGW) {
        const int it = it8 >> 3, mtp2 = it8 & 7;
        const int b = it >> 6, g = (it >> 3) & 7, lt = it & 7, l2 = 32 * lt + tk;
        float twc[4], tws[4]; twc[0] = 1.f; tws[0] = 0.f;
#pragma unroll
        for (int p = 1; p < 4; ++p) { const float x = (float)(l2 * p) * (2.0f / 1024.0f); twc[p] = cospif(x); tws[p] = sinpif(x); }
        const bf16* xin = XN + (size_t)(NPR + b * 1024 + 32 * lt + tk) * 1024 + g * 128 + 8 * hh;
        bf16* zt = WSB(WS_YTS) + (size_t)b * 4 * 1024 * 512 + (size_t)(g * 128 + 16 * hh) * 512 + l2;
        {
            const int mtp = mtp2 >> 1, ph = mtp2 & 1;
            f32x16 Zr[2], Zi[2];
#pragma unroll
            for (int p = 0; p < 2; ++p)
#pragma unroll
                for (int r = 0; r < 16; ++r) { Zr[p][r] = 0.f; Zi[p][r] = 0.f; }
#pragma unroll
            for (int l1 = 0; l1 < 4; ++l1) {
                f32x16 yc, ys;
#pragma unroll
                for (int r = 0; r < 16; ++r) { yc[r] = 0.f; ys[r] = 0.f; }
#pragma unroll
                for (int s = 0; s < 8; ++s) {
                    const bf16x8 hbv = *(const bf16x8*)(xin + (size_t)(256 * l1) * 1024 + 16 * s);
                    const bf16x8 ac = *(const LAS bf16x8*)(Wd + (32 * mtp + tk) * WST + 16 * s + 8 * hh), as = *(const LAS bf16x8*)(Wd + (128 + 32 * mtp + tk) * WST + 16 * s + 8 * hh);
                    yc = mfma32(ac, hbv, yc); ys = mfma32(as, hbv, ys);
                }
                if (ph == 0) { Zr[0] += yc; Zi[0] -= ys; if (l1 & 1) { Zr[1] -= yc; Zi[1] += ys; } else { Zr[1] += yc; Zi[1] -= ys; } }
                else {
                    if (l1 == 0) { Zr[0] += yc; Zi[0] -= ys; Zr[1] += yc; Zi[1] -= ys; }
                    else if (l1 == 1) { Zr[0] -= ys; Zi[0] -= yc; Zr[1] += ys; Zi[1] += yc; }
                    else if (l1 == 2) { Zr[0] -= yc; Zi[0] += ys; Zr[1] -= yc; Zi[1] += ys; }
                    else { Zr[0] += ys; Zi[0] += yc; Zr[1] -= ys; Zi[1] -= yc; }
                }
                asm volatile("" : "+v"(Zr[0]), "+v"(Zi[0]), "+v"(Zr[1]), "+v"(Zi[1]));
            }
            typedef __attribute__((address_space(1))) bf16* gbp;
#pragma unroll
            for (int pi = 0; pi < 2; ++pi) {
                const int p = ph + 2 * pi;
                const float c = 0.5f * (p == 0 ? twc[0] : p == 1 ? twc[1] : p == 2 ? twc[2] : twc[3]), s = 0.5f * (p == 0 ? tws[0] : p == 1 ? tws[1] : p == 2 ? tws[2] : tws[3]);
#pragma unroll
                for (int rq = 0; rq < 4; ++rq) {
                    gbp pp = (gbp)(zt + (size_t)p * 1024 * 512 + (size_t)(32 * mtp + 4 * rq) * 512);
                    asm volatile("" : "+v"(pp));
#pragma unroll
                    for (int e = 0; e < 4; ++e) { const float zr = Zr[pi][4 * rq + e], zi = Zi[pi][4 * rq + e];
                        pp[(size_t)e * 512] = f2bf(zr * c + zi * s); pp[(size_t)e * 512 + 256] = f2bf(zr * s - zi * c); }
                }
            }
        }
    }
    for (int it2 = gw; it2 < (NPR / 32) * 16; it2 += NGW) {
        const int it = it2 >> 1, hsel = it2 & 1;
        const int r0 = (it >> 3) * 32, g = it & 7;
        bf16x8 hb[8];
#pragma unroll
        for (int s = 0; s < 8; ++s) hb[s] = *(const bf16x8*)(XN + (size_t)(r0 + tk) * 1024 + g * 128 + 16 * s + 8 * hh);
        bf16* dst; int ld, Lh, l;
        if (r0 < NPR) { const int b = r0 >> 8; l = (r0 & 255) + tk; dst = WSB(WS_YTP) + (size_t)b * 1024 * 512; ld = 512; Lh = 256; }
        else { const int sb = (r0 - NPR) >> 10; l = ((r0 - NPR) & 1023) + tk; dst = WSB(WS_YTS) + (size_t)sb * 1024 * 2048; ld = 2048; Lh = 1024; }
#pragma unroll 1
        for (int half = hsel; half <= hsel; ++half) {
            f32x16 acc[4];
#pragma unroll
            for (int mt = 0; mt < 4; ++mt)
#pragma unroll
                for (int r = 0; r < 16; ++r) acc[mt][r] = 0.f;
#pragma unroll
            for (int s = 0; s < 8; ++s)
#pragma unroll
                for (int mt = 0; mt < 4; ++mt) { const bf16x8 af = *(const LAS bf16x8*)(Wd + (32 * (4 * half + mt) + tk) * WST + 16 * s + 8 * hh); acc[mt] = mfma32(af, hb[s], acc[mt]);
                    if (mt == 3 && (s & 1)) asm volatile("" : "+v"(acc[0]), "+v"(acc[1]), "+v"(acc[2]), "+v"(acc[3]) :: "memory"); }
            LAS bf16* St = (LAS bf16*)(lds + 69632 + wave * 10240);
#pragma unroll
            for (int mt = 0; mt < 4; ++mt)
#pragma unroll
                for (int rq = 0; rq < 4; ++rq)
#pragma unroll
                    for (int e = 0; e < 4; ++e) St[(32 * mt + 16 * hh + 4 * rq + e) * 40 + tk] = f2bf(acc[mt][4 * rq + e]);
            asm volatile("s_waitcnt lgkmcnt(0)" ::: "memory");
            {   const int lbase = l - tk, chunk = lane & 3;
#pragma unroll
                for (int j = 0; j < 8; ++j) { const int row = (lane >> 2) + 16 * j;
                    *(u32x4*)(dst + (size_t)(g * 128 + row) * ld + half * Lh + lbase + 8 * chunk) = *(const LAS u32x4*)(St + row * 40 + 8 * chunk); } }
            asm volatile("s_waitcnt lgkmcnt(0)" ::: "memory");
        }
    }
}

constexpr int NPHASE = 20;
__global__ void __launch_bounds__(512, 2) mk_fwd(Args a0) {
    extern __shared__ __attribute__((aligned(16))) unsigned char lds_raw[];
    LAS unsigned char* lds = (LAS unsigned char*)lds_raw;
    const int tid = threadIdx.x, bid = blockIdx.x, G = gridDim.x;
    volatile LAS unsigned* MISC = (volatile LAS unsigned*)(lds + MISC_OFF);
    if (tid < 32) MISC[tid] = 0u;
    if (tid < 29) *(LAS unsigned long long*)(lds + PTAB_OFF + 8 * tid) = (unsigned long long)(tid < 27 ? a0.in[tid] : tid == 27 ? (const void*)a0.out : (const void*)a0.ws);
    __syncthreads();
    const int ph_lo = a0.ph_lo, ph_hi = a0.ph_hi;
    unsigned char* const ws_ctl = a0.ws;
    const bool one_launch = (ph_hi - ph_lo) > 1;
    XcdBarrier bar; bar.bar = (unsigned*)(ws_ctl + WS_CTL) + 4096; bar.x = 0; bar.st = nullptr;
    if (one_launch) bar = xcd_barrier_post((unsigned*)(ws_ctl + WS_CTL) + 4096, MISC + 8);
#ifndef DUP_PHASE
#define DUP_PHASE -1
#endif
#ifndef DUP_N
#define DUP_N 2
#endif
#ifndef ONLY_PHASE
#define ONLY_PHASE -1
#endif
#define XSL(i) ((unsigned*)(a.ws + WS_XSLOT) + (size_t)(i) * 2 * 64 * 160 * 4)
#define XCN(i) ((unsigned*)(a.ws + WS_CTL) + 8192 + (i) * 2 * 64 * 16)
#define IN(k) ((ONLY_PHASE < 0 || ONLY_PHASE == (k)) && ph_lo <= (k) && (k) < ph_hi)
#define SEAM(k) do { if (IN(k) && IN((k) + 1)) xcd_barrier(bar); } while (0)
    if (IN(1)) { const Args a = load_args(lds, ph_lo, ph_hi); const float* gains = FIN(I_GAINS); phase_prep<3>(a, lds, bid, G); phase_first_norm(a, lds, bid, G, gains + 0 * 1024); } SEAM(1);
    if (IN(2)) for (int rep_ = 0; rep_ < (DUP_PHASE == 2 ? DUP_N : 1); ++rep_) { if (rep_) xcd_barrier(bar); const Args a = load_args(lds, ph_lo, ph_hi); const float* gains = FIN(I_GAINS); (void)gains;
        pg8::Gemm g{1024, 1024, 1024}; pg8::PlainOrder160 S; S.init(WSB(WS_XN), WSB(WS_WIN), NT, INE_PAD, 1024, 1024, G, bid);
        EpiProj E{WSB(WS_Q), WSB(WS_KP), WSB(WS_KS), WSB(WS_VTP), WSB(WS_VTS), (bf16*)a.out, a.out + OUT_CK, a.out + OUT_CV, WSF(WS_ROPE)};
        pg8::gemm_phase160b(lds, g, S, E);
    } SEAM(2);
    if (IN(3)) for (int rep_ = 0; rep_ < (DUP_PHASE == 3 ? DUP_N : 1); ++rep_) { if (rep_) xcd_barrier(bar); const Args a = load_args(lds, ph_lo, ph_hi); const float* gains = FIN(I_GAINS); (void)gains;
#ifndef NO_FRONT
        phase_wkv_front(a, lds, bid, G);
#endif
#ifdef DUP_FRONT
        __syncthreads(); phase_wkv_front(a, lds, bid, G);
#endif
        __syncthreads();
#ifndef NO_ATT
        phase_attention(a, lds, bid, G);
#endif
#ifdef DUP_ATT
        __syncthreads(); phase_attention(a, lds, bid, G);
#endif
    } SEAM(3);
    if (IN(4)) for (int rep_ = 0; rep_ < (DUP_PHASE == 4 ? DUP_N : 1); ++rep_) { if (rep_) xcd_barrier(bar); const Args a = load_args(lds, ph_lo, ph_hi); const float* gains = FIN(I_GAINS); (void)gains;
#if defined(DUP_P4)
        phase_wkv_chain<true>(a, lds, bid, G); phase_prep<2>(a, lds, bid, G); xcd_barrier(bar);
#elif defined(DUP_CHAIN)
        phase_wkv_chain<true>(a, lds, bid, G); xcd_barrier(bar);
#elif defined(DUP_PREP2)
        phase_prep<2>(a, lds, bid, G); xcd_barrier(bar);
#endif
        phase_wkv_chain(a, lds, bid, G);
        if (G == 256) {
            const int wv_ = __builtin_amdgcn_readfirstlane(threadIdx.x >> 6);
            if (bid < 128) phase_prep<2>(a, lds, bid, G, wv_ == 0 ? -1 : (bid * 7 + wv_ - 1) * 3, 3, 2688);
        } else phase_prep<2>(a, lds, bid, G);
    } SEAM(4);
    if (IN(6)) for (int rep_ = 0; rep_ < (DUP_PHASE == 6 ? DUP_N : 1); ++rep_) { if (rep_) xcd_barrier(bar); const Args a = load_args(lds, ph_lo, ph_hi); const float* gains = FIN(I_GAINS); (void)gains;
        phase_combine<true>(a, bid, G);
        pg8::Gemm g{1024, 1024, 1024}; pg8::PlainOrder160 S; S.init(WSB(WS_XN), WSB(WS_WO), NT, 1024, 1024, 1024, G, bid);
        {
            pg8::Unit u0;
            if (S.next(0, u0) && u0.pm * 160 + 160 > NPR) {
                const unsigned want = (unsigned)(u0.pm * 160 + 160 - (u0.pm * 160 > NPR ? u0.pm * 160 : NPR));
                if (threadIdx.x == 0) { unsigned* pc = (unsigned*)(a.ws + WS_PCNT) + u0.pm * 16; unsigned spins = 0;
                    while (__hip_atomic_load(pc, __ATOMIC_RELAXED, __HIP_MEMORY_SCOPE_AGENT) < want) { __builtin_amdgcn_s_sleep(2); if (++spins > (1u << 20)) break; } }
            }
            __syncthreads();
        }
        EpiResNorm<true, false> E{FIN(I_XP), FIN(I_XS), nullptr, WSB(WS_XB), nullptr, WSB(WS_XN), gains + 1 * 1024, gains + 2 * 1024, WSF(WS_MOD), 2048, 0, 3072, 4096, 0, XSL(0), XCN(0)}; pg8::gemm_phase160b(lds, g, S, E);
    } SEAM(6);
    if (IN(8)) for (int rep_ = 0; rep_ < (DUP_PHASE == 8 ? DUP_N : 1); ++rep_) { if (rep_) xcd_barrier(bar); const Args a = load_args(lds, ph_lo, ph_hi); const float* gains = FIN(I_GAINS); (void)gains;
        pg8::Gemm g{1024, 1024, 1024}; pg8::PlainOrder S; S.init(WSB(WS_XN), WSB(WS_WFI), NT, DFF2, 1024, 1024, G, bid);
        EpiFfnConv E{WSB(WS_ACT), FIN(I_CONVW), FIN(I_CONVB), WSF(WS_SB), (LAS float*)(lds + 131072)}; pg8::gemm_phase(lds, g, S, E);
        { const int nun = (NT / 256) * (DFF2 / 256), nfull = nun % G;
          if (nfull == 0) phase_transpose_wfi1<0>(a, lds, bid, G); else if (bid >= nfull) phase_transpose_wfi1<0>(a, lds, bid - nfull, G - nfull); }
    }
    SEAM(8);
    if (IN(10)) for (int rep_ = 0; rep_ < (DUP_PHASE == 10 ? DUP_N : 1); ++rep_) { if (rep_) xcd_barrier(bar); const Args a = load_args(lds, ph_lo, ph_hi); const float* gains = FIN(I_GAINS); (void)gains;
        pg8::Gemm g{DFF, DFF, DFF}; pg8::PlainOrder160 S; S.init(WSB(WS_ACT), WSB(WS_WFO), NT, 1024, DFF, DFF, G, bid);
        ffn_seam_fixup(S, 160, WSB(WS_ACT), FIN(I_CONVW), WSF(WS_SB));
        EpiResNorm<false, false> E{nullptr, nullptr, WSB(WS_XB), WSB(WS_XB), nullptr, WSB(WS_XN), gains + 3 * 1024, gains + 4 * 1024, WSF(WS_MOD), 5120, 0, 0, 1024, 1, XSL(1), XCN(1)}; pg8::gemm_phase160b(lds, g, S, E);
    } SEAM(10);
    if (IN(12)) for (int rep_ = 0; rep_ < (DUP_PHASE == 12 ? DUP_N : 1); ++rep_) { if (rep_) xcd_barrier(bar); const Args a = load_args(lds, ph_lo, ph_hi); const float* gains = FIN(I_GAINS); (void)gains; phase_chdft(a, lds, bid, G); } SEAM(12);
    if (IN(13)) for (int rep_ = 0; rep_ < (DUP_PHASE == 13 ? DUP_N : 1); ++rep_) { if (rep_) xcd_barrier(bar); const Args a = load_args(lds, ph_lo, ph_hi); const float* gains = FIN(I_GAINS); (void)gains;
        { pg8::Gemm g{512, 512, 512}; DftOrder S{G, bid, (const char*)WSB(WS_A2P), (const char*)WSB(WS_YTS), (const char*)WSB(WS_YTP)}; EpiDft E{WSB(WS_XN)}; pg8::gemm_phase(lds, g, S, E); }
    } SEAM(13);
    if (IN(14)) for (int rep_ = 0; rep_ < (DUP_PHASE == 14 ? DUP_N : 1); ++rep_) { if (rep_) xcd_barrier(bar); const Args a = load_args(lds, ph_lo, ph_hi); const float* gains = FIN(I_GAINS); (void)gains;
        pg8::Gemm g{1024, 1024, 1024}; pg8::PlainOrder160 S; S.init(WSB(WS_XN), WSB(WS_WODD), NT, 1024, 1024, 1024, G, bid);
        EpiResNorm<false, false> E{nullptr, nullptr, WSB(WS_XB), WSB(WS_XB), nullptr, WSB(WS_XN), gains + 5 * 1024, gains + 6 * 1024, WSF(WS_MOD), 2048, 1, 3072, 4096, 1, XSL(2), XCN(2)}; pg8::gemm_phase160b(lds, g, S, E);
    } SEAM(14);
    if (IN(16)) for (int rep_ = 0; rep_ < (DUP_PHASE == 16 ? DUP_N : 1); ++rep_) { if (rep_) xcd_barrier(bar); const Args a = load_args(lds, ph_lo, ph_hi); const float* gains = FIN(I_GAINS); (void)gains;
        pg8::Gemm g{1024, 1024, 1024}; pg8::PlainOrder S; S.init(WSB(WS_XN), WSB(WS_WFI) + (size_t)DFF2 * 1024, NT, DFF2, 1024, 1024, G, bid);
        EpiFfnConv E{WSB(WS_ACT), FIN(I_CONVW) + 3 * DFF, FIN(I_CONVB) + DFF, WSF(WS_SB), (LAS float*)(lds + 131072)}; pg8::gemm_phase(lds, g, S, E);
        { const int nun = (NT / 256) * (DFF2 / 256), nfull = nun % G;
          if (nfull == 0) phase_transpose_wfi1<1>(a, lds, bid, G); else if (bid >= nfull) phase_transpose_wfi1<1>(a, lds, bid - nfull, G - nfull); }
    }
    SEAM(16);
    if (IN(18)) for (int rep_ = 0; rep_ < (DUP_PHASE == 18 ? DUP_N : 1); ++rep_) { if (rep_) xcd_barrier(bar); const Args a = load_args(lds, ph_lo, ph_hi); const float* gains = FIN(I_GAINS); (void)gains;
        pg8::Gemm g{DFF, DFF, DFF}; pg8::PlainOrder160 S; S.init(WSB(WS_ACT), WSB(WS_WFO) + (size_t)1024 * DFF, NT, 1024, DFF, DFF, G, bid);
        ffn_seam_fixup(S, 160, WSB(WS_ACT), FIN(I_CONVW) + 3 * DFF, WSF(WS_SB));
        EpiResNorm<false, true> E{nullptr, nullptr, WSB(WS_XB), nullptr, a.out, nullptr, gains + 7 * 1024, nullptr, WSF(WS_MOD), 5120, 1, 0, 0, 1, XSL(3), XCN(3)}; pg8::gemm_phase160b(lds, g, S, E);
    }
#undef IN
#undef SEAM
#undef XSL
#undef XCN
}

extern "C" void kernel_launch(void* const* d_in, const int* in_sizes, int n_in, void* d_out, int out_size, void* d_ws, size_t ws_size, hipStream_t stream) {
    static int grid = 0;
    if (grid == 0) {
        if (n_in != 27 || ws_size < WS_END) { fprintf(stderr, "kernel_launch: unexpected n_in %d / ws %zu\n", n_in, ws_size); grid = -1; return; }
        int dev = 0, cus = 0;
        if (hipGetDevice(&dev) != hipSuccess || hipDeviceGetAttribute(&cus, hipDeviceAttributeMultiprocessorCount, dev) != hipSuccess) { grid = -1; return; }
        if (hipFuncSetAttribute((const void*)mk_fwd, hipFuncAttributeMaxDynamicSharedMemorySize, LDS_BYTES) != hipSuccess) { fprintf(stderr, "kernel_launch: hipFuncSetAttribute failed\n"); grid = -1; return; }
        (void)hipGetLastError();
        if (cus < 256) { fprintf(stderr, "kernel_launch: needs 256 CUs (one workgroup per CU, 256 GEMM units per fused-norm phase), found %d\n", cus); grid = -1; return; }
        grid = 256;
    }
    if (grid < 0) return;
    (void)hipMemsetAsync((char*)d_ws + WS_CTL, 0, CTL_ZERO_BYTES, stream);
    Args a{};
    for (int i = 0; i < 27; ++i) a.in[i] = d_in[i];
    a.out = (float*)d_out; a.ws = (unsigned char*)d_ws;
#if MK_N_LAUNCHES == 1
    a.ph_lo = 0; a.ph_hi = NPHASE;
    hipLaunchKernelGGL(mk_fwd, dim3(grid), dim3(512), LDS_BYTES, stream, a);
#else
    for (int ph = 0; ph < NPHASE; ++ph) { a.ph_lo = ph; a.ph_hi = ph + 1; hipLaunchKernelGGL(mk_fwd, dim3(grid), dim3(512), LDS_BYTES, stream, a); }
#endif
}
```
